# Optimizing an MI355X kernel written in HIP

```python
import math
import jax, jax.numpy as jnp
from jax import lax
import numpy as np

D_MODEL = 2048
BATCH = 2
SEQ = 16384
DEPTH = 4
DEC_BATCH = 2
DEC_SEQ = 8192
PAST_LEN = 128

N_MIXERS = 2
N_RWKV_LAYERS = (DEPTH + N_MIXERS - 1) // N_MIXERS
N_ATTN_LAYERS = DEPTH // N_MIXERS

RWKV_HEAD = 64
RWKV_HEADS = D_MODEL // RWKV_HEAD
DECAY_LORA = 96
ICLR_LORA = 96
VRES_LORA = 64
GATE_LORA = 256
GN_EPS = 64e-5
N_SHIFT_MIX = 6

ATT_HEAD = 128
ATT_HEADS = D_MODEL // ATT_HEAD
DILATED_GROUPS = ((128, 1), (512, 4), (2048, 16))
N_GROUPS = len(DILATED_GROUPS)
ROPE_THETA = 500000.0
ROPE_DIM = ATT_HEAD // 4

D_FF = 5632
NORM_EPS = 1e-6

kernel_name = 'hybrid_rwkv7_dilated_attn_macaron_encoder'


def rms_norm(x, g):
    xf = x.astype(jnp.float32)
    y = xf * lax.rsqrt(jnp.mean(xf * xf, axis=-1, keepdims=True) + NORM_EPS)
    return (y * g.astype(jnp.float32)).astype(x.dtype)


def swiglu(x, w_gate, w_up, w_down):
    return (jax.nn.silu(x @ w_gate) * (x @ w_up)) @ w_down


def centred_shift(x):
    prev = jnp.pad(x[:, :-1], ((0, 0), (1, 0), (0, 0)))
    nxt = jnp.pad(x[:, 1:], ((0, 0), (0, 1), (0, 0)))
    return 0.5 * (prev + nxt) - x


def wkv7_scan(r, w, k, v, a, b, reverse):
    B, S, H, N = r.shape

    def step(state, inp):
        r_t, w_t, k_t, v_t, a_t, b_t = inp
        sa = jnp.einsum('bhvk,bhk->bhv', state, a_t)
        state = (state * w_t[:, :, None, :] + sa[..., None] * b_t[:, :, None, :]
                 + v_t[..., None] * k_t[:, :, None, :])
        return state, jnp.einsum('bhvk,bhk->bhv', state, r_t)

    xs = tuple(jnp.moveaxis(t, 1, 0) for t in (r, w, k, v, a, b))
    state0 = jnp.zeros((B, H, N, N), jnp.float32)
    _, y = lax.scan(step, state0, xs, reverse=reverse)
    return jnp.moveaxis(y, 0, 1)


def rwkv7_mix(x, v_first, mu, w_rkv, w0, w1, w2, a0, a1, a2, g1, g2,
              k_k, k_a, r_k, gn_w, gn_b, w_o, vres):
    B, S, D = x.shape
    H, N = RWKV_HEADS, RWKV_HEAD
    f32 = jnp.float32
    xx = centred_shift(x)
    xr, xw, xk, xv, xa, xg = [x + xx * mu[i] for i in range(N_SHIFT_MIX)]
    r = xr @ w_rkv[0]
    k = xk @ w_rkv[1]
    v = xv @ w_rkv[2]
    if vres is None:
        v_first = v
    else:
        v0, v1, v2 = vres
        v = v + (v_first - v) * jax.nn.sigmoid(v0 + (xv @ v1) @ v2)
    g = jax.nn.sigmoid(xg @ g1) @ g2

    def heads(t):
        return t.astype(f32).reshape(B, S, H, N)

    rh, vh, kh = heads(r), heads(v), heads(k)
    kk = heads(k * k_k)
    kk = kk / jnp.maximum(jnp.linalg.norm(kk, axis=-1, keepdims=True), 1e-12)
    k_a_h = k_a.astype(f32).reshape(H, N)
    ys, kds = [], []
    for d in range(2):
        w_log = -jax.nn.softplus(-(w0[d] + jnp.tanh(xw @ w1[d]) @ w2[d])) - 0.5
        decay = jnp.exp(-jnp.exp(heads(w_log)))
        a = heads(jax.nn.sigmoid(a0[d] + (xa @ a1[d]) @ a2[d]))
        kd = kh * (1.0 + (a - 1.0) * k_a_h)
        ys.append(wkv7_scan(rh, decay, kd, vh, -kk, kk * a, reverse=(d == 1)))
        kds.append(kd)
    y = ys[0] + ys[1]
    mean = jnp.mean(y, axis=-1, keepdims=True)
    var = jnp.mean(jnp.square(y - mean), axis=-1, keepdims=True)
    y = ((y - mean) * lax.rsqrt(var + GN_EPS)).reshape(B, S, D)
    y = y * gn_w.astype(f32) + gn_b.astype(f32)
    k_mean = 0.5 * (kds[0] + kds[1])
    bonus = jnp.sum(rh * k_mean * r_k.astype(f32), axis=-1, keepdims=True) * vh
    o = (y + bonus.reshape(B, S, D)) * g.astype(f32)
    return o.astype(x.dtype) @ w_o, v_first


def rope_partial(x, pos):
    half = ROPE_DIM // 2
    inv = ROPE_THETA ** (-jnp.arange(half, dtype=jnp.float32) / half)
    ang = pos.astype(jnp.float32)[:, None] * inv[None, :]
    cos = jnp.cos(ang)[None, :, None, :]
    sin = jnp.sin(ang)[None, :, None, :]
    xr = x[..., :ROPE_DIM].astype(jnp.float32)
    x1, x2 = xr[..., :half], xr[..., half:]
    rot = jnp.concatenate([x1 * cos - x2 * sin, x1 * sin + x2 * cos], axis=-1)
    return jnp.concatenate([rot.astype(x.dtype), x[..., ROPE_DIM:]], axis=-1)


def banded_attention(q, k, v, half):
    Nn, L, H, dh = q.shape
    nb = -(-L // half)
    Lp = nb * half
    pad = Lp - L
    qb = jnp.pad(q, ((0, 0), (0, pad), (0, 0), (0, 0))).reshape(Nn, nb, half, H, dh)

    def key_windows(t):
        tp = jnp.pad(t, ((0, 0), (half, pad + half), (0, 0), (0, 0)))
        tp = tp.reshape(Nn, nb + 2, half, H, dh)
        return jnp.concatenate([tp[:, :-2], tp[:, 1:-1], tp[:, 2:]], axis=2)

    kw, vw = key_windows(k), key_windows(v)
    qi = jnp.arange(half)[:, None]
    kj = jnp.arange(3 * half)[None, :]
    rel = kj - half - qi
    kpos = jnp.arange(nb)[:, None, None] * half - half + kj[None]
    valid = (jnp.abs(rel)[None] <= half) & (kpos >= 0) & (kpos < L)
    s = jnp.einsum('nbqhd,nbkhd->nbhqk', qb, kw,
                   preferred_element_type=jnp.float32) * (dh ** -0.5)
    s = jnp.where(valid[None, :, None], s, -jnp.inf)
    lse = jax.nn.logsumexp(s, axis=-1)
    p = jnp.exp(s - lse[..., None])
    o = jnp.einsum('nbhqk,nbkhd->nbqhd', p.astype(v.dtype), vw)
    o = o.reshape(Nn, Lp, H, dh)[:, :L]
    lse = lse.transpose(0, 1, 3, 2).reshape(Nn, Lp, H)[:, :L]
    return o, lse


def dilated_group(q, k, v, window, dil):
    B, S, H, dh = q.shape
    half = window // (2 * dil)

    def to_classes(t):
        return t.reshape(B, S // dil, dil, H, dh).transpose(0, 2, 1, 3, 4).reshape(B * dil, S // dil, H, dh)

    o, lse = banded_attention(to_classes(q), to_classes(k), to_classes(v), half)
    o = o.reshape(B, dil, S // dil, H, dh).transpose(0, 2, 1, 3, 4).reshape(B, S, H, dh)
    lse = lse.reshape(B, dil, S // dil, H).transpose(0, 2, 1, 3).reshape(B, S, H)
    return o, lse


def dilated_attention_mix(x, w_qkv, w_o):
    B, S, D = x.shape
    qkv = (x @ w_qkv).reshape(B, S, N_GROUPS, 3, ATT_HEADS, ATT_HEAD)
    pos = jnp.arange(S)
    outs, lses = [], []
    for gi, (window, dil) in enumerate(DILATED_GROUPS):
        q = rope_partial(qkv[:, :, gi, 0], pos)
        k = rope_partial(qkv[:, :, gi, 1], pos)
        o, lse = dilated_group(q, k, qkv[:, :, gi, 2], window, dil)
        outs.append(o)
        lses.append(lse)
    wts = jax.nn.softmax(jnp.stack(lses, axis=0), axis=0)
    o = jnp.einsum('gbsh,gbshd->bshd', wts, jnp.stack(outs, axis=0).astype(jnp.float32))
    return o.reshape(B, S, D).astype(x.dtype) @ w_o


def encoder_trunk(x, norm_pre, norm_post, ffn_w_gate, ffn_w_up, ffn_w_down,
                  rwkv_mu, rwkv_w_rkv, rwkv_w0, rwkv_w1, rwkv_w2, rwkv_a0, rwkv_a1, rwkv_a2,
                  rwkv_v0, rwkv_v1, rwkv_v2, rwkv_g1, rwkv_g2, rwkv_k_k, rwkv_k_a, rwkv_r_k,
                  rwkv_gn_w, rwkv_gn_b, rwkv_w_o, attn_w_qkv, attn_w_o):
    v_first = None
    for layer in range(DEPTH):
        h = swiglu(rms_norm(x, norm_pre[layer, 0]), ffn_w_gate[layer, 0], ffn_w_up[layer, 0], ffn_w_down[layer, 0])
        x = x + 0.5 * rms_norm(h, norm_post[layer, 0])
        h = rms_norm(x, norm_pre[layer, 1])
        j = layer // N_MIXERS
        if layer % N_MIXERS == 0:
            vres = None if j == 0 else (rwkv_v0[j - 1], rwkv_v1[j - 1], rwkv_v2[j - 1])
            h, v_first = rwkv7_mix(h, v_first, rwkv_mu[j], rwkv_w_rkv[j], rwkv_w0[j], rwkv_w1[j], rwkv_w2[j],
                                   rwkv_a0[j], rwkv_a1[j], rwkv_a2[j], rwkv_g1[j], rwkv_g2[j],
                                   rwkv_k_k[j], rwkv_k_a[j], rwkv_r_k[j], rwkv_gn_w[j], rwkv_gn_b[j],
                                   rwkv_w_o[j], vres)
        else:
            h = dilated_attention_mix(h, attn_w_qkv[j], attn_w_o[j])
        x = x + rms_norm(h, norm_post[layer, 1])
        h = swiglu(rms_norm(x, norm_pre[layer, 2]), ffn_w_gate[layer, 1], ffn_w_up[layer, 1], ffn_w_down[layer, 1])
        x = x + 0.5 * rms_norm(h, norm_post[layer, 2])
    return x


def setup_inputs(seed: int = 0) -> dict:
    key = jax.random.key(seed)
    keys = list(jax.random.split(key, 40))
    D, F, H, N = D_MODEL, D_FF, RWKV_HEADS, RWKV_HEAD
    NA, NB = N_RWKV_LAYERS, N_ATTN_LAYERS

    def nrm(shape, scale):
        return scale * jax.random.normal(keys.pop(), shape, jnp.float32)

    def unif(shape, lo, hi):
        return jax.random.uniform(keys.pop(), shape, jnp.float32, lo, hi)

    return {
        'x_prompt': nrm((BATCH, SEQ, D), 1.0),
        'x_sample': nrm((DEC_BATCH, DEC_SEQ, D), 1.0),
        'norm_pre': 1.0 + nrm((DEPTH, 3, D), 0.05),
        'norm_post': 1.0 + nrm((DEPTH, 3, D), 0.05),
        'ffn_w_gate': nrm((DEPTH, 2, D, F), D ** -0.5),
        'ffn_w_up': nrm((DEPTH, 2, D, F), D ** -0.5),
        'ffn_w_down': nrm((DEPTH, 2, F, D), F ** -0.5),
        'rwkv_mu': unif((NA, N_SHIFT_MIX, D), 0.0, 1.0),
        'rwkv_w_rkv': nrm((NA, 3, D, D), D ** -0.5),
        'rwkv_w0': unif((NA, 2, D), -6.0, -1.0),
        'rwkv_w1': nrm((NA, 2, D, DECAY_LORA), D ** -0.5),
        'rwkv_w2': nrm((NA, 2, DECAY_LORA, D), 0.3 * DECAY_LORA ** -0.5),
        'rwkv_a0': nrm((NA, 2, D), 0.5),
        'rwkv_a1': nrm((NA, 2, D, ICLR_LORA), D ** -0.5),
        'rwkv_a2': nrm((NA, 2, ICLR_LORA, D), 0.5 * ICLR_LORA ** -0.5),
        'rwkv_v0': nrm((NA - 1, D), 0.5),
        'rwkv_v1': nrm((NA - 1, D, VRES_LORA), D ** -0.5),
        'rwkv_v2': nrm((NA - 1, VRES_LORA, D), 0.5 * VRES_LORA ** -0.5),
        'rwkv_g1': nrm((NA, D, GATE_LORA), D ** -0.5),
        'rwkv_g2': nrm((NA, GATE_LORA, D), GATE_LORA ** -0.5),
        'rwkv_k_k': 1.0 + nrm((NA, D), 0.1),
        'rwkv_k_a': 1.0 + nrm((NA, D), 0.1),
        'rwkv_r_k': nrm((NA, H, N), 0.1),
        'rwkv_gn_w': 1.0 + nrm((NA, D), 0.05),
        'rwkv_gn_b': nrm((NA, D), 0.01),
        'rwkv_w_o': nrm((NA, D, D), D ** -0.5),
        'attn_w_qkv': nrm((NB, D, N_GROUPS * 3 * ATT_HEADS * ATT_HEAD), D ** -0.5),
        'attn_w_o': nrm((NB, ATT_HEADS * ATT_HEAD, D), (ATT_HEADS * ATT_HEAD) ** -0.5),
    }


def reference(x_prompt, x_sample, norm_pre, norm_post, ffn_w_gate, ffn_w_up, ffn_w_down,
              rwkv_mu, rwkv_w_rkv, rwkv_w0, rwkv_w1, rwkv_w2, rwkv_a0, rwkv_a1, rwkv_a2,
              rwkv_v0, rwkv_v1, rwkv_v2, rwkv_g1, rwkv_g2, rwkv_k_k, rwkv_k_a, rwkv_r_k,
              rwkv_gn_w, rwkv_gn_b, rwkv_w_o, attn_w_qkv, attn_w_o):
    weights = (norm_pre, norm_post, ffn_w_gate, ffn_w_up, ffn_w_down,
               rwkv_mu, rwkv_w_rkv, rwkv_w0, rwkv_w1, rwkv_w2, rwkv_a0, rwkv_a1, rwkv_a2,
               rwkv_v0, rwkv_v1, rwkv_v2, rwkv_g1, rwkv_g2, rwkv_k_k, rwkv_k_a, rwkv_r_k,
               rwkv_gn_w, rwkv_gn_b, rwkv_w_o, attn_w_qkv, attn_w_o)
    y_prompt = encoder_trunk(x_prompt, *weights)
    y_sample = encoder_trunk(x_sample, *weights)
    return (y_prompt, y_sample)
```

```cpp
#include <hip/hip_runtime.h>
#include <cstdio>
#include <cstdint>

#ifndef MK_ONE_LAUNCH
#define MK_ONE_LAUNCH 1
#endif

#ifndef PHASE_ATTR
#define PHASE_ATTR __forceinline__
#endif
#define LAS __attribute__((address_space(3)))
#define GAS __attribute__((address_space(1)))
typedef unsigned short bf16_t;
typedef short bf16x8 __attribute__((ext_vector_type(8)));
typedef float f32x4 __attribute__((ext_vector_type(4)));
typedef float f32x2 __attribute__((ext_vector_type(2)));
typedef unsigned u32x4 __attribute__((ext_vector_type(4)));
typedef unsigned u32x2 __attribute__((ext_vector_type(2)));
typedef __bf16 bf16x2_t __attribute__((ext_vector_type(2)));

constexpr int D = 2048, FF = 5632, TT = 49152, DEPTH = 4;
constexpr int HID = 1024;
constexpr int NG1 = 3 * D + 256, NG2 = 768;
constexpr float NORM_EPS = 1e-6f, GN_EPS = 64e-5f;

__device__ __forceinline__ float bflo(unsigned w) { return __uint_as_float(w << 16); }
__device__ __forceinline__ float bfhi(unsigned w) { return __uint_as_float(w & 0xffff0000u); }
__device__ __forceinline__ unsigned pk2(float lo, float hi) { f32x2 v = {lo, hi}; bf16x2_t b = __builtin_convertvector(v, bf16x2_t); return __builtin_bit_cast(unsigned, b); }
__device__ __forceinline__ float wave_sum(float v) {
#pragma unroll
    for (int o = 1; o < 64; o <<= 1) v += __shfl_xor(v, o);
    return v;
}
#define LDS_BAR() asm volatile("s_waitcnt lgkmcnt(0)\n\ts_barrier" ::: "memory")
__device__ __forceinline__ float fast_exp(float x) { return __builtin_amdgcn_exp2f(x * 1.4426950408889634f); }
__device__ __forceinline__ float sigmoidf_(float x) { return __builtin_amdgcn_rcpf(1.0f + fast_exp(-x)); }
__device__ __forceinline__ float siluf_(float x) { return x * sigmoidf_(x); }
__device__ __forceinline__ float tanhf_(float x) { return 1.0f - 2.0f * __builtin_amdgcn_rcpf(1.0f + fast_exp(2.0f * x)); }
__device__ __forceinline__ void row_decode(int row, int& base, int& pos, int& len) {
    if (row < 32768) { base = row & ~16383; pos = row & 16383; len = 16384; }
    else { const int r2 = row - 32768; base = 32768 + (r2 & ~8191); pos = r2 & 8191; len = 8192; }
}

namespace pg8 {
#define PG8_LAS __attribute__((address_space(3)))
constexpr int BM = 256, BK = 64, HALF = 128, HTB = HALF * BK * 2, STAGE_BYTES = 8 * HTB, NXCD = 8, WGM = 8;
__host__ __device__ __forceinline__ int lds_byte(int r, int c) { const int st = (r >> 4) * 2 + (c >> 5), rr = r & 15, cc = c & 31, ob = rr * 64 + cc * 2; return st * 1024 + (ob ^ (((ob >> 9) & 1) << 5)); }
__host__ __device__ __forceinline__ void stage_rc(int b, int& R, int& C) { const int st = b / 1024, sb = b % 1024, swz = sb ^ (((sb >> 9) & 1) << 5); R = (st >> 1) * 16 + swz / 64; C = (st & 1) * 32 + (swz % 64) / 2; }
__host__ __device__ __forceinline__ int perm32(int rho) { const int n = rho >> 4, i = rho & 15; return 8 * (i >> 2) + 4 * n + (i & 3); }
struct Unit { int pm, pn; };
struct Gemm { const bf16_t* A; const bf16_t* Bt; int M, N, K, lda; size_t a_gstride = 0; int g0 = 1 << 30, g1 = 1 << 30; };
struct StaticOrder {
    int nM, nN, nwg, G, c;
    __host__ __device__ void init(int M, int N, int G_, int c_) { nM = M / BM; nN = N / BM; nwg = nM * nN; G = G_; c = c_; }
    __host__ __device__ bool next(int i, Unit& u) const {
        const long L = (long)i * G + c; if (L >= nwg) return false;
        int wgid = (int)L; { const int q = nwg / NXCD, r = nwg % NXCD, xcd = wgid % NXCD, off = wgid / NXCD; wgid = (xcd < r ? xcd * (q + 1) : r * (q + 1) + (xcd - r) * q) + off; }
        const int nig = WGM * nN, gid = wgid / nig, fm = gid * WGM, gsz = (nM - fm) < WGM ? (nM - fm) : WGM;
        u.pm = fm + ((wgid % nig) % gsz); u.pn = (wgid % nig) / gsz; return true;
    }
    __device__ __forceinline__ void a_ready(const Unit&) const {}
    __device__ __forceinline__ void done(const Unit&) const {}
};

struct EpiSwiGLU {
    static constexpr bool PERM = true, AFTER_DRAIN = false;
    bf16_t* H; const float* rs;
    __device__ __forceinline__ void operator()(const f32x4 (&acc)[2][2][4][2], const Unit& u, int wr, int wc, int fr, int fq) const {
        const int row0 = u.pm * BM + wr * 64 + fr, col = u.pn * 128 + wc * 32 + 8 * fq;
#pragma unroll
        for (int ai = 0; ai < 2; ++ai)
#pragma unroll
            for (int m = 0; m < 4; ++m) { const int row = row0 + ai * HALF + m * 16; const float r = rs[row];
                const f32x4 g0 = acc[ai][0][m][0] * r, g1 = acc[ai][0][m][1] * r, u0 = acc[ai][1][m][0] * r, u1 = acc[ai][1][m][1] * r;
                u32x4 w;
                w.x = pk2(siluf_(g0[0]) * u0[0], siluf_(g0[1]) * u0[1]); w.y = pk2(siluf_(g0[2]) * u0[2], siluf_(g0[3]) * u0[3]);
                w.z = pk2(siluf_(g1[0]) * u1[0], siluf_(g1[1]) * u1[1]); w.w = pk2(siluf_(g1[2]) * u1[2], siluf_(g1[3]) * u1[3]);
                *(u32x4*)(H + (size_t)row * FF + col) = w;
            }
    }
};
struct EpiPlain {
    static constexpr bool PERM = true, AFTER_DRAIN = false;
    bf16_t* O; int ldc;
    __device__ __forceinline__ void operator()(const f32x4 (&acc)[2][2][4][2], const Unit& u, int wr, int wc, int fr, int fq) const {
        const int row0 = u.pm * BM + wr * 64 + fr, col0 = u.pn * BM + wc * 32 + 8 * fq;
#pragma unroll
        for (int ai = 0; ai < 2; ++ai)
#pragma unroll
            for (int m = 0; m < 4; ++m) { bf16_t* rowp = O + (size_t)(row0 + ai * HALF + m * 16) * ldc + col0;
#pragma unroll
                for (int bj = 0; bj < 2; ++bj) { const f32x4 v0 = acc[ai][bj][m][0], v1 = acc[ai][bj][m][1];
                    u32x4 w; w.x = pk2(v0[0], v0[1]); w.y = pk2(v0[2], v0[3]); w.z = pk2(v1[0], v1[1]); w.w = pk2(v1[2], v1[3]);
                    *(u32x4*)(rowp + bj * HALF) = w; } }
    }
};
struct EpiQKV {
    static constexpr bool PERM = true, AFTER_DRAIN = false;
    bf16_t* O; const f32x2* tab; const float* rs;
    __device__ __forceinline__ void operator()(const f32x4 (&acc)[2][2][4][2], const Unit& u, int wr, int wc, int fr, int fq) const {
        const int row0 = u.pm * BM + wr * 64 + fr, col0 = u.pn * BM + wc * 32 + 8 * fq;
        const bool rot = (u.pn < 16);
        f32x2 cs[2][4];
#pragma unroll
        for (int ai = 0; ai < 2; ++ai)
#pragma unroll
            for (int m = 0; m < 4; ++m) { cs[ai][m] = (f32x2){1.f, 0.f};
                if (rot) { const int row = row0 + ai * HALF + m * 16; const int pos = row < 32768 ? (row & 16383) : (row & 8191); cs[ai][m] = tab[pos * 16 + 4 * wc + fq]; } }
#pragma unroll
        for (int ai = 0; ai < 2; ++ai)
#pragma unroll
            for (int m = 0; m < 4; ++m) { const int row = row0 + ai * HALF + m * 16; bf16_t* rowp = O + (size_t)row * (3 * D) + col0; const f32x2 c = cs[ai][m]; const float r = rs[row];
#pragma unroll
                for (int bj = 0; bj < 2; ++bj) { const f32x4 v0 = acc[ai][bj][m][0] * r, v1 = acc[ai][bj][m][1] * r;
                    u32x4 w; w.x = pk2(v0[0] * c[0] - v0[1] * c[1], v0[0] * c[1] + v0[1] * c[0]); w.y = pk2(v0[2], v0[3]); w.z = pk2(v1[0], v1[1]); w.w = pk2(v1[2], v1[3]);
                    *(u32x4*)(rowp + bj * HALF) = w; } }
    }
};
struct EpiG1 {
    static constexpr bool PERM = true, AFTER_DRAIN = false;
    unsigned char* ws; size_t r_off, v_off, h_off; int mode;
    __device__ __forceinline__ void operator()(const f32x4 (&acc)[2][2][4][2], const Unit& u, int wr, int wc, int fr, int fq) const {
        const int row0 = u.pm * BM + wr * 64 + fr; const int t = u.pn >> 3;
        size_t off = r_off + (size_t)t * (192u << 20); int ldc = D, colt = (u.pn & 7) * BM, act = 0;
        if (t == 2) off = v_off;
        if (t >= 3) { off = h_off; ldc = HID; colt = 768; }
        if (mode == 1) { off = h_off; ldc = HID; colt = u.pn * BM; act = (u.pn == 0) ? 1 : ((u.pn == 2) ? 2 : 0); }
        bf16_t* base = (bf16_t*)(ws + off);
        const int col0 = colt + wc * 32 + 8 * fq;
#pragma unroll
        for (int ai = 0; ai < 2; ++ai)
#pragma unroll
            for (int m = 0; m < 4; ++m) { bf16_t* rowp = base + (size_t)(row0 + ai * HALF + m * 16) * ldc + col0;
#pragma unroll
                for (int bj = 0; bj < 2; ++bj) { f32x4 v0 = acc[ai][bj][m][0], v1 = acc[ai][bj][m][1];
                    if (act == 1) {
#pragma unroll
                        for (int j = 0; j < 4; ++j) { v0[j] = tanhf_(v0[j]); v1[j] = tanhf_(v1[j]); } }
                    if (act == 2) {
#pragma unroll
                        for (int j = 0; j < 4; ++j) { v0[j] = sigmoidf_(v0[j]); v1[j] = sigmoidf_(v1[j]); } }
                    u32x4 w; w.x = pk2(v0[0], v0[1]); w.y = pk2(v0[2], v0[3]); w.z = pk2(v1[0], v1[1]); w.w = pk2(v1[2], v1[3]);
                    *(u32x4*)(rowp + bj * HALF) = w; } }
    }
};
struct EpiVres {
    static constexpr bool PERM = true, AFTER_DRAIN = false;
    bf16_t* V; const bf16_t* VF; const float* v0;
    __device__ __forceinline__ void operator()(const f32x4 (&acc)[2][2][4][2], const Unit& u, int wr, int wc, int fr, int fq) const {
        const int row0 = u.pm * BM + wr * 64 + fr, col0 = u.pn * BM + wc * 32 + 8 * fq;
#pragma unroll
        for (int ai = 0; ai < 2; ++ai)
#pragma unroll
            for (int m = 0; m < 4; ++m) { const size_t ro = (size_t)(row0 + ai * HALF + m * 16) * D + col0;
#pragma unroll
                for (int bj = 0; bj < 2; ++bj) { const f32x4 a0 = acc[ai][bj][m][0], a1 = acc[ai][bj][m][1];
                    const u32x4 vv = *(const u32x4*)(V + ro + bj * HALF), vf = *(const u32x4*)(VF + ro + bj * HALF);
                    const f32x4 b0 = *(const f32x4*)(v0 + col0 + bj * HALF), b1 = *(const f32x4*)(v0 + col0 + bj * HALF + 4);
                    float o[8]; const unsigned vw[4] = {vv.x, vv.y, vv.z, vv.w}, fw[4] = {vf.x, vf.y, vf.z, vf.w};
#pragma unroll
                    for (int j = 0; j < 4; ++j) { const float g0 = sigmoidf_((j < 2 ? b0[2 * j] : b1[2 * j - 4]) + (j < 2 ? a0[2 * j] : a1[2 * j - 4]));
                        const float g1 = sigmoidf_((j < 2 ? b0[2 * j + 1] : b1[2 * j - 3]) + (j < 2 ? a0[2 * j + 1] : a1[2 * j - 3]));
                        const float x0 = bflo(vw[j]), x1 = bfhi(vw[j]), f0 = bflo(fw[j]), f1 = bfhi(fw[j]);
                        o[2 * j] = x0 + (f0 - x0) * g0; o[2 * j + 1] = x1 + (f1 - x1) * g1; }
                    u32x4 w; w.x = pk2(o[0], o[1]); w.y = pk2(o[2], o[3]); w.z = pk2(o[4], o[5]); w.w = pk2(o[6], o[7]);
                    *(u32x4*)(V + ro + bj * HALF) = w; } }
    }
};
struct EpiGmul {
    static constexpr bool PERM = true, AFTER_DRAIN = false;
    bf16_t* Y;
    __device__ __forceinline__ void operator()(const f32x4 (&acc)[2][2][4][2], const Unit& u, int wr, int wc, int fr, int fq) const {
        const int row0 = u.pm * BM + wr * 64 + fr, col0 = u.pn * BM + wc * 32 + 8 * fq;
#pragma unroll
        for (int ai = 0; ai < 2; ++ai)
#pragma unroll
            for (int m = 0; m < 4; ++m) { const size_t ro = (size_t)(row0 + ai * HALF + m * 16) * D + col0;
#pragma unroll
                for (int bj = 0; bj < 2; ++bj) { const f32x4 a0 = acc[ai][bj][m][0], a1 = acc[ai][bj][m][1];
                    const u32x4 y = *(const u32x4*)(Y + ro + bj * HALF);
                    u32x4 w; w.x = pk2(bflo(y.x) * a0[0], bfhi(y.x) * a0[1]); w.y = pk2(bflo(y.y) * a0[2], bfhi(y.y) * a0[3]);
                    w.z = pk2(bflo(y.z) * a1[0], bfhi(y.z) * a1[1]); w.w = pk2(bflo(y.w) * a1[2], bfhi(y.w) * a1[3]);
                    *(u32x4*)(Y + ro + bj * HALF) = w; } }
    }
};

template <class Epi, class Sched, bool ALIGN_EPI = false, bool SP2 = false>
__device__ __forceinline__ void gemm_phase(PG8_LAS unsigned char* lds, const Gemm g, const Sched& S, const Epi& E, const int tid) {
    const int wid = __builtin_amdgcn_readfirstlane(tid >> 6), lane = tid & 63, wr = wid >> 2, wc = wid & 3, fr = lane & 15, fq = lane >> 4;
    const int K = g.K, nt = K / BK, lda = g.lda;
    unsigned voffA[2], voffB[2];
#pragma unroll
    for (int i = 0; i < 2; ++i) { int R, C; stage_rc(tid * 16 + i * 8192, R, C); const int Rb = Epi::PERM ? ((R & ~31) + perm32(R & 31)) : R;
        voffA[i] = (unsigned)(R * lda + C) * 2u; voffB[i] = (unsigned)(Rb * K + C) * 2u; }
    const size_t kstep = (size_t)(BK * 2);
    const size_t hstepA = (size_t)HALF * lda * 2, hstepB = (size_t)HALF * K * 2;
    const size_t tstepA = 2 * hstepA, tstepB = 2 * hstepB;
    const unsigned ldsw = (unsigned)wid * 1024u;
    const int aoff = lds_byte(wr * 64 + fr, fq * 8), boff = lds_byte(wc * 32 + fr, fq * 8);
#define PG8_SA(b, h) (((b) * 2 + (h)) * HTB)
#define PG8_SB(b, h) ((4 + (b) * 2 + (h)) * HTB)
#define PG8_STAGE(bufoff, gbase, voff) do { _Pragma("unroll") for (int _i = 0; _i < 2; ++_i) \
        __builtin_amdgcn_global_load_lds((const unsigned*)((const char*)(gbase) + (voff)[_i]), (PG8_LAS unsigned*)(lds + (bufoff) + ldsw + _i * 8192), 16, 0, 0); } while (0)
#define PG8_LDA(dst, b, h) do { _Pragma("unroll") for (int m = 0; m < 4; ++m) _Pragma("unroll") for (int k = 0; k < 2; ++k) dst[m][k] = *(const PG8_LAS bf16x8*)(lds + PG8_SA(b, h) + aoff + m * 2048 + k * 1024); } while (0)
#define PG8_LDB(dst, b, h) do { _Pragma("unroll") for (int n = 0; n < 2; ++n) _Pragma("unroll") for (int k = 0; k < 2; ++k) dst[n][k] = *(const PG8_LAS bf16x8*)(lds + PG8_SB(b, h) + boff + n * 2048 + k * 1024); } while (0)
#define PG8_MMA(ai, bj, At, Bt) do { __builtin_amdgcn_s_setprio(1); _Pragma("unroll") for (int m = 0; m < 4; ++m) _Pragma("unroll") for (int n = 0; n < 2; ++n) _Pragma("unroll") for (int k = 0; k < 2; ++k) \
        acc[ai][bj][m][n] = __builtin_amdgcn_mfma_f32_16x16x32_bf16(Bt[n][k], At[m][k], acc[ai][bj][m][n], 0, 0, 0); __builtin_amdgcn_s_setprio(0); } while (0)
#define PG8_WAIT_V(n) asm volatile("s_waitcnt vmcnt(" #n ")" ::: "memory")
#define PG8_WAIT_L(n) asm volatile("s_waitcnt lgkmcnt(" #n ")" ::: "memory")
#define PG8_BAR __builtin_amdgcn_s_barrier()
#define PG8_SCHED __builtin_amdgcn_sched_barrier(0)
    Unit cur, nxt; int ui = 0;
    if (!S.next(0, cur)) return;
    f32x4 acc[2][2][4][2];
#pragma unroll
    for (int a = 0; a < 2; ++a)
#pragma unroll
        for (int b = 0; b < 2; ++b)
#pragma unroll
            for (int m = 0; m < 4; ++m)
#pragma unroll
                for (int n = 0; n < 2; ++n) acc[a][b][m][n] = (f32x4){0.f, 0.f, 0.f, 0.f};
    bf16x8 At[4][2], B0[2][2], B1[2][2];
    const char* cA = (const char*)g.A + (size_t)cur.pm * tstepA + (size_t)((cur.pn >= g.g0) + (cur.pn >= g.g1)) * g.a_gstride; const char* cB = (const char*)g.Bt + (size_t)cur.pn * tstepB;
    S.a_ready(cur);
    if constexpr (SP2) {
        PG8_STAGE(PG8_SB(0, 0), cB, voffB); PG8_STAGE(PG8_SB(0, 1), cB + hstepB, voffB); PG8_STAGE(PG8_SA(0, 0), cA, voffA); PG8_STAGE(PG8_SA(0, 1), cA + hstepA, voffA);
        if (wr == 1) PG8_BAR;
        PG8_WAIT_V(2); PG8_BAR;
        PG8_STAGE(PG8_SB(1, 0), cB + kstep, voffB); PG8_STAGE(PG8_SA(1, 0), cA + kstep, voffA); PG8_STAGE(PG8_SB(1, 1), cB + hstepB + kstep, voffB);
        PG8_WAIT_V(6); PG8_BAR;
    } else {
        PG8_STAGE(PG8_SB(0, 0), cB, voffB); PG8_STAGE(PG8_SA(0, 0), cA, voffA); PG8_STAGE(PG8_SB(0, 1), cB + hstepB, voffB); PG8_STAGE(PG8_SA(0, 1), cA + hstepA, voffA);
        if (wr == 1) PG8_BAR;
        PG8_WAIT_V(4); PG8_BAR;
        PG8_STAGE(PG8_SB(1, 0), cB + kstep, voffB); PG8_STAGE(PG8_SA(1, 0), cA + kstep, voffA); PG8_STAGE(PG8_SB(1, 1), cB + hstepB + kstep, voffB);
        PG8_WAIT_V(6); PG8_BAR;
    }
    for (;;) {
        const bool has_next = S.next(ui + 1, nxt);
        const char* nA = has_next ? (const char*)g.A + (size_t)nxt.pm * tstepA + (size_t)((nxt.pn >= g.g0) + (nxt.pn >= g.g1)) * g.a_gstride : cA; const char* nB = has_next ? (const char*)g.Bt + (size_t)nxt.pn * tstepB : cB;
        for (int t = 0; t < nt; t += 2) {
            const bool last = (t == nt - 2);
            const char* a1 = cA + (size_t)(t + 1) * kstep;
            const char* a2 = last ? nA : cA + (size_t)(t + 2) * kstep; const char* b2 = last ? nB : cB + (size_t)(t + 2) * kstep;
            const char* a3 = a2 + kstep; const char* b3 = b2 + kstep;
            if (last && has_next) S.a_ready(nxt);
            if constexpr (SP2) {
            PG8_LDB(B0, 0, 0); PG8_LDB(B1, 0, 1); PG8_SCHED; PG8_LDA(At, 0, 0); PG8_STAGE(PG8_SA(1, 1), a1 + hstepA, voffA);
            PG8_WAIT_V(8); PG8_WAIT_L(0); PG8_BAR; PG8_MMA(0, 0, At, B0); PG8_MMA(0, 1, At, B1); PG8_BAR; PG8_SCHED;
            PG8_LDA(At, 0, 1); PG8_STAGE(PG8_SB(0, 0), b2, voffB); PG8_STAGE(PG8_SB(0, 1), b2 + hstepB, voffB); PG8_STAGE(PG8_SA(0, 0), a2, voffA);
            PG8_WAIT_V(8); PG8_WAIT_L(0); PG8_BAR; PG8_MMA(1, 0, At, B0); PG8_MMA(1, 1, At, B1); PG8_BAR; PG8_SCHED;
            PG8_LDB(B0, 1, 0); PG8_LDB(B1, 1, 1); PG8_SCHED; PG8_LDA(At, 1, 0); PG8_STAGE(PG8_SA(0, 1), a2 + hstepA, voffA);
            PG8_WAIT_V(8); PG8_WAIT_L(0); PG8_BAR; PG8_MMA(0, 0, At, B0); PG8_MMA(0, 1, At, B1); PG8_BAR; PG8_SCHED;
            PG8_LDA(At, 1, 1); PG8_STAGE(PG8_SB(1, 0), b3, voffB); PG8_STAGE(PG8_SB(1, 1), b3 + hstepB, voffB); PG8_STAGE(PG8_SA(1, 0), a3, voffA);
            PG8_WAIT_V(8); PG8_WAIT_L(0); PG8_BAR; PG8_MMA(1, 0, At, B0); PG8_MMA(1, 1, At, B1); PG8_BAR; PG8_SCHED;
            } else {
            PG8_LDB(B0, 0, 0); PG8_SCHED; PG8_LDA(At, 0, 0); PG8_STAGE(PG8_SA(1, 1), a1 + hstepA, voffA);
            PG8_WAIT_L(8); PG8_BAR; PG8_WAIT_L(0); PG8_MMA(0, 0, At, B0); PG8_BAR; PG8_SCHED;
            PG8_LDB(B1, 0, 1); PG8_STAGE(PG8_SB(0, 0), b2, voffB);
            PG8_BAR; PG8_WAIT_L(0); PG8_MMA(0, 1, At, B1); PG8_BAR;
            PG8_LDA(At, 0, 1); PG8_STAGE(PG8_SA(0, 0), a2, voffA);
            PG8_BAR; PG8_WAIT_L(0); PG8_MMA(1, 0, At, B0); PG8_BAR; PG8_SCHED;
            PG8_STAGE(PG8_SB(0, 1), b2 + hstepB, voffB);
            PG8_WAIT_V(6); PG8_BAR; PG8_MMA(1, 1, At, B1); PG8_BAR;
            PG8_LDB(B0, 1, 0); PG8_SCHED; PG8_LDA(At, 1, 0); PG8_STAGE(PG8_SA(0, 1), a2 + hstepA, voffA);
            PG8_WAIT_L(8); PG8_BAR; PG8_WAIT_L(0); PG8_MMA(0, 0, At, B0); PG8_BAR; PG8_SCHED;
            PG8_LDB(B1, 1, 1); PG8_STAGE(PG8_SB(1, 0), b3, voffB);
            PG8_BAR; PG8_WAIT_L(0); PG8_MMA(0, 1, At, B1); PG8_BAR;
            PG8_LDA(At, 1, 1); PG8_STAGE(PG8_SA(1, 0), a3, voffA);
            PG8_BAR; PG8_WAIT_L(0); PG8_MMA(1, 0, At, B0); PG8_BAR; PG8_SCHED;
            PG8_STAGE(PG8_SB(1, 1), b3 + hstepB, voffB);
            PG8_WAIT_V(6); PG8_BAR; PG8_MMA(1, 1, At, B1); PG8_BAR;
            }
        }
        if constexpr (ALIGN_EPI) { if (wr == 0) PG8_BAR; }
        if constexpr (!Epi::AFTER_DRAIN) { E(acc, cur, wr, wc, fr, fq); S.done(cur); }
        if (!has_next) break;
#pragma unroll
        for (int a = 0; a < 2; ++a)
#pragma unroll
            for (int b = 0; b < 2; ++b)
#pragma unroll
                for (int m = 0; m < 4; ++m)
#pragma unroll
                    for (int n = 0; n < 2; ++n) acc[a][b][m][n] = (f32x4){0.f, 0.f, 0.f, 0.f};
        cur = nxt; cA = nA; cB = nB; ++ui;
        if constexpr (ALIGN_EPI) { if (wr == 1) PG8_BAR; }
    }
    PG8_WAIT_V(0);
    if constexpr (!ALIGN_EPI) { if (wr == 0) PG8_BAR; }
    PG8_BAR;
#undef PG8_SA
#undef PG8_SB
#undef PG8_STAGE
#undef PG8_LDA
#undef PG8_LDB
#undef PG8_MMA
#undef PG8_WAIT_V
#undef PG8_WAIT_L
#undef PG8_BAR
#undef PG8_SCHED
}
}

#define XB_TMO      128
#define XB_XCNT(j)  (256  + 64 * (j))
#define XB_XSUB(j)  (1280 + 64 * (j))
#define XB_XGEN(j)  (2304 + 64 * (j))
#define XB_TOP      3328
#define XB_TOPGEN   3392
#define XCD_BAR_WORDS 3456
#define XB_SPIN_CAP (1u << 22)
__device__ __forceinline__ unsigned xb_ld(unsigned* p)              { return __hip_atomic_load(p, __ATOMIC_RELAXED, __HIP_MEMORY_SCOPE_AGENT); }
__device__ __forceinline__ unsigned xb_add(unsigned* p, unsigned v) { return __hip_atomic_fetch_add(p, v, __ATOMIC_RELAXED, __HIP_MEMORY_SCOPE_AGENT); }
__device__ __forceinline__ unsigned xb_xcc_id() { return (unsigned)__builtin_amdgcn_s_getreg((3 << 11) | 20) & 0xFu; }
#define XB_SPIN(cond, bar) do { unsigned _sp = 0; while (cond) { __builtin_amdgcn_s_sleep(1); \
    if ((++_sp & 255u) == 0u) { if (xb_ld(&(bar)[XB_TMO])) break; if (_sp > XB_SPIN_CAP) { atomicAdd(&(bar)[XB_TMO], 1u); break; } } } } while (0)
struct XcdBarrier { unsigned* bar; unsigned x; volatile LAS unsigned* st; };
__device__ __forceinline__ XcdBarrier xcd_barrier_post(unsigned* bar, volatile LAS unsigned* st) {
    XcdBarrier b; b.bar = bar; b.x = xb_xcc_id(); b.st = st;
    if (threadIdx.x == 0) (void)xb_add(&bar[XB_XCNT(b.x)], 1u);
    return b;
}
__device__ __forceinline__ void xcd_barrier_complete(unsigned* bar, unsigned x, unsigned& nloc, unsigned& nx) {
    const unsigned G = gridDim.x * gridDim.y * gridDim.z;
    unsigned sum, cnt, mine, sp = 0u;
    for (;;) {
        sum = 0u; cnt = 0u; mine = 0u;
#pragma unroll
        for (unsigned j = 0; j < 16; ++j) { const unsigned c = xb_ld(&bar[XB_XCNT(j)]); sum += c; cnt += (c > 0u) ? 1u : 0u; mine = (j == x) ? c : mine; }
        if (sum == G) break;
        __builtin_amdgcn_s_sleep(1);
        if ((++sp & 255u) == 0u) { if (xb_ld(&bar[XB_TMO])) break; if (sp > XB_SPIN_CAP) { atomicAdd(&bar[XB_TMO], 1u); break; } }
    }
    nloc = mine > 0u ? mine : 1u; nx = cnt > 0u ? cnt : 1u;
}
__device__ __forceinline__ void xcd_barrier(const XcdBarrier& b) {
    asm volatile("s_waitcnt vmcnt(0)" ::: "memory");
    __syncthreads();
    if (threadIdx.x == 0) {
        unsigned* bar = b.bar;
        __builtin_amdgcn_s_waitcnt(0);
        unsigned nloc = b.st[0], nx = b.st[1];
        if (nloc == 0u) { xcd_barrier_complete(bar, b.x, nloc, nx); b.st[0] = nloc; b.st[1] = nx; }
        const unsigned old = xb_add(&bar[XB_XSUB(b.x)], 1u);
        const unsigned gen = old / nloc;
        if (old + 1u == (gen + 1u) * nloc) {
            __builtin_amdgcn_fence(__ATOMIC_RELEASE, "agent");
            asm volatile("s_waitcnt vmcnt(0)" ::: "memory");
            const unsigned og = xb_add(&bar[XB_TOP], 1u);
            const unsigned tg = og / nx;
            if (og + 1u == (tg + 1u) * nx) xb_add(&bar[XB_TOPGEN], 1u);
            else XB_SPIN(xb_ld(&bar[XB_TOPGEN]) == tg, bar);
            __builtin_amdgcn_fence(__ATOMIC_ACQUIRE, "agent");
            xb_add(&bar[XB_XGEN(b.x)], 1u);
            asm volatile("s_waitcnt vmcnt(0)" ::: "memory");
        } else {
            XB_SPIN(xb_ld(&bar[XB_XGEN(b.x)]) == gen, bar);
            __builtin_amdgcn_fence(__ATOMIC_ACQUIRE, "agent");
            asm volatile("s_waitcnt vmcnt(0)" ::: "memory");
        }
    }
    __syncthreads();
}

constexpr size_t MiB = 1u << 20;
constexpr size_t WS_CTL = 0, CTL_ZERO_BYTES = 1 * MiB;
constexpr size_t WS_ROPE = 1 * MiB;
constexpr size_t WS_WTS = 4 * MiB;
constexpr size_t W_UP0 = WS_WTS, W_DN0 = WS_WTS + 44 * MiB, W_UP1 = WS_WTS + 66 * MiB, W_DN1 = WS_WTS + 110 * MiB;
constexpr size_t W_MIX = WS_WTS + 132 * MiB;
constexpr size_t W_G2 = W_MIX + 25 * MiB, W_GG = W_MIX + 28 * MiB, W_GV = W_MIX + 29 * MiB;
constexpr size_t W_GO = WS_WTS + 212 * MiB;
constexpr size_t WS_VF = 228 * MiB;
constexpr size_t WS_POOL = 420 * MiB;
constexpr size_t P_XN = WS_POOL;
constexpr size_t P_H = WS_POOL + 192 * MiB, P_HOUT = WS_POOL + 720 * MiB;
constexpr size_t P_MIX = WS_POOL + 192 * MiB;
constexpr size_t P_YF = WS_POOL + 192 * MiB, P_YB = WS_POOL + 384 * MiB, P_R = WS_POOL + 768 * MiB, P_K = WS_POOL + 960 * MiB, P_V = WS_POOL + 1152 * MiB,
                 P_HID = WS_POOL + 1344 * MiB, P_BS = WS_POOL + 1440 * MiB;
constexpr size_t P_QKV = WS_POOL + 192 * MiB, P_O0 = WS_POOL + 768 * MiB, P_LSE = WS_POOL + 1344 * MiB;
constexpr size_t WS_END = WS_POOL + 1452 * MiB;
constexpr int CW_BAR = 4096;
constexpr size_t WS_SCANFLAG = 512 * 1024;
constexpr int SCAN_NH = 63;
constexpr int SCAN_DUMP_U = 4592, SCAN_SLOT = 73728, SCAN_SLOTS_OUT = 5461;
constexpr size_t WS_RSX = 65536;

constexpr int RING_BYTES = 131072, CTRL_OFF = 143360, MISC_OFF = CTRL_OFF + 256, LDS_BYTES = 163840;
constexpr int NWAVES = 8;

struct Args { const float* in[28]; float* out; unsigned char* ws; int step_lo, step_hi; };

struct Seg { unsigned long long woff, soff, doff; int widx, sidx, ldw, col0, ldt, row0, k0dst, nkb, nnb, ilv, item0, pad0; };
__device__ __forceinline__ void seg_add(LAS Seg* s, int& n, int& items, int widx, size_t woff, int sidx, size_t soff, size_t doff, int ldw, int col0, int ldt, int row0, int k0dst, int nkb, int nnb, int ilv) {
    s[n].widx = widx; s[n].woff = woff; s[n].sidx = sidx; s[n].soff = soff; s[n].doff = doff; s[n].ldw = ldw; s[n].col0 = col0; s[n].ldt = ldt; s[n].row0 = row0; s[n].k0dst = k0dst; s[n].nkb = nkb; s[n].nnb = nnb; s[n].ilv = ilv; s[n].item0 = items;
    items += nkb * nnb; ++n;
}

extern __shared__ __attribute__((aligned(16))) unsigned char lds_raw[];
constexpr int PTR_OFF = CTRL_OFF + 512;
__device__ __forceinline__ unsigned long long ptr_ld(int i) {
    const LAS unsigned* p = (const LAS unsigned*)((LAS unsigned char*)lds_raw + PTR_OFF) + 2 * i;
    const unsigned lo = __builtin_amdgcn_readfirstlane(p[0]), hi = __builtin_amdgcn_readfirstlane(p[1]);
    return ((unsigned long long)hi << 32) | lo;
}
__device__ __forceinline__ const float* inp(int i) { return (const float*)(const GAS float*)ptr_ld(i); }
__device__ __forceinline__ float* outp() { return (float*)(GAS float*)ptr_ld(28); }
__device__ __forceinline__ unsigned char* wsp() { return (unsigned char*)(GAS unsigned char*)ptr_ld(29); }
#define FRAME() LAS unsigned char* lds = (LAS unsigned char*)lds_raw; int tid = threadIdx.x; asm volatile("" : "+v"(tid)); const int lane = tid & 63, wave = __builtin_amdgcn_readfirstlane(tid >> 6); \
    int bid_ = blockIdx.x, G = gridDim.x; asm volatile("" : "+s"(bid_), "+s"(G)); const int gw = bid_ * NWAVES + wave, NGW = G * NWAVES; unsigned char* ws = wsp(); (void)lds; (void)lane; (void)gw; (void)NGW; (void)ws; (void)G

static __device__ PHASE_ATTR void ph_init() {
    FRAME();
    const float* in0 = inp(0); const float* in1 = inp(1);
    {
        f32x2* tab = (f32x2*)(ws + WS_ROPE);
        for (int idx = bid_ * 512 + tid; idx < 16384 * 16; idx += G * 512) {
            const int pos = idx >> 4, i = idx & 15;
            double iv = 1.0;
            iv = (i == 1) ? 0.44036660267178046 : iv; iv = (i == 2) ? 0.19392274474868576 : iv; iv = (i == 3) ? 0.08539710028576561 : iv; iv = (i == 4) ? 0.03760603093086393 : iv;
            iv = (i == 5) ? 0.016560440080994446 : iv; iv = (i == 6) ? 0.007292664737217109 : iv; iv = (i == 7) ? 0.003211445994752591 : iv; iv = (i == 8) ? 0.001414213562373095 : iv;
            iv = (i == 9) ? 0.000622772421914596 : iv; iv = (i == 10) ? 0.0002742481756762073 : iv; iv = (i == 11) ? 0.00012076973741146504 : iv; iv = (i == 12) ? 5.318295896944988e-05 : iv;
            iv = (i == 13) ? 2.341999896140934e-05 : iv; iv = (i == 14) ? 1.031338537721246e-05 : iv; iv = (i == 15) ? 4.5416704806078695e-06 : iv;
            double t = (double)pos * iv * 0.15915494309189535; t = t - __builtin_rint(t);
            const float tf = (float)t;
            tab[idx] = (f32x2){__builtin_amdgcn_cosf(tf), __builtin_amdgcn_sinf(tf)};
        }
    }
    bf16_t* XB = (bf16_t*)(ws + P_XN); float* RSX = (float*)(ws + WS_RSX);
    for (int row = gw; row < TT; row += NGW) {
        const float* src = row < 32768 ? in0 + (size_t)row * D : in1 + (size_t)(row - 32768) * D;
        float ss = 0.f;
#pragma unroll
        for (int i = 0; i < 4; ++i) { const int e = 8 * (lane + 64 * i); const f32x4 a = *(const f32x4*)(src + e), b = *(const f32x4*)(src + e + 4);
#pragma unroll
            for (int j = 0; j < 4; ++j) ss += a[j] * a[j] + b[j] * b[j];
            *(u32x4*)(XB + (size_t)row * D + e) = (u32x4){pk2(a[0], a[1]), pk2(a[2], a[3]), pk2(b[0], b[1]), pk2(b[2], b[3])}; }
        const float rx = rsqrtf(wave_sum(ss) * (1.0f / D) + NORM_EPS);
        if (lane == 0) RSX[row] = rx;
    }
}

__device__ __forceinline__ void conv_load(const LAS Seg* sp, int local, int lane, f32x4 (&v)[8]) {
    const int widx = sp->widx; if (widx < 0) return;
    const int ldw = sp->ldw, nnb = sp->nnb, kb = local / nnb, nb = local % nnb;
    const float* p = inp(widx) + sp->woff + (size_t)(64 * kb + (lane >> 3)) * ldw + sp->col0 + 32 * nb + 4 * (lane & 7);
#pragma unroll
    for (int i = 0; i < 8; ++i) v[i] = *(const f32x4*)(p + (size_t)(8 * i) * ldw);
}
__device__ __forceinline__ void conv_finish(const LAS Seg* sp, int local, LAS float* scr, int lane, const f32x4 (&v)[8], unsigned char* ws) {
    const int widx = sp->widx, sidx = sp->sidx, ldt = sp->ldt, row0 = sp->row0, k0dst = sp->k0dst, nnb = sp->nnb, ilv = sp->ilv;
    bf16_t* dst = (bf16_t*)(ws + sp->doff);
    const int kb = local / nnb, nb = local % nnb, k0 = 64 * kb, n0 = 32 * nb, c = lane & 7;
    if (widx >= 0) {
        const float* scale = sidx >= 0 ? inp(sidx) + sp->soff + k0 + (lane >> 3) : nullptr;
#pragma unroll
        for (int i = 0; i < 8; ++i) { const int kk = (lane >> 3) + 8 * i; const float sc = scale ? scale[8 * i] : 1.0f;
            LAS float* s = scr + kk * 33 + 4 * (lane & 7); s[0] = v[i][0] * sc; s[1] = v[i][1] * sc; s[2] = v[i][2] * sc; s[3] = v[i][3] * sc; }
        asm volatile("s_waitcnt lgkmcnt(0)" ::: "memory");
    }
#pragma unroll
    for (int j = 0; j < 4; ++j) { const int n = (lane >> 3) + 8 * j; const int nn = n0 + n;
        int drow = row0 + ((ilv == 1) ? (256 * (nn >> 7) + (nn & 127)) : nn);
        if (ilv == 2 && ((nn >> 11) % 3) < 2) {
            const int co = nn & 127;
            const int nl = co < 32 ? (8 * (co & 15) + (co >> 4)) : (8 * ((co - 32) / 6) + 2 + (co - 32) % 6);
            drow = row0 + (nn & ~127) + nl; }
        u32x4 o = {0u, 0u, 0u, 0u};
        if (widx >= 0) { const LAS float* s = scr + (8 * c) * 33 + n;
            o.x = pk2(s[0 * 33], s[1 * 33]); o.y = pk2(s[2 * 33], s[3 * 33]); o.z = pk2(s[4 * 33], s[5 * 33]); o.w = pk2(s[6 * 33], s[7 * 33]); }
        *(u32x4*)(dst + (size_t)drow * ldt + k0dst + k0 + 8 * c) = o; }
    asm volatile("s_waitcnt lgkmcnt(0)" ::: "memory");
}
static __device__ PHASE_ATTR void ph_conv(int L) {
    FRAME();
    const int jm = L >> 1; const bool is_attn = (L & 1) != 0;
    LAS Seg* segs = (LAS Seg*)lds; LAS int* nseg_p = (LAS int*)(lds + 4096); LAS float* scr = (LAS float*)(lds + 8192 + wave * 8448);
    if (tid == 0) {
        int n = 0, items = 0;
        for (int f = 0; f < 2; ++f) {
            const size_t wo = (size_t)(L * 2 + f) * D * FF;
            const size_t up = f ? W_UP1 : W_UP0, dn = f ? W_DN1 : W_DN0;
            seg_add(segs, n, items, 4, wo, 2, (size_t)(L * 3 + 2 * f) * D, up, FF, 0, D, 0, 0, D / 64, FF / 32, 1);
            seg_add(segs, n, items, 5, wo, 2, (size_t)(L * 3 + 2 * f) * D, up, FF, 0, D, 128, 0, D / 64, FF / 32, 1);
            seg_add(segs, n, items, 6, wo, -1, 0, dn, D, 0, FF, 0, 0, FF / 64, D / 32, 0);
        }
        if (!is_attn) {
            for (int p = 0; p < 3; ++p) seg_add(segs, n, items, 8, (size_t)(jm * 3 + p) * D * D, -1, 0, W_MIX, D, 0, D, p * D, 0, D / 64, D / 32, 0);
            if (jm > 0) { seg_add(segs, n, items, 16, (size_t)(jm - 1) * D * 64, -1, 0, W_MIX, 64, 0, D, 3 * D, 0, D / 64, 2, 0);
                          seg_add(segs, n, items, -1, 0, -1, 0, W_MIX, 0, 0, D, 3 * D + 64, 0, D / 64, 6, 0);
                          seg_add(segs, n, items, 17, (size_t)(jm - 1) * 64 * D, -1, 0, W_GV, D, 0, 256, 0, 0, 1, D / 32, 0);
                          seg_add(segs, n, items, -1, 0, -1, 0, W_GV, 0, 0, 256, 0, 64, 3, D / 32, 0); }
            else seg_add(segs, n, items, -1, 0, -1, 0, W_MIX, 0, 0, D, 3 * D, 0, D / 64, 8, 0);
            for (int d = 0; d < 2; ++d) {
                seg_add(segs, n, items, 10, (size_t)(jm * 2 + d) * D * 96, -1, 0, W_G2, 96, 0, D, d * 128, 0, D / 64, 3, 0);
                seg_add(segs, n, items, -1, 0, -1, 0, W_G2, 0, 0, D, d * 128 + 96, 0, D / 64, 1, 0);
                seg_add(segs, n, items, 13, (size_t)(jm * 2 + d) * D * 96, -1, 0, W_G2, 96, 0, D, 256 + d * 128, 0, D / 64, 3, 0);
                seg_add(segs, n, items, -1, 0, -1, 0, W_G2, 0, 0, D, 256 + d * 128 + 96, 0, D / 64, 1, 0);
            }
            seg_add(segs, n, items, 18, (size_t)jm * D * 256, -1, 0, W_G2, 256, 0, D, 512, 0, D / 64, 8, 0);
            seg_add(segs, n, items, 19, (size_t)jm * 256 * D, -1, 0, W_GG, D, 0, 256, 0, 0, 4, D / 32, 0);
            seg_add(segs, n, items, 25, (size_t)jm * D * D, -1, 0, W_GO, D, 0, D, 0, 0, D / 64, D / 32, 0);
        } else {
            seg_add(segs, n, items, 26, (size_t)jm * D * 9 * D, 2, (size_t)(L * 3 + 1) * D, W_MIX, 9 * D, 0, D, 0, 0, D / 64, 9 * D / 32, 2);
            seg_add(segs, n, items, 27, (size_t)jm * D * D, -1, 0, W_GO, D, 0, D, 0, 0, D / 64, D / 32, 0);
        }
        segs[n].item0 = items; nseg_p[0] = n; nseg_p[1] = items;
    }
    __syncthreads();
    const int total = nseg_p[1];
    f32x4 cur[8], nxt[8];
#pragma unroll
    for (int i = 0; i < 8; ++i) { cur[i] = (f32x4){0.f, 0.f, 0.f, 0.f}; nxt[i] = cur[i]; }
    int it = gw, si = 0;
    if (it < total) { while (it >= segs[si + 1].item0) ++si; conv_load(segs + si, it - segs[si].item0, lane, cur); }
    while (it < total) {
        const int itn = it + NGW; int sn = si;
        if (itn < total) { while (itn >= segs[sn + 1].item0) ++sn; conv_load(segs + sn, itn - segs[sn].item0, lane, nxt); }
        conv_finish(segs + si, it - segs[si].item0, scr, lane, cur, ws);
#pragma unroll
        for (int i = 0; i < 8; ++i) cur[i] = nxt[i];
        it = itn; si = sn;
    }
    __syncthreads();
}

static __device__ PHASE_ATTR void ph_ffn_up(int f) {
    FRAME();
    pg8::Gemm g{(const bf16_t*)(ws + P_XN), (const bf16_t*)(ws + (f ? W_UP1 : W_UP0)), TT, 2 * FF, D, D}; pg8::StaticOrder S; S.init(TT, 2 * FF, G, bid_);
    pg8::EpiSwiGLU E{(bf16_t*)(ws + P_H), (const float*)(ws + WS_RSX)};
    pg8::gemm_phase<pg8::EpiSwiGLU, pg8::StaticOrder, true, true>(lds, g, S, E, tid);
}
static __device__ PHASE_ATTR void ph_gemm_plain(size_t a_off, int lda, size_t b_off, int N, int K, size_t o_off, int ldc) {
    FRAME();
    pg8::Gemm g{(const bf16_t*)(ws + a_off), (const bf16_t*)(ws + b_off), TT, N, K, lda}; pg8::StaticOrder S; S.init(TT, N, G, bid_);
    pg8::EpiPlain E{(bf16_t*)(ws + o_off), ldc};
    pg8::gemm_phase<pg8::EpiPlain, pg8::StaticOrder, true, true>(lds, g, S, E, tid);
}
static __device__ PHASE_ATTR void ph_qkv(int gi) {
    FRAME();
    pg8::Gemm g{(const bf16_t*)(ws + P_XN), (const bf16_t*)(ws + W_MIX) + (size_t)gi * 3 * D * D, TT, 3 * D, D, D}; pg8::StaticOrder S; S.init(TT, 3 * D, G, bid_);
    pg8::EpiQKV E{(bf16_t*)(ws + P_QKV), (const f32x2*)(ws + WS_ROPE), (const float*)(ws + WS_RSX)};
    pg8::gemm_phase<pg8::EpiQKV, pg8::StaticOrder, true, true>(lds, g, S, E, tid);
}
static __device__ PHASE_ATTR void ph_g1(int jm, int round) {
    FRAME();
    pg8::Gemm g{(const bf16_t*)(ws + P_MIX), (const bf16_t*)(ws + (round ? W_G2 : W_MIX)), TT, round ? NG2 : NG1, D, D, (size_t)192 * MiB, round ? 1 : 8, round ? 2 : 16};
    pg8::StaticOrder S; S.init(TT, round ? NG2 : NG1, G, bid_);
    pg8::EpiG1 E{ws, P_R, (jm == 0 ? WS_VF : P_V), P_HID, round};
    pg8::gemm_phase<pg8::EpiG1, pg8::StaticOrder, true, true>(lds, g, S, E, tid);
}
static __device__ PHASE_ATTR void ph_gv(int jm) {
    FRAME();
    pg8::Gemm g{(const bf16_t*)(ws + P_HID) + 768, (const bf16_t*)(ws + W_GV), TT, D, 256, HID}; pg8::StaticOrder S; S.init(TT, D, G, bid_);
    pg8::EpiVres E{(bf16_t*)(ws + P_V), (const bf16_t*)(ws + WS_VF), inp(15) + (size_t)(jm - 1) * D};
    pg8::gemm_phase<pg8::EpiVres, pg8::StaticOrder, true, true>(lds, g, S, E, tid);
}
static __device__ PHASE_ATTR void ph_gg() {
    FRAME();
    pg8::Gemm g{(const bf16_t*)(ws + P_HID) + 512, (const bf16_t*)(ws + W_GG), TT, D, 256, HID}; pg8::StaticOrder S; S.init(TT, D, G, bid_);
    pg8::EpiGmul E{(bf16_t*)(ws + P_YF)};
    pg8::gemm_phase<pg8::EpiGmul, pg8::StaticOrder, true, true>(lds, g, S, E, tid);
}

static __device__ PHASE_ATTR void ph_mix(int jm, int round) {
    FRAME();
    const bf16_t* XB = (const bf16_t*)(ws + P_XN); const float* RSX = (const float*)(ws + WS_RSX); bf16_t* MX = (bf16_t*)(ws + P_MIX);
    const float* mu = inp(7) + (size_t)jm * 6 * D; const float* gpre = inp(2) + (size_t)((2 * jm) * 3 + 1) * D;
    const int m0 = round ? 1 : 0, m1 = round ? 4 : 2, m2 = round ? 5 : 3;
    u32x4 cq[4], pq[4], nq[4]; float rcq, rpq, rnq;
#define MIX_LOAD(row_) do { const int r_ = (row_); int base_, pos_, len_; row_decode(r_, base_, pos_, len_); const bf16_t* a_ = XB + (size_t)r_ * D; \
        rcq = RSX[r_]; rpq = pos_ > 0 ? RSX[r_ - 1] : 0.f; rnq = pos_ < len_ - 1 ? RSX[r_ + 1] : 0.f; \
        _Pragma("unroll") for (int i = 0; i < 4; ++i) { const int e = 8 * (lane + 64 * i); cq[i] = *(const u32x4*)(a_ + e); pq[i] = (u32x4){0u, 0u, 0u, 0u}; nq[i] = (u32x4){0u, 0u, 0u, 0u}; \
            if (pos_ > 0) pq[i] = *(const u32x4*)(a_ - D + e); if (pos_ < len_ - 1) nq[i] = *(const u32x4*)(a_ + D + e); } } while (0)
    int row = gw;
    if (row < TT) MIX_LOAD(row);
    for (; row < TT; row += NGW) {
        u32x4 cc[4], pc[4], nc[4];
#pragma unroll
        for (int i = 0; i < 4; ++i) { cc[i] = cq[i]; pc[i] = pq[i]; nc[i] = nq[i]; }
        const float rc = rcq, rp = rpq, rn = rnq;
        if (row + NGW < TT) MIX_LOAD(row + NGW);
#pragma unroll
        for (int i = 0; i < 4; ++i) { const int e = 8 * (lane + 64 * i);
            const unsigned cw[4] = {cc[i].x, cc[i].y, cc[i].z, cc[i].w}, pw[4] = {pc[i].x, pc[i].y, pc[i].z, pc[i].w}, nw[4] = {nc[i].x, nc[i].y, nc[i].z, nc[i].w};
            const f32x4 ga = *(const f32x4*)(gpre + e), gb = *(const f32x4*)(gpre + e + 4);
            float cv[8], xx[8];
#pragma unroll
            for (int j = 0; j < 4; ++j) { const float g0 = j < 2 ? ga[2 * j] : gb[2 * j - 4], g1 = j < 2 ? ga[2 * j + 1] : gb[2 * j - 3];
                cv[2 * j] = bflo(cw[j]) * rc * g0; cv[2 * j + 1] = bfhi(cw[j]) * rc * g1;
                xx[2 * j] = 0.5f * (bflo(pw[j]) * rp + bflo(nw[j]) * rn) * g0 - cv[2 * j]; xx[2 * j + 1] = 0.5f * (bfhi(pw[j]) * rp + bfhi(nw[j]) * rn) * g1 - cv[2 * j + 1]; }
#pragma unroll
            for (int m = 0; m < 3; ++m) { const int mi = m == 0 ? m0 : (m == 1 ? m1 : m2);
                const f32x4 ma = *(const f32x4*)(mu + mi * D + e), mb = *(const f32x4*)(mu + mi * D + e + 4);
                const u32x4 o = {pk2(cv[0] + xx[0] * ma[0], cv[1] + xx[1] * ma[1]), pk2(cv[2] + xx[2] * ma[2], cv[3] + xx[3] * ma[3]), pk2(cv[4] + xx[4] * mb[0], cv[5] + xx[5] * mb[1]), pk2(cv[6] + xx[6] * mb[2], cv[7] + xx[7] * mb[3])};
                *(u32x4*)(MX + (size_t)m * TT * D + (size_t)row * D + e) = o; }
        }
    }
#undef MIX_LOAD
}

static __device__ __forceinline__ void scan_stage_e(LAS unsigned char* lds, f32x4 (&ST)[4], const int lane, const int vb) {
    constexpr int RS = 72;
    LAS bf16_t* AH = (LAS bf16_t*)(lds); LAS bf16_t* RH = (LAS bf16_t*)(lds + 9216); LAS bf16_t* BT = (LAS bf16_t*)(lds + 36864); LAS bf16_t* YS = (LAS bf16_t*)(lds + 64512);
    LAS unsigned char* KVI = lds + 73728; LAS unsigned char* MAKV = lds + 90112; LAS unsigned char* NRKV = lds + 98304;
    LAS unsigned char* MABF = lds + 108544; LAS unsigned char* NRBF = lds + 112640; LAS bf16_t* TTI = (LAS bf16_t*)(lds + 122880); LAS float* GL = (LAS float*)(lds + 125440);
    const int c15 = lane & 15, g = lane >> 4; const f32x4 zero4 = {0.f, 0.f, 0.f, 0.f};
#define PK_LO(x) __builtin_bit_cast(bf16x8, (u32x4){pk2((x)[0], (x)[1]), pk2((x)[2], (x)[3]), 0u, 0u})
#define PK_2(x, y) __builtin_bit_cast(bf16x8, (u32x4){pk2((x)[0], (x)[1]), pk2((x)[2], (x)[3]), pk2((y)[0], (y)[1]), pk2((y)[2], (y)[3])})
#define ROWFRAG(P) __builtin_bit_cast(bf16x8, (u32x4){(P)[0].x, (P)[0].y, (P)[1].x, (P)[1].y})
                u32x2 ahq[4][4], mkq[4];
#pragma unroll
                for (int tb = 0; tb < 4; ++tb) { const LAS bf16_t* ap = AH + (16 * tb + c15) * RS + 4 * g;
#pragma unroll
                    for (int q = 0; q < 4; ++q) ahq[tb][q] = *(const LAS u32x2*)(ap + 16 * q);
                    mkq[tb] = *(const LAS u32x2*)(MAKV + ((tb * 4 + vb) * 64 + lane) * 8); }
                const u32x4 Sf0 = {pk2(ST[0][0], ST[0][1]), pk2(ST[0][2], ST[0][3]), pk2(ST[1][0], ST[1][1]), pk2(ST[1][2], ST[1][3])};
                const u32x4 Sf1 = {pk2(ST[2][0], ST[2][1]), pk2(ST[2][2], ST[2][3]), pk2(ST[3][0], ST[3][1]), pk2(ST[3][2], ST[3][3])};
                __builtin_amdgcn_sched_barrier(0);
                u32x2 tfq[4]; bf16x8 mf[4];
#pragma unroll
                for (int tb = 0; tb < 4; ++tb) { tfq[tb] = *(const LAS u32x2*)(TTI + (tb * 16 + c15) * 20 + 4 * g); mf[tb] = *(const LAS bf16x8*)(MABF + (tb * 64 + lane) * 16); }
                f32x4 U[4];
#pragma unroll
                for (int tb = 0; tb < 4; ++tb) {
                    f32x4 acc = {bflo(mkq[tb].x), bfhi(mkq[tb].x), bflo(mkq[tb].y), bfhi(mkq[tb].y)};
                    acc = __builtin_amdgcn_mfma_f32_16x16x32_bf16(ROWFRAG(ahq[tb]), __builtin_bit_cast(bf16x8, Sf0), acc, 0, 0, 0);
                    acc = __builtin_amdgcn_mfma_f32_16x16x32_bf16(ROWFRAG(ahq[tb] + 2), __builtin_bit_cast(bf16x8, Sf1), acc, 0, 0, 0);
                    U[tb] = acc; }
                __builtin_amdgcn_sched_barrier(0);
                u32x2 rhq[4][4], nkq[4];
#pragma unroll
                for (int tb = 0; tb < 4; ++tb) { const LAS bf16_t* rp = RH + (16 * tb + c15) * RS + 4 * g;
#pragma unroll
                    for (int q = 0; q < 4; ++q) rhq[tb][q] = *(const LAS u32x2*)(rp + 16 * q);
                    nkq[tb] = *(const LAS u32x2*)(NRKV + ((tb * 4 + vb) * 64 + lane) * 8); }
                f32x4 Y1[4];
#pragma unroll
                for (int tb = 0; tb < 4; ++tb) {
                    f32x4 acy = {bflo(nkq[tb].x), bfhi(nkq[tb].x), bflo(nkq[tb].y), bfhi(nkq[tb].y)};
                    acy = __builtin_amdgcn_mfma_f32_16x16x32_bf16(ROWFRAG(rhq[tb]), __builtin_bit_cast(bf16x8, Sf0), acy, 0, 0, 0);
                    acy = __builtin_amdgcn_mfma_f32_16x16x32_bf16(ROWFRAG(rhq[tb] + 2), __builtin_bit_cast(bf16x8, Sf1), acy, 0, 0, 0);
                    Y1[tb] = acy; }
                const bf16x8 tf0 = __builtin_bit_cast(bf16x8, (u32x4){tfq[0].x, tfq[0].y, 0u, 0u}), tf1 = __builtin_bit_cast(bf16x8, (u32x4){tfq[1].x, tfq[1].y, 0u, 0u});
                const bf16x8 tf2 = __builtin_bit_cast(bf16x8, (u32x4){tfq[2].x, tfq[2].y, 0u, 0u}), tf3 = __builtin_bit_cast(bf16x8, (u32x4){tfq[3].x, tfq[3].y, 0u, 0u});
                f32x4 SA0 = __builtin_amdgcn_mfma_f32_16x16x32_bf16(tf0, PK_LO(U[0]), zero4, 0, 0, 0);
                f32x4 rhs = __builtin_amdgcn_mfma_f32_16x16x32_bf16(mf[0], PK_LO(SA0), U[1], 0, 0, 0);
                f32x4 SA1 = __builtin_amdgcn_mfma_f32_16x16x32_bf16(tf1, PK_LO(rhs), zero4, 0, 0, 0);
                const bf16x8 SAf0 = PK_2(SA0, SA1);
                rhs = __builtin_amdgcn_mfma_f32_16x16x32_bf16(mf[1], SAf0, U[2], 0, 0, 0);
                f32x4 SA2 = __builtin_amdgcn_mfma_f32_16x16x32_bf16(tf2, PK_LO(rhs), zero4, 0, 0, 0);
                rhs = __builtin_amdgcn_mfma_f32_16x16x32_bf16(mf[2], SAf0, U[3], 0, 0, 0);
                rhs = __builtin_amdgcn_mfma_f32_16x16x32_bf16(mf[3], PK_LO(SA2), rhs, 0, 0, 0);
                f32x4 SA3 = __builtin_amdgcn_mfma_f32_16x16x32_bf16(tf3, PK_LO(rhs), zero4, 0, 0, 0);
                const bf16x8 SAf1 = PK_2(SA2, SA3);
                __builtin_amdgcn_sched_barrier(0);
                bf16x8 nrf[6];
#pragma unroll
                for (int i = 0; i < 6; ++i) nrf[i] = *(const LAS bf16x8*)(NRBF + (i * 64 + lane) * 16);
                f32x4 kvq[4], glq[4]; u32x2 btq[4][4];
#pragma unroll
                for (int kb = 0; kb < 4; ++kb) { const LAS bf16_t* bp = BT + (16 * kb + c15) * RS + 4 * g;
#pragma unroll
                    for (int q = 0; q < 4; ++q) btq[kb][q] = *(const LAS u32x2*)(bp + 16 * q);
                    kvq[kb] = *(const LAS f32x4*)(KVI + ((kb * 4 + vb) * 64 + lane) * 16); glq[kb] = *(const LAS f32x4*)(GL + 16 * kb + 4 * g); }
#pragma unroll
                for (int tb = 0; tb < 4; ++tb) { const int nb = tb == 0 ? 0 : (tb == 1 ? 1 : (tb == 2 ? 2 : 4));
                    f32x4 acc = __builtin_amdgcn_mfma_f32_16x16x32_bf16(nrf[nb], SAf0, Y1[tb], 0, 0, 0);
                    if (tb >= 2) acc = __builtin_amdgcn_mfma_f32_16x16x32_bf16(nrf[nb + 1], SAf1, acc, 0, 0, 0);
#pragma unroll
                    for (int r = 0; r < 4; ++r) YS[(16 * tb + 4 * g + r) * RS + 16 * vb + c15] = (bf16_t)(pk2(acc[r], 0.f) & 0xffffu); }
#pragma unroll
                for (int kb = 0; kb < 4; ++kb) { f32x4 acc = kvq[kb];
                    acc = __builtin_amdgcn_mfma_f32_16x16x32_bf16(ROWFRAG(btq[kb]), SAf0, acc, 0, 0, 0);
                    acc = __builtin_amdgcn_mfma_f32_16x16x32_bf16(ROWFRAG(btq[kb] + 2), SAf1, acc, 0, 0, 0);
                    ST[kb] = glq[kb] * (ST[kb] + acc); }
#undef ROWFRAG
#undef PK_LO
#undef PK_2
}

template <int CTRL> __device__ __forceinline__ float dpp_row_shr(float v) { return __builtin_bit_cast(float, __builtin_amdgcn_update_dpp(0, __builtin_bit_cast(int, v), CTRL, 0xf, 0xf, true)); }
static __device__ PHASE_ATTR void ph_scan(int jm) {
    FRAME();
    const bf16_t* Rb = (const bf16_t*)(ws + P_R); const bf16_t* Kb = (const bf16_t*)(ws + P_K); const bf16_t* Vb = (const bf16_t*)(ws + (jm == 0 ? WS_VF : P_V));
    const bf16_t* Hd = (const bf16_t*)(ws + P_HID); float* BS = (float*)(ws + P_BS);
    constexpr int RS = 72;
    LAS bf16_t* AH = (LAS bf16_t*)(lds); LAS bf16_t* RH = (LAS bf16_t*)(lds + 9216); LAS bf16_t* BH = (LAS bf16_t*)(lds + 18432); LAS bf16_t* KH = (LAS bf16_t*)(lds + 27648);
    LAS bf16_t* BT = (LAS bf16_t*)(lds + 36864); LAS bf16_t* KT = (LAS bf16_t*)(lds + 46080); LAS bf16_t* VT = (LAS bf16_t*)(lds + 55296); LAS bf16_t* YS = (LAS bf16_t*)(lds + 64512);
    LAS unsigned char* KVI = lds + 73728; LAS unsigned char* MAKV = lds + 90112; LAS unsigned char* NRKV = lds + 98304;
    LAS float* SEG = (LAS float*)(lds + 106496); LAS float* NRM = (LAS float*)(lds + 107520); LAS float* BON = (LAS float*)(lds + 108032);
    LAS unsigned char* MABF = lds + 108544; LAS unsigned char* NRBF = lds + 112640;
    LAS float* MS = (LAS float*)(lds + 118784); LAS bf16_t* TTI = (LAS bf16_t*)(lds + 122880);
    LAS float* GL = (LAS float*)(lds + 125440); LAS float* PAR = (LAS float*)(lds + 125696);
    LAS unsigned char* W2F = lds + 147456;
    LAS unsigned char* A2F = lds + 126976;
    const int c15 = lane & 15, g = lane >> 4;
    const int tbq = wave & 3, half = wave >> 2;
    const int tF = tid >> 3, c8 = tid & 7;
    const int tbD = wave & 3, kindD = wave >> 2;
    const f32x4 zero4 = {0.f, 0.f, 0.f, 0.f};
    for (int it = bid_; it < 256; it += G) {
        const int seq = it & 3, head = (it >> 2) & 31, dir = it >> 7;
        const bool split = (G == 256);
        const bool helper = split && seq >= 2;
        const int pair = (seq & 1) | (head << 1) | (dir << 6);
        unsigned* flag = (unsigned*)(ws + WS_SCANFLAG + (size_t)jm * 8192 + (size_t)pair * 64);
#pragma unroll 1
        for (int pass = helper ? 0 : 1; pass < 2; ++pass) {
        __syncthreads();
        if (tid < 64) { const int c = head * 64 + tid;
            PAR[tid] = inp(9)[(size_t)(jm * 2 + dir) * D + c]; PAR[64 + tid] = inp(12)[(size_t)(jm * 2 + dir) * D + c];
            PAR[128 + tid] = inp(20)[(size_t)jm * D + c]; PAR[192 + tid] = inp(21)[(size_t)jm * D + c]; PAR[256 + tid] = inp(22)[(size_t)jm * D + c]; }
        int lane_s = lane; asm volatile("" : "+v"(lane_s));
        const int c15s = lane_s & 15, gs = lane_s >> 4;
#pragma unroll
        for (int kind = 0; kind < 2; ++kind)
#pragma unroll
            for (int cbi = 0; cbi < 2; ++cbi) { const float* M = (kind == 0 ? inp(11) : inp(14)) + (size_t)(jm * 2 + dir) * 96 * D + head * 64;
                const unsigned mo = (unsigned)(8 * gs * D + 16 * (2 * half + cbi) + c15s);
#pragma unroll
                for (int ks = 0; ks < 3; ++ks) { float x[8];
#pragma unroll
                    for (int j = 0; j < 8; ++j) x[j] = M[mo + (unsigned)((32 * ks + j) * D)];
                    const u32x4 w = {pk2(x[0], x[1]), pk2(x[2], x[3]), pk2(x[4], x[5]), pk2(x[6], x[7])};
                    *(LAS u32x4*)((kind == 0 ? W2F : A2F) + (((half * 2 + cbi) * 3 + ks) * 64 + lane_s) * 16) = w; }
                __builtin_amdgcn_sched_barrier(0); }
        bf16_t* yd = (bf16_t*)(ws + (dir ? P_YB : P_YF));
        const int cofs = head * 64 + 32 * half + 4 * g;
        bf16x8 hwf[3], haf[3]; u32x2 rq[2], kq[2], vq[2];
#define SCAN_PREFETCH(chunk_) do { const int st_ = (chunk_) * 64 + 16 * tbq + c15; const size_t row_ = (size_t)(base + (dir ? (len - 1 - st_) : st_)); \
            const bf16_t* hp_ = Hd + row_ * HID + dir * 128 + 8 * g; \
            _Pragma("unroll") for (int ks = 0; ks < 3; ++ks) { hwf[ks] = *(const bf16x8*)(hp_ + 32 * ks); haf[ks] = *(const bf16x8*)(hp_ + 256 + 32 * ks); } \
            _Pragma("unroll") for (int cbi = 0; cbi < 2; ++cbi) { rq[cbi] = *(const u32x2*)(Rb + row_ * D + cofs + 16 * cbi); kq[cbi] = *(const u32x2*)(Kb + row_ * D + cofs + 16 * cbi); vq[cbi] = *(const u32x2*)(Vb + row_ * D + cofs + 16 * cbi); } } while (0)
        const int sq = pass ? seq : seq - 2; const bool pre = (pass == 0);
        const int base = sq < 2 ? sq * 16384 : 32768 + (sq - 2) * 8192, len = sq < 2 ? 16384 : 8192;
        const int nch = len >> 6;
        const int c0 = pre ? nch - SCAN_NH : 0;
        const int cfull = (split && !pre && sq < 2) ? nch - SCAN_NH : nch;
        f32x4 ST[4] = {zero4, zero4, zero4, zero4};
        SCAN_PREFETCH(c0);
        __syncthreads();
#pragma unroll 1
        for (int chunk = c0; chunk < cfull; ++chunk) {
            int tid_o = tid; asm volatile("" : "+v"(tid_o));
            const int lane = tid_o & 63, c15 = lane & 15, g = lane >> 4, tF = tid_o >> 3, c8 = tid_o & 7;
            const int cofs = head * 64 + 32 * half + 4 * g;
            const int tq = 16 * tbq + c15;
            const int stq = chunk * 64 + tq; const size_t rowq = (size_t)(base + (dir ? (len - 1 - stq) : stq));
            float r8[8], lw8[8], asg[8], kkr[8], kd8[8], pfx[8]; u32x2 vkeep[2];
            {
                f32x4 accw[2] = {zero4, zero4}, acca[2] = {zero4, zero4};
#pragma unroll
                for (int cbi = 0; cbi < 2; ++cbi)
#pragma unroll
                    for (int ks = 0; ks < 3; ++ks) { accw[cbi] = __builtin_amdgcn_mfma_f32_16x16x32_bf16(*(const LAS bf16x8*)(W2F + (((half * 2 + cbi) * 3 + ks) * 64 + lane) * 16), hwf[ks], accw[cbi], 0, 0, 0); acca[cbi] = __builtin_amdgcn_mfma_f32_16x16x32_bf16(*(const LAS bf16x8*)(A2F + (((half * 2 + cbi) * 3 + ks) * 64 + lane) * 16), haf[ks], acca[cbi], 0, 0, 0); }
                float k8[8]; float ss = 0.f, bon = 0.f;
#pragma unroll
                for (int cbi = 0; cbi < 2; ++cbi) { const int cl = 32 * half + 16 * cbi + 4 * g;
                    const f32x4 w0v = *(const LAS f32x4*)(PAR + cl), a0v = *(const LAS f32x4*)(PAR + 64 + cl), kkv = *(const LAS f32x4*)(PAR + 128 + cl), kav = *(const LAS f32x4*)(PAR + 192 + cl), rkv = *(const LAS f32x4*)(PAR + 256 + cl);
                    const unsigned rw2[2] = {rq[cbi].x, rq[cbi].y}, kw2[2] = {kq[cbi].x, kq[cbi].y}; vkeep[cbi] = vq[cbi];
#pragma unroll
                    for (int r = 0; r < 4; ++r) { const int e = 4 * cbi + r;
                        r8[e] = (r & 1) ? bfhi(rw2[r >> 1]) : bflo(rw2[r >> 1]); k8[e] = (r & 1) ? bfhi(kw2[r >> 1]) : bflo(kw2[r >> 1]);
                        const float wr = w0v[r] + accw[cbi][r], ar = a0v[r] + acca[cbi][r];
                        const float z = -wr; const float sp = fmaxf(z, 0.f) + __logf(1.0f + __expf(-fabsf(z)));
                        lw8[e] = -__expf(-sp - 0.5f);
                        asg[e] = __builtin_amdgcn_rcpf(1.0f + __expf(-ar)); kkr[e] = k8[e] * kkv[r]; ss += kkr[e] * kkr[e];
                        kd8[e] = k8[e] * (1.0f + (asg[e] - 1.0f) * kav[r]); bon += r8[e] * kd8[e] * rkv[r]; } }
                ss += __shfl_xor(ss, 16); ss += __shfl_xor(ss, 32); bon += __shfl_xor(bon, 16); bon += __shfl_xor(bon, 32);
                if (g == 0) { NRM[half * 64 + tq] = ss; BON[half * 64 + tq] = bon; }
#pragma unroll
                for (int e = 0; e < 8; ++e) { float x = lw8[e]; x += dpp_row_shr<0x111>(x); x += dpp_row_shr<0x112>(x); x += dpp_row_shr<0x114>(x); x += dpp_row_shr<0x118>(x); pfx[e] = x; }
                if (c15 == 15) { *(LAS f32x4*)(SEG + tbq * 64 + 32 * half + 4 * g) = (f32x4){pfx[0], pfx[1], pfx[2], pfx[3]}; *(LAS f32x4*)(SEG + tbq * 64 + 32 * half + 16 + 4 * g) = (f32x4){pfx[4], pfx[5], pfx[6], pfx[7]}; }
            }
            if (chunk > c0 && !pre) { const int st = (chunk - 1) * 64 + tF; const int p = dir ? (len - 1 - st) : st;
                *(u32x4*)(yd + (size_t)(base + p) * D + head * 64 + 8 * c8) = *(const LAS u32x4*)(YS + tF * RS + 8 * c8); }
            __syncthreads();
            {
                f32x4 of0 = zero4, of1 = zero4;
                for (int s = 0; s < tbq; ++s) { of0 += *(const LAS f32x4*)(SEG + s * 64 + 32 * half + 4 * g); of1 += *(const LAS f32x4*)(SEG + s * 64 + 32 * half + 16 + 4 * g); }
                const float inv = __builtin_amdgcn_rcpf(fmaxf(sqrtf(NRM[tq] + NRM[64 + tq]), 1e-12f));
                if (half == 0 && g == 0) BS[((size_t)dir * TT + rowq) * 32 + head] = BON[tq] + BON[64 + tq];
#pragma unroll
                for (int cbi = 0; cbi < 2; ++cbi) { const int cl = 32 * half + 16 * cbi + 4 * g; float ah[4], bh[4], kh[4], rh[4];
#pragma unroll
                    for (int r = 0; r < 4; ++r) { const int e = 4 * cbi + r; const float lg = pfx[e] + (cbi ? of1[r] : of0[r]); const float lm = lg - lw8[e];
                        const float e1 = __expf(lg), e2 = __builtin_amdgcn_rcpf(e1), e3 = __expf(lm); const float kk = kkr[e] * inv;
                        ah[r] = -kk * e3; bh[r] = kk * asg[e] * e2; kh[r] = kd8[e] * e2; rh[r] = r8[e] * e1; }
                    const u32x2 aw = {pk2(ah[0], ah[1]), pk2(ah[2], ah[3])}, bw = {pk2(bh[0], bh[1]), pk2(bh[2], bh[3])}, kw = {pk2(kh[0], kh[1]), pk2(kh[2], kh[3])}, rw = {pk2(rh[0], rh[1]), pk2(rh[2], rh[3])};
                    *(LAS u32x2*)(AH + tq * RS + cl) = aw; *(LAS u32x2*)(BH + tq * RS + cl) = bw; *(LAS u32x2*)(KH + tq * RS + cl) = kw; *(LAS u32x2*)(RH + tq * RS + cl) = rw;
                    const unsigned bww[2] = {bw.x, bw.y}, kww[2] = {kw.x, kw.y}, vww[2] = {vkeep[cbi].x, vkeep[cbi].y};
#pragma unroll
                    for (int r = 0; r < 4; ++r) { BT[(cl + r) * RS + tq] = (bf16_t)((r & 1) ? (bww[r >> 1] >> 16) : (bww[r >> 1] & 0xffffu)); KT[(cl + r) * RS + tq] = (bf16_t)((r & 1) ? (kww[r >> 1] >> 16) : (kww[r >> 1] & 0xffffu));
                        VT[(cl + r) * RS + tq] = (bf16_t)((r & 1) ? (vww[r >> 1] >> 16) : (vww[r >> 1] & 0xffffu)); }
                    if (tq == 63) *(LAS f32x4*)(GL + cl) = (f32x4){__expf(pfx[4 * cbi] + (cbi ? of1[0] : of0[0])), __expf(pfx[4 * cbi + 1] + (cbi ? of1[1] : of0[1])), __expf(pfx[4 * cbi + 2] + (cbi ? of1[2] : of0[2])), __expf(pfx[4 * cbi + 3] + (cbi ? of1[3] : of0[3]))}; }
            }
            __syncthreads();
            {
                const int tloc = c15;
                if (kindD == 0) {
                    bf16x8 bfA[2];
#pragma unroll
                    for (int ks = 0; ks < 2; ++ks) bfA[ks] = *(const LAS bf16x8*)(AH + (16 * tbD + c15) * RS + 32 * ks + 8 * g);
                    f32x4 GT1[4] = {zero4, zero4, zero4, zero4};
#pragma unroll
                    for (int ib = 0; ib < 4; ++ib) if (ib <= tbD) {
                        f32x4 a1 = zero4;
#pragma unroll
                        for (int ks = 0; ks < 2; ++ks) a1 = __builtin_amdgcn_mfma_f32_16x16x32_bf16(*(const LAS bf16x8*)(BH + (16 * ib + c15) * RS + 32 * ks + 8 * g), bfA[ks], a1, 0, 0, 0);
                        if (ib == tbD) {
#pragma unroll
                            for (int r = 0; r < 4; ++r) if (!(4 * g + r < tloc)) a1[r] = 0.f; }
                        GT1[ib] = a1;
                    }
                    const f32x4 m1 = (tbD >= 2) ? GT1[1] : zero4, m2 = (tbD == 3) ? GT1[2] : zero4;
                    const u32x4 F01 = {pk2(GT1[0][0], GT1[0][1]), pk2(GT1[0][2], GT1[0][3]), pk2(m1[0], m1[1]), pk2(m1[2], m1[3])};
                    const u32x4 F23 = {pk2(m2[0], m2[1]), pk2(m2[2], m2[3]), 0u, 0u};
                    if (tbD == 1) *(LAS u32x4*)(MABF + (0 * 64 + lane) * 16) = F01;
                    if (tbD == 2) *(LAS u32x4*)(MABF + (1 * 64 + lane) * 16) = F01;
                    if (tbD == 3) { *(LAS u32x4*)(MABF + (2 * 64 + lane) * 16) = F01; *(LAS u32x4*)(MABF + (3 * 64 + lane) * 16) = F23; }
                    f32x4 dg = GT1[0]; dg = (tbD == 1) ? GT1[1] : dg; dg = (tbD == 2) ? GT1[2] : dg; dg = (tbD == 3) ? GT1[3] : dg;
                    *(LAS f32x4*)(MS + (tbD * 16 + c15) * 16 + 4 * g) = dg;
                    asm volatile("s_waitcnt lgkmcnt(0)" ::: "memory");
                    const int lane_o = lane;
                    if (lane < 16) { float x[16];
#pragma unroll
                        for (int t = 0; t < 16; ++t) { const LAS f32x4* mr = (const LAS f32x4*)(MS + (tbD * 16 + t) * 16); float s = (t == lane_o) ? 1.0f : 0.0f;
#pragma unroll
                            for (int i4 = 0; i4 < (t + 3) / 4; ++i4) { const f32x4 m = mr[i4];
#pragma unroll
                                for (int q = 0; q < 4; ++q) if (4 * i4 + q < t) s += m[q] * x[4 * i4 + q]; }
                            x[t] = s; }
#pragma unroll
                        for (int t = 0; t < 16; ++t) TTI[(tbD * 16 + t) * 20 + lane] = (bf16_t)(pk2(x[t], 0.f) & 0xffffu); }
                } else {
                    bf16x8 bfR[2], bfA[2];
#pragma unroll
                    for (int ks = 0; ks < 2; ++ks) { bfR[ks] = *(const LAS bf16x8*)(RH + (16 * tbD + c15) * RS + 32 * ks + 8 * g); bfA[ks] = *(const LAS bf16x8*)(AH + (16 * tbD + c15) * RS + 32 * ks + 8 * g); }
                    f32x4 GT1[4] = {zero4, zero4, zero4, zero4}, GT2[4] = {zero4, zero4, zero4, zero4}, GT3[4] = {zero4, zero4, zero4, zero4};
#pragma unroll
                    for (int ib = 0; ib < 4; ++ib) if (ib <= tbD) {
                        f32x4 a1 = zero4, a2 = zero4, a3 = zero4;
#pragma unroll
                        for (int ks = 0; ks < 2; ++ks) { const bf16x8 f1 = *(const LAS bf16x8*)(BH + (16 * ib + c15) * RS + 32 * ks + 8 * g), f2 = *(const LAS bf16x8*)(KH + (16 * ib + c15) * RS + 32 * ks + 8 * g);
                            a1 = __builtin_amdgcn_mfma_f32_16x16x32_bf16(f1, bfR[ks], a1, 0, 0, 0); a2 = __builtin_amdgcn_mfma_f32_16x16x32_bf16(f2, bfR[ks], a2, 0, 0, 0); a3 = __builtin_amdgcn_mfma_f32_16x16x32_bf16(f2, bfA[ks], a3, 0, 0, 0); }
                        if (ib == tbD) {
#pragma unroll
                            for (int r = 0; r < 4; ++r) { const int il = 4 * g + r; if (!(il <= tloc)) { a1[r] = 0.f; a2[r] = 0.f; } if (!(il < tloc)) a3[r] = 0.f; } }
                        GT1[ib] = a1; GT2[ib] = a2; GT3[ib] = a3;
                    }
                    const u32x4 F01 = {pk2(GT1[0][0], GT1[0][1]), pk2(GT1[0][2], GT1[0][3]), pk2(GT1[1][0], GT1[1][1]), pk2(GT1[1][2], GT1[1][3])};
                    const u32x4 F23 = {pk2(GT1[2][0], GT1[2][1]), pk2(GT1[2][2], GT1[2][3]), pk2(GT1[3][0], GT1[3][1]), pk2(GT1[3][2], GT1[3][3])};
                    const int nb = tbD == 0 ? 0 : (tbD == 1 ? 1 : (tbD == 2 ? 2 : 4));
                    *(LAS u32x4*)(NRBF + (nb * 64 + lane) * 16) = F01;
                    if (tbD >= 2) *(LAS u32x4*)(NRBF + ((nb + 1) * 64 + lane) * 16) = F23;
                    const u32x4 N_01 = {pk2(GT2[0][0], GT2[0][1]), pk2(GT2[0][2], GT2[0][3]), pk2(GT2[1][0], GT2[1][1]), pk2(GT2[1][2], GT2[1][3])};
                    const u32x4 N_23 = {pk2(GT2[2][0], GT2[2][1]), pk2(GT2[2][2], GT2[2][3]), pk2(GT2[3][0], GT2[3][1]), pk2(GT2[3][2], GT2[3][3])};
                    const u32x4 M_01 = {pk2(GT3[0][0], GT3[0][1]), pk2(GT3[0][2], GT3[0][3]), pk2(GT3[1][0], GT3[1][1]), pk2(GT3[1][2], GT3[1][3])};
                    const u32x4 M_23 = {pk2(GT3[2][0], GT3[2][1]), pk2(GT3[2][2], GT3[2][3]), pk2(GT3[3][0], GT3[3][1]), pk2(GT3[3][2], GT3[3][3])};
#pragma unroll
                    for (int vb = 0; vb < 4; ++vb) { const LAS bf16_t* vp = VT + (16 * vb + c15) * RS + 4 * g;
                        const u32x2 v0 = *(const LAS u32x2*)(vp), v1 = *(const LAS u32x2*)(vp + 16);
                        const bf16x8 vf01 = __builtin_bit_cast(bf16x8, (u32x4){v0.x, v0.y, v1.x, v1.y});
                        f32x4 accn = __builtin_amdgcn_mfma_f32_16x16x32_bf16(__builtin_bit_cast(bf16x8, N_01), vf01, zero4, 0, 0, 0);
                        f32x4 accm = __builtin_amdgcn_mfma_f32_16x16x32_bf16(__builtin_bit_cast(bf16x8, M_01), vf01, zero4, 0, 0, 0);
                        if (tbD >= 2) { const u32x2 v2 = *(const LAS u32x2*)(vp + 32), v3 = *(const LAS u32x2*)(vp + 48);
                            const bf16x8 vf23 = __builtin_bit_cast(bf16x8, (u32x4){v2.x, v2.y, v3.x, v3.y});
                            accn = __builtin_amdgcn_mfma_f32_16x16x32_bf16(__builtin_bit_cast(bf16x8, N_23), vf23, accn, 0, 0, 0);
                            accm = __builtin_amdgcn_mfma_f32_16x16x32_bf16(__builtin_bit_cast(bf16x8, M_23), vf23, accm, 0, 0, 0); }
                        *(LAS u32x2*)(NRKV + ((tbD * 4 + vb) * 64 + lane) * 8) = (u32x2){pk2(accn[0], accn[1]), pk2(accn[2], accn[3])};
                        *(LAS u32x2*)(MAKV + ((tbD * 4 + vb) * 64 + lane) * 8) = (u32x2){pk2(accm[0], accm[1]), pk2(accm[2], accm[3])}; }
                }
#pragma unroll
                for (int q2 = 0; q2 < 2; ++q2) { const int id = 2 * wave + q2, kb = id >> 2, vb = id & 3; f32x4 acc = zero4;
#pragma unroll
                    for (int ks = 0; ks < 2; ++ks) acc = __builtin_amdgcn_mfma_f32_16x16x32_bf16(*(const LAS bf16x8*)(KT + (16 * kb + c15) * RS + 32 * ks + 8 * g), *(const LAS bf16x8*)(VT + (16 * vb + c15) * RS + 32 * ks + 8 * g), acc, 0, 0, 0);
                    *(LAS f32x4*)(KVI + (id * 64 + lane) * 16) = acc; }
            }
            __syncthreads();
            if (chunk + 1 < cfull) SCAN_PREFETCH(chunk + 1);
            if (pre) {
                const int j = chunk - c0; const int slot = __builtin_amdgcn_readfirstlane(pair * SCAN_NH + j);
                unsigned char* dstp = slot < SCAN_SLOTS_OUT ? (unsigned char*)outp() + (size_t)slot * SCAN_SLOT : (unsigned char*)ws + WS_POOL + 576 * MiB + (size_t)(slot - SCAN_SLOTS_OUT) * SCAN_SLOT;
                const __amdgpu_buffer_rsrc_t drs = __builtin_amdgcn_make_buffer_rsrc(dstp, 0, SCAN_SLOT, 0x00020000);
#pragma unroll
                for (int q = 0; q < 9; ++q) { const int u = tid_o + 512 * q;
                    if (u < SCAN_DUMP_U) { const int off = u < 1152 ? 16 * u : (u < 1728 ? 36864 + 16 * (u - 1152) : (u < 3776 ? 73728 + 16 * (u - 1728) : (u < 4416 ? 108544 + 16 * (u - 3776) : 122880 + 16 * (u - 4416))));
                        __builtin_amdgcn_raw_buffer_store_b128(*(const LAS u32x4*)(lds + off), drs, 16 * u, 0, 16); } }
            } else {
            if (wave < 4) scan_stage_e(lds, ST, lane, wave);
            __syncthreads();
            }
        }
        if (pre) {
            asm volatile("s_waitcnt vmcnt(0)" ::: "memory");
            __syncthreads();
            if (tid == 0) __hip_atomic_store((GAS unsigned*)flag, (unsigned)SCAN_NH, __ATOMIC_RELAXED, __HIP_MEMORY_SCOPE_AGENT);
        }
        if (cfull < nch) {
            if (wave == 0) {
                while ((unsigned)__builtin_amdgcn_readfirstlane(__hip_atomic_load((GAS unsigned*)flag, __ATOMIC_RELAXED, __HIP_MEMORY_SCOPE_AGENT)) < (unsigned)SCAN_NH) __builtin_amdgcn_s_sleep(2);
                __builtin_amdgcn_fence(__ATOMIC_ACQUIRE, "agent"); }
            __syncthreads();
            u32x4 pf[9];
#define DUMP_OFF(u) ((u) < 1152 ? 16 * (u) : ((u) < 1728 ? 36864 + 16 * ((u) - 1152) : ((u) < 3776 ? 73728 + 16 * ((u) - 1728) : ((u) < 4416 ? 108544 + 16 * ((u) - 3776) : 122880 + 16 * ((u) - 4416)))))
#define DUMP_LOAD(j_) do { const int slot_ = __builtin_amdgcn_readfirstlane(pair * SCAN_NH + (j_)); \
            const u32x4* srcp_ = (const u32x4*)(slot_ < SCAN_SLOTS_OUT ? (const unsigned char*)outp() + (size_t)slot_ * SCAN_SLOT : (const unsigned char*)ws + WS_POOL + 576 * MiB + (size_t)(slot_ - SCAN_SLOTS_OUT) * SCAN_SLOT); \
            _Pragma("unroll") for (int q = 0; q < 9; ++q) { const int u = tid_p + 512 * q; if (u < SCAN_DUMP_U) pf[q] = srcp_[u]; } } while (0)
            int tid_p = tid; asm volatile("" : "+v"(tid_p));
            DUMP_LOAD(0);
#pragma unroll 1
            for (int chunk = cfull; chunk < nch; ++chunk) {
                int tid_o = tid; asm volatile("" : "+v"(tid_o));
                const int tF = tid_o >> 3, c8 = tid_o & 7; const int tid_p = tid_o;
#pragma unroll
                for (int q = 0; q < 9; ++q) { const int u = tid_o + 512 * q; if (u < SCAN_DUMP_U) *(LAS u32x4*)(lds + DUMP_OFF(u)) = pf[q]; }
                { const int st = (chunk - 1) * 64 + tF; const int p = dir ? (len - 1 - st) : st;
                  *(u32x4*)(yd + (size_t)(base + p) * D + head * 64 + 8 * c8) = *(const LAS u32x4*)(YS + tF * RS + 8 * c8); }
                __syncthreads();
                if (chunk + 1 < nch) DUMP_LOAD(chunk + 1 - cfull);
                if (wave < 4) scan_stage_e(lds, ST, tid_o & 63, wave);
                __syncthreads();
            }
#undef DUMP_LOAD
#undef DUMP_OFF
        }
        if (!pre) { const int tF = tid >> 3, c8 = tid & 7; const int st = (nch - 1) * 64 + tF; const int p = dir ? (len - 1 - st) : st;
          *(u32x4*)(yd + (size_t)(base + p) * D + head * 64 + 8 * c8) = *(const LAS u32x4*)(YS + tF * RS + 8 * c8); }
        }
#undef SCAN_PREFETCH
    }
}

static __device__ PHASE_ATTR void ph_fin(int jm) {
    FRAME();
    bf16_t* YF = (bf16_t*)(ws + P_YF); const bf16_t* YB = (const bf16_t*)(ws + P_YB); const bf16_t* Vb = (const bf16_t*)(ws + (jm == 0 ? WS_VF : P_V)); const float* BS = (const float*)(ws + P_BS);
    const float* gnw = inp(23) + (size_t)jm * D; const float* gnb = inp(24) + (size_t)jm * D;
    u32x4 aq[4], bq[4], vq4[4]; float b0q[4], b1q[4];
#define FIN_LOAD(row_) do { const size_t r_ = (size_t)(row_); \
        _Pragma("unroll") for (int i = 0; i < 4; ++i) { const int e = 8 * (lane + 64 * i); aq[i] = *(const u32x4*)(YF + r_ * D + e); bq[i] = *(const u32x4*)(YB + r_ * D + e); vq4[i] = *(const u32x4*)(Vb + r_ * D + e); \
            b0q[i] = BS[r_ * 32 + (e >> 6)]; b1q[i] = BS[((size_t)TT + r_) * 32 + (e >> 6)]; } } while (0)
    int row = gw;
    if (row < TT) FIN_LOAD(row);
    for (; row < TT; row += NGW) {
        u32x4 ac[4], bc[4], vc[4]; float b0c[4], b1c[4];
#pragma unroll
        for (int i = 0; i < 4; ++i) { ac[i] = aq[i]; bc[i] = bq[i]; vc[i] = vq4[i]; b0c[i] = b0q[i]; b1c[i] = b1q[i]; }
        if (row + NGW < TT) FIN_LOAD(row + NGW);
#pragma unroll
        for (int i = 0; i < 4; ++i) { const int e = 8 * (lane + 64 * i);
            const unsigned aw[4] = {ac[i].x, ac[i].y, ac[i].z, ac[i].w}, bw[4] = {bc[i].x, bc[i].y, bc[i].z, bc[i].w}, vw[4] = {vc[i].x, vc[i].y, vc[i].z, vc[i].w};
            float y[8], v8[8]; float s = 0.f;
#pragma unroll
            for (int j = 0; j < 4; ++j) { y[2 * j] = bflo(aw[j]) + bflo(bw[j]); y[2 * j + 1] = bfhi(aw[j]) + bfhi(bw[j]); v8[2 * j] = bflo(vw[j]); v8[2 * j + 1] = bfhi(vw[j]); s += y[2 * j] + y[2 * j + 1]; }
            s += __shfl_xor(s, 1); s += __shfl_xor(s, 2); s += __shfl_xor(s, 4);
            const float mean = s * (1.0f / 64.0f); float q = 0.f;
#pragma unroll
            for (int j = 0; j < 8; ++j) { y[j] -= mean; q += y[j] * y[j]; }
            q += __shfl_xor(q, 1); q += __shfl_xor(q, 2); q += __shfl_xor(q, 4);
            const float rstd = rsqrtf(q * (1.0f / 64.0f) + GN_EPS);
            const float bonus = 0.5f * (b0c[i] + b1c[i]);
            const f32x4 w0 = *(const f32x4*)(gnw + e), w1 = *(const f32x4*)(gnw + e + 4), c0 = *(const f32x4*)(gnb + e), c1 = *(const f32x4*)(gnb + e + 4);
            float o[8];
#pragma unroll
            for (int j = 0; j < 8; ++j) o[j] = y[j] * rstd * (j < 4 ? w0[j] : w1[j - 4]) + (j < 4 ? c0[j] : c1[j - 4]) + bonus * v8[j];
            *(u32x4*)(YF + (size_t)row * D + e) = (u32x4){pk2(o[0], o[1]), pk2(o[2], o[3]), pk2(o[4], o[5]), pk2(o[6], o[7])}; }
    }
#undef FIN_LOAD
}

typedef short v4i16_t __attribute__((ext_vector_type(4)));
struct AttItem { int base, h, c, b0, Lc; };
__device__ __forceinline__ AttItem att_decode(int pair, int dsh) {
    const int it = pair * 2; int seq, h, cb, S_len;
    if (it < 8192) { seq = it >> 12; h = (it >> 8) & 15; cb = it & 255; S_len = 16384; }
    else { const int i2 = it - 8192; seq = 2 + (i2 >> 11); h = (i2 >> 7) & 15; cb = i2 & 127; S_len = 8192; }
    AttItem a; a.base = seq < 2 ? seq * 16384 : 32768 + (seq - 2) * 8192; a.h = h; a.Lc = S_len >> dsh; const int nb = a.Lc >> 6; a.c = cb / nb; a.b0 = cb % nb; return a;
}
static __device__ PHASE_ATTR void ph_att(int gi) {
    FRAME();
    const int dil = 1 << (2 * gi), dsh = 2 * gi;
    const bf16_t* QKV = (const bf16_t*)(ws + P_QKV);
    bf16_t* const Og = (bf16_t*)(ws + P_O0 + (size_t)gi * 192 * MiB); float* const LSEg = (float*)(ws + P_LSE) + (size_t)gi * TT * 16;
    bf16_t* const O0 = (bf16_t*)(ws + P_O0); const bf16_t* const O1 = (const bf16_t*)(ws + P_O0 + 192 * MiB); const float* const LS = (const float*)(ws + P_LSE);
    constexpr int KRS = 136, VRS = 144;
    LAS bf16_t* Ks = (LAS bf16_t*)lds; LAS bf16_t* Vs = (LAS bf16_t*)(lds + 256 * KRS * 2);
    const int qi = wave >> 2, wi = wave & 3, c15 = lane & 15, gq = lane >> 4;
    u32x4 kv[16]; bf16x8 qf[4];
#define ATT_PREFETCH(A) do { _Pragma("unroll") for (int i = 0; i < 16; ++i) { const int key = (tid >> 4) + 32 * (i & 7), part = tid & 15; \
            int ip = 64 * ((A).b0 - 1) + key; ip = ip < 0 ? 0 : (ip > (A).Lc - 1 ? (A).Lc - 1 : ip); \
            kv[i] = *(const u32x4*)(QKV + (size_t)((A).base + ip * dil + (A).c) * (3 * D) + ((i >> 3) ? 2 * D : D) + (A).h * 128 + 8 * part); } \
        { const size_t rq = (size_t)((A).base + (64 * ((A).b0 + qi) + 16 * wi + c15) * dil + (A).c); \
          _Pragma("unroll") for (int ks = 0; ks < 4; ++ks) qf[ks] = *(const bf16x8*)(QKV + rq * (3 * D) + (A).h * 128 + 32 * ks + 8 * gq); } } while (0)
    const int ppw = (6144 + G - 1) / G;
    int pair = bid_ * ppw; const int pair_end = (pair + ppw < 6144) ? pair + ppw : 6144;
    if (pair < pair_end) { const AttItem A0 = att_decode(pair, dsh); ATT_PREFETCH(A0); }
    for (; pair < pair_end; ++pair) {
        const AttItem A = att_decode(pair, dsh);
        const int base = A.base, h = A.h, c = A.c, Lc = A.Lc;
#pragma unroll
        for (int i = 0; i < 16; ++i) { const int key = (tid >> 4) + 32 * (i & 7), part = tid & 15;
            if (i >> 3) *(LAS u32x4*)(Vs + key * VRS + 8 * part) = kv[i]; else *(LAS u32x4*)(Ks + key * KRS + 8 * part) = kv[i]; }
        bf16x8 q[4];
#pragma unroll
        for (int ks = 0; ks < 4; ++ks) q[ks] = qf[ks];
        const int b = A.b0 + qi;
        const int iq = 64 * b + 16 * wi + c15; const size_t rowq = (size_t)(base + iq * dil + c);
        LDS_BAR();
        if (pair + 1 < pair_end) { const AttItem An = att_decode(pair + 1, dsh); ATT_PREFETCH(An); }
        const int k0w = 16 * wi;
        f32x4 sc[9];
#pragma unroll
        for (int nt = 0; nt < 9; ++nt) { const LAS bf16_t* kp = Ks + (64 * qi + k0w + 16 * nt + c15) * KRS + 8 * gq;
            f32x4 a = {0.f, 0.f, 0.f, 0.f};
#pragma unroll
            for (int ks = 0; ks < 4; ++ks) a = __builtin_amdgcn_mfma_f32_16x16x32_bf16(*(const LAS bf16x8*)(kp + 32 * ks), q[ks], a, 0, 0, 0);
            sc[nt] = a * 0.08838834764831845f; }
#pragma unroll
        for (int r = 0; r < 4; ++r) { const int d0 = 4 * gq + r - c15;
            if (d0 < 0) sc[0][r] = -INFINITY;
            if (d0 > 0) sc[8][r] = -INFINITY; }
        if (b == 0 || b == (Lc >> 6) - 1) {
#pragma unroll
            for (int nt = 0; nt < 9; ++nt)
#pragma unroll
                for (int r = 0; r < 4; ++r) { const int ip = 64 * (b - 1) + k0w + 16 * nt + 4 * gq + r; if (ip < 0 || ip >= Lc) sc[nt][r] = -INFINITY; } }
        float mx = -INFINITY;
#pragma unroll
        for (int nt = 0; nt < 9; ++nt) mx = fmaxf(mx, fmaxf(fmaxf(sc[nt][0], sc[nt][1]), fmaxf(sc[nt][2], sc[nt][3])));
        mx = fmaxf(mx, __shfl_xor(mx, 16)); mx = fmaxf(mx, __shfl_xor(mx, 32));
        float sum = 0.f;
#pragma unroll
        for (int nt = 0; nt < 9; ++nt)
#pragma unroll
            for (int r = 0; r < 4; ++r) { const float p = fast_exp(sc[nt][r] - mx); sc[nt][r] = p; sum += p; }
        sum += __shfl_xor(sum, 16); sum += __shfl_xor(sum, 32);
        const float rs = __builtin_amdgcn_rcpf(sum); const float lse = mx + __logf(sum);
        float w0 = 0.f, w1 = 0.f, w2 = 1.f;
        if (gi == 2) { const float l0 = LS[rowq * 16 + h], l1 = LS[((size_t)TT + rowq) * 16 + h]; const float m = fmaxf(lse, fmaxf(l0, l1));
            w0 = fast_exp(l0 - m); w1 = fast_exp(l1 - m); w2 = fast_exp(lse - m); const float r3 = __builtin_amdgcn_rcpf(w0 + w1 + w2); w0 *= r3; w1 *= r3; w2 *= r3; }
        else if (gq == 0) LSEg[rowq * 16 + h] = lse;
        bf16x8 pf[5];
#pragma unroll
        for (int ks = 0; ks < 4; ++ks) { const f32x4 p0 = sc[2 * ks] * rs, p1 = sc[2 * ks + 1] * rs;
            const u32x4 w = {pk2(p0[0], p0[1]), pk2(p0[2], p0[3]), pk2(p1[0], p1[1]), pk2(p1[2], p1[3])}; pf[ks] = __builtin_bit_cast(bf16x8, w); }
        { const f32x4 p0 = sc[8] * rs; const u32x4 w = {pk2(p0[0], p0[1]), pk2(p0[2], p0[3]), 0u, 0u}; pf[4] = __builtin_bit_cast(bf16x8, w); }
        const LAS bf16_t* vbase = Vs + (64 * qi + k0w + 4 * gq + (c15 >> 2)) * VRS + 4 * (c15 & 3);
#pragma unroll
        for (int dt = 0; dt < 8; ++dt) {
            f32x4 o = {0.f, 0.f, 0.f, 0.f};
#pragma unroll
            for (int ks = 0; ks < 5; ++ks) {
                const v4i16_t lo = __builtin_amdgcn_ds_read_tr16_b64_v4i16((LAS v4i16_t*)(vbase + (32 * ks) * VRS + 16 * dt));
                v4i16_t hi = {0, 0, 0, 0};
                if (ks < 4) hi = __builtin_amdgcn_ds_read_tr16_b64_v4i16((LAS v4i16_t*)(vbase + (32 * ks + 16) * VRS + 16 * dt));
                const bf16x8 vf = {lo[0], lo[1], lo[2], lo[3], hi[0], hi[1], hi[2], hi[3]};
                o = __builtin_amdgcn_mfma_f32_16x16x32_bf16(vf, pf[ks], o, 0, 0, 0);
            }
            const size_t oo = rowq * D + h * 128 + 16 * dt + 4 * gq;
            if (gi == 2) { const u32x2 a0 = *(const u32x2*)(O0 + oo), a1 = *(const u32x2*)(O1 + oo);
                o = (f32x4){w0 * bflo(a0.x) + w1 * bflo(a1.x) + w2 * o[0], w0 * bfhi(a0.x) + w1 * bfhi(a1.x) + w2 * o[1], w0 * bflo(a0.y) + w1 * bflo(a1.y) + w2 * o[2], w0 * bfhi(a0.y) + w1 * bfhi(a1.y) + w2 * o[3]};
                *(u32x2*)(O0 + oo) = (u32x2){pk2(o[0], o[1]), pk2(o[2], o[3])}; }
            else *(u32x2*)(Og + oo) = (u32x2){pk2(o[0], o[1]), pk2(o[2], o[3])};
        }
        LDS_BAR();
    }
#undef ATT_PREFETCH
}

static __device__ PHASE_ATTR void ph_norm(int L, int sub, size_t h_off) {
    FRAME();
    float* Y = outp(); bf16_t* XB = (bf16_t*)(ws + P_XN);
    float* RSX = (float*)(ws + WS_RSX); const bf16_t* hsrc = (const bf16_t*)(ws + h_off);
    const float alpha = (sub == 1) ? 1.0f : 0.5f;
    const float* gpost = inp(3) + (size_t)(L * 3 + sub) * D;
    const bool last = (L == DEPTH - 1 && sub == 2), first = (L == 0 && sub == 0); const float* in0 = inp(0); const float* in1 = inp(1);
    u32x4 hq[4], xq[4]; f32x4 xf[4][2];
#define NORM_LOAD(row_) do { const size_t r_ = (size_t)(row_); \
        _Pragma("unroll") for (int i = 0; i < 4; ++i) { const int e = 8 * (lane + 64 * i); hq[i] = *(const u32x4*)(hsrc + r_ * D + e); \
            if (first) { const float* xs_ = r_ < 32768 ? in0 + r_ * D : in1 + (r_ - 32768) * D; xf[i][0] = *(const f32x4*)(xs_ + e); xf[i][1] = *(const f32x4*)(xs_ + e + 4); } \
            else xq[i] = *(const u32x4*)(XB + r_ * D + e); } } while (0)
    int row = gw;
    if (row < TT) NORM_LOAD(row);
    for (; row < TT; row += NGW) {
        float xv[4][8]; float ssh = 0.f;
        float hv[4][8];
#pragma unroll
        for (int i = 0; i < 4; ++i) {
            if (first) {
#pragma unroll
                for (int j = 0; j < 4; ++j) { xv[i][j] = xf[i][0][j]; xv[i][4 + j] = xf[i][1][j]; } }
            else { const unsigned xww[4] = {xq[i].x, xq[i].y, xq[i].z, xq[i].w};
#pragma unroll
                for (int j = 0; j < 4; ++j) { xv[i][2 * j] = bflo(xww[j]); xv[i][2 * j + 1] = bfhi(xww[j]); } }
            const unsigned hww[4] = {hq[i].x, hq[i].y, hq[i].z, hq[i].w};
#pragma unroll
            for (int j = 0; j < 4; ++j) { hv[i][2 * j] = bflo(hww[j]); hv[i][2 * j + 1] = bfhi(hww[j]); ssh += hv[i][2 * j] * hv[i][2 * j] + hv[i][2 * j + 1] * hv[i][2 * j + 1]; } }
        if (row + NGW < TT) NORM_LOAD(row + NGW);
        const float rh = rsqrtf(wave_sum(ssh) * (1.0f / D) + NORM_EPS) * alpha;
        float ssx = 0.f;
        float* ydst = Y + (size_t)row * D;
#pragma unroll
        for (int i = 0; i < 4; ++i) { const int e = 8 * (lane + 64 * i); const f32x4 ga = *(const f32x4*)(gpost + e), gb = *(const f32x4*)(gpost + e + 4);
#pragma unroll
            for (int j = 0; j < 8; ++j) { xv[i][j] += hv[i][j] * rh * (j < 4 ? ga[j] : gb[j - 4]); ssx += xv[i][j] * xv[i][j]; }
            if (last) { *(f32x4*)(ydst + e) = (f32x4){xv[i][0], xv[i][1], xv[i][2], xv[i][3]}; *(f32x4*)(ydst + e + 4) = (f32x4){xv[i][4], xv[i][5], xv[i][6], xv[i][7]}; }
            else *(u32x4*)(XB + (size_t)row * D + e) = (u32x4){pk2(xv[i][0], xv[i][1]), pk2(xv[i][2], xv[i][3]), pk2(xv[i][4], xv[i][5]), pk2(xv[i][6], xv[i][7])}; }
        if (!last) { const float rx = rsqrtf(wave_sum(ssx) * (1.0f / D) + NORM_EPS); if (lane == 0) RSX[row] = rx; }
    }
#undef NORM_LOAD
}
static __device__ __noinline__ void grid_bar() {
    LAS unsigned char* lds = (LAS unsigned char*)lds_raw;
    XcdBarrier b; b.bar = (unsigned*)(wsp() + WS_CTL) + CW_BAR; b.st = (volatile LAS unsigned*)(lds + MISC_OFF) + 8; b.x = b.st[2];
    xcd_barrier(b);
}
#define STEP(call) do { if (step >= lo && step < hi) { call; if (step + 1 < hi) grid_bar(); } ++step; } while (0)
template <int L> __device__ __forceinline__ void layer_prog(int& step, const int lo, const int hi) {
    constexpr int jm = L >> 1; constexpr bool is_attn = (L & 1) != 0;
    STEP(ph_ffn_up(0));
    STEP(ph_gemm_plain(P_H, FF, W_DN0, D, FF, P_HOUT, D));
    STEP(ph_norm(L, 0, P_HOUT));
    if constexpr (!is_attn) {
        STEP(ph_mix(jm, 0));
        STEP(ph_g1(jm, 0));
        STEP(ph_mix(jm, 1));
        STEP(ph_g1(jm, 1));
        if constexpr (jm > 0) { STEP(ph_gv(jm)); } else { ++step; }
        STEP(ph_scan(jm));
        STEP(ph_fin(jm));
        STEP(ph_gg());
        STEP(ph_gemm_plain(P_YF, D, W_GO, D, D, P_R, D));
        STEP(ph_norm(L, 1, P_R));
    } else {
        STEP(ph_qkv(0));
        STEP(ph_att(0));
        STEP(ph_qkv(1));
        STEP(ph_att(1));
        STEP(ph_qkv(2));
        STEP(ph_att(2));
        STEP(ph_gemm_plain(P_O0, D, W_GO, D, D, P_QKV, D));
        STEP(ph_norm(L, 1, P_QKV));
    }
    STEP(ph_ffn_up(1));
    STEP(ph_gemm_plain(P_H, FF, W_DN1, D, FF, P_HOUT, D));
    STEP({ ph_norm(L, 2, P_HOUT); if (L + 1 < DEPTH) ph_conv(L + 1); });
}
__global__ void __launch_bounds__(NWAVES * 64, 2) enc_fwd(Args args) {
    LAS unsigned char* lds = (LAS unsigned char*)lds_raw;
    volatile LAS unsigned* MISC = (volatile LAS unsigned*)(lds + MISC_OFF);
    const int tid = threadIdx.x;
    if (tid < 128) ((LAS unsigned*)(lds + CTRL_OFF))[tid] = 0u;
    if (tid < 30) { const unsigned long long v = tid < 28 ? (unsigned long long)args.in[tid] : (tid == 28 ? (unsigned long long)args.out : (unsigned long long)args.ws);
        LAS unsigned* p = (LAS unsigned*)(lds + PTR_OFF) + 2 * tid; p[0] = (unsigned)v; p[1] = (unsigned)(v >> 32); }
    __syncthreads();
    const int lo = args.step_lo, hi = args.step_hi;
    if (hi - lo > 1) { const XcdBarrier b = xcd_barrier_post((unsigned*)(args.ws + WS_CTL) + CW_BAR, MISC + 8); if (tid == 0) MISC[10] = b.x; }
    __syncthreads();
    int step = 0;
    STEP({ ph_init(); ph_conv(0); });
    layer_prog<0>(step, lo, hi);
    layer_prog<1>(step, lo, hi);
    layer_prog<2>(step, lo, hi);
    layer_prog<3>(step, lo, hi);
}
#undef STEP

static int n_steps_total() {
    int s = 1;
    for (int L = 0; L < DEPTH; ++L) { s += 3; s += (L & 1) ? 8 : 10; s += 3; }
    return s;
}

extern "C" void kernel_launch(void* const* d_in, const int* in_sizes, int n_in, void* d_out, int out_size, void* d_ws, size_t ws_size, hipStream_t stream) {
    static int grid = 0;
    if (grid == 0) {
        if (n_in != 28 || out_size != TT * D || ws_size < WS_END) { fprintf(stderr, "kernel_launch: unexpected shapes (n_in %d, out %d, ws %zu, need %zu)\n", n_in, out_size, ws_size, (size_t)WS_END); grid = -1; return; }
        int dev = 0, cus = 0, per_cu = 0;
        if (hipGetDevice(&dev) != hipSuccess || hipDeviceGetAttribute(&cus, hipDeviceAttributeMultiprocessorCount, dev) != hipSuccess) { grid = -1; return; }
        if (hipFuncSetAttribute((const void*)enc_fwd, hipFuncAttributeMaxDynamicSharedMemorySize, LDS_BYTES) != hipSuccess) { grid = -1; return; }
        if (hipOccupancyMaxActiveBlocksPerMultiprocessor(&per_cu, (const void*)enc_fwd, NWAVES * 64, LDS_BYTES) != hipSuccess || per_cu < 1) { fprintf(stderr, "kernel_launch: occupancy query says %d\n", per_cu); }
        (void)hipGetLastError();
        grid = cus;
    }
    if (grid < 0) return;
    (void)hipMemsetAsync((char*)d_ws + WS_CTL, 0, CTL_ZERO_BYTES, stream);
    Args a{};
    for (int i = 0; i < 28; ++i) a.in[i] = (const float*)d_in[i];
    a.out = (float*)d_out; a.ws = (unsigned char*)d_ws;
    const int NS = n_steps_total();
#if MK_ONE_LAUNCH
    a.step_lo = 0; a.step_hi = NS;
    hipLaunchKernelGGL(enc_fwd, dim3(grid), dim3(NWAVES * 64), LDS_BYTES, stream, a);
#else
    for (int s = 0; s < NS; ++s) {
        a.step_lo = s; a.step_hi = s + 1;
        hipLaunchKernelGGL(enc_fwd, dim3(grid), dim3(NWAVES * 64), LDS_BYTES, stream, a);
    }
#endif
}
```

```cpp
#include <hip/hip_runtime.h>
#include <cstdio>
#include <cstdint>

#ifndef MK_ONE_LAUNCH
#define MK_ONE_LAUNCH 1
#endif

#ifndef PHASE_ATTR
#define PHASE_ATTR __forceinline__
#endif
#define LAS __attribute__((address_space(3)))
#define GAS __attribute__((address_space(1)))
typedef unsigned short bf16_t;
typedef short bf16x8 __attribute__((ext_vector_type(8)));
typedef float f32x4 __attribute__((ext_vector_type(4)));
typedef float f32x2 __attribute__((ext_vector_type(2)));
typedef unsigned u32x4 __attribute__((ext_vector_type(4)));
typedef unsigned u32x2 __attribute__((ext_vector_type(2)));
typedef __bf16 bf16x2_t __attribute__((ext_vector_type(2)));

constexpr int D = 2048, FF = 5632, TT = 49152, DEPTH = 4;
constexpr int HID = 1024;
constexpr int NG1 = 3 * D + 256, NG2 = 768;
constexpr float NORM_EPS = 1e-6f, GN_EPS = 64e-5f;

__device__ __forceinline__ float bflo(unsigned w) { return __uint_as_float(w << 16); }
__device__ __forceinline__ float bfhi(unsigned w) { return __uint_as_float(w & 0xffff0000u); }
__device__ __forceinline__ unsigned pk2(float lo, float hi) { f32x2 v = {lo, hi}; bf16x2_t b = __builtin_convertvector(v, bf16x2_t); return __builtin_bit_cast(unsigned, b); }
__device__ __forceinline__ float wave_sum(float v) {
#pragma unroll
    for (int o = 1; o < 64; o <<= 1) v += __shfl_xor(v, o);
    return v;
}
__device__ __forceinline__ float fast_exp(float x) { return __builtin_amdgcn_exp2f(x * 1.4426950408889634f); }
__device__ __forceinline__ float sigmoidf_(float x) { return __builtin_amdgcn_rcpf(1.0f + fast_exp(-x)); }
__device__ __forceinline__ float siluf_(float x) { return x * sigmoidf_(x); }
__device__ __forceinline__ float tanhf_(float x) { return 1.0f - 2.0f * __builtin_amdgcn_rcpf(1.0f + fast_exp(2.0f * x)); }
__device__ __forceinline__ void row_decode(int row, int& base, int& pos, int& len) {
    if (row < 32768) { base = row & ~16383; pos = row & 16383; len = 16384; }
    else { const int r2 = row - 32768; base = 32768 + (r2 & ~8191); pos = r2 & 8191; len = 8192; }
}

namespace pg8 {
#define PG8_LAS __attribute__((address_space(3)))
constexpr int BM = 256, BK = 64, HALF = 128, HTB = HALF * BK * 2, STAGE_BYTES = 8 * HTB, NXCD = 8, WGM = 8;
__host__ __device__ __forceinline__ int lds_byte(int r, int c) { const int st = (r >> 4) * 2 + (c >> 5), rr = r & 15, cc = c & 31, ob = rr * 64 + cc * 2; return st * 1024 + (ob ^ (((ob >> 9) & 1) << 5)); }
__host__ __device__ __forceinline__ void stage_rc(int b, int& R, int& C) { const int st = b / 1024, sb = b % 1024, swz = sb ^ (((sb >> 9) & 1) << 5); R = (st >> 1) * 16 + swz / 64; C = (st & 1) * 32 + (swz % 64) / 2; }
__host__ __device__ __forceinline__ int perm32(int rho) { const int n = rho >> 4, i = rho & 15; return 8 * (i >> 2) + 4 * n + (i & 3); }
struct Unit { int pm, pn; };
struct Gemm { const bf16_t* A; const bf16_t* Bt; int M, N, K, lda; size_t a_gstride = 0; int g0 = 1 << 30, g1 = 1 << 30; };
struct StaticOrder {
    int nM, nN, nwg, G, c;
    __host__ __device__ void init(int M, int N, int G_, int c_) { nM = M / BM; nN = N / BM; nwg = nM * nN; G = G_; c = c_; }
    __host__ __device__ bool next(int i, Unit& u) const {
        const long L = (long)i * G + c; if (L >= nwg) return false;
        int wgid = (int)L; { const int q = nwg / NXCD, r = nwg % NXCD, xcd = wgid % NXCD, off = wgid / NXCD; wgid = (xcd < r ? xcd * (q + 1) : r * (q + 1) + (xcd - r) * q) + off; }
        const int nig = WGM * nN, gid = wgid / nig, fm = gid * WGM, gsz = (nM - fm) < WGM ? (nM - fm) : WGM;
        u.pm = fm + ((wgid % nig) % gsz); u.pn = (wgid % nig) / gsz; return true;
    }
    __device__ __forceinline__ void a_ready(const Unit&) const {}
    __device__ __forceinline__ void done(const Unit&) const {}
};

struct EpiSwiGLU {
    static constexpr bool PERM = true, AFTER_DRAIN = false;
    bf16_t* H; const float* rs;
    __device__ __forceinline__ void operator()(const f32x4 (&acc)[2][2][4][2], const Unit& u, int wr, int wc, int fr, int fq) const {
        const int row0 = u.pm * BM + wr * 64 + fr, col = u.pn * 128 + wc * 32 + 8 * fq;
#pragma unroll
        for (int ai = 0; ai < 2; ++ai)
#pragma unroll
            for (int m = 0; m < 4; ++m) { const int row = row0 + ai * HALF + m * 16; const float r = rs[row];
                const f32x4 g0 = acc[ai][0][m][0] * r, g1 = acc[ai][0][m][1] * r, u0 = acc[ai][1][m][0] * r, u1 = acc[ai][1][m][1] * r;
                u32x4 w;
                w.x = pk2(siluf_(g0[0]) * u0[0], siluf_(g0[1]) * u0[1]); w.y = pk2(siluf_(g0[2]) * u0[2], siluf_(g0[3]) * u0[3]);
                w.z = pk2(siluf_(g1[0]) * u1[0], siluf_(g1[1]) * u1[1]); w.w = pk2(siluf_(g1[2]) * u1[2], siluf_(g1[3]) * u1[3]);
                *(u32x4*)(H + (size_t)row * FF + col) = w;
            }
    }
};
struct EpiPlain {
    static constexpr bool PERM = true, AFTER_DRAIN = false;
    bf16_t* O; int ldc;
    __device__ __forceinline__ void operator()(const f32x4 (&acc)[2][2][4][2], const Unit& u, int wr, int wc, int fr, int fq) const {
        const int row0 = u.pm * BM + wr * 64 + fr, col0 = u.pn * BM + wc * 32 + 8 * fq;
#pragma unroll
        for (int ai = 0; ai < 2; ++ai)
#pragma unroll
            for (int m = 0; m < 4; ++m) { bf16_t* rowp = O + (size_t)(row0 + ai * HALF + m * 16) * ldc + col0;
#pragma unroll
                for (int bj = 0; bj < 2; ++bj) { const f32x4 v0 = acc[ai][bj][m][0], v1 = acc[ai][bj][m][1];
                    u32x4 w; w.x = pk2(v0[0], v0[1]); w.y = pk2(v0[2], v0[3]); w.z = pk2(v1[0], v1[1]); w.w = pk2(v1[2], v1[3]);
                    *(u32x4*)(rowp + bj * HALF) = w; } }
    }
};
struct EpiQKV {
    static constexpr bool PERM = true, AFTER_DRAIN = false;
    bf16_t* O; const f32x2* tab; const float* rs;
    __device__ __forceinline__ void operator()(const f32x4 (&acc)[2][2][4][2], const Unit& u, int wr, int wc, int fr, int fq) const {
        const int row0 = u.pm * BM + wr * 64 + fr, col0 = u.pn * BM + wc * 32 + 8 * fq;
        const bool rot = (u.pn < 16);
        f32x2 cs[2][4];
#pragma unroll
        for (int ai = 0; ai < 2; ++ai)
#pragma unroll
            for (int m = 0; m < 4; ++m) { cs[ai][m] = (f32x2){1.f, 0.f};
                if (rot) { const int row = row0 + ai * HALF + m * 16; const int pos = row < 32768 ? (row & 16383) : (row & 8191); cs[ai][m] = tab[pos * 16 + 4 * wc + fq]; } }
#pragma unroll
        for (int ai = 0; ai < 2; ++ai)
#pragma unroll
            for (int m = 0; m < 4; ++m) { const int row = row0 + ai * HALF + m * 16; bf16_t* rowp = O + (size_t)row * (3 * D) + col0; const f32x2 c = cs[ai][m]; const float r = rs[row];
#pragma unroll
                for (int bj = 0; bj < 2; ++bj) { const f32x4 v0 = acc[ai][bj][m][0] * r, v1 = acc[ai][bj][m][1] * r;
                    u32x4 w; w.x = pk2(v0[0] * c[0] - v0[1] * c[1], v0[0] * c[1] + v0[1] * c[0]); w.y = pk2(v0[2], v0[3]); w.z = pk2(v1[0], v1[1]); w.w = pk2(v1[2], v1[3]);
                    *(u32x4*)(rowp + bj * HALF) = w; } }
    }
};
struct EpiG1 {
    static constexpr bool PERM = true, AFTER_DRAIN = false;
    unsigned char* ws; size_t r_off, v_off, h_off; int mode;
    __device__ __forceinline__ void operator()(const f32x4 (&acc)[2][2][4][2], const Unit& u, int wr, int wc, int fr, int fq) const {
        const int row0 = u.pm * BM + wr * 64 + fr; const int t = u.pn >> 3;
        size_t off = r_off + (size_t)t * (192u << 20); int ldc = D, colt = (u.pn & 7) * BM, act = 0;
        if (t == 2) off = v_off;
        if (t >= 3) { off = h_off; ldc = HID; colt = 768; }
        if (mode == 1) { off = h_off; ldc = HID; colt = u.pn * BM; act = (u.pn == 0) ? 1 : ((u.pn == 2) ? 2 : 0); }
        bf16_t* base = (bf16_t*)(ws + off);
        const int col0 = colt + wc * 32 + 8 * fq;
#pragma unroll
        for (int ai = 0; ai < 2; ++ai)
#pragma unroll
            for (int m = 0; m < 4; ++m) { bf16_t* rowp = base + (size_t)(row0 + ai * HALF + m * 16) * ldc + col0;
#pragma unroll
                for (int bj = 0; bj < 2; ++bj) { f32x4 v0 = acc[ai][bj][m][0], v1 = acc[ai][bj][m][1];
                    if (act == 1) {
#pragma unroll
                        for (int j = 0; j < 4; ++j) { v0[j] = tanhf_(v0[j]); v1[j] = tanhf_(v1[j]); } }
                    if (act == 2) {
#pragma unroll
                        for (int j = 0; j < 4; ++j) { v0[j] = sigmoidf_(v0[j]); v1[j] = sigmoidf_(v1[j]); } }
                    u32x4 w; w.x = pk2(v0[0], v0[1]); w.y = pk2(v0[2], v0[3]); w.z = pk2(v1[0], v1[1]); w.w = pk2(v1[2], v1[3]);
                    *(u32x4*)(rowp + bj * HALF) = w; } }
    }
};
struct EpiVres {
    static constexpr bool PERM = true, AFTER_DRAIN = false;
    bf16_t* V; const bf16_t* VF; const float* v0;
    __device__ __forceinline__ void operator()(const f32x4 (&acc)[2][2][4][2], const Unit& u, int wr, int wc, int fr, int fq) const {
        const int row0 = u.pm * BM + wr * 64 + fr, col0 = u.pn * BM + wc * 32 + 8 * fq;
#pragma unroll
        for (int ai = 0; ai < 2; ++ai)
#pragma unroll
            for (int m = 0; m < 4; ++m) { const size_t ro = (size_t)(row0 + ai * HALF + m * 16) * D + col0;
#pragma unroll
                for (int bj = 0; bj < 2; ++bj) { const f32x4 a0 = acc[ai][bj][m][0], a1 = acc[ai][bj][m][1];
                    const u32x4 vv = *(const u32x4*)(V + ro + bj * HALF), vf = *(const u32x4*)(VF + ro + bj * HALF);
                    const f32x4 b0 = *(const f32x4*)(v0 + col0 + bj * HALF), b1 = *(const f32x4*)(v0 + col0 + bj * HALF + 4);
                    float o[8]; const unsigned vw[4] = {vv.x, vv.y, vv.z, vv.w}, fw[4] = {vf.x, vf.y, vf.z, vf.w};
#pragma unroll
                    for (int j = 0; j < 4; ++j) { const float g0 = sigmoidf_((j < 2 ? b0[2 * j] : b1[2 * j - 4]) + (j < 2 ? a0[2 * j] : a1[2 * j - 4]));
                        const float g1 = sigmoidf_((j < 2 ? b0[2 * j + 1] : b1[2 * j - 3]) + (j < 2 ? a0[2 * j + 1] : a1[2 * j - 3]));
                        const float x0 = bflo(vw[j]), x1 = bfhi(vw[j]), f0 = bflo(fw[j]), f1 = bfhi(fw[j]);
                        o[2 * j] = x0 + (f0 - x0) * g0; o[2 * j + 1] = x1 + (f1 - x1) * g1; }
                    u32x4 w; w.x = pk2(o[0], o[1]); w.y = pk2(o[2], o[3]); w.z = pk2(o[4], o[5]); w.w = pk2(o[6], o[7]);
                    *(u32x4*)(V + ro + bj * HALF) = w; } }
    }
};
struct EpiGmul {
    static constexpr bool PERM = true, AFTER_DRAIN = false;
    bf16_t* Y;
    __device__ __forceinline__ void operator()(const f32x4 (&acc)[2][2][4][2], const Unit& u, int wr, int wc, int fr, int fq) const {
        const int row0 = u.pm * BM + wr * 64 + fr, col0 = u.pn * BM + wc * 32 + 8 * fq;
#pragma unroll
        for (int ai = 0; ai < 2; ++ai)
#pragma unroll
            for (int m = 0; m < 4; ++m) { const size_t ro = (size_t)(row0 + ai * HALF + m * 16) * D + col0;
#pragma unroll
                for (int bj = 0; bj < 2; ++bj) { const f32x4 a0 = acc[ai][bj][m][0], a1 = acc[ai][bj][m][1];
                    const u32x4 y = *(const u32x4*)(Y + ro + bj * HALF);
                    u32x4 w; w.x = pk2(bflo(y.x) * a0[0], bfhi(y.x) * a0[1]); w.y = pk2(bflo(y.y) * a0[2], bfhi(y.y) * a0[3]);
                    w.z = pk2(bflo(y.z) * a1[0], bfhi(y.z) * a1[1]); w.w = pk2(bflo(y.w) * a1[2], bfhi(y.w) * a1[3]);
                    *(u32x4*)(Y + ro + bj * HALF) = w; } }
    }
};

template <class Epi, class Sched, bool ALIGN_EPI = false, bool SP2 = false>
__device__ __forceinline__ void gemm_phase(PG8_LAS unsigned char* lds, const Gemm g, const Sched& S, const Epi& E, const int tid) {
    const int wid = __builtin_amdgcn_readfirstlane(tid >> 6), lane = tid & 63, wr = wid >> 2, wc = wid & 3, fr = lane & 15, fq = lane >> 4;
    const int K = g.K, nt = K / BK, lda = g.lda;
    unsigned voffA[2], voffB[2];
#pragma unroll
    for (int i = 0; i < 2; ++i) { int R, C; stage_rc(tid * 16 + i * 8192, R, C); const int Rb = Epi::PERM ? ((R & ~31) + perm32(R & 31)) : R;
        voffA[i] = (unsigned)(R * lda + C) * 2u; voffB[i] = (unsigned)(Rb * K + C) * 2u; }
    const size_t kstep = (size_t)(BK * 2);
    const size_t hstepA = (size_t)HALF * lda * 2, hstepB = (size_t)HALF * K * 2;
    const size_t tstepA = 2 * hstepA, tstepB = 2 * hstepB;
    const unsigned ldsw = (unsigned)wid * 1024u;
    const int aoff = lds_byte(wr * 64 + fr, fq * 8), boff = lds_byte(wc * 32 + fr, fq * 8);
#define PG8_SA(b, h) (((b) * 2 + (h)) * HTB)
#define PG8_SB(b, h) ((4 + (b) * 2 + (h)) * HTB)
#define PG8_STAGE(bufoff, gbase, voff) do { _Pragma("unroll") for (int _i = 0; _i < 2; ++_i) \
        __builtin_amdgcn_global_load_lds((const unsigned*)((const char*)(gbase) + (voff)[_i]), (PG8_LAS unsigned*)(lds + (bufoff) + ldsw + _i * 8192), 16, 0, 0); } while (0)
#define PG8_LDA(dst, b, h) do { _Pragma("unroll") for (int m = 0; m < 4; ++m) _Pragma("unroll") for (int k = 0; k < 2; ++k) dst[m][k] = *(const PG8_LAS bf16x8*)(lds + PG8_SA(b, h) + aoff + m * 2048 + k * 1024); } while (0)
#define PG8_LDB(dst, b, h) do { _Pragma("unroll") for (int n = 0; n < 2; ++n) _Pragma("unroll") for (int k = 0; k < 2; ++k) dst[n][k] = *(const PG8_LAS bf16x8*)(lds + PG8_SB(b, h) + boff + n * 2048 + k * 1024); } while (0)
#define PG8_MMA(ai, bj, At, Bt) do { __builtin_amdgcn_s_setprio(1); _Pragma("unroll") for (int m = 0; m < 4; ++m) _Pragma("unroll") for (int n = 0; n < 2; ++n) _Pragma("unroll") for (int k = 0; k < 2; ++k) \
        acc[ai][bj][m][n] = __builtin_amdgcn_mfma_f32_16x16x32_bf16(Bt[n][k], At[m][k], acc[ai][bj][m][n], 0, 0, 0); __builtin_amdgcn_s_setprio(0); } while (0)
#define PG8_WAIT_V(n) asm volatile("s_waitcnt vmcnt(" #n ")" ::: "memory")
#define PG8_WAIT_L(n) asm volatile("s_waitcnt lgkmcnt(" #n ")" ::: "memory")
#define PG8_BAR __builtin_amdgcn_s_barrier()
#define PG8_SCHED __builtin_amdgcn_sched_barrier(0)
    Unit cur, nxt; int ui = 0;
    if (!S.next(0, cur)) return;
    f32x4 acc[2][2][4][2];
#pragma unroll
    for (int a = 0; a < 2; ++a)
#pragma unroll
        for (int b = 0; b < 2; ++b)
#pragma unroll
            for (int m = 0; m < 4; ++m)
#pragma unroll
                for (int n = 0; n < 2; ++n) acc[a][b][m][n] = (f32x4){0.f, 0.f, 0.f, 0.f};
    bf16x8 At[4][2], B0[2][2], B1[2][2];
    const char* cA = (const char*)g.A + (size_t)cur.pm * tstepA + (size_t)((cur.pn >= g.g0) + (cur.pn >= g.g1)) * g.a_gstride; const char* cB = (const char*)g.Bt + (size_t)cur.pn * tstepB;
    S.a_ready(cur);
    if constexpr (SP2) {
        PG8_STAGE(PG8_SB(0, 0), cB, voffB); PG8_STAGE(PG8_SB(0, 1), cB + hstepB, voffB); PG8_STAGE(PG8_SA(0, 0), cA, voffA); PG8_STAGE(PG8_SA(0, 1), cA + hstepA, voffA);
        if (wr == 1) PG8_BAR;
        PG8_WAIT_V(2); PG8_BAR;
        PG8_STAGE(PG8_SB(1, 0), cB + kstep, voffB); PG8_STAGE(PG8_SA(1, 0), cA + kstep, voffA); PG8_STAGE(PG8_SB(1, 1), cB + hstepB + kstep, voffB);
        PG8_WAIT_V(6); PG8_BAR;
    } else {
        PG8_STAGE(PG8_SB(0, 0), cB, voffB); PG8_STAGE(PG8_SA(0, 0), cA, voffA); PG8_STAGE(PG8_SB(0, 1), cB + hstepB, voffB); PG8_STAGE(PG8_SA(0, 1), cA + hstepA, voffA);
        if (wr == 1) PG8_BAR;
        PG8_WAIT_V(4); PG8_BAR;
        PG8_STAGE(PG8_SB(1, 0), cB + kstep, voffB); PG8_STAGE(PG8_SA(1, 0), cA + kstep, voffA); PG8_STAGE(PG8_SB(1, 1), cB + hstepB + kstep, voffB);
        PG8_WAIT_V(6); PG8_BAR;
    }
    for (;;) {
        const bool has_next = S.next(ui + 1, nxt);
        const char* nA = has_next ? (const char*)g.A + (size_t)nxt.pm * tstepA + (size_t)((nxt.pn >= g.g0) + (nxt.pn >= g.g1)) * g.a_gstride : cA; const char* nB = has_next ? (const char*)g.Bt + (size_t)nxt.pn * tstepB : cB;
        for (int t = 0; t < nt; t += 2) {
            const bool last = (t == nt - 2);
            const char* a1 = cA + (size_t)(t + 1) * kstep;
            const char* a2 = last ? nA : cA + (size_t)(t + 2) * kstep; const char* b2 = last ? nB : cB + (size_t)(t + 2) * kstep;
            const char* a3 = a2 + kstep; const char* b3 = b2 + kstep;
            if (last && has_next) S.a_ready(nxt);
            if constexpr (SP2) {
            PG8_LDB(B0, 0, 0); PG8_LDB(B1, 0, 1); PG8_SCHED; PG8_LDA(At, 0, 0); PG8_STAGE(PG8_SA(1, 1), a1 + hstepA, voffA);
            PG8_WAIT_V(8); PG8_WAIT_L(0); PG8_BAR; PG8_MMA(0, 0, At, B0); PG8_MMA(0, 1, At, B1); PG8_BAR; PG8_SCHED;
            PG8_LDA(At, 0, 1); PG8_STAGE(PG8_SB(0, 0), b2, voffB); PG8_STAGE(PG8_SB(0, 1), b2 + hstepB, voffB); PG8_STAGE(PG8_SA(0, 0), a2, voffA);
            PG8_WAIT_V(8); PG8_WAIT_L(0); PG8_BAR; PG8_MMA(1, 0, At, B0); PG8_MMA(1, 1, At, B1); PG8_BAR; PG8_SCHED;
            PG8_LDB(B0, 1, 0); PG8_LDB(B1, 1, 1); PG8_SCHED; PG8_LDA(At, 1, 0); PG8_STAGE(PG8_SA(0, 1), a2 + hstepA, voffA);
            PG8_WAIT_V(8); PG8_WAIT_L(0); PG8_BAR; PG8_MMA(0, 0, At, B0); PG8_MMA(0, 1, At, B1); PG8_BAR; PG8_SCHED;
            PG8_LDA(At, 1, 1); PG8_STAGE(PG8_SB(1, 0), b3, voffB); PG8_STAGE(PG8_SB(1, 1), b3 + hstepB, voffB); PG8_STAGE(PG8_SA(1, 0), a3, voffA);
            PG8_WAIT_V(8); PG8_WAIT_L(0); PG8_BAR; PG8_MMA(1, 0, At, B0); PG8_MMA(1, 1, At, B1); PG8_BAR; PG8_SCHED;
            } else {
            PG8_LDB(B0, 0, 0); PG8_SCHED; PG8_LDA(At, 0, 0); PG8_STAGE(PG8_SA(1, 1), a1 + hstepA, voffA);
            PG8_WAIT_L(8); PG8_BAR; PG8_WAIT_L(0); PG8_MMA(0, 0, At, B0); PG8_BAR; PG8_SCHED;
            PG8_LDB(B1, 0, 1); PG8_STAGE(PG8_SB(0, 0), b2, voffB);
            PG8_BAR; PG8_WAIT_L(0); PG8_MMA(0, 1, At, B1); PG8_BAR;
            PG8_LDA(At, 0, 1); PG8_STAGE(PG8_SA(0, 0), a2, voffA);
            PG8_BAR; PG8_WAIT_L(0); PG8_MMA(1, 0, At, B0); PG8_BAR; PG8_SCHED;
            PG8_STAGE(PG8_SB(0, 1), b2 + hstepB, voffB);
            PG8_WAIT_V(6); PG8_BAR; PG8_MMA(1, 1, At, B1); PG8_BAR;
            PG8_LDB(B0, 1, 0); PG8_SCHED; PG8_LDA(At, 1, 0); PG8_STAGE(PG8_SA(0, 1), a2 + hstepA, voffA);
            PG8_WAIT_L(8); PG8_BAR; PG8_WAIT_L(0); PG8_MMA(0, 0, At, B0); PG8_BAR; PG8_SCHED;
            PG8_LDB(B1, 1, 1); PG8_STAGE(PG8_SB(1, 0), b3, voffB);
            PG8_BAR; PG8_WAIT_L(0); PG8_MMA(0, 1, At, B1); PG8_BAR;
            PG8_LDA(At, 1, 1); PG8_STAGE(PG8_SA(1, 0), a3, voffA);
            PG8_BAR; PG8_WAIT_L(0); PG8_MMA(1, 0, At, B0); PG8_BAR; PG8_SCHED;
            PG8_STAGE(PG8_SB(1, 1), b3 + hstepB, voffB);
            PG8_WAIT_V(6); PG8_BAR; PG8_MMA(1, 1, At, B1); PG8_BAR;
            }
        }
        if constexpr (ALIGN_EPI) { if (wr == 0) PG8_BAR; }
        if constexpr (!Epi::AFTER_DRAIN) { E(acc, cur, wr, wc, fr, fq); S.done(cur); }
        if (!has_next) break;
#pragma unroll
        for (int a = 0; a < 2; ++a)
#pragma unroll
            for (int b = 0; b < 2; ++b)
#pragma unroll
                for (int m = 0; m < 4; ++m)
#pragma unroll
                    for (int n = 0; n < 2; ++n) acc[a][b][m][n] = (f32x4){0.f, 0.f, 0.f, 0.f};
        cur = nxt; cA = nA; cB = nB; ++ui;
        if constexpr (ALIGN_EPI) { if (wr == 1) PG8_BAR; }
    }
    PG8_WAIT_V(0);
    if constexpr (!ALIGN_EPI) { if (wr == 0) PG8_BAR; }
    PG8_BAR;
#undef PG8_SA
#undef PG8_SB
#undef PG8_STAGE
#undef PG8_LDA
#undef PG8_LDB
#undef PG8_MMA
#undef PG8_WAIT_V
#undef PG8_WAIT_L
#undef PG8_BAR
#undef PG8_SCHED
}
}

#define XB_TMO      128
#define XB_XCNT(j)  (256  + 64 * (j))
#define XB_XSUB(j)  (1280 + 64 * (j))
#define XB_XGEN(j)  (2304 + 64 * (j))
#define XB_TOP      3328
#define XB_TOPGEN   3392
#define XCD_BAR_WORDS 3456
#define XB_SPIN_CAP (1u << 22)
__device__ __forceinline__ unsigned xb_ld(unsigned* p)              { return __hip_atomic_load(p, __ATOMIC_RELAXED, __HIP_MEMORY_SCOPE_AGENT); }
__device__ __forceinline__ unsigned xb_add(unsigned* p, unsigned v) { return __hip_atomic_fetch_add(p, v, __ATOMIC_RELAXED, __HIP_MEMORY_SCOPE_AGENT); }
__device__ __forceinline__ unsigned xb_xcc_id() { return (unsigned)__builtin_amdgcn_s_getreg((3 << 11) | 20) & 0xFu; }
#define XB_SPIN(cond, bar) do { unsigned _sp = 0; while (cond) { __builtin_amdgcn_s_sleep(1); \
    if ((++_sp & 255u) == 0u) { if (xb_ld(&(bar)[XB_TMO])) break; if (_sp > XB_SPIN_CAP) { atomicAdd(&(bar)[XB_TMO], 1u); break; } } } } while (0)
struct XcdBarrier { unsigned* bar; unsigned x; volatile LAS unsigned* st; };
__device__ __forceinline__ XcdBarrier xcd_barrier_post(unsigned* bar, volatile LAS unsigned* st) {
    XcdBarrier b; b.bar = bar; b.x = xb_xcc_id(); b.st = st;
    if (threadIdx.x == 0) (void)xb_add(&bar[XB_XCNT(b.x)], 1u);
    return b;
}
__device__ __forceinline__ void xcd_barrier_complete(unsigned* bar, unsigned x, unsigned& nloc, unsigned& nx) {
    const unsigned G = gridDim.x * gridDim.y * gridDim.z;
    unsigned sum, cnt, mine, sp = 0u;
    for (;;) {
        sum = 0u; cnt = 0u; mine = 0u;
#pragma unroll
        for (unsigned j = 0; j < 16; ++j) { const unsigned c = xb_ld(&bar[XB_XCNT(j)]); sum += c; cnt += (c > 0u) ? 1u : 0u; mine = (j == x) ? c : mine; }
        if (sum == G) break;
        __builtin_amdgcn_s_sleep(1);
        if ((++sp & 255u) == 0u) { if (xb_ld(&bar[XB_TMO])) break; if (sp > XB_SPIN_CAP) { atomicAdd(&bar[XB_TMO], 1u); break; } }
    }
    nloc = mine > 0u ? mine : 1u; nx = cnt > 0u ? cnt : 1u;
}
__device__ __forceinline__ void xcd_barrier(const XcdBarrier& b) {
    asm volatile("s_waitcnt vmcnt(0)" ::: "memory");
    __syncthreads();
    if (threadIdx.x == 0) {
        unsigned* bar = b.bar;
        __builtin_amdgcn_s_waitcnt(0);
        unsigned nloc = b.st[0], nx = b.st[1];
        if (nloc == 0u) { xcd_barrier_complete(bar, b.x, nloc, nx); b.st[0] = nloc; b.st[1] = nx; }
        const unsigned old = xb_add(&bar[XB_XSUB(b.x)], 1u);
        const unsigned gen = old / nloc;
        if (old + 1u == (gen + 1u) * nloc) {
            __builtin_amdgcn_fence(__ATOMIC_RELEASE, "agent");
            asm volatile("s_waitcnt vmcnt(0)" ::: "memory");
            const unsigned og = xb_add(&bar[XB_TOP], 1u);
            const unsigned tg = og / nx;
            if (og + 1u == (tg + 1u) * nx) xb_add(&bar[XB_TOPGEN], 1u);
            else XB_SPIN(xb_ld(&bar[XB_TOPGEN]) == tg, bar);
            __builtin_amdgcn_fence(__ATOMIC_ACQUIRE, "agent");
            xb_add(&bar[XB_XGEN(b.x)], 1u);
            asm volatile("s_waitcnt vmcnt(0)" ::: "memory");
        } else {
            XB_SPIN(xb_ld(&bar[XB_XGEN(b.x)]) == gen, bar);
            __builtin_amdgcn_fence(__ATOMIC_ACQUIRE, "agent");
            asm volatile("s_waitcnt vmcnt(0)" ::: "memory");
        }
    }
    __syncthreads();
}

constexpr size_t MiB = 1u << 20;
constexpr size_t WS_CTL = 0, CTL_ZERO_BYTES = 1 * MiB;
constexpr size_t WS_ROPE = 1 * MiB;
constexpr size_t WS_WTS = 4 * MiB;
constexpr size_t W_UP0 = WS_WTS, W_DN0 = WS_WTS + 44 * MiB, W_UP1 = WS_WTS + 66 * MiB, W_DN1 = WS_WTS + 110 * MiB;
constexpr size_t W_MIX = WS_WTS + 132 * MiB;
constexpr size_t W_G2 = W_MIX + 25 * MiB, W_GG = W_MIX + 28 * MiB, W_GV = W_MIX + 29 * MiB;
constexpr size_t W_GO = WS_WTS + 212 * MiB;
constexpr size_t WS_VF = 228 * MiB;
constexpr size_t WS_POOL = 420 * MiB;
constexpr size_t P_XN = WS_POOL;
constexpr size_t P_H = WS_POOL + 192 * MiB, P_HOUT = WS_POOL + 720 * MiB;
constexpr size_t P_MIX = WS_POOL + 192 * MiB;
constexpr size_t P_YF = WS_POOL + 192 * MiB, P_YB = WS_POOL + 384 * MiB, P_R = WS_POOL + 768 * MiB, P_K = WS_POOL + 960 * MiB, P_V = WS_POOL + 1152 * MiB,
                 P_HID = WS_POOL + 1344 * MiB, P_BS = WS_POOL + 1440 * MiB;
constexpr size_t P_QKV = WS_POOL + 192 * MiB, P_O0 = WS_POOL + 768 * MiB, P_LSE = WS_POOL + 1344 * MiB;
constexpr size_t WS_END = WS_POOL + 1452 * MiB;
constexpr int CW_BAR = 4096;
constexpr size_t WS_SCANFLAG = 512 * 1024;
constexpr int SCAN_NH = 63;
constexpr int SCAN_DUMP_U = 4592, SCAN_SLOT = 73728, SCAN_SLOTS_OUT = 5461;
constexpr size_t WS_RSX = 65536;

constexpr int RING_BYTES = 131072, CTRL_OFF = 143360, MISC_OFF = CTRL_OFF + 256, LDS_BYTES = 163840;
constexpr int NWAVES = 8;

struct Args { const float* in[28]; float* out; unsigned char* ws; int step_lo, step_hi; };

struct Seg { unsigned long long woff, soff, doff; int widx, sidx, ldw, col0, ldt, row0, k0dst, nkb, nnb, ilv, item0, pad0; };
__device__ __forceinline__ void seg_add(LAS Seg* s, int& n, int& items, int widx, size_t woff, int sidx, size_t soff, size_t doff, int ldw, int col0, int ldt, int row0, int k0dst, int nkb, int nnb, int ilv) {
    s[n].widx = widx; s[n].woff = woff; s[n].sidx = sidx; s[n].soff = soff; s[n].doff = doff; s[n].ldw = ldw; s[n].col0 = col0; s[n].ldt = ldt; s[n].row0 = row0; s[n].k0dst = k0dst; s[n].nkb = nkb; s[n].nnb = nnb; s[n].ilv = ilv; s[n].item0 = items;
    items += nkb * nnb; ++n;
}

extern __shared__ __attribute__((aligned(16))) unsigned char lds_raw[];
constexpr int PTR_OFF = CTRL_OFF + 512;
__device__ __forceinline__ unsigned long long ptr_ld(int i) {
    const LAS unsigned* p = (const LAS unsigned*)((LAS unsigned char*)lds_raw + PTR_OFF) + 2 * i;
    const unsigned lo = __builtin_amdgcn_readfirstlane(p[0]), hi = __builtin_amdgcn_readfirstlane(p[1]);
    return ((unsigned long long)hi << 32) | lo;
}
__device__ __forceinline__ const float* inp(int i) { return (const float*)(const GAS float*)ptr_ld(i); }
__device__ __forceinline__ float* outp() { return (float*)(GAS float*)ptr_ld(28); }
__device__ __forceinline__ unsigned char* wsp() { return (unsigned char*)(GAS unsigned char*)ptr_ld(29); }
#define FRAME() LAS unsigned char* lds = (LAS unsigned char*)lds_raw; int tid = threadIdx.x; asm volatile("" : "+v"(tid)); const int lane = tid & 63, wave = __builtin_amdgcn_readfirstlane(tid >> 6); \
    int bid_ = blockIdx.x, G = gridDim.x; asm volatile("" : "+s"(bid_), "+s"(G)); const int gw = bid_ * NWAVES + wave, NGW = G * NWAVES; unsigned char* ws = wsp(); (void)lds; (void)lane; (void)gw; (void)NGW; (void)ws; (void)G

static __device__ PHASE_ATTR void ph_init() {
    FRAME();
    const float* in0 = inp(0); const float* in1 = inp(1);
    {
        f32x2* tab = (f32x2*)(ws + WS_ROPE);
        for (int idx = bid_ * 512 + tid; idx < 16384 * 16; idx += G * 512) {
            const int pos = idx >> 4, i = idx & 15;
            double iv = 1.0;
            iv = (i == 1) ? 0.44036660267178046 : iv; iv = (i == 2) ? 0.19392274474868576 : iv; iv = (i == 3) ? 0.08539710028576561 : iv; iv = (i == 4) ? 0.03760603093086393 : iv;
            iv = (i == 5) ? 0.016560440080994446 : iv; iv = (i == 6) ? 0.007292664737217109 : iv; iv = (i == 7) ? 0.003211445994752591 : iv; iv = (i == 8) ? 0.001414213562373095 : iv;
            iv = (i == 9) ? 0.000622772421914596 : iv; iv = (i == 10) ? 0.0002742481756762073 : iv; iv = (i == 11) ? 0.00012076973741146504 : iv; iv = (i == 12) ? 5.318295896944988e-05 : iv;
            iv = (i == 13) ? 2.341999896140934e-05 : iv; iv = (i == 14) ? 1.031338537721246e-05 : iv; iv = (i == 15) ? 4.5416704806078695e-06 : iv;
            double t = (double)pos * iv * 0.15915494309189535; t = t - __builtin_rint(t);
            const float tf = (float)t;
            tab[idx] = (f32x2){__builtin_amdgcn_cosf(tf), __builtin_amdgcn_sinf(tf)};
        }
    }
    bf16_t* XB = (bf16_t*)(ws + P_XN); float* RSX = (float*)(ws + WS_RSX);
    for (int row = gw; row < TT; row += NGW) {
        const float* src = row < 32768 ? in0 + (size_t)row * D : in1 + (size_t)(row - 32768) * D;
        float ss = 0.f;
#pragma unroll
        for (int i = 0; i < 4; ++i) { const int e = 8 * (lane + 64 * i); const f32x4 a = *(const f32x4*)(src + e), b = *(const f32x4*)(src + e + 4);
#pragma unroll
            for (int j = 0; j < 4; ++j) ss += a[j] * a[j] + b[j] * b[j];
            *(u32x4*)(XB + (size_t)row * D + e) = (u32x4){pk2(a[0], a[1]), pk2(a[2], a[3]), pk2(b[0], b[1]), pk2(b[2], b[3])}; }
        const float rx = rsqrtf(wave_sum(ss) * (1.0f / D) + NORM_EPS);
        if (lane == 0) RSX[row] = rx;
    }
}

__device__ __forceinline__ void conv_load(const LAS Seg* sp, int local, int lane, f32x4 (&v)[8]) {
    const int widx = sp->widx; if (widx < 0) return;
    const int ldw = sp->ldw, nnb = sp->nnb, kb = local / nnb, nb = local % nnb;
    const float* p = inp(widx) + sp->woff + (size_t)(64 * kb + (lane >> 3)) * ldw + sp->col0 + 32 * nb + 4 * (lane & 7);
#pragma unroll
    for (int i = 0; i < 8; ++i) v[i] = *(const f32x4*)(p + (size_t)(8 * i) * ldw);
}
__device__ __forceinline__ void conv_finish(const LAS Seg* sp, int local, LAS float* scr, int lane, const f32x4 (&v)[8], unsigned char* ws) {
    const int widx = sp->widx, sidx = sp->sidx, ldt = sp->ldt, row0 = sp->row0, k0dst = sp->k0dst, nnb = sp->nnb, ilv = sp->ilv;
    bf16_t* dst = (bf16_t*)(ws + sp->doff);
    const int kb = local / nnb, nb = local % nnb, k0 = 64 * kb, n0 = 32 * nb, c = lane & 7;
    if (widx >= 0) {
        const float* scale = sidx >= 0 ? inp(sidx) + sp->soff + k0 + (lane >> 3) : nullptr;
#pragma unroll
        for (int i = 0; i < 8; ++i) { const int kk = (lane >> 3) + 8 * i; const float sc = scale ? scale[8 * i] : 1.0f;
            LAS float* s = scr + kk * 33 + 4 * (lane & 7); s[0] = v[i][0] * sc; s[1] = v[i][1] * sc; s[2] = v[i][2] * sc; s[3] = v[i][3] * sc; }
        asm volatile("s_waitcnt lgkmcnt(0)" ::: "memory");
    }
#pragma unroll
    for (int j = 0; j < 4; ++j) { const int n = (lane >> 3) + 8 * j; const int nn = n0 + n;
        int drow = row0 + ((ilv == 1) ? (256 * (nn >> 7) + (nn & 127)) : nn);
        if (ilv == 2 && ((nn >> 11) % 3) < 2) {
            const int co = nn & 127;
            const int nl = co < 32 ? (8 * (co & 15) + (co >> 4)) : (8 * ((co - 32) / 6) + 2 + (co - 32) % 6);
            drow = row0 + (nn & ~127) + nl; }
        u32x4 o = {0u, 0u, 0u, 0u};
        if (widx >= 0) { const LAS float* s = scr + (8 * c) * 33 + n;
            o.x = pk2(s[0 * 33], s[1 * 33]); o.y = pk2(s[2 * 33], s[3 * 33]); o.z = pk2(s[4 * 33], s[5 * 33]); o.w = pk2(s[6 * 33], s[7 * 33]); }
        *(u32x4*)(dst + (size_t)drow * ldt + k0dst + k0 + 8 * c) = o; }
    asm volatile("s_waitcnt lgkmcnt(0)" ::: "memory");
}
static __device__ PHASE_ATTR void ph_conv(int L) {
    FRAME();
    const int jm = L >> 1; const bool is_attn = (L & 1) != 0;
    LAS Seg* segs = (LAS Seg*)lds; LAS int* nseg_p = (LAS int*)(lds + 4096); LAS float* scr = (LAS float*)(lds + 8192 + wave * 8448);
    if (tid == 0) {
        int n = 0, items = 0;
        for (int f = 0; f < 2; ++f) {
            const size_t wo = (size_t)(L * 2 + f) * D * FF;
            const size_t up = f ? W_UP1 : W_UP0, dn = f ? W_DN1 : W_DN0;
            seg_add(segs, n, items, 4, wo, 2, (size_t)(L * 3 + 2 * f) * D, up, FF, 0, D, 0, 0, D / 64, FF / 32, 1);
            seg_add(segs, n, items, 5, wo, 2, (size_t)(L * 3 + 2 * f) * D, up, FF, 0, D, 128, 0, D / 64, FF / 32, 1);
            seg_add(segs, n, items, 6, wo, -1, 0, dn, D, 0, FF, 0, 0, FF / 64, D / 32, 0);
        }
        if (!is_attn) {
            for (int p = 0; p < 3; ++p) seg_add(segs, n, items, 8, (size_t)(jm * 3 + p) * D * D, -1, 0, W_MIX, D, 0, D, p * D, 0, D / 64, D / 32, 0);
            if (jm > 0) { seg_add(segs, n, items, 16, (size_t)(jm - 1) * D * 64, -1, 0, W_MIX, 64, 0, D, 3 * D, 0, D / 64, 2, 0);
                          seg_add(segs, n, items, -1, 0, -1, 0, W_MIX, 0, 0, D, 3 * D + 64, 0, D / 64, 6, 0);
                          seg_add(segs, n, items, 17, (size_t)(jm - 1) * 64 * D, -1, 0, W_GV, D, 0, 256, 0, 0, 1, D / 32, 0);
                          seg_add(segs, n, items, -1, 0, -1, 0, W_GV, 0, 0, 256, 0, 64, 3, D / 32, 0); }
            else seg_add(segs, n, items, -1, 0, -1, 0, W_MIX, 0, 0, D, 3 * D, 0, D / 64, 8, 0);
            for (int d = 0; d < 2; ++d) {
                seg_add(segs, n, items, 10, (size_t)(jm * 2 + d) * D * 96, -1, 0, W_G2, 96, 0, D, d * 128, 0, D / 64, 3, 0);
                seg_add(segs, n, items, -1, 0, -1, 0, W_G2, 0, 0, D, d * 128 + 96, 0, D / 64, 1, 0);
                seg_add(segs, n, items, 13, (size_t)(jm * 2 + d) * D * 96, -1, 0, W_G2, 96, 0, D, 256 + d * 128, 0, D / 64, 3, 0);
                seg_add(segs, n, items, -1, 0, -1, 0, W_G2, 0, 0, D, 256 + d * 128 + 96, 0, D / 64, 1, 0);
            }
            seg_add(segs, n, items, 18, (size_t)jm * D * 256, -1, 0, W_G2, 256, 0, D, 512, 0, D / 64, 8, 0);
            seg_add(segs, n, items, 19, (size_t)jm * 256 * D, -1, 0, W_GG, D, 0, 256, 0, 0, 4, D / 32, 0);
            seg_add(segs, n, items, 25, (size_t)jm * D * D, -1, 0, W_GO, D, 0, D, 0, 0, D / 64, D / 32, 0);
        } else {
            seg_add(segs, n, items, 26, (size_t)jm * D * 9 * D, 2, (size_t)(L * 3 + 1) * D, W_MIX, 9 * D, 0, D, 0, 0, D / 64, 9 * D / 32, 2);
            seg_add(segs, n, items, 27, (size_t)jm * D * D, -1, 0, W_GO, D, 0, D, 0, 0, D / 64, D / 32, 0);
        }
        segs[n].item0 = items; nseg_p[0] = n; nseg_p[1] = items;
    }
    __syncthreads();
    const int total = nseg_p[1];
    f32x4 cur[8], nxt[8];
#pragma unroll
    for (int i = 0; i < 8; ++i) { cur[i] = (f32x4){0.f, 0.f, 0.f, 0.f}; nxt[i] = cur[i]; }
    int it = gw, si = 0;
    if (it < total) { while (it >= segs[si + 1].item0) ++si; conv_load(segs + si, it - segs[si].item0, lane, cur); }
    while (it < total) {
        const int itn = it + NGW; int sn = si;
        if (itn < total) { while (itn >= segs[sn + 1].item0) ++sn; conv_load(segs + sn, itn - segs[sn].item0, lane, nxt); }
        conv_finish(segs + si, it - segs[si].item0, scr, lane, cur, ws);
#pragma unroll
        for (int i = 0; i < 8; ++i) cur[i] = nxt[i];
        it = itn; si = sn;
    }
    __syncthreads();
}

static __device__ PHASE_ATTR void ph_ffn_up(int f) {
    FRAME();
    pg8::Gemm g{(const bf16_t*)(ws + P_XN), (const bf16_t*)(ws + (f ? W_UP1 : W_UP0)), TT, 2 * FF, D, D}; pg8::StaticOrder S; S.init(TT, 2 * FF, G, bid_);
    pg8::EpiSwiGLU E{(bf16_t*)(ws + P_H), (const float*)(ws + WS_RSX)};
    pg8::gemm_phase<pg8::EpiSwiGLU, pg8::StaticOrder, true, true>(lds, g, S, E, tid);
}
static __device__ PHASE_ATTR void ph_gemm_plain(size_t a_off, int lda, size_t b_off, int N, int K, size_t o_off, int ldc) {
    FRAME();
    pg8::Gemm g{(const bf16_t*)(ws + a_off), (const bf16_t*)(ws + b_off), TT, N, K, lda}; pg8::StaticOrder S; S.init(TT, N, G, bid_);
    pg8::EpiPlain E{(bf16_t*)(ws + o_off), ldc};
    pg8::gemm_phase<pg8::EpiPlain, pg8::StaticOrder, true, true>(lds, g, S, E, tid);
}
static __device__ PHASE_ATTR void ph_qkv(int gi) {
    FRAME();
    pg8::Gemm g{(const bf16_t*)(ws + P_XN), (const bf16_t*)(ws + W_MIX) + (size_t)gi * 3 * D * D, TT, 3 * D, D, D}; pg8::StaticOrder S; S.init(TT, 3 * D, G, bid_);
    pg8::EpiQKV E{(bf16_t*)(ws + P_QKV), (const f32x2*)(ws + WS_ROPE), (const float*)(ws + WS_RSX)};
    pg8::gemm_phase<pg8::EpiQKV, pg8::StaticOrder, true, true>(lds, g, S, E, tid);
}
static __device__ PHASE_ATTR void ph_g1(int jm, int round) {
    FRAME();
    pg8::Gemm g{(const bf16_t*)(ws + P_MIX), (const bf16_t*)(ws + (round ? W_G2 : W_MIX)), TT, round ? NG2 : NG1, D, D, (size_t)192 * MiB, round ? 1 : 8, round ? 2 : 16};
    pg8::StaticOrder S; S.init(TT, round ? NG2 : NG1, G, bid_);
    pg8::EpiG1 E{ws, P_R, (jm == 0 ? WS_VF : P_V), P_HID, round};
    pg8::gemm_phase<pg8::EpiG1, pg8::StaticOrder, true, true>(lds, g, S, E, tid);
}
static __device__ PHASE_ATTR void ph_gv(int jm) {
    FRAME();
    pg8::Gemm g{(const bf16_t*)(ws + P_HID) + 768, (const bf16_t*)(ws + W_GV), TT, D, 256, HID}; pg8::StaticOrder S; S.init(TT, D, G, bid_);
    pg8::EpiVres E{(bf16_t*)(ws + P_V), (const bf16_t*)(ws + WS_VF), inp(15) + (size_t)(jm - 1) * D};
    pg8::gemm_phase<pg8::EpiVres, pg8::StaticOrder, true, true>(lds, g, S, E, tid);
}
static __device__ PHASE_ATTR void ph_gg() {
    FRAME();
    pg8::Gemm g{(const bf16_t*)(ws + P_HID) + 512, (const bf16_t*)(ws + W_GG), TT, D, 256, HID}; pg8::StaticOrder S; S.init(TT, D, G, bid_);
    pg8::EpiGmul E{(bf16_t*)(ws + P_YF)};
    pg8::gemm_phase<pg8::EpiGmul, pg8::StaticOrder, true, true>(lds, g, S, E, tid);
}

static __device__ PHASE_ATTR void ph_mix(int jm, int round) {
    FRAME();
    const bf16_t* XB = (const bf16_t*)(ws + P_XN); const float* RSX = (const float*)(ws + WS_RSX); bf16_t* MX = (bf16_t*)(ws + P_MIX);
    const float* mu = inp(7) + (size_t)jm * 6 * D; const float* gpre = inp(2) + (size_t)((2 * jm) * 3 + 1) * D;
    const int m0 = round ? 1 : 0, m1 = round ? 4 : 2, m2 = round ? 5 : 3;
    u32x4 cq[4], pq[4], nq[4]; float rcq, rpq, rnq;
#define MIX_LOAD(row_) do { const int r_ = (row_); int base_, pos_, len_; row_decode(r_, base_, pos_, len_); const bf16_t* a_ = XB + (size_t)r_ * D; \
        rcq = RSX[r_]; rpq = pos_ > 0 ? RSX[r_ - 1] : 0.f; rnq = pos_ < len_ - 1 ? RSX[r_ + 1] : 0.f; \
        _Pragma("unroll") for (int i = 0; i < 4; ++i) { const int e = 8 * (lane + 64 * i); cq[i] = *(const u32x4*)(a_ + e); pq[i] = (u32x4){0u, 0u, 0u, 0u}; nq[i] = (u32x4){0u, 0u, 0u, 0u}; \
            if (pos_ > 0) pq[i] = *(const u32x4*)(a_ - D + e); if (pos_ < len_ - 1) nq[i] = *(const u32x4*)(a_ + D + e); } } while (0)
    int row = gw;
    if (row < TT) MIX_LOAD(row);
    for (; row < TT; row += NGW) {
        u32x4 cc[4], pc[4], nc[4];
#pragma unroll
        for (int i = 0; i < 4; ++i) { cc[i] = cq[i]; pc[i] = pq[i]; nc[i] = nq[i]; }
        const float rc = rcq, rp = rpq, rn = rnq;
        if (row + NGW < TT) MIX_LOAD(row + NGW);
#pragma unroll
        for (int i = 0; i < 4; ++i) { const int e = 8 * (lane + 64 * i);
            const unsigned cw[4] = {cc[i].x, cc[i].y, cc[i].z, cc[i].w}, pw[4] = {pc[i].x, pc[i].y, pc[i].z, pc[i].w}, nw[4] = {nc[i].x, nc[i].y, nc[i].z, nc[i].w};
            const f32x4 ga = *(const f32x4*)(gpre + e), gb = *(const f32x4*)(gpre + e + 4);
            float cv[8], xx[8];
#pragma unroll
            for (int j = 0; j < 4; ++j) { const float g0 = j < 2 ? ga[2 * j] : gb[2 * j - 4], g1 = j < 2 ? ga[2 * j + 1] : gb[2 * j - 3];
                cv[2 * j] = bflo(cw[j]) * rc * g0; cv[2 * j + 1] = bfhi(cw[j]) * rc * g1;
                xx[2 * j] = 0.5f * (bflo(pw[j]) * rp + bflo(nw[j]) * rn) * g0 - cv[2 * j]; xx[2 * j + 1] = 0.5f * (bfhi(pw[j]) * rp + bfhi(nw[j]) * rn) * g1 - cv[2 * j + 1]; }
#pragma unroll
            for (int m = 0; m < 3; ++m) { const int mi = m == 0 ? m0 : (m == 1 ? m1 : m2);
                const f32x4 ma = *(const f32x4*)(mu + mi * D + e), mb = *(const f32x4*)(mu + mi * D + e + 4);
                const u32x4 o = {pk2(cv[0] + xx[0] * ma[0], cv[1] + xx[1] * ma[1]), pk2(cv[2] + xx[2] * ma[2], cv[3] + xx[3] * ma[3]), pk2(cv[4] + xx[4] * mb[0], cv[5] + xx[5] * mb[1]), pk2(cv[6] + xx[6] * mb[2], cv[7] + xx[7] * mb[3])};
                *(u32x4*)(MX + (size_t)m * TT * D + (size_t)row * D + e) = o; }
        }
    }
#undef MIX_LOAD
}

static __device__ __forceinline__ void scan_stage_e(LAS unsigned char* lds, f32x4 (&ST)[4], const int lane, const int vb) {
    constexpr int RS = 72;
    LAS bf16_t* AH = (LAS bf16_t*)(lds); LAS bf16_t* RH = (LAS bf16_t*)(lds + 9216); LAS bf16_t* BT = (LAS bf16_t*)(lds + 36864); LAS bf16_t* YS = (LAS bf16_t*)(lds + 64512);
    LAS unsigned char* KVI = lds + 73728; LAS unsigned char* MAKV = lds + 90112; LAS unsigned char* NRKV = lds + 98304;
    LAS unsigned char* MABF = lds + 108544; LAS unsigned char* NRBF = lds + 112640; LAS bf16_t* TTI = (LAS bf16_t*)(lds + 122880); LAS float* GL = (LAS float*)(lds + 125440);
    const int c15 = lane & 15, g = lane >> 4; const f32x4 zero4 = {0.f, 0.f, 0.f, 0.f};
#define PK_LO(x) __builtin_bit_cast(bf16x8, (u32x4){pk2((x)[0], (x)[1]), pk2((x)[2], (x)[3]), 0u, 0u})
#define PK_2(x, y) __builtin_bit_cast(bf16x8, (u32x4){pk2((x)[0], (x)[1]), pk2((x)[2], (x)[3]), pk2((y)[0], (y)[1]), pk2((y)[2], (y)[3])})
#define ROWFRAG(P) __builtin_bit_cast(bf16x8, (u32x4){(P)[0].x, (P)[0].y, (P)[1].x, (P)[1].y})
                u32x2 ahq[4][4], mkq[4];
#pragma unroll
                for (int tb = 0; tb < 4; ++tb) { const LAS bf16_t* ap = AH + (16 * tb + c15) * RS + 4 * g;
#pragma unroll
                    for (int q = 0; q < 4; ++q) ahq[tb][q] = *(const LAS u32x2*)(ap + 16 * q);
                    mkq[tb] = *(const LAS u32x2*)(MAKV + ((tb * 4 + vb) * 64 + lane) * 8); }
                const u32x4 Sf0 = {pk2(ST[0][0], ST[0][1]), pk2(ST[0][2], ST[0][3]), pk2(ST[1][0], ST[1][1]), pk2(ST[1][2], ST[1][3])};
                const u32x4 Sf1 = {pk2(ST[2][0], ST[2][1]), pk2(ST[2][2], ST[2][3]), pk2(ST[3][0], ST[3][1]), pk2(ST[3][2], ST[3][3])};
                __builtin_amdgcn_sched_barrier(0);
                u32x2 tfq[4]; bf16x8 mf[4];
#pragma unroll
                for (int tb = 0; tb < 4; ++tb) { tfq[tb] = *(const LAS u32x2*)(TTI + (tb * 16 + c15) * 20 + 4 * g); mf[tb] = *(const LAS bf16x8*)(MABF + (tb * 64 + lane) * 16); }
                f32x4 U[4];
#pragma unroll
                for (int tb = 0; tb < 4; ++tb) {
                    f32x4 acc = {bflo(mkq[tb].x), bfhi(mkq[tb].x), bflo(mkq[tb].y), bfhi(mkq[tb].y)};
                    acc = __builtin_amdgcn_mfma_f32_16x16x32_bf16(ROWFRAG(ahq[tb]), __builtin_bit_cast(bf16x8, Sf0), acc, 0, 0, 0);
                    acc = __builtin_amdgcn_mfma_f32_16x16x32_bf16(ROWFRAG(ahq[tb] + 2), __builtin_bit_cast(bf16x8, Sf1), acc, 0, 0, 0);
                    U[tb] = acc; }
                __builtin_amdgcn_sched_barrier(0);
                u32x2 rhq[4][4], nkq[4];
#pragma unroll
                for (int tb = 0; tb < 4; ++tb) { const LAS bf16_t* rp = RH + (16 * tb + c15) * RS + 4 * g;
#pragma unroll
                    for (int q = 0; q < 4; ++q) rhq[tb][q] = *(const LAS u32x2*)(rp + 16 * q);
                    nkq[tb] = *(const LAS u32x2*)(NRKV + ((tb * 4 + vb) * 64 + lane) * 8); }
                f32x4 Y1[4];
#pragma unroll
                for (int tb = 0; tb < 4; ++tb) {
                    f32x4 acy = {bflo(nkq[tb].x), bfhi(nkq[tb].x), bflo(nkq[tb].y), bfhi(nkq[tb].y)};
                    acy = __builtin_amdgcn_mfma_f32_16x16x32_bf16(ROWFRAG(rhq[tb]), __builtin_bit_cast(bf16x8, Sf0), acy, 0, 0, 0);
                    acy = __builtin_amdgcn_mfma_f32_16x16x32_bf16(ROWFRAG(rhq[tb] + 2), __builtin_bit_cast(bf16x8, Sf1), acy, 0, 0, 0);
                    Y1[tb] = acy; }
                const bf16x8 tf0 = __builtin_bit_cast(bf16x8, (u32x4){tfq[0].x, tfq[0].y, 0u, 0u}), tf1 = __builtin_bit_cast(bf16x8, (u32x4){tfq[1].x, tfq[1].y, 0u, 0u});
                const bf16x8 tf2 = __builtin_bit_cast(bf16x8, (u32x4){tfq[2].x, tfq[2].y, 0u, 0u}), tf3 = __builtin_bit_cast(bf16x8, (u32x4){tfq[3].x, tfq[3].y, 0u, 0u});
                f32x4 SA0 = __builtin_amdgcn_mfma_f32_16x16x32_bf16(tf0, PK_LO(U[0]), zero4, 0, 0, 0);
                f32x4 rhs = __builtin_amdgcn_mfma_f32_16x16x32_bf16(mf[0], PK_LO(SA0), U[1], 0, 0, 0);
                f32x4 SA1 = __builtin_amdgcn_mfma_f32_16x16x32_bf16(tf1, PK_LO(rhs), zero4, 0, 0, 0);
                const bf16x8 SAf0 = PK_2(SA0, SA1);
                rhs = __builtin_amdgcn_mfma_f32_16x16x32_bf16(mf[1], SAf0, U[2], 0, 0, 0);
                f32x4 SA2 = __builtin_amdgcn_mfma_f32_16x16x32_bf16(tf2, PK_LO(rhs), zero4, 0, 0, 0);
                rhs = __builtin_amdgcn_mfma_f32_16x16x32_bf16(mf[2], SAf0, U[3], 0, 0, 0);
                rhs = __builtin_amdgcn_mfma_f32_16x16x32_bf16(mf[3], PK_LO(SA2), rhs, 0, 0, 0);
                f32x4 SA3 = __builtin_amdgcn_mfma_f32_16x16x32_bf16(tf3, PK_LO(rhs), zero4, 0, 0, 0);
                const bf16x8 SAf1 = PK_2(SA2, SA3);
                __builtin_amdgcn_sched_barrier(0);
                bf16x8 nrf[6];
#pragma unroll
                for (int i = 0; i < 6; ++i) nrf[i] = *(const LAS bf16x8*)(NRBF + (i * 64 + lane) * 16);
                f32x4 kvq[4], glq[4]; u32x2 btq[4][4];
#pragma unroll
                for (int kb = 0; kb < 4; ++kb) { const LAS bf16_t* bp = BT + (16 * kb + c15) * RS + 4 * g;
#pragma unroll
                    for (int q = 0; q < 4; ++q) btq[kb][q] = *(const LAS u32x2*)(bp + 16 * q);
                    kvq[kb] = *(const LAS f32x4*)(KVI + ((kb * 4 + vb) * 64 + lane) * 16); glq[kb] = *(const LAS f32x4*)(GL + 16 * kb + 4 * g); }
#pragma unroll
                for (int tb = 0; tb < 4; ++tb) { const int nb = tb == 0 ? 0 : (tb == 1 ? 1 : (tb == 2 ? 2 : 4));
                    f32x4 acc = __builtin_amdgcn_mfma_f32_16x16x32_bf16(nrf[nb], SAf0, Y1[tb], 0, 0, 0);
                    if (tb >= 2) acc = __builtin_amdgcn_mfma_f32_16x16x32_bf16(nrf[nb + 1], SAf1, acc, 0, 0, 0);
#pragma unroll
                    for (int r = 0; r < 4; ++r) YS[(16 * tb + 4 * g + r) * RS + 16 * vb + c15] = (bf16_t)(pk2(acc[r], 0.f) & 0xffffu); }
#pragma unroll
                for (int kb = 0; kb < 4; ++kb) { f32x4 acc = kvq[kb];
                    acc = __builtin_amdgcn_mfma_f32_16x16x32_bf16(ROWFRAG(btq[kb]), SAf0, acc, 0, 0, 0);
                    acc = __builtin_amdgcn_mfma_f32_16x16x32_bf16(ROWFRAG(btq[kb] + 2), SAf1, acc, 0, 0, 0);
                    ST[kb] = glq[kb] * (ST[kb] + acc); }
#undef ROWFRAG
#undef PK_LO
#undef PK_2
}

template <int CTRL> __device__ __forceinline__ float dpp_row_shr(float v) { return __builtin_bit_cast(float, __builtin_amdgcn_update_dpp(0, __builtin_bit_cast(int, v), CTRL, 0xf, 0xf, true)); }
static __device__ PHASE_ATTR void ph_scan(int jm) {
    FRAME();
    const bf16_t* Rb = (const bf16_t*)(ws + P_R); const bf16_t* Kb = (const bf16_t*)(ws + P_K); const bf16_t* Vb = (const bf16_t*)(ws + (jm == 0 ? WS_VF : P_V));
    const bf16_t* Hd = (const bf16_t*)(ws + P_HID); float* BS = (float*)(ws + P_BS);
    constexpr int RS = 72;
    LAS bf16_t* AH = (LAS bf16_t*)(lds); LAS bf16_t* RH = (LAS bf16_t*)(lds + 9216); LAS bf16_t* BH = (LAS bf16_t*)(lds + 18432); LAS bf16_t* KH = (LAS bf16_t*)(lds + 27648);
    LAS bf16_t* BT = (LAS bf16_t*)(lds + 36864); LAS bf16_t* KT = (LAS bf16_t*)(lds + 46080); LAS bf16_t* VT = (LAS bf16_t*)(lds + 55296); LAS bf16_t* YS = (LAS bf16_t*)(lds + 64512);
    LAS unsigned char* KVI = lds + 73728; LAS unsigned char* MAKV = lds + 90112; LAS unsigned char* NRKV = lds + 98304;
    LAS float* SEG = (LAS float*)(lds + 106496); LAS float* NRM = (LAS float*)(lds + 107520); LAS float* BON = (LAS float*)(lds + 108032);
    LAS unsigned char* MABF = lds + 108544; LAS unsigned char* NRBF = lds + 112640;
    LAS float* MS = (LAS float*)(lds + 118784); LAS bf16_t* TTI = (LAS bf16_t*)(lds + 122880);
    LAS float* GL = (LAS float*)(lds + 125440); LAS float* PAR = (LAS float*)(lds + 125696);
    LAS unsigned char* W2F = lds + 147456;
    LAS unsigned char* A2F = lds + 126976;
    const int c15 = lane & 15, g = lane >> 4;
    const int tbq = wave & 3, half = wave >> 2;
    const int tF = tid >> 3, c8 = tid & 7;
    const int tbD = wave & 3, kindD = wave >> 2;
    const f32x4 zero4 = {0.f, 0.f, 0.f, 0.f};
    for (int it = bid_; it < 256; it += G) {
        const int seq = it & 3, head = (it >> 2) & 31, dir = it >> 7;
        const bool split = (G == 256);
        const bool helper = split && seq >= 2;
        const int pair = (seq & 1) | (head << 1) | (dir << 6);
        unsigned* flag = (unsigned*)(ws + WS_SCANFLAG + (size_t)jm * 8192 + (size_t)pair * 64);
#pragma unroll 1
        for (int pass = helper ? 0 : 1; pass < 2; ++pass) {
        __syncthreads();
        if (tid < 64) { const int c = head * 64 + tid;
            PAR[tid] = inp(9)[(size_t)(jm * 2 + dir) * D + c]; PAR[64 + tid] = inp(12)[(size_t)(jm * 2 + dir) * D + c];
            PAR[128 + tid] = inp(20)[(size_t)jm * D + c]; PAR[192 + tid] = inp(21)[(size_t)jm * D + c]; PAR[256 + tid] = inp(22)[(size_t)jm * D + c]; }
        int lane_s = lane; asm volatile("" : "+v"(lane_s));
        const int c15s = lane_s & 15, gs = lane_s >> 4;
#pragma unroll
        for (int kind = 0; kind < 2; ++kind)
#pragma unroll
            for (int cbi = 0; cbi < 2; ++cbi) { const float* M = (kind == 0 ? inp(11) : inp(14)) + (size_t)(jm * 2 + dir) * 96 * D + head * 64;
                const unsigned mo = (unsigned)(8 * gs * D + 16 * (2 * half + cbi) + c15s);
#pragma unroll
                for (int ks = 0; ks < 3; ++ks) { float x[8];
#pragma unroll
                    for (int j = 0; j < 8; ++j) x[j] = M[mo + (unsigned)((32 * ks + j) * D)];
                    const u32x4 w = {pk2(x[0], x[1]), pk2(x[2], x[3]), pk2(x[4], x[5]), pk2(x[6], x[7])};
                    *(LAS u32x4*)((kind == 0 ? W2F : A2F) + (((half * 2 + cbi) * 3 + ks) * 64 + lane_s) * 16) = w; }
                __builtin_amdgcn_sched_barrier(0); }
        bf16_t* yd = (bf16_t*)(ws + (dir ? P_YB : P_YF));
        const int cofs = head * 64 + 32 * half + 4 * g;
        bf16x8 hwf[3], haf[3]; u32x2 rq[2], kq[2], vq[2];
#define SCAN_PREFETCH(chunk_) do { const int st_ = (chunk_) * 64 + 16 * tbq + c15; const size_t row_ = (size_t)(base + (dir ? (len - 1 - st_) : st_)); \
            const bf16_t* hp_ = Hd + row_ * HID + dir * 128 + 8 * g; \
            _Pragma("unroll") for (int ks = 0; ks < 3; ++ks) { hwf[ks] = *(const bf16x8*)(hp_ + 32 * ks); haf[ks] = *(const bf16x8*)(hp_ + 256 + 32 * ks); } \
            _Pragma("unroll") for (int cbi = 0; cbi < 2; ++cbi) { rq[cbi] = *(const u32x2*)(Rb + row_ * D + cofs + 16 * cbi); kq[cbi] = *(const u32x2*)(Kb + row_ * D + cofs + 16 * cbi); vq[cbi] = *(const u32x2*)(Vb + row_ * D + cofs + 16 * cbi); } } while (0)
        const int sq = pass ? seq : seq - 2; const bool pre = (pass == 0);
        const int base = sq < 2 ? sq * 16384 : 32768 + (sq - 2) * 8192, len = sq < 2 ? 16384 : 8192;
        const int nch = len >> 6;
        const int c0 = pre ? nch - SCAN_NH : 0;
        const int cfull = (split && !pre && sq < 2) ? nch - SCAN_NH : nch;
        f32x4 ST[4] = {zero4, zero4, zero4, zero4};
        SCAN_PREFETCH(c0);
        __syncthreads();
#pragma unroll 1
        for (int chunk = c0; chunk < cfull; ++chunk) {
            int tid_o = tid; asm volatile("" : "+v"(tid_o));
            const int lane = tid_o & 63, c15 = lane & 15, g = lane >> 4, tF = tid_o >> 3, c8 = tid_o & 7;
            const int cofs = head * 64 + 32 * half + 4 * g;
            const int tq = 16 * tbq + c15;
            const int stq = chunk * 64 + tq; const size_t rowq = (size_t)(base + (dir ? (len - 1 - stq) : stq));
            float r8[8], lw8[8], asg[8], kkr[8], kd8[8], pfx[8]; u32x2 vkeep[2];
            {
                f32x4 accw[2] = {zero4, zero4}, acca[2] = {zero4, zero4};
#pragma unroll
                for (int cbi = 0; cbi < 2; ++cbi)
#pragma unroll
                    for (int ks = 0; ks < 3; ++ks) { accw[cbi] = __builtin_amdgcn_mfma_f32_16x16x32_bf16(*(const LAS bf16x8*)(W2F + (((half * 2 + cbi) * 3 + ks) * 64 + lane) * 16), hwf[ks], accw[cbi], 0, 0, 0); acca[cbi] = __builtin_amdgcn_mfma_f32_16x16x32_bf16(*(const LAS bf16x8*)(A2F + (((half * 2 + cbi) * 3 + ks) * 64 + lane) * 16), haf[ks], acca[cbi], 0, 0, 0); }
                float k8[8]; float ss = 0.f, bon = 0.f;
#pragma unroll
                for (int cbi = 0; cbi < 2; ++cbi) { const int cl = 32 * half + 16 * cbi + 4 * g;
                    const f32x4 w0v = *(const LAS f32x4*)(PAR + cl), a0v = *(const LAS f32x4*)(PAR + 64 + cl), kkv = *(const LAS f32x4*)(PAR + 128 + cl), kav = *(const LAS f32x4*)(PAR + 192 + cl), rkv = *(const LAS f32x4*)(PAR + 256 + cl);
                    const unsigned rw2[2] = {rq[cbi].x, rq[cbi].y}, kw2[2] = {kq[cbi].x, kq[cbi].y}; vkeep[cbi] = vq[cbi];
#pragma unroll
                    for (int r = 0; r < 4; ++r) { const int e = 4 * cbi + r;
                        r8[e] = (r & 1) ? bfhi(rw2[r >> 1]) : bflo(rw2[r >> 1]); k8[e] = (r & 1) ? bfhi(kw2[r >> 1]) : bflo(kw2[r >> 1]);
                        const float wr = w0v[r] + accw[cbi][r], ar = a0v[r] + acca[cbi][r];
                        const float z = -wr; const float sp = fmaxf(z, 0.f) + __logf(1.0f + __expf(-fabsf(z)));
                        lw8[e] = -__expf(-sp - 0.5f);
                        asg[e] = __builtin_amdgcn_rcpf(1.0f + __expf(-ar)); kkr[e] = k8[e] * kkv[r]; ss += kkr[e] * kkr[e];
                        kd8[e] = k8[e] * (1.0f + (asg[e] - 1.0f) * kav[r]); bon += r8[e] * kd8[e] * rkv[r]; } }
                ss += __shfl_xor(ss, 16); ss += __shfl_xor(ss, 32); bon += __shfl_xor(bon, 16); bon += __shfl_xor(bon, 32);
                if (g == 0) { NRM[half * 64 + tq] = ss; BON[half * 64 + tq] = bon; }
#pragma unroll
                for (int e = 0; e < 8; ++e) { float x = lw8[e]; x += dpp_row_shr<0x111>(x); x += dpp_row_shr<0x112>(x); x += dpp_row_shr<0x114>(x); x += dpp_row_shr<0x118>(x); pfx[e] = x; }
                if (c15 == 15) { *(LAS f32x4*)(SEG + tbq * 64 + 32 * half + 4 * g) = (f32x4){pfx[0], pfx[1], pfx[2], pfx[3]}; *(LAS f32x4*)(SEG + tbq * 64 + 32 * half + 16 + 4 * g) = (f32x4){pfx[4], pfx[5], pfx[6], pfx[7]}; }
            }
            if (chunk > c0 && !pre) { const int st = (chunk - 1) * 64 + tF; const int p = dir ? (len - 1 - st) : st;
                *(u32x4*)(yd + (size_t)(base + p) * D + head * 64 + 8 * c8) = *(const LAS u32x4*)(YS + tF * RS + 8 * c8); }
            __syncthreads();
            {
                f32x4 of0 = zero4, of1 = zero4;
                for (int s = 0; s < tbq; ++s) { of0 += *(const LAS f32x4*)(SEG + s * 64 + 32 * half + 4 * g); of1 += *(const LAS f32x4*)(SEG + s * 64 + 32 * half + 16 + 4 * g); }
                const float inv = __builtin_amdgcn_rcpf(fmaxf(sqrtf(NRM[tq] + NRM[64 + tq]), 1e-12f));
                if (half == 0 && g == 0) BS[((size_t)dir * TT + rowq) * 32 + head] = BON[tq] + BON[64 + tq];
#pragma unroll
                for (int cbi = 0; cbi < 2; ++cbi) { const int cl = 32 * half + 16 * cbi + 4 * g; float ah[4], bh[4], kh[4], rh[4];
#pragma unroll
                    for (int r = 0; r < 4; ++r) { const int e = 4 * cbi + r; const float lg = pfx[e] + (cbi ? of1[r] : of0[r]); const float lm = lg - lw8[e];
                        const float e1 = __expf(lg), e2 = __builtin_amdgcn_rcpf(e1), e3 = __expf(lm); const float kk = kkr[e] * inv;
                        ah[r] = -kk * e3; bh[r] = kk * asg[e] * e2; kh[r] = kd8[e] * e2; rh[r] = r8[e] * e1; }
                    const u32x2 aw = {pk2(ah[0], ah[1]), pk2(ah[2], ah[3])}, bw = {pk2(bh[0], bh[1]), pk2(bh[2], bh[3])}, kw = {pk2(kh[0], kh[1]), pk2(kh[2], kh[3])}, rw = {pk2(rh[0], rh[1]), pk2(rh[2], rh[3])};
                    *(LAS u32x2*)(AH + tq * RS + cl) = aw; *(LAS u32x2*)(BH + tq * RS + cl) = bw; *(LAS u32x2*)(KH + tq * RS + cl) = kw; *(LAS u32x2*)(RH + tq * RS + cl) = rw;
                    const unsigned bww[2] = {bw.x, bw.y}, kww[2] = {kw.x, kw.y}, vww[2] = {vkeep[cbi].x, vkeep[cbi].y};
#pragma unroll
                    for (int r = 0; r < 4; ++r) { BT[(cl + r) * RS + tq] = (bf16_t)((r & 1) ? (bww[r >> 1] >> 16) : (bww[r >> 1] & 0xffffu)); KT[(cl + r) * RS + tq] = (bf16_t)((r & 1) ? (kww[r >> 1] >> 16) : (kww[r >> 1] & 0xffffu));
                        VT[(cl + r) * RS + tq] = (bf16_t)((r & 1) ? (vww[r >> 1] >> 16) : (vww[r >> 1] & 0xffffu)); }
                    if (tq == 63) *(LAS f32x4*)(GL + cl) = (f32x4){__expf(pfx[4 * cbi] + (cbi ? of1[0] : of0[0])), __expf(pfx[4 * cbi + 1] + (cbi ? of1[1] : of0[1])), __expf(pfx[4 * cbi + 2] + (cbi ? of1[2] : of0[2])), __expf(pfx[4 * cbi + 3] + (cbi ? of1[3] : of0[3]))}; }
            }
            __syncthreads();
            {
                const int tloc = c15;
                if (kindD == 0) {
                    bf16x8 bfA[2];
#pragma unroll
                    for (int ks = 0; ks < 2; ++ks) bfA[ks] = *(const LAS bf16x8*)(AH + (16 * tbD + c15) * RS + 32 * ks + 8 * g);
                    f32x4 GT1[4] = {zero4, zero4, zero4, zero4};
#pragma unroll
                    for (int ib = 0; ib < 4; ++ib) if (ib <= tbD) {
                        f32x4 a1 = zero4;
#pragma unroll
                        for (int ks = 0; ks < 2; ++ks) a1 = __builtin_amdgcn_mfma_f32_16x16x32_bf16(*(const LAS bf16x8*)(BH + (16 * ib + c15) * RS + 32 * ks + 8 * g), bfA[ks], a1, 0, 0, 0);
                        if (ib == tbD) {
#pragma unroll
                            for (int r = 0; r < 4; ++r) if (!(4 * g + r < tloc)) a1[r] = 0.f; }
                        GT1[ib] = a1;
                    }
                    const f32x4 m1 = (tbD >= 2) ? GT1[1] : zero4, m2 = (tbD == 3) ? GT1[2] : zero4;
                    const u32x4 F01 = {pk2(GT1[0][0], GT1[0][1]), pk2(GT1[0][2], GT1[0][3]), pk2(m1[0], m1[1]), pk2(m1[2], m1[3])};
                    const u32x4 F23 = {pk2(m2[0], m2[1]), pk2(m2[2], m2[3]), 0u, 0u};
                    if (tbD == 1) *(LAS u32x4*)(MABF + (0 * 64 + lane) * 16) = F01;
                    if (tbD == 2) *(LAS u32x4*)(MABF + (1 * 64 + lane) * 16) = F01;
                    if (tbD == 3) { *(LAS u32x4*)(MABF + (2 * 64 + lane) * 16) = F01; *(LAS u32x4*)(MABF + (3 * 64 + lane) * 16) = F23; }
                    f32x4 dg = GT1[0]; dg = (tbD == 1) ? GT1[1] : dg; dg = (tbD == 2) ? GT1[2] : dg; dg = (tbD == 3) ? GT1[3] : dg;
                    *(LAS f32x4*)(MS + (tbD * 16 + c15) * 16 + 4 * g) = dg;
                    asm volatile("s_waitcnt lgkmcnt(0)" ::: "memory");
                    const int lane_o = lane;
                    if (lane < 16) { float x[16];
#pragma unroll
                        for (int t = 0; t < 16; ++t) { const LAS f32x4* mr = (const LAS f32x4*)(MS + (tbD * 16 + t) * 16); float s = (t == lane_o) ? 1.0f : 0.0f;
#pragma unroll
                            for (int i4 = 0; i4 < (t + 3) / 4; ++i4) { const f32x4 m = mr[i4];
#pragma unroll
                                for (int q = 0; q < 4; ++q) if (4 * i4 + q < t) s += m[q] * x[4 * i4 + q]; }
                            x[t] = s; }
#pragma unroll
                        for (int t = 0; t < 16; ++t) TTI[(tbD * 16 + t) * 20 + lane] = (bf16_t)(pk2(x[t], 0.f) & 0xffffu); }
                } else {
                    bf16x8 bfR[2], bfA[2];
#pragma unroll
                    for (int ks = 0; ks < 2; ++ks) { bfR[ks] = *(const LAS bf16x8*)(RH + (16 * tbD + c15) * RS + 32 * ks + 8 * g); bfA[ks] = *(const LAS bf16x8*)(AH + (16 * tbD + c15) * RS + 32 * ks + 8 * g); }
                    f32x4 GT1[4] = {zero4, zero4, zero4, zero4}, GT2[4] = {zero4, zero4, zero4, zero4}, GT3[4] = {zero4, zero4, zero4, zero4};
#pragma unroll
                    for (int ib = 0; ib < 4; ++ib) if (ib <= tbD) {
                        f32x4 a1 = zero4, a2 = zero4, a3 = zero4;
#pragma unroll
                        for (int ks = 0; ks < 2; ++ks) { const bf16x8 f1 = *(const LAS bf16x8*)(BH + (16 * ib + c15) * RS + 32 * ks + 8 * g), f2 = *(const LAS bf16x8*)(KH + (16 * ib + c15) * RS + 32 * ks + 8 * g);
                            a1 = __builtin_amdgcn_mfma_f32_16x16x32_bf16(f1, bfR[ks], a1, 0, 0, 0); a2 = __builtin_amdgcn_mfma_f32_16x16x32_bf16(f2, bfR[ks], a2, 0, 0, 0); a3 = __builtin_amdgcn_mfma_f32_16x16x32_bf16(f2, bfA[ks], a3, 0, 0, 0); }
                        if (ib == tbD) {
#pragma unroll
                            for (int r = 0; r < 4; ++r) { const int il = 4 * g + r; if (!(il <= tloc)) { a1[r] = 0.f; a2[r] = 0.f; } if (!(il < tloc)) a3[r] = 0.f; } }
                        GT1[ib] = a1; GT2[ib] = a2; GT3[ib] = a3;
                    }
                    const u32x4 F01 = {pk2(GT1[0][0], GT1[0][1]), pk2(GT1[0][2], GT1[0][3]), pk2(GT1[1][0], GT1[1][1]), pk2(GT1[1][2], GT1[1][3])};
                    const u32x4 F23 = {pk2(GT1[2][0], GT1[2][1]), pk2(GT1[2][2], GT1[2][3]), pk2(GT1[3][0], GT1[3][1]), pk2(GT1[3][2], GT1[3][3])};
                    const int nb = tbD == 0 ? 0 : (tbD == 1 ? 1 : (tbD == 2 ? 2 : 4));
                    *(LAS u32x4*)(NRBF + (nb * 64 + lane) * 16) = F01;
                    if (tbD >= 2) *(LAS u32x4*)(NRBF + ((nb + 1) * 64 + lane) * 16) = F23;
                    const u32x4 N_01 = {pk2(GT2[0][0], GT2[0][1]), pk2(GT2[0][2], GT2[0][3]), pk2(GT2[1][0], GT2[1][1]), pk2(GT2[1][2], GT2[1][3])};
                    const u32x4 N_23 = {pk2(GT2[2][0], GT2[2][1]), pk2(GT2[2][2], GT2[2][3]), pk2(GT2[3][0], GT2[3][1]), pk2(GT2[3][2], GT2[3][3])};
                    const u32x4 M_01 = {pk2(GT3[0][0], GT3[0][1]), pk2(GT3[0][2], GT3[0][3]), pk2(GT3[1][0], GT3[1][1]), pk2(GT3[1][2], GT3[1][3])};
                    const u32x4 M_23 = {pk2(GT3[2][0], GT3[2][1]), pk2(GT3[2][2], GT3[2][3]), pk2(GT3[3][0], GT3[3][1]), pk2(GT3[3][2], GT3[3][3])};
#pragma unroll
                    for (int vb = 0; vb < 4; ++vb) { const LAS bf16_t* vp = VT + (16 * vb + c15) * RS + 4 * g;
                        const u32x2 v0 = *(const LAS u32x2*)(vp), v1 = *(const LAS u32x2*)(vp + 16);
                        const bf16x8 vf01 = __builtin_bit_cast(bf16x8, (u32x4){v0.x, v0.y, v1.x, v1.y});
                        f32x4 accn = __builtin_amdgcn_mfma_f32_16x16x32_bf16(__builtin_bit_cast(bf16x8, N_01), vf01, zero4, 0, 0, 0);
                        f32x4 accm = __builtin_amdgcn_mfma_f32_16x16x32_bf16(__builtin_bit_cast(bf16x8, M_01), vf01, zero4, 0, 0, 0);
                        if (tbD >= 2) { const u32x2 v2 = *(const LAS u32x2*)(vp + 32), v3 = *(const LAS u32x2*)(vp + 48);
                            const bf16x8 vf23 = __builtin_bit_cast(bf16x8, (u32x4){v2.x, v2.y, v3.x, v3.y});
                            accn = __builtin_amdgcn_mfma_f32_16x16x32_bf16(__builtin_bit_cast(bf16x8, N_23), vf23, accn, 0, 0, 0);
                            accm = __builtin_amdgcn_mfma_f32_16x16x32_bf16(__builtin_bit_cast(bf16x8, M_23), vf23, accm, 0, 0, 0); }
                        *(LAS u32x2*)(NRKV + ((tbD * 4 + vb) * 64 + lane) * 8) = (u32x2){pk2(accn[0], accn[1]), pk2(accn[2], accn[3])};
                        *(LAS u32x2*)(MAKV + ((tbD * 4 + vb) * 64 + lane) * 8) = (u32x2){pk2(accm[0], accm[1]), pk2(accm[2], accm[3])}; }
                }
#pragma unroll
                for (int q2 = 0; q2 < 2; ++q2) { const int id = 2 * wave + q2, kb = id >> 2, vb = id & 3; f32x4 acc = zero4;
#pragma unroll
                    for (int ks = 0; ks < 2; ++ks) acc = __builtin_amdgcn_mfma_f32_16x16x32_bf16(*(const LAS bf16x8*)(KT + (16 * kb + c15) * RS + 32 * ks + 8 * g), *(const LAS bf16x8*)(VT + (16 * vb + c15) * RS + 32 * ks + 8 * g), acc, 0, 0, 0);
                    *(LAS f32x4*)(KVI + (id * 64 + lane) * 16) = acc; }
            }
            __syncthreads();
            if (chunk + 1 < cfull) SCAN_PREFETCH(chunk + 1);
            if (pre) {
                const int j = chunk - c0; const int slot = __builtin_amdgcn_readfirstlane(pair * SCAN_NH + j);
                unsigned char* dstp = slot < SCAN_SLOTS_OUT ? (unsigned char*)outp() + (size_t)slot * SCAN_SLOT : (unsigned char*)ws + WS_POOL + 576 * MiB + (size_t)(slot - SCAN_SLOTS_OUT) * SCAN_SLOT;
                const __amdgpu_buffer_rsrc_t drs = __builtin_amdgcn_make_buffer_rsrc(dstp, 0, SCAN_SLOT, 0x00020000);
#pragma unroll
                for (int q = 0; q < 9; ++q) { const int u = tid_o + 512 * q;
                    if (u < SCAN_DUMP_U) { const int off = u < 1152 ? 16 * u : (u < 1728 ? 36864 + 16 * (u - 1152) : (u < 3776 ? 73728 + 16 * (u - 1728) : (u < 4416 ? 108544 + 16 * (u - 3776) : 122880 + 16 * (u - 4416))));
                        __builtin_amdgcn_raw_buffer_store_b128(*(const LAS u32x4*)(lds + off), drs, 16 * u, 0, 16); } }
            } else {
            if (wave < 4) scan_stage_e(lds, ST, lane, wave);
            __syncthreads();
            }
        }
        if (pre) {
            asm volatile("s_waitcnt vmcnt(0)" ::: "memory");
            __syncthreads();
            if (tid == 0) __hip_atomic_store((GAS unsigned*)flag, (unsigned)SCAN_NH, __ATOMIC_RELAXED, __HIP_MEMORY_SCOPE_AGENT);
        }
        if (cfull < nch) {
            if (wave == 0) {
                while ((unsigned)__builtin_amdgcn_readfirstlane(__hip_atomic_load((GAS unsigned*)flag, __ATOMIC_RELAXED, __HIP_MEMORY_SCOPE_AGENT)) < (unsigned)SCAN_NH) __builtin_amdgcn_s_sleep(2);
                __builtin_amdgcn_fence(__ATOMIC_ACQUIRE, "agent"); }
            __syncthreads();
            u32x4 pf[9];
#define DUMP_OFF(u) ((u) < 1152 ? 16 * (u) : ((u) < 1728 ? 36864 + 16 * ((u) - 1152) : ((u) < 3776 ? 73728 + 16 * ((u) - 1728) : ((u) < 4416 ? 108544 + 16 * ((u) - 3776) : 122880 + 16 * ((u) - 4416)))))
#define DUMP_LOAD(j_) do { const int slot_ = __builtin_amdgcn_readfirstlane(pair * SCAN_NH + (j_)); \
            const u32x4* srcp_ = (const u32x4*)(slot_ < SCAN_SLOTS_OUT ? (const unsigned char*)outp() + (size_t)slot_ * SCAN_SLOT : (const unsigned char*)ws + WS_POOL + 576 * MiB + (size_t)(slot_ - SCAN_SLOTS_OUT) * SCAN_SLOT); \
            _Pragma("unroll") for (int q = 0; q < 9; ++q) { const int u = tid_p + 512 * q; if (u < SCAN_DUMP_U) pf[q] = srcp_[u]; } } while (0)
            int tid_p = tid; asm volatile("" : "+v"(tid_p));
            DUMP_LOAD(0);
#pragma unroll 1
            for (int chunk = cfull; chunk < nch; ++chunk) {
                int tid_o = tid; asm volatile("" : "+v"(tid_o));
                const int tF = tid_o >> 3, c8 = tid_o & 7; const int tid_p = tid_o;
#pragma unroll
                for (int q = 0; q < 9; ++q) { const int u = tid_o + 512 * q; if (u < SCAN_DUMP_U) *(LAS u32x4*)(lds + DUMP_OFF(u)) = pf[q]; }
                { const int st = (chunk - 1) * 64 + tF; const int p = dir ? (len - 1 - st) : st;
                  *(u32x4*)(yd + (size_t)(base + p) * D + head * 64 + 8 * c8) = *(const LAS u32x4*)(YS + tF * RS + 8 * c8); }
                __syncthreads();
                if (chunk + 1 < nch) DUMP_LOAD(chunk + 1 - cfull);
                if (wave < 4) scan_stage_e(lds, ST, tid_o & 63, wave);
                __syncthreads();
            }
#undef DUMP_LOAD
#undef DUMP_OFF
        }
        if (!pre) { const int tF = tid >> 3, c8 = tid & 7; const int st = (nch - 1) * 64 + tF; const int p = dir ? (len - 1 - st) : st;
          *(u32x4*)(yd + (size_t)(base + p) * D + head * 64 + 8 * c8) = *(const LAS u32x4*)(YS + tF * RS + 8 * c8); }
        }
#undef SCAN_PREFETCH
    }
}

static __device__ PHASE_ATTR void ph_fin(int jm) {
    FRAME();
    bf16_t* YF = (bf16_t*)(ws + P_YF); const bf16_t* YB = (const bf16_t*)(ws + P_YB); const bf16_t* Vb = (const bf16_t*)(ws + (jm == 0 ? WS_VF : P_V)); const float* BS = (const float*)(ws + P_BS);
    const float* gnw = inp(23) + (size_t)jm * D; const float* gnb = inp(24) + (size_t)jm * D;
    u32x4 aq[4], bq[4], vq4[4]; float b0q[4], b1q[4];
#define FIN_LOAD(row_) do { const size_t r_ = (size_t)(row_); \
        _Pragma("unroll") for (int i = 0; i < 4; ++i) { const int e = 8 * (lane + 64 * i); aq[i] = *(const u32x4*)(YF + r_ * D + e); bq[i] = *(const u32x4*)(YB + r_ * D + e); vq4[i] = *(const u32x4*)(Vb + r_ * D + e); \
            b0q[i] = BS[r_ * 32 + (e >> 6)]; b1q[i] = BS[((size_t)TT + r_) * 32 + (e >> 6)]; } } while (0)
    int row = gw;
    if (row < TT) FIN_LOAD(row);
    for (; row < TT; row += NGW) {
        u32x4 ac[4], bc[4], vc[4]; float b0c[4], b1c[4];
#pragma unroll
        for (int i = 0; i < 4; ++i) { ac[i] = aq[i]; bc[i] = bq[i]; vc[i] = vq4[i]; b0c[i] = b0q[i]; b1c[i] = b1q[i]; }
        if (row + NGW < TT) FIN_LOAD(row + NGW);
#pragma unroll
        for (int i = 0; i < 4; ++i) { const int e = 8 * (lane + 64 * i);
            const unsigned aw[4] = {ac[i].x, ac[i].y, ac[i].z, ac[i].w}, bw[4] = {bc[i].x, bc[i].y, bc[i].z, bc[i].w}, vw[4] = {vc[i].x, vc[i].y, vc[i].z, vc[i].w};
            float y[8], v8[8]; float s = 0.f;
#pragma unroll
            for (int j = 0; j < 4; ++j) { y[2 * j] = bflo(aw[j]) + bflo(bw[j]); y[2 * j + 1] = bfhi(aw[j]) + bfhi(bw[j]); v8[2 * j] = bflo(vw[j]); v8[2 * j + 1] = bfhi(vw[j]); s += y[2 * j] + y[2 * j + 1]; }
            s += __shfl_xor(s, 1); s += __shfl_xor(s, 2); s += __shfl_xor(s, 4);
            const float mean = s * (1.0f / 64.0f); float q = 0.f;
#pragma unroll
            for (int j = 0; j < 8; ++j) { y[j] -= mean; q += y[j] * y[j]; }
            q += __shfl_xor(q, 1); q += __shfl_xor(q, 2); q += __shfl_xor(q, 4);
            const float rstd = rsqrtf(q * (1.0f / 64.0f) + GN_EPS);
            const float bonus = 0.5f * (b0c[i] + b1c[i]);
            const f32x4 w0 = *(const f32x4*)(gnw + e), w1 = *(const f32x4*)(gnw + e + 4), c0 = *(const f32x4*)(gnb + e), c1 = *(const f32x4*)(gnb + e + 4);
            float o[8];
#pragma unroll
            for (int j = 0; j < 8; ++j) o[j] = y[j] * rstd * (j < 4 ? w0[j] : w1[j - 4]) + (j < 4 ? c0[j] : c1[j - 4]) + bonus * v8[j];
            *(u32x4*)(YF + (size_t)row * D + e) = (u32x4){pk2(o[0], o[1]), pk2(o[2], o[3]), pk2(o[4], o[5]), pk2(o[6], o[7])}; }
    }
#undef FIN_LOAD
}

typedef short v4i16_t __attribute__((ext_vector_type(4)));
struct AttItem { int base, h, c, b0, Lc; };
__device__ __forceinline__ AttItem att_decode(int pair, int dsh) {
    const int it = pair * 2; int seq, h, cb, S_len;
    if (it < 8192) { seq = it >> 12; h = (it >> 8) & 15; cb = it & 255; S_len = 16384; }
    else { const int i2 = it - 8192; seq = 2 + (i2 >> 11); h = (i2 >> 7) & 15; cb = i2 & 127; S_len = 8192; }
    AttItem a; a.base = seq < 2 ? seq * 16384 : 32768 + (seq - 2) * 8192; a.h = h; a.Lc = S_len >> dsh; const int nb = a.Lc >> 6; a.c = cb / nb; a.b0 = cb % nb; return a;
}
static __device__ PHASE_ATTR void ph_att(int gi) {
    FRAME();
    const int dil = 1 << (2 * gi), dsh = 2 * gi;
    const bf16_t* QKV = (const bf16_t*)(ws + P_QKV);
    bf16_t* const Og = (bf16_t*)(ws + P_O0 + (size_t)gi * 192 * MiB); float* const LSEg = (float*)(ws + P_LSE) + (size_t)gi * TT * 16;
    bf16_t* const O0 = (bf16_t*)(ws + P_O0); const bf16_t* const O1 = (const bf16_t*)(ws + P_O0 + 192 * MiB); const float* const LS = (const float*)(ws + P_LSE);
    constexpr int KRS = 136, VRS = 144;
    LAS bf16_t* Ks = (LAS bf16_t*)lds; LAS bf16_t* Vs = (LAS bf16_t*)(lds + 256 * KRS * 2);
    const int qi = wave >> 2, wi = wave & 3, c15 = lane & 15, gq = lane >> 4;
    u32x4 kv[16]; bf16x8 qf[4];
#define ATT_PREFETCH(A) do { _Pragma("unroll") for (int i = 0; i < 16; ++i) { const int key = (tid >> 4) + 32 * (i & 7), part = tid & 15; \
            int ip = 64 * ((A).b0 - 1) + key; ip = ip < 0 ? 0 : (ip > (A).Lc - 1 ? (A).Lc - 1 : ip); \
            kv[i] = *(const u32x4*)(QKV + (size_t)((A).base + ip * dil + (A).c) * (3 * D) + ((i >> 3) ? 2 * D : D) + (A).h * 128 + 8 * part); } \
        { const size_t rq = (size_t)((A).base + (64 * ((A).b0 + qi) + 16 * wi + c15) * dil + (A).c); \
          _Pragma("unroll") for (int ks = 0; ks < 4; ++ks) qf[ks] = *(const bf16x8*)(QKV + rq * (3 * D) + (A).h * 128 + 32 * ks + 8 * gq); } } while (0)
    const int ppw = (6144 + G - 1) / G;
    int pair = bid_ * ppw; const int pair_end = (pair + ppw < 6144) ? pair + ppw : 6144;
    if (pair < pair_end) { const AttItem A0 = att_decode(pair, dsh); ATT_PREFETCH(A0); }
    for (; pair < pair_end; ++pair) {
        const AttItem A = att_decode(pair, dsh);
        const int base = A.base, h = A.h, c = A.c, Lc = A.Lc;
#pragma unroll
        for (int i = 0; i < 16; ++i) { const int key = (tid >> 4) + 32 * (i & 7), part = tid & 15;
            if (i >> 3) *(LAS u32x4*)(Vs + key * VRS + 8 * part) = kv[i]; else *(LAS u32x4*)(Ks + key * KRS + 8 * part) = kv[i]; }
        bf16x8 q[4];
#pragma unroll
        for (int ks = 0; ks < 4; ++ks) q[ks] = qf[ks];
        const int b = A.b0 + qi;
        const int iq = 64 * b + 16 * wi + c15; const size_t rowq = (size_t)(base + iq * dil + c);
        __syncthreads();
        if (pair + 1 < pair_end) { const AttItem An = att_decode(pair + 1, dsh); ATT_PREFETCH(An); }
        const int k0w = 16 * wi;
        f32x4 sc[9];
#pragma unroll
        for (int nt = 0; nt < 9; ++nt) { const LAS bf16_t* kp = Ks + (64 * qi + k0w + 16 * nt + c15) * KRS + 8 * gq;
            f32x4 a = {0.f, 0.f, 0.f, 0.f};
#pragma unroll
            for (int ks = 0; ks < 4; ++ks) a = __builtin_amdgcn_mfma_f32_16x16x32_bf16(*(const LAS bf16x8*)(kp + 32 * ks), q[ks], a, 0, 0, 0);
            sc[nt] = a * 0.08838834764831845f; }
#pragma unroll
        for (int r = 0; r < 4; ++r) { const int d0 = 4 * gq + r - c15;
            if (d0 < 0) sc[0][r] = -INFINITY;
            if (d0 > 0) sc[8][r] = -INFINITY; }
        if (b == 0 || b == (Lc >> 6) - 1) {
#pragma unroll
            for (int nt = 0; nt < 9; ++nt)
#pragma unroll
                for (int r = 0; r < 4; ++r) { const int ip = 64 * (b - 1) + k0w + 16 * nt + 4 * gq + r; if (ip < 0 || ip >= Lc) sc[nt][r] = -INFINITY; } }
        float mx = -INFINITY;
#pragma unroll
        for (int nt = 0; nt < 9; ++nt) mx = fmaxf(mx, fmaxf(fmaxf(sc[nt][0], sc[nt][1]), fmaxf(sc[nt][2], sc[nt][3])));
        mx = fmaxf(mx, __shfl_xor(mx, 16)); mx = fmaxf(mx, __shfl_xor(mx, 32));
        float sum = 0.f;
#pragma unroll
        for (int nt = 0; nt < 9; ++nt)
#pragma unroll
            for (int r = 0; r < 4; ++r) { const float p = fast_exp(sc[nt][r] - mx); sc[nt][r] = p; sum += p; }
        sum += __shfl_xor(sum, 16); sum += __shfl_xor(sum, 32);
        const float rs = __builtin_amdgcn_rcpf(sum); const float lse = mx + __logf(sum);
        float w0 = 0.f, w1 = 0.f, w2 = 1.f;
        if (gi == 2) { const float l0 = LS[rowq * 16 + h], l1 = LS[((size_t)TT + rowq) * 16 + h]; const float m = fmaxf(lse, fmaxf(l0, l1));
            w0 = fast_exp(l0 - m); w1 = fast_exp(l1 - m); w2 = fast_exp(lse - m); const float r3 = __builtin_amdgcn_rcpf(w0 + w1 + w2); w0 *= r3; w1 *= r3; w2 *= r3; }
        else if (gq == 0) LSEg[rowq * 16 + h] = lse;
        bf16x8 pf[5];
#pragma unroll
        for (int ks = 0; ks < 4; ++ks) { const f32x4 p0 = sc[2 * ks] * rs, p1 = sc[2 * ks + 1] * rs;
            const u32x4 w = {pk2(p0[0], p0[1]), pk2(p0[2], p0[3]), pk2(p1[0], p1[1]), pk2(p1[2], p1[3])}; pf[ks] = __builtin_bit_cast(bf16x8, w); }
        { const f32x4 p0 = sc[8] * rs; const u32x4 w = {pk2(p0[0], p0[1]), pk2(p0[2], p0[3]), 0u, 0u}; pf[4] = __builtin_bit_cast(bf16x8, w); }
        const LAS bf16_t* vbase = Vs + (64 * qi + k0w + 4 * gq + (c15 >> 2)) * VRS + 4 * (c15 & 3);
#pragma unroll
        for (int dt = 0; dt < 8; ++dt) {
            f32x4 o = {0.f, 0.f, 0.f, 0.f};
#pragma unroll
            for (int ks = 0; ks < 5; ++ks) {
                const v4i16_t lo = __builtin_amdgcn_ds_read_tr16_b64_v4i16((LAS v4i16_t*)(vbase + (32 * ks) * VRS + 16 * dt));
                v4i16_t hi = {0, 0, 0, 0};
                if (ks < 4) hi = __builtin_amdgcn_ds_read_tr16_b64_v4i16((LAS v4i16_t*)(vbase + (32 * ks + 16) * VRS + 16 * dt));
                const bf16x8 vf = {lo[0], lo[1], lo[2], lo[3], hi[0], hi[1], hi[2], hi[3]};
                o = __builtin_amdgcn_mfma_f32_16x16x32_bf16(vf, pf[ks], o, 0, 0, 0);
            }
            const size_t oo = rowq * D + h * 128 + 16 * dt + 4 * gq;
            if (gi == 2) { const u32x2 a0 = *(const u32x2*)(O0 + oo), a1 = *(const u32x2*)(O1 + oo);
                o = (f32x4){w0 * bflo(a0.x) + w1 * bflo(a1.x) + w2 * o[0], w0 * bfhi(a0.x) + w1 * bfhi(a1.x) + w2 * o[1], w0 * bflo(a0.y) + w1 * bflo(a1.y) + w2 * o[2], w0 * bfhi(a0.y) + w1 * bfhi(a1.y) + w2 * o[3]};
                *(u32x2*)(O0 + oo) = (u32x2){pk2(o[0], o[1]), pk2(o[2], o[3])}; }
            else *(u32x2*)(Og + oo) = (u32x2){pk2(o[0], o[1]), pk2(o[2], o[3])};
        }
        __syncthreads();
    }
#undef ATT_PREFETCH
}

static __device__ PHASE_ATTR void ph_norm(int L, int sub, size_t h_off) {
    FRAME();
    float* Y = outp(); bf16_t* XB = (bf16_t*)(ws + P_XN);
    float* RSX = (float*)(ws + WS_RSX); const bf16_t* hsrc = (const bf16_t*)(ws + h_off);
    const float alpha = (sub == 1) ? 1.0f : 0.5f;
    const float* gpost = inp(3) + (size_t)(L * 3 + sub) * D;
    const bool last = (L == DEPTH - 1 && sub == 2), first = (L == 0 && sub == 0); const float* in0 = inp(0); const float* in1 = inp(1);
    u32x4 hq[4], xq[4]; f32x4 xf[4][2];
#define NORM_LOAD(row_) do { const size_t r_ = (size_t)(row_); \
        _Pragma("unroll") for (int i = 0; i < 4; ++i) { const int e = 8 * (lane + 64 * i); hq[i] = *(const u32x4*)(hsrc + r_ * D + e); \
            if (first) { const float* xs_ = r_ < 32768 ? in0 + r_ * D : in1 + (r_ - 32768) * D; xf[i][0] = *(const f32x4*)(xs_ + e); xf[i][1] = *(const f32x4*)(xs_ + e + 4); } \
            else xq[i] = *(const u32x4*)(XB + r_ * D + e); } } while (0)
    int row = gw;
    if (row < TT) NORM_LOAD(row);
    for (; row < TT; row += NGW) {
        float xv[4][8]; float ssh = 0.f;
        float hv[4][8];
#pragma unroll
        for (int i = 0; i < 4; ++i) {
            if (first) {
#pragma unroll
                for (int j = 0; j < 4; ++j) { xv[i][j] = xf[i][0][j]; xv[i][4 + j] = xf[i][1][j]; } }
            else { const unsigned xww[4] = {xq[i].x, xq[i].y, xq[i].z, xq[i].w};
#pragma unroll
                for (int j = 0; j < 4; ++j) { xv[i][2 * j] = bflo(xww[j]); xv[i][2 * j + 1] = bfhi(xww[j]); } }
            const unsigned hww[4] = {hq[i].x, hq[i].y, hq[i].z, hq[i].w};
#pragma unroll
            for (int j = 0; j < 4; ++j) { hv[i][2 * j] = bflo(hww[j]); hv[i][2 * j + 1] = bfhi(hww[j]); ssh += hv[i][2 * j] * hv[i][2 * j] + hv[i][2 * j + 1] * hv[i][2 * j + 1]; } }
        if (row + NGW < TT) NORM_LOAD(row + NGW);
        const float rh = rsqrtf(wave_sum(ssh) * (1.0f / D) + NORM_EPS) * alpha;
        float ssx = 0.f;
        float* ydst = Y + (size_t)row * D;
#pragma unroll
        for (int i = 0; i < 4; ++i) { const int e = 8 * (lane + 64 * i); const f32x4 ga = *(const f32x4*)(gpost + e), gb = *(const f32x4*)(gpost + e + 4);
#pragma unroll
            for (int j = 0; j < 8; ++j) { xv[i][j] += hv[i][j] * rh * (j < 4 ? ga[j] : gb[j - 4]); ssx += xv[i][j] * xv[i][j]; }
            if (last) { *(f32x4*)(ydst + e) = (f32x4){xv[i][0], xv[i][1], xv[i][2], xv[i][3]}; *(f32x4*)(ydst + e + 4) = (f32x4){xv[i][4], xv[i][5], xv[i][6], xv[i][7]}; }
            else *(u32x4*)(XB + (size_t)row * D + e) = (u32x4){pk2(xv[i][0], xv[i][1]), pk2(xv[i][2], xv[i][3]), pk2(xv[i][4], xv[i][5]), pk2(xv[i][6], xv[i][7])}; }
        if (!last) { const float rx = rsqrtf(wave_sum(ssx) * (1.0f / D) + NORM_EPS); if (lane == 0) RSX[row] = rx; }
    }
#undef NORM_LOAD
}
static __device__ __noinline__ void grid_bar() {
    LAS unsigned char* lds = (LAS unsigned char*)lds_raw;
    XcdBarrier b; b.bar = (unsigned*)(wsp() + WS_CTL) + CW_BAR; b.st = (volatile LAS unsigned*)(lds + MISC_OFF) + 8; b.x = b.st[2];
    xcd_barrier(b);
}
#define STEP(call) do { if (step >= lo && step < hi) { call; if (step + 1 < hi) grid_bar(); } ++step; } while (0)
template <int L> __device__ __forceinline__ void layer_prog(int& step, const int lo, const int hi) {
    constexpr int jm = L >> 1; constexpr bool is_attn = (L & 1) != 0;
    STEP(ph_ffn_up(0));
    STEP(ph_gemm_plain(P_H, FF, W_DN0, D, FF, P_HOUT, D));
    STEP(ph_norm(L, 0, P_HOUT));
    if constexpr (!is_attn) {
        STEP(ph_mix(jm, 0));
        STEP(ph_g1(jm, 0));
        STEP(ph_mix(jm, 1));
        STEP(ph_g1(jm, 1));
        if constexpr (jm > 0) { STEP(ph_gv(jm)); } else { ++step; }
        STEP(ph_scan(jm));
        STEP(ph_fin(jm));
        STEP(ph_gg());
        STEP(ph_gemm_plain(P_YF, D, W_GO, D, D, P_R, D));
        STEP(ph_norm(L, 1, P_R));
    } else {
        STEP(ph_qkv(0));
        STEP(ph_att(0));
        STEP(ph_qkv(1));
        STEP(ph_att(1));
        STEP(ph_qkv(2));
        STEP(ph_att(2));
        STEP(ph_gemm_plain(P_O0, D, W_GO, D, D, P_QKV, D));
        STEP(ph_norm(L, 1, P_QKV));
    }
    STEP(ph_ffn_up(1));
    STEP(ph_gemm_plain(P_H, FF, W_DN1, D, FF, P_HOUT, D));
    STEP({ ph_norm(L, 2, P_HOUT); if (L + 1 < DEPTH) ph_conv(L + 1); });
}
__global__ void __launch_bounds__(NWAVES * 64, 2) enc_fwd(Args args) {
    LAS unsigned char* lds = (LAS unsigned char*)lds_raw;
    volatile LAS unsigned* MISC = (volatile LAS unsigned*)(lds + MISC_OFF);
    const int tid = threadIdx.x;
    if (tid < 128) ((LAS unsigned*)(lds + CTRL_OFF))[tid] = 0u;
    if (tid < 30) { const unsigned long long v = tid < 28 ? (unsigned long long)args.in[tid] : (tid == 28 ? (unsigned long long)args.out : (unsigned long long)args.ws);
        LAS unsigned* p = (LAS unsigned*)(lds + PTR_OFF) + 2 * tid; p[0] = (unsigned)v; p[1] = (unsigned)(v >> 32); }
    __syncthreads();
    const int lo = args.step_lo, hi = args.step_hi;
    if (hi - lo > 1) { const XcdBarrier b = xcd_barrier_post((unsigned*)(args.ws + WS_CTL) + CW_BAR, MISC + 8); if (tid == 0) MISC[10] = b.x; }
    __syncthreads();
    int step = 0;
    STEP({ ph_init(); ph_conv(0); });
    layer_prog<0>(step, lo, hi);
    layer_prog<1>(step, lo, hi);
    layer_prog<2>(step, lo, hi);
    layer_prog<3>(step, lo, hi);
}
#undef STEP

static int n_steps_total() {
    int s = 1;
    for (int L = 0; L < DEPTH; ++L) { s += 3; s += (L & 1) ? 8 : 10; s += 3; }
    return s;
}

extern "C" void kernel_launch(void* const* d_in, const int* in_sizes, int n_in, void* d_out, int out_size, void* d_ws, size_t ws_size, hipStream_t stream) {
    static int grid = 0;
    if (grid == 0) {
        if (n_in != 28 || out_size != TT * D || ws_size < WS_END) { fprintf(stderr, "kernel_launch: unexpected shapes (n_in %d, out %d, ws %zu, need %zu)\n", n_in, out_size, ws_size, (size_t)WS_END); grid = -1; return; }
        int dev = 0, cus = 0, per_cu = 0;
        if (hipGetDevice(&dev) != hipSuccess || hipDeviceGetAttribute(&cus, hipDeviceAttributeMultiprocessorCount, dev) != hipSuccess) { grid = -1; return; }
        if (hipFuncSetAttribute((const void*)enc_fwd, hipFuncAttributeMaxDynamicSharedMemorySize, LDS_BYTES) != hipSuccess) { grid = -1; return; }
        if (hipOccupancyMaxActiveBlocksPerMultiprocessor(&per_cu, (const void*)enc_fwd, NWAVES * 64, LDS_BYTES) != hipSuccess || per_cu < 1) { fprintf(stderr, "kernel_launch: occupancy query says %d\n", per_cu); }
        (void)hipGetLastError();
        grid = cus;
    }
    if (grid < 0) return;
    (void)hipMemsetAsync((char*)d_ws + WS_CTL, 0, CTL_ZERO_BYTES, stream);
    Args a{};
    for (int i = 0; i < 28; ++i) a.in[i] = (const float*)d_in[i];
    a.out = (float*)d_out; a.ws = (unsigned char*)d_ws;
    const int NS = n_steps_total();
#if MK_ONE_LAUNCH
    a.step_lo = 0; a.step_hi = NS;
    hipLaunchKernelGGL(enc_fwd, dim3(grid), dim3(NWAVES * 64), LDS_BYTES, stream, a);
#else
    for (int s = 0; s < NS; ++s) {
        a.step_lo = s; a.step_hi = s + 1;
        hipLaunchKernelGGL(enc_fwd, dim3(grid), dim3(NWAVES * 64), LDS_BYTES, stream, a);
    }
#endif
}
```

```cpp
#include <hip/hip_runtime.h>
#include <cstdio>
#include <cstdint>

#ifndef MK_ONE_LAUNCH
#define MK_ONE_LAUNCH 1
#endif

#ifndef PHASE_ATTR
#define PHASE_ATTR __forceinline__
#endif
#define LAS __attribute__((address_space(3)))
#define GAS __attribute__((address_space(1)))
typedef unsigned short bf16_t;
typedef short bf16x8 __attribute__((ext_vector_type(8)));
typedef float f32x4 __attribute__((ext_vector_type(4)));
typedef float f32x2 __attribute__((ext_vector_type(2)));
typedef unsigned u32x4 __attribute__((ext_vector_type(4)));
typedef unsigned u32x2 __attribute__((ext_vector_type(2)));
typedef __bf16 bf16x2_t __attribute__((ext_vector_type(2)));

constexpr int D = 2048, FF = 5632, TT = 49152, DEPTH = 4;
constexpr int HID = 1024;
constexpr int NG1 = 3 * D + 256, NG2 = 768;
constexpr float NORM_EPS = 1e-6f, GN_EPS = 64e-5f;

__device__ __forceinline__ float bflo(unsigned w) { return __uint_as_float(w << 16); }
__device__ __forceinline__ float bfhi(unsigned w) { return __uint_as_float(w & 0xffff0000u); }
__device__ __forceinline__ unsigned pk2(float lo, float hi) { f32x2 v = {lo, hi}; bf16x2_t b = __builtin_convertvector(v, bf16x2_t); return __builtin_bit_cast(unsigned, b); }
__device__ __forceinline__ float wave_sum(float v) {
#pragma unroll
    for (int o = 1; o < 64; o <<= 1) v += __shfl_xor(v, o);
    return v;
}
__device__ __forceinline__ float fast_exp(float x) { return __builtin_amdgcn_exp2f(x * 1.4426950408889634f); }
__device__ __forceinline__ float sigmoidf_(float x) { return __builtin_amdgcn_rcpf(1.0f + fast_exp(-x)); }
__device__ __forceinline__ float siluf_(float x) { return x * sigmoidf_(x); }
__device__ __forceinline__ float tanhf_(float x) { return 1.0f - 2.0f * __builtin_amdgcn_rcpf(1.0f + fast_exp(2.0f * x)); }
__device__ __forceinline__ void row_decode(int row, int& base, int& pos, int& len) {
    if (row < 32768) { base = row & ~16383; pos = row & 16383; len = 16384; }
    else { const int r2 = row - 32768; base = 32768 + (r2 & ~8191); pos = r2 & 8191; len = 8192; }
}

namespace pg8 {
#define PG8_LAS __attribute__((address_space(3)))
constexpr int BM = 256, BK = 64, HALF = 128, HTB = HALF * BK * 2, STAGE_BYTES = 8 * HTB, NXCD = 8, WGM = 8;
__host__ __device__ __forceinline__ int lds_byte(int r, int c) { const int st = (r >> 4) * 2 + (c >> 5), rr = r & 15, cc = c & 31, ob = rr * 64 + cc * 2; return st * 1024 + (ob ^ (((ob >> 9) & 1) << 5)); }
__host__ __device__ __forceinline__ void stage_rc(int b, int& R, int& C) { const int st = b / 1024, sb = b % 1024, swz = sb ^ (((sb >> 9) & 1) << 5); R = (st >> 1) * 16 + swz / 64; C = (st & 1) * 32 + (swz % 64) / 2; }
__host__ __device__ __forceinline__ int perm32(int rho) { const int n = rho >> 4, i = rho & 15; return 8 * (i >> 2) + 4 * n + (i & 3); }
struct Unit { int pm, pn; };
struct Gemm { const bf16_t* A; const bf16_t* Bt; int M, N, K, lda; size_t a_gstride = 0; int g0 = 1 << 30, g1 = 1 << 30; };
struct StaticOrder {
    int nM, nN, nwg, G, c;
    __host__ __device__ void init(int M, int N, int G_, int c_) { nM = M / BM; nN = N / BM; nwg = nM * nN; G = G_; c = c_; }
    __host__ __device__ bool next(int i, Unit& u) const {
        const long L = (long)i * G + c; if (L >= nwg) return false;
        int wgid = (int)L; { const int q = nwg / NXCD, r = nwg % NXCD, xcd = wgid % NXCD, off = wgid / NXCD; wgid = (xcd < r ? xcd * (q + 1) : r * (q + 1) + (xcd - r) * q) + off; }
        const int nig = WGM * nN, gid = wgid / nig, fm = gid * WGM, gsz = (nM - fm) < WGM ? (nM - fm) : WGM;
        u.pm = fm + ((wgid % nig) % gsz); u.pn = (wgid % nig) / gsz; return true;
    }
    __device__ __forceinline__ void a_ready(const Unit&) const {}
    __device__ __forceinline__ void done(const Unit&) const {}
};

struct EpiSwiGLU {
    static constexpr bool PERM = true, AFTER_DRAIN = false;
    bf16_t* H; const float* rs;
    __device__ __forceinline__ void operator()(const f32x4 (&acc)[2][2][4][2], const Unit& u, int wr, int wc, int fr, int fq) const {
        const int row0 = u.pm * BM + wr * 64 + fr, col = u.pn * 128 + wc * 32 + 8 * fq;
#pragma unroll
        for (int ai = 0; ai < 2; ++ai)
#pragma unroll
            for (int m = 0; m < 4; ++m) { const int row = row0 + ai * HALF + m * 16; const float r = rs[row];
                const f32x4 g0 = acc[ai][0][m][0] * r, g1 = acc[ai][0][m][1] * r, u0 = acc[ai][1][m][0] * r, u1 = acc[ai][1][m][1] * r;
                u32x4 w;
                w.x = pk2(siluf_(g0[0]) * u0[0], siluf_(g0[1]) * u0[1]); w.y = pk2(siluf_(g0[2]) * u0[2], siluf_(g0[3]) * u0[3]);
                w.z = pk2(siluf_(g1[0]) * u1[0], siluf_(g1[1]) * u1[1]); w.w = pk2(siluf_(g1[2]) * u1[2], siluf_(g1[3]) * u1[3]);
                *(u32x4*)(H + (size_t)row * FF + col) = w;
            }
    }
};
struct EpiPlain {
    static constexpr bool PERM = true, AFTER_DRAIN = false;
    bf16_t* O; int ldc;
    __device__ __forceinline__ void operator()(const f32x4 (&acc)[2][2][4][2], const Unit& u, int wr, int wc, int fr, int fq) const {
        const int row0 = u.pm * BM + wr * 64 + fr, col0 = u.pn * BM + wc * 32 + 8 * fq;
#pragma unroll
        for (int ai = 0; ai < 2; ++ai)
#pragma unroll
            for (int m = 0; m < 4; ++m) { bf16_t* rowp = O + (size_t)(row0 + ai * HALF + m * 16) * ldc + col0;
#pragma unroll
                for (int bj = 0; bj < 2; ++bj) { const f32x4 v0 = acc[ai][bj][m][0], v1 = acc[ai][bj][m][1];
                    u32x4 w; w.x = pk2(v0[0], v0[1]); w.y = pk2(v0[2], v0[3]); w.z = pk2(v1[0], v1[1]); w.w = pk2(v1[2], v1[3]);
                    *(u32x4*)(rowp + bj * HALF) = w; } }
    }
};
struct EpiQKV {
    static constexpr bool PERM = true, AFTER_DRAIN = false;
    bf16_t* O; const f32x2* tab; const float* rs;
    __device__ __forceinline__ void operator()(const f32x4 (&acc)[2][2][4][2], const Unit& u, int wr, int wc, int fr, int fq) const {
        const int row0 = u.pm * BM + wr * 64 + fr, col0 = u.pn * BM + wc * 32 + 8 * fq;
        const bool rot = (u.pn < 16);
        f32x2 cs[2][4];
#pragma unroll
        for (int ai = 0; ai < 2; ++ai)
#pragma unroll
            for (int m = 0; m < 4; ++m) { cs[ai][m] = (f32x2){1.f, 0.f};
                if (rot) { const int row = row0 + ai * HALF + m * 16; const int pos = row < 32768 ? (row & 16383) : (row & 8191); cs[ai][m] = tab[pos * 16 + 4 * wc + fq]; } }
#pragma unroll
        for (int ai = 0; ai < 2; ++ai)
#pragma unroll
            for (int m = 0; m < 4; ++m) { const int row = row0 + ai * HALF + m * 16; bf16_t* rowp = O + (size_t)row * (3 * D) + col0; const f32x2 c = cs[ai][m]; const float r = rs[row];
#pragma unroll
                for (int bj = 0; bj < 2; ++bj) { const f32x4 v0 = acc[ai][bj][m][0] * r, v1 = acc[ai][bj][m][1] * r;
                    u32x4 w; w.x = pk2(v0[0] * c[0] - v0[1] * c[1], v0[0] * c[1] + v0[1] * c[0]); w.y = pk2(v0[2], v0[3]); w.z = pk2(v1[0], v1[1]); w.w = pk2(v1[2], v1[3]);
                    *(u32x4*)(rowp + bj * HALF) = w; } }
    }
};
struct EpiG1 {
    static constexpr bool PERM = true, AFTER_DRAIN = false;
    unsigned char* ws; size_t r_off, v_off, h_off; int mode;
    __device__ __forceinline__ void operator()(const f32x4 (&acc)[2][2][4][2], const Unit& u, int wr, int wc, int fr, int fq) const {
        const int row0 = u.pm * BM + wr * 64 + fr; const int t = u.pn >> 3;
        size_t off = r_off + (size_t)t * (192u << 20); int ldc = D, colt = (u.pn & 7) * BM, act = 0;
        if (t == 2) off = v_off;
        if (t >= 3) { off = h_off; ldc = HID; colt = 768; }
        if (mode == 1) { off = h_off; ldc = HID; colt = u.pn * BM; act = (u.pn == 0) ? 1 : ((u.pn == 2) ? 2 : 0); }
        bf16_t* base = (bf16_t*)(ws + off);
        const int col0 = colt + wc * 32 + 8 * fq;
#pragma unroll
        for (int ai = 0; ai < 2; ++ai)
#pragma unroll
            for (int m = 0; m < 4; ++m) { bf16_t* rowp = base + (size_t)(row0 + ai * HALF + m * 16) * ldc + col0;
#pragma unroll
                for (int bj = 0; bj < 2; ++bj) { f32x4 v0 = acc[ai][bj][m][0], v1 = acc[ai][bj][m][1];
                    if (act == 1) {
#pragma unroll
                        for (int j = 0; j < 4; ++j) { v0[j] = tanhf_(v0[j]); v1[j] = tanhf_(v1[j]); } }
                    if (act == 2) {
#pragma unroll
                        for (int j = 0; j < 4; ++j) { v0[j] = sigmoidf_(v0[j]); v1[j] = sigmoidf_(v1[j]); } }
                    u32x4 w; w.x = pk2(v0[0], v0[1]); w.y = pk2(v0[2], v0[3]); w.z = pk2(v1[0], v1[1]); w.w = pk2(v1[2], v1[3]);
                    *(u32x4*)(rowp + bj * HALF) = w; } }
    }
};
struct EpiVres {
    static constexpr bool PERM = true, AFTER_DRAIN = false;
    bf16_t* V; const bf16_t* VF; const float* v0;
    __device__ __forceinline__ void operator()(const f32x4 (&acc)[2][2][4][2], const Unit& u, int wr, int wc, int fr, int fq) const {
        const int row0 = u.pm * BM + wr * 64 + fr, col0 = u.pn * BM + wc * 32 + 8 * fq;
#pragma unroll
        for (int ai = 0; ai < 2; ++ai)
#pragma unroll
            for (int m = 0; m < 4; ++m) { const size_t ro = (size_t)(row0 + ai * HALF + m * 16) * D + col0;
#pragma unroll
                for (int bj = 0; bj < 2; ++bj) { const f32x4 a0 = acc[ai][bj][m][0], a1 = acc[ai][bj][m][1];
                    const u32x4 vv = *(const u32x4*)(V + ro + bj * HALF), vf = *(const u32x4*)(VF + ro + bj * HALF);
                    const f32x4 b0 = *(const f32x4*)(v0 + col0 + bj * HALF), b1 = *(const f32x4*)(v0 + col0 + bj * HALF + 4);
                    float o[8]; const unsigned vw[4] = {vv.x, vv.y, vv.z, vv.w}, fw[4] = {vf.x, vf.y, vf.z, vf.w};
#pragma unroll
                    for (int j = 0; j < 4; ++j) { const float g0 = sigmoidf_((j < 2 ? b0[2 * j] : b1[2 * j - 4]) + (j < 2 ? a0[2 * j] : a1[2 * j - 4]));
                        const float g1 = sigmoidf_((j < 2 ? b0[2 * j + 1] : b1[2 * j - 3]) + (j < 2 ? a0[2 * j + 1] : a1[2 * j - 3]));
                        const float x0 = bflo(vw[j]), x1 = bfhi(vw[j]), f0 = bflo(fw[j]), f1 = bfhi(fw[j]);
                        o[2 * j] = x0 + (f0 - x0) * g0; o[2 * j + 1] = x1 + (f1 - x1) * g1; }
                    u32x4 w; w.x = pk2(o[0], o[1]); w.y = pk2(o[2], o[3]); w.z = pk2(o[4], o[5]); w.w = pk2(o[6], o[7]);
                    *(u32x4*)(V + ro + bj * HALF) = w; } }
    }
};
struct EpiGmul {
    static constexpr bool PERM = true, AFTER_DRAIN = false;
    bf16_t* Y;
    __device__ __forceinline__ void operator()(const f32x4 (&acc)[2][2][4][2], const Unit& u, int wr, int wc, int fr, int fq) const {
        const int row0 = u.pm * BM + wr * 64 + fr, col0 = u.pn * BM + wc * 32 + 8 * fq;
#pragma unroll
        for (int ai = 0; ai < 2; ++ai)
#pragma unroll
            for (int m = 0; m < 4; ++m) { const size_t ro = (size_t)(row0 + ai * HALF + m * 16) * D + col0;
#pragma unroll
                for (int bj = 0; bj < 2; ++bj) { const f32x4 a0 = acc[ai][bj][m][0], a1 = acc[ai][bj][m][1];
                    const u32x4 y = *(const u32x4*)(Y + ro + bj * HALF);
                    u32x4 w; w.x = pk2(bflo(y.x) * a0[0], bfhi(y.x) * a0[1]); w.y = pk2(bflo(y.y) * a0[2], bfhi(y.y) * a0[3]);
                    w.z = pk2(bflo(y.z) * a1[0], bfhi(y.z) * a1[1]); w.w = pk2(bflo(y.w) * a1[2], bfhi(y.w) * a1[3]);
                    *(u32x4*)(Y + ro + bj * HALF) = w; } }
    }
};

template <class Epi, class Sched, bool ALIGN_EPI = false, bool SP2 = false>
__device__ __forceinline__ void gemm_phase(PG8_LAS unsigned char* lds, const Gemm g, const Sched& S, const Epi& E, const int tid) {
    const int wid = __builtin_amdgcn_readfirstlane(tid >> 6), lane = tid & 63, wr = wid >> 2, wc = wid & 3, fr = lane & 15, fq = lane >> 4;
    const int K = g.K, nt = K / BK, lda = g.lda;
    unsigned voffA[2], voffB[2];
#pragma unroll
    for (int i = 0; i < 2; ++i) { int R, C; stage_rc(tid * 16 + i * 8192, R, C); const int Rb = Epi::PERM ? ((R & ~31) + perm32(R & 31)) : R;
        voffA[i] = (unsigned)(R * lda + C) * 2u; voffB[i] = (unsigned)(Rb * K + C) * 2u; }
    const size_t kstep = (size_t)(BK * 2);
    const size_t hstepA = (size_t)HALF * lda * 2, hstepB = (size_t)HALF * K * 2;
    const size_t tstepA = 2 * hstepA, tstepB = 2 * hstepB;
    const unsigned ldsw = (unsigned)wid * 1024u;
    const int aoff = lds_byte(wr * 64 + fr, fq * 8), boff = lds_byte(wc * 32 + fr, fq * 8);
#define PG8_SA(b, h) (((b) * 2 + (h)) * HTB)
#define PG8_SB(b, h) ((4 + (b) * 2 + (h)) * HTB)
#define PG8_STAGE(bufoff, gbase, voff) do { _Pragma("unroll") for (int _i = 0; _i < 2; ++_i) \
        __builtin_amdgcn_global_load_lds((const unsigned*)((const char*)(gbase) + (voff)[_i]), (PG8_LAS unsigned*)(lds + (bufoff) + ldsw + _i * 8192), 16, 0, 0); } while (0)
#define PG8_LDA(dst, b, h) do { _Pragma("unroll") for (int m = 0; m < 4; ++m) _Pragma("unroll") for (int k = 0; k < 2; ++k) dst[m][k] = *(const PG8_LAS bf16x8*)(lds + PG8_SA(b, h) + aoff + m * 2048 + k * 1024); } while (0)
#define PG8_LDB(dst, b, h) do { _Pragma("unroll") for (int n = 0; n < 2; ++n) _Pragma("unroll") for (int k = 0; k < 2; ++k) dst[n][k] = *(const PG8_LAS bf16x8*)(lds + PG8_SB(b, h) + boff + n * 2048 + k * 1024); } while (0)
#define PG8_MMA(ai, bj, At, Bt) do { __builtin_amdgcn_s_setprio(1); _Pragma("unroll") for (int m = 0; m < 4; ++m) _Pragma("unroll") for (int n = 0; n < 2; ++n) _Pragma("unroll") for (int k = 0; k < 2; ++k) \
        acc[ai][bj][m][n] = __builtin_amdgcn_mfma_f32_16x16x32_bf16(Bt[n][k], At[m][k], acc[ai][bj][m][n], 0, 0, 0); __builtin_amdgcn_s_setprio(0); } while (0)
#define PG8_WAIT_V(n) asm volatile("s_waitcnt vmcnt(" #n ")" ::: "memory")
#define PG8_WAIT_L(n) asm volatile("s_waitcnt lgkmcnt(" #n ")" ::: "memory")
#define PG8_BAR __builtin_amdgcn_s_barrier()
#define PG8_SCHED __builtin_amdgcn_sched_barrier(0)
    Unit cur, nxt; int ui = 0;
    if (!S.next(0, cur)) return;
    f32x4 acc[2][2][4][2];
#pragma unroll
    for (int a = 0; a < 2; ++a)
#pragma unroll
        for (int b = 0; b < 2; ++b)
#pragma unroll
            for (int m = 0; m < 4; ++m)
#pragma unroll
                for (int n = 0; n < 2; ++n) acc[a][b][m][n] = (f32x4){0.f, 0.f, 0.f, 0.f};
    bf16x8 At[4][2], B0[2][2], B1[2][2];
    const char* cA = (const char*)g.A + (size_t)cur.pm * tstepA + (size_t)((cur.pn >= g.g0) + (cur.pn >= g.g1)) * g.a_gstride; const char* cB = (const char*)g.Bt + (size_t)cur.pn * tstepB;
    S.a_ready(cur);
    if constexpr (SP2) {
        PG8_STAGE(PG8_SB(0, 0), cB, voffB); PG8_STAGE(PG8_SB(0, 1), cB + hstepB, voffB); PG8_STAGE(PG8_SA(0, 0), cA, voffA); PG8_STAGE(PG8_SA(0, 1), cA + hstepA, voffA);
        if (wr == 1) PG8_BAR;
        PG8_WAIT_V(2); PG8_BAR;
        PG8_STAGE(PG8_SB(1, 0), cB + kstep, voffB); PG8_STAGE(PG8_SA(1, 0), cA + kstep, voffA); PG8_STAGE(PG8_SB(1, 1), cB + hstepB + kstep, voffB);
        PG8_WAIT_V(6); PG8_BAR;
    } else {
        PG8_STAGE(PG8_SB(0, 0), cB, voffB); PG8_STAGE(PG8_SA(0, 0), cA, voffA); PG8_STAGE(PG8_SB(0, 1), cB + hstepB, voffB); PG8_STAGE(PG8_SA(0, 1), cA + hstepA, voffA);
        if (wr == 1) PG8_BAR;
        PG8_WAIT_V(4); PG8_BAR;
        PG8_STAGE(PG8_SB(1, 0), cB + kstep, voffB); PG8_STAGE(PG8_SA(1, 0), cA + kstep, voffA); PG8_STAGE(PG8_SB(1, 1), cB + hstepB + kstep, voffB);
        PG8_WAIT_V(6); PG8_BAR;
    }
    for (;;) {
        const bool has_next = S.next(ui + 1, nxt);
        const char* nA = has_next ? (const char*)g.A + (size_t)nxt.pm * tstepA + (size_t)((nxt.pn >= g.g0) + (nxt.pn >= g.g1)) * g.a_gstride : cA; const char* nB = has_next ? (const char*)g.Bt + (size_t)nxt.pn * tstepB : cB;
        for (int t = 0; t < nt; t += 2) {
            const bool last = (t == nt - 2);
            const char* a1 = cA + (size_t)(t + 1) * kstep;
            const char* a2 = last ? nA : cA + (size_t)(t + 2) * kstep; const char* b2 = last ? nB : cB + (size_t)(t + 2) * kstep;
            const char* a3 = a2 + kstep; const char* b3 = b2 + kstep;
            if (last && has_next) S.a_ready(nxt);
            if constexpr (SP2) {
            PG8_LDB(B0, 0, 0); PG8_LDB(B1, 0, 1); PG8_SCHED; PG8_LDA(At, 0, 0); PG8_STAGE(PG8_SA(1, 1), a1 + hstepA, voffA);
            PG8_WAIT_V(8); PG8_WAIT_L(0); PG8_BAR; PG8_MMA(0, 0, At, B0); PG8_MMA(0, 1, At, B1); PG8_BAR; PG8_SCHED;
            PG8_LDA(At, 0, 1); PG8_STAGE(PG8_SB(0, 0), b2, voffB); PG8_STAGE(PG8_SB(0, 1), b2 + hstepB, voffB); PG8_STAGE(PG8_SA(0, 0), a2, voffA);
            PG8_WAIT_V(8); PG8_WAIT_L(0); PG8_BAR; PG8_MMA(1, 0, At, B0); PG8_MMA(1, 1, At, B1); PG8_BAR; PG8_SCHED;
            PG8_LDB(B0, 1, 0); PG8_LDB(B1, 1, 1); PG8_SCHED; PG8_LDA(At, 1, 0); PG8_STAGE(PG8_SA(0, 1), a2 + hstepA, voffA);
            PG8_WAIT_V(8); PG8_WAIT_L(0); PG8_BAR; PG8_MMA(0, 0, At, B0); PG8_MMA(0, 1, At, B1); PG8_BAR; PG8_SCHED;
            PG8_LDA(At, 1, 1); PG8_STAGE(PG8_SB(1, 0), b3, voffB); PG8_STAGE(PG8_SB(1, 1), b3 + hstepB, voffB); PG8_STAGE(PG8_SA(1, 0), a3, voffA);
            PG8_WAIT_V(8); PG8_WAIT_L(0); PG8_BAR; PG8_MMA(1, 0, At, B0); PG8_MMA(1, 1, At, B1); PG8_BAR; PG8_SCHED;
            } else {
            PG8_LDB(B0, 0, 0); PG8_SCHED; PG8_LDA(At, 0, 0); PG8_STAGE(PG8_SA(1, 1), a1 + hstepA, voffA);
            PG8_WAIT_L(8); PG8_BAR; PG8_WAIT_L(0); PG8_MMA(0, 0, At, B0); PG8_BAR; PG8_SCHED;
            PG8_LDB(B1, 0, 1); PG8_STAGE(PG8_SB(0, 0), b2, voffB);
            PG8_BAR; PG8_WAIT_L(0); PG8_MMA(0, 1, At, B1); PG8_BAR;
            PG8_LDA(At, 0, 1); PG8_STAGE(PG8_SA(0, 0), a2, voffA);
            PG8_BAR; PG8_WAIT_L(0); PG8_MMA(1, 0, At, B0); PG8_BAR; PG8_SCHED;
            PG8_STAGE(PG8_SB(0, 1), b2 + hstepB, voffB);
            PG8_WAIT_V(6); PG8_BAR; PG8_MMA(1, 1, At, B1); PG8_BAR;
            PG8_LDB(B0, 1, 0); PG8_SCHED; PG8_LDA(At, 1, 0); PG8_STAGE(PG8_SA(0, 1), a2 + hstepA, voffA);
            PG8_WAIT_L(8); PG8_BAR; PG8_WAIT_L(0); PG8_MMA(0, 0, At, B0); PG8_BAR; PG8_SCHED;
            PG8_LDB(B1, 1, 1); PG8_STAGE(PG8_SB(1, 0), b3, voffB);
            PG8_BAR; PG8_WAIT_L(0); PG8_MMA(0, 1, At, B1); PG8_BAR;
            PG8_LDA(At, 1, 1); PG8_STAGE(PG8_SA(1, 0), a3, voffA);
            PG8_BAR; PG8_WAIT_L(0); PG8_MMA(1, 0, At, B0); PG8_BAR; PG8_SCHED;
            PG8_STAGE(PG8_SB(1, 1), b3 + hstepB, voffB);
            PG8_WAIT_V(6); PG8_BAR; PG8_MMA(1, 1, At, B1); PG8_BAR;
            }
        }
        if constexpr (ALIGN_EPI) { if (wr == 0) PG8_BAR; }
        if constexpr (!Epi::AFTER_DRAIN) { E(acc, cur, wr, wc, fr, fq); S.done(cur); }
        if (!has_next) break;
#pragma unroll
        for (int a = 0; a < 2; ++a)
#pragma unroll
            for (int b = 0; b < 2; ++b)
#pragma unroll
                for (int m = 0; m < 4; ++m)
#pragma unroll
                    for (int n = 0; n < 2; ++n) acc[a][b][m][n] = (f32x4){0.f, 0.f, 0.f, 0.f};
        cur = nxt; cA = nA; cB = nB; ++ui;
        if constexpr (ALIGN_EPI) { if (wr == 1) PG8_BAR; }
    }
    PG8_WAIT_V(0);
    if constexpr (!ALIGN_EPI) { if (wr == 0) PG8_BAR; }
    PG8_BAR;
#undef PG8_SA
#undef PG8_SB
#undef PG8_STAGE
#undef PG8_LDA
#undef PG8_LDB
#undef PG8_MMA
#undef PG8_WAIT_V
#undef PG8_WAIT_L
#undef PG8_BAR
#undef PG8_SCHED
}
}

#define XB_TMO      128
#define XB_XCNT(j)  (256  + 64 * (j))
#define XB_XSUB(j)  (1280 + 64 * (j))
#define XB_XGEN(j)  (2304 + 64 * (j))
#define XB_TOP      3328
#define XB_TOPGEN   3392
#define XCD_BAR_WORDS 3456
#define XB_SPIN_CAP (1u << 22)
__device__ __forceinline__ unsigned xb_ld(unsigned* p)              { return __hip_atomic_load(p, __ATOMIC_RELAXED, __HIP_MEMORY_SCOPE_AGENT); }
__device__ __forceinline__ unsigned xb_add(unsigned* p, unsigned v) { return __hip_atomic_fetch_add(p, v, __ATOMIC_RELAXED, __HIP_MEMORY_SCOPE_AGENT); }
__device__ __forceinline__ unsigned xb_xcc_id() { return (unsigned)__builtin_amdgcn_s_getreg((3 << 11) | 20) & 0xFu; }
#define XB_SPIN(cond, bar) do { unsigned _sp = 0; while (cond) { __builtin_amdgcn_s_sleep(1); \
    if ((++_sp & 255u) == 0u) { if (xb_ld(&(bar)[XB_TMO])) break; if (_sp > XB_SPIN_CAP) { atomicAdd(&(bar)[XB_TMO], 1u); break; } } } } while (0)
struct XcdBarrier { unsigned* bar; unsigned x; volatile LAS unsigned* st; };
__device__ __forceinline__ XcdBarrier xcd_barrier_post(unsigned* bar, volatile LAS unsigned* st) {
    XcdBarrier b; b.bar = bar; b.x = xb_xcc_id(); b.st = st;
    if (threadIdx.x == 0) (void)xb_add(&bar[XB_XCNT(b.x)], 1u);
    return b;
}
__device__ __forceinline__ void xcd_barrier_complete(unsigned* bar, unsigned x, unsigned& nloc, unsigned& nx) {
    const unsigned G = gridDim.x * gridDim.y * gridDim.z;
    unsigned sum, cnt, mine, sp = 0u;
    for (;;) {
        sum = 0u; cnt = 0u; mine = 0u;
#pragma unroll
        for (unsigned j = 0; j < 16; ++j) { const unsigned c = xb_ld(&bar[XB_XCNT(j)]); sum += c; cnt += (c > 0u) ? 1u : 0u; mine = (j == x) ? c : mine; }
        if (sum == G) break;
        __builtin_amdgcn_s_sleep(1);
        if ((++sp & 255u) == 0u) { if (xb_ld(&bar[XB_TMO])) break; if (sp > XB_SPIN_CAP) { atomicAdd(&bar[XB_TMO], 1u); break; } }
    }
    nloc = mine > 0u ? mine : 1u; nx = cnt > 0u ? cnt : 1u;
}
__device__ __forceinline__ void xcd_barrier(const XcdBarrier& b) {
    asm volatile("s_waitcnt vmcnt(0)" ::: "memory");
    __syncthreads();
    if (threadIdx.x == 0) {
        unsigned* bar = b.bar;
        __builtin_amdgcn_s_waitcnt(0);
        unsigned nloc = b.st[0], nx = b.st[1];
        if (nloc == 0u) { xcd_barrier_complete(bar, b.x, nloc, nx); b.st[0] = nloc; b.st[1] = nx; }
        const unsigned old = xb_add(&bar[XB_XSUB(b.x)], 1u);
        const unsigned gen = old / nloc;
        if (old + 1u == (gen + 1u) * nloc) {
            __builtin_amdgcn_fence(__ATOMIC_RELEASE, "agent");
            asm volatile("s_waitcnt vmcnt(0)" ::: "memory");
            const unsigned og = xb_add(&bar[XB_TOP], 1u);
            const unsigned tg = og / nx;
            if (og + 1u == (tg + 1u) * nx) xb_add(&bar[XB_TOPGEN], 1u);
            else XB_SPIN(xb_ld(&bar[XB_TOPGEN]) == tg, bar);
            __builtin_amdgcn_fence(__ATOMIC_ACQUIRE, "agent");
            xb_add(&bar[XB_XGEN(b.x)], 1u);
            asm volatile("s_waitcnt vmcnt(0)" ::: "memory");
        } else {
            XB_SPIN(xb_ld(&bar[XB_XGEN(b.x)]) == gen, bar);
            __builtin_amdgcn_fence(__ATOMIC_ACQUIRE, "agent");
            asm volatile("s_waitcnt vmcnt(0)" ::: "memory");
        }
    }
    __syncthreads();
}

constexpr size_t MiB = 1u << 20;
constexpr size_t WS_CTL = 0, CTL_ZERO_BYTES = 1 * MiB;
constexpr size_t WS_ROPE = 1 * MiB;
constexpr size_t WS_WTS = 4 * MiB;
constexpr size_t W_UP0 = WS_WTS, W_DN0 = WS_WTS + 44 * MiB, W_UP1 = WS_WTS + 66 * MiB, W_DN1 = WS_WTS + 110 * MiB;
constexpr size_t W_MIX = WS_WTS + 132 * MiB;
constexpr size_t W_G2 = W_MIX + 25 * MiB, W_GG = W_MIX + 28 * MiB, W_GV = W_MIX + 29 * MiB;
constexpr size_t W_GO = WS_WTS + 212 * MiB;
constexpr size_t WS_VF = 228 * MiB;
constexpr size_t WS_POOL = 420 * MiB;
constexpr size_t P_XN = WS_POOL;
constexpr size_t P_H = WS_POOL + 192 * MiB, P_HOUT = WS_POOL + 720 * MiB;
constexpr size_t P_MIX = WS_POOL + 192 * MiB;
constexpr size_t P_YF = WS_POOL + 192 * MiB, P_YB = WS_POOL + 384 * MiB, P_R = WS_POOL + 768 * MiB, P_K = WS_POOL + 960 * MiB, P_V = WS_POOL + 1152 * MiB,
                 P_HID = WS_POOL + 1344 * MiB, P_BS = WS_POOL + 1440 * MiB;
constexpr size_t P_QKV = WS_POOL + 192 * MiB, P_O0 = WS_POOL + 768 * MiB, P_LSE = WS_POOL + 1344 * MiB;
constexpr size_t WS_END = WS_POOL + 1452 * MiB;
constexpr int CW_BAR = 4096;
constexpr size_t WS_SCANFLAG = 512 * 1024;
constexpr int SCAN_NH = 63;
constexpr int SCAN_DUMP_U = 4592, SCAN_SLOT = 73728, SCAN_SLOTS_OUT = 5461;
constexpr size_t WS_RSX = 65536;

constexpr int RING_BYTES = 131072, CTRL_OFF = 143360, MISC_OFF = CTRL_OFF + 256, LDS_BYTES = 163840;
constexpr int NWAVES = 8;

struct Args { const float* in[28]; float* out; unsigned char* ws; int step_lo, step_hi; };

struct Seg { unsigned long long woff, soff, doff; int widx, sidx, ldw, col0, ldt, row0, k0dst, nkb, nnb, ilv, item0, pad0; };
__device__ __forceinline__ void seg_add(LAS Seg* s, int& n, int& items, int widx, size_t woff, int sidx, size_t soff, size_t doff, int ldw, int col0, int ldt, int row0, int k0dst, int nkb, int nnb, int ilv) {
    s[n].widx = widx; s[n].woff = woff; s[n].sidx = sidx; s[n].soff = soff; s[n].doff = doff; s[n].ldw = ldw; s[n].col0 = col0; s[n].ldt = ldt; s[n].row0 = row0; s[n].k0dst = k0dst; s[n].nkb = nkb; s[n].nnb = nnb; s[n].ilv = ilv; s[n].item0 = items;
    items += nkb * nnb; ++n;
}

extern __shared__ __attribute__((aligned(16))) unsigned char lds_raw[];
constexpr int PTR_OFF = CTRL_OFF + 512;
__device__ __forceinline__ unsigned long long ptr_ld(int i) {
    const LAS unsigned* p = (const LAS unsigned*)((LAS unsigned char*)lds_raw + PTR_OFF) + 2 * i;
    const unsigned lo = __builtin_amdgcn_readfirstlane(p[0]), hi = __builtin_amdgcn_readfirstlane(p[1]);
    return ((unsigned long long)hi << 32) | lo;
}
__device__ __forceinline__ const float* inp(int i) { return (const float*)(const GAS float*)ptr_ld(i); }
__device__ __forceinline__ float* outp() { return (float*)(GAS float*)ptr_ld(28); }
__device__ __forceinline__ unsigned char* wsp() { return (unsigned char*)(GAS unsigned char*)ptr_ld(29); }
#define FRAME() LAS unsigned char* lds = (LAS unsigned char*)lds_raw; int tid = threadIdx.x; asm volatile("" : "+v"(tid)); const int lane = tid & 63, wave = __builtin_amdgcn_readfirstlane(tid >> 6); \
    int bid_ = blockIdx.x, G = gridDim.x; asm volatile("" : "+s"(bid_), "+s"(G)); const int gw = bid_ * NWAVES + wave, NGW = G * NWAVES; unsigned char* ws = wsp(); (void)lds; (void)lane; (void)gw; (void)NGW; (void)ws; (void)G

static __device__ PHASE_ATTR void ph_init() {
    FRAME();
    const float* in0 = inp(0); const float* in1 = inp(1);
    {
        f32x2* tab = (f32x2*)(ws + WS_ROPE);
        for (int idx = bid_ * 512 + tid; idx < 16384 * 16; idx += G * 512) {
            const int pos = idx >> 4, i = idx & 15;
            double iv = 1.0;
            iv = (i == 1) ? 0.44036660267178046 : iv; iv = (i == 2) ? 0.19392274474868576 : iv; iv = (i == 3) ? 0.08539710028576561 : iv; iv = (i == 4) ? 0.03760603093086393 : iv;
            iv = (i == 5) ? 0.016560440080994446 : iv; iv = (i == 6) ? 0.007292664737217109 : iv; iv = (i == 7) ? 0.003211445994752591 : iv; iv = (i == 8) ? 0.001414213562373095 : iv;
            iv = (i == 9) ? 0.000622772421914596 : iv; iv = (i == 10) ? 0.0002742481756762073 : iv; iv = (i == 11) ? 0.00012076973741146504 : iv; iv = (i == 12) ? 5.318295896944988e-05 : iv;
            iv = (i == 13) ? 2.341999896140934e-05 : iv; iv = (i == 14) ? 1.031338537721246e-05 : iv; iv = (i == 15) ? 4.5416704806078695e-06 : iv;
            double t = (double)pos * iv * 0.15915494309189535; t = t - __builtin_rint(t);
            const float tf = (float)t;
            tab[idx] = (f32x2){__builtin_amdgcn_cosf(tf), __builtin_amdgcn_sinf(tf)};
        }
    }
    bf16_t* XB = (bf16_t*)(ws + P_XN); float* RSX = (float*)(ws + WS_RSX);
    for (int row = gw; row < TT; row += NGW) {
        const float* src = row < 32768 ? in0 + (size_t)row * D : in1 + (size_t)(row - 32768) * D;
        float ss = 0.f;
#pragma unroll
        for (int i = 0; i < 4; ++i) { const int e = 8 * (lane + 64 * i); const f32x4 a = *(const f32x4*)(src + e), b = *(const f32x4*)(src + e + 4);
#pragma unroll
            for (int j = 0; j < 4; ++j) ss += a[j] * a[j] + b[j] * b[j];
            *(u32x4*)(XB + (size_t)row * D + e) = (u32x4){pk2(a[0], a[1]), pk2(a[2], a[3]), pk2(b[0], b[1]), pk2(b[2], b[3])}; }
        const float rx = rsqrtf(wave_sum(ss) * (1.0f / D) + NORM_EPS);
        if (lane == 0) RSX[row] = rx;
    }
}

__device__ __forceinline__ void conv_load(const LAS Seg* sp, int local, int lane, f32x4 (&v)[8]) {
    const int widx = sp->widx; if (widx < 0) return;
    const int ldw = sp->ldw, nnb = sp->nnb, kb = local / nnb, nb = local % nnb;
    const float* p = inp(widx) + sp->woff + (size_t)(64 * kb + (lane >> 3)) * ldw + sp->col0 + 32 * nb + 4 * (lane & 7);
#pragma unroll
    for (int i = 0; i < 8; ++i) v[i] = *(const f32x4*)(p + (size_t)(8 * i) * ldw);
}
__device__ __forceinline__ void conv_finish(const LAS Seg* sp, int local, LAS float* scr, int lane, const f32x4 (&v)[8], unsigned char* ws) {
    const int widx = sp->widx, sidx = sp->sidx, ldt = sp->ldt, row0 = sp->row0, k0dst = sp->k0dst, nnb = sp->nnb, ilv = sp->ilv;
    bf16_t* dst = (bf16_t*)(ws + sp->doff);
    const int kb = local / nnb, nb = local % nnb, k0 = 64 * kb, n0 = 32 * nb, c = lane & 7;
    if (widx >= 0) {
        const float* scale = sidx >= 0 ? inp(sidx) + sp->soff + k0 + (lane >> 3) : nullptr;
#pragma unroll
        for (int i = 0; i < 8; ++i) { const int kk = (lane >> 3) + 8 * i; const float sc = scale ? scale[8 * i] : 1.0f;
            LAS float* s = scr + kk * 33 + 4 * (lane & 7); s[0] = v[i][0] * sc; s[1] = v[i][1] * sc; s[2] = v[i][2] * sc; s[3] = v[i][3] * sc; }
        asm volatile("s_waitcnt lgkmcnt(0)" ::: "memory");
    }
#pragma unroll
    for (int j = 0; j < 4; ++j) { const int n = (lane >> 3) + 8 * j; const int nn = n0 + n;
        int drow = row0 + ((ilv == 1) ? (256 * (nn >> 7) + (nn & 127)) : nn);
        if (ilv == 2 && ((nn >> 11) % 3) < 2) {
            const int co = nn & 127;
            const int nl = co < 32 ? (8 * (co & 15) + (co >> 4)) : (8 * ((co - 32) / 6) + 2 + (co - 32) % 6);
            drow = row0 + (nn & ~127) + nl; }
        u32x4 o = {0u, 0u, 0u, 0u};
        if (widx >= 0) { const LAS float* s = scr + (8 * c) * 33 + n;
            o.x = pk2(s[0 * 33], s[1 * 33]); o.y = pk2(s[2 * 33], s[3 * 33]); o.z = pk2(s[4 * 33], s[5 * 33]); o.w = pk2(s[6 * 33], s[7 * 33]); }
        *(u32x4*)(dst + (size_t)drow * ldt + k0dst + k0 + 8 * c) = o; }
    asm volatile("s_waitcnt lgkmcnt(0)" ::: "memory");
}
static __device__ PHASE_ATTR void ph_conv(int L) {
    FRAME();
    const int jm = L >> 1; const bool is_attn = (L & 1) != 0;
    LAS Seg* segs = (LAS Seg*)lds; LAS int* nseg_p = (LAS int*)(lds + 4096); LAS float* scr = (LAS float*)(lds + 8192 + wave * 8448);
    if (tid == 0) {
        int n = 0, items = 0;
        for (int f = 0; f < 2; ++f) {
            const size_t wo = (size_t)(L * 2 + f) * D * FF;
            const size_t up = f ? W_UP1 : W_UP0, dn = f ? W_DN1 : W_DN0;
            seg_add(segs, n, items, 4, wo, 2, (size_t)(L * 3 + 2 * f) * D, up, FF, 0, D, 0, 0, D / 64, FF / 32, 1);
            seg_add(segs, n, items, 5, wo, 2, (size_t)(L * 3 + 2 * f) * D, up, FF, 0, D, 128, 0, D / 64, FF / 32, 1);
            seg_add(segs, n, items, 6, wo, -1, 0, dn, D, 0, FF, 0, 0, FF / 64, D / 32, 0);
        }
        if (!is_attn) {
            for (int p = 0; p < 3; ++p) seg_add(segs, n, items, 8, (size_t)(jm * 3 + p) * D * D, -1, 0, W_MIX, D, 0, D, p * D, 0, D / 64, D / 32, 0);
            if (jm > 0) { seg_add(segs, n, items, 16, (size_t)(jm - 1) * D * 64, -1, 0, W_MIX, 64, 0, D, 3 * D, 0, D / 64, 2, 0);
                          seg_add(segs, n, items, -1, 0, -1, 0, W_MIX, 0, 0, D, 3 * D + 64, 0, D / 64, 6, 0);
                          seg_add(segs, n, items, 17, (size_t)(jm - 1) * 64 * D, -1, 0, W_GV, D, 0, 256, 0, 0, 1, D / 32, 0);
                          seg_add(segs, n, items, -1, 0, -1, 0, W_GV, 0, 0, 256, 0, 64, 3, D / 32, 0); }
            else seg_add(segs, n, items, -1, 0, -1, 0, W_MIX, 0, 0, D, 3 * D, 0, D / 64, 8, 0);
            for (int d = 0; d < 2; ++d) {
                seg_add(segs, n, items, 10, (size_t)(jm * 2 + d) * D * 96, -1, 0, W_G2, 96, 0, D, d * 128, 0, D / 64, 3, 0);
                seg_add(segs, n, items, -1, 0, -1, 0, W_G2, 0, 0, D, d * 128 + 96, 0, D / 64, 1, 0);
                seg_add(segs, n, items, 13, (size_t)(jm * 2 + d) * D * 96, -1, 0, W_G2, 96, 0, D, 256 + d * 128, 0, D / 64, 3, 0);
                seg_add(segs, n, items, -1, 0, -1, 0, W_G2, 0, 0, D, 256 + d * 128 + 96, 0, D / 64, 1, 0);
            }
            seg_add(segs, n, items, 18, (size_t)jm * D * 256, -1, 0, W_G2, 256, 0, D, 512, 0, D / 64, 8, 0);
            seg_add(segs, n, items, 19, (size_t)jm * 256 * D, -1, 0, W_GG, D, 0, 256, 0, 0, 4, D / 32, 0);
            seg_add(segs, n, items, 25, (size_t)jm * D * D, -1, 0, W_GO, D, 0, D, 0, 0, D / 64, D / 32, 0);
        } else {
            seg_add(segs, n, items, 26, (size_t)jm * D * 9 * D, 2, (size_t)(L * 3 + 1) * D, W_MIX, 9 * D, 0, D, 0, 0, D / 64, 9 * D / 32, 2);
            seg_add(segs, n, items, 27, (size_t)jm * D * D, -1, 0, W_GO, D, 0, D, 0, 0, D / 64, D / 32, 0);
        }
        segs[n].item0 = items; nseg_p[0] = n; nseg_p[1] = items;
    }
    __syncthreads();
    const int total = nseg_p[1];
    f32x4 cur[8], nxt[8];
#pragma unroll
    for (int i = 0; i < 8; ++i) { cur[i] = (f32x4){0.f, 0.f, 0.f, 0.f}; nxt[i] = cur[i]; }
    int it = gw, si = 0;
    if (it < total) { while (it >= segs[si + 1].item0) ++si; conv_load(segs + si, it - segs[si].item0, lane, cur); }
    while (it < total) {
        const int itn = it + NGW; int sn = si;
        if (itn < total) { while (itn >= segs[sn + 1].item0) ++sn; conv_load(segs + sn, itn - segs[sn].item0, lane, nxt); }
        conv_finish(segs + si, it - segs[si].item0, scr, lane, cur, ws);
#pragma unroll
        for (int i = 0; i < 8; ++i) cur[i] = nxt[i];
        it = itn; si = sn;
    }
    __syncthreads();
}

static __device__ PHASE_ATTR void ph_ffn_up(int f) {
    FRAME();
    pg8::Gemm g{(const bf16_t*)(ws + P_XN), (const bf16_t*)(ws + (f ? W_UP1 : W_UP0)), TT, 2 * FF, D, D}; pg8::StaticOrder S; S.init(TT, 2 * FF, G, bid_);
    pg8::EpiSwiGLU E{(bf16_t*)(ws + P_H), (const float*)(ws + WS_RSX)};
    pg8::gemm_phase<pg8::EpiSwiGLU, pg8::StaticOrder, true, true>(lds, g, S, E, tid);
}
static __device__ PHASE_ATTR void ph_gemm_plain(size_t a_off, int lda, size_t b_off, int N, int K, size_t o_off, int ldc) {
    FRAME();
    pg8::Gemm g{(const bf16_t*)(ws + a_off), (const bf16_t*)(ws + b_off), TT, N, K, lda}; pg8::StaticOrder S; S.init(TT, N, G, bid_);
    pg8::EpiPlain E{(bf16_t*)(ws + o_off), ldc};
    pg8::gemm_phase<pg8::EpiPlain, pg8::StaticOrder, true, true>(lds, g, S, E, tid);
}
static __device__ PHASE_ATTR void ph_qkv(int gi) {
    FRAME();
    pg8::Gemm g{(const bf16_t*)(ws + P_XN), (const bf16_t*)(ws + W_MIX) + (size_t)gi * 3 * D * D, TT, 3 * D, D, D}; pg8::StaticOrder S; S.init(TT, 3 * D, G, bid_);
    pg8::EpiQKV E{(bf16_t*)(ws + P_QKV), (const f32x2*)(ws + WS_ROPE), (const float*)(ws + WS_RSX)};
    pg8::gemm_phase<pg8::EpiQKV, pg8::StaticOrder, true, true>(lds, g, S, E, tid);
}
static __device__ PHASE_ATTR void ph_g1(int jm, int round) {
    FRAME();
    pg8::Gemm g{(const bf16_t*)(ws + P_MIX), (const bf16_t*)(ws + (round ? W_G2 : W_MIX)), TT, round ? NG2 : NG1, D, D, (size_t)192 * MiB, round ? 1 : 8, round ? 2 : 16};
    pg8::StaticOrder S; S.init(TT, round ? NG2 : NG1, G, bid_);
    pg8::EpiG1 E{ws, P_R, (jm == 0 ? WS_VF : P_V), P_HID, round};
    pg8::gemm_phase<pg8::EpiG1, pg8::StaticOrder, true, true>(lds, g, S, E, tid);
}
static __device__ PHASE_ATTR void ph_gv(int jm) {
    FRAME();
    pg8::Gemm g{(const bf16_t*)(ws + P_HID) + 768, (const bf16_t*)(ws + W_GV), TT, D, 256, HID}; pg8::StaticOrder S; S.init(TT, D, G, bid_);
    pg8::EpiVres E{(bf16_t*)(ws + P_V), (const bf16_t*)(ws + WS_VF), inp(15) + (size_t)(jm - 1) * D};
    pg8::gemm_phase<pg8::EpiVres, pg8::StaticOrder, true, true>(lds, g, S, E, tid);
}
static __device__ PHASE_ATTR void ph_gg() {
    FRAME();
    pg8::Gemm g{(const bf16_t*)(ws + P_HID) + 512, (const bf16_t*)(ws + W_GG), TT, D, 256, HID}; pg8::StaticOrder S; S.init(TT, D, G, bid_);
    pg8::EpiGmul E{(bf16_t*)(ws + P_YF)};
    pg8::gemm_phase<pg8::EpiGmul, pg8::StaticOrder, true, true>(lds, g, S, E, tid);
}

static __device__ PHASE_ATTR void ph_mix(int jm, int round) {
    FRAME();
    const bf16_t* XB = (const bf16_t*)(ws + P_XN); const float* RSX = (const float*)(ws + WS_RSX); bf16_t* MX = (bf16_t*)(ws + P_MIX);
    const float* mu = inp(7) + (size_t)jm * 6 * D; const float* gpre = inp(2) + (size_t)((2 * jm) * 3 + 1) * D;
    const int m0 = round ? 1 : 0, m1 = round ? 4 : 2, m2 = round ? 5 : 3;
    u32x4 cq[4], pq[4], nq[4]; float rcq, rpq, rnq;
#define MIX_LOAD(row_) do { const int r_ = (row_); int base_, pos_, len_; row_decode(r_, base_, pos_, len_); const bf16_t* a_ = XB + (size_t)r_ * D; \
        rcq = RSX[r_]; rpq = pos_ > 0 ? RSX[r_ - 1] : 0.f; rnq = pos_ < len_ - 1 ? RSX[r_ + 1] : 0.f; \
        _Pragma("unroll") for (int i = 0; i < 4; ++i) { const int e = 8 * (lane + 64 * i); cq[i] = *(const u32x4*)(a_ + e); pq[i] = (u32x4){0u, 0u, 0u, 0u}; nq[i] = (u32x4){0u, 0u, 0u, 0u}; \
            if (pos_ > 0) pq[i] = *(const u32x4*)(a_ - D + e); if (pos_ < len_ - 1) nq[i] = *(const u32x4*)(a_ + D + e); } } while (0)
    int row = gw;
    if (row < TT) MIX_LOAD(row);
    for (; row < TT; row += NGW) {
        u32x4 cc[4], pc[4], nc[4];
#pragma unroll
        for (int i = 0; i < 4; ++i) { cc[i] = cq[i]; pc[i] = pq[i]; nc[i] = nq[i]; }
        const float rc = rcq, rp = rpq, rn = rnq;
        if (row + NGW < TT) MIX_LOAD(row + NGW);
#pragma unroll
        for (int i = 0; i < 4; ++i) { const int e = 8 * (lane + 64 * i);
            const unsigned cw[4] = {cc[i].x, cc[i].y, cc[i].z, cc[i].w}, pw[4] = {pc[i].x, pc[i].y, pc[i].z, pc[i].w}, nw[4] = {nc[i].x, nc[i].y, nc[i].z, nc[i].w};
            const f32x4 ga = *(const f32x4*)(gpre + e), gb = *(const f32x4*)(gpre + e + 4);
            float cv[8], xx[8];
#pragma unroll
            for (int j = 0; j < 4; ++j) { const float g0 = j < 2 ? ga[2 * j] : gb[2 * j - 4], g1 = j < 2 ? ga[2 * j + 1] : gb[2 * j - 3];
                cv[2 * j] = bflo(cw[j]) * rc * g0; cv[2 * j + 1] = bfhi(cw[j]) * rc * g1;
                xx[2 * j] = 0.5f * (bflo(pw[j]) * rp + bflo(nw[j]) * rn) * g0 - cv[2 * j]; xx[2 * j + 1] = 0.5f * (bfhi(pw[j]) * rp + bfhi(nw[j]) * rn) * g1 - cv[2 * j + 1]; }
#pragma unroll
            for (int m = 0; m < 3; ++m) { const int mi = m == 0 ? m0 : (m == 1 ? m1 : m2);
                const f32x4 ma = *(const f32x4*)(mu + mi * D + e), mb = *(const f32x4*)(mu + mi * D + e + 4);
                const u32x4 o = {pk2(cv[0] + xx[0] * ma[0], cv[1] + xx[1] * ma[1]), pk2(cv[2] + xx[2] * ma[2], cv[3] + xx[3] * ma[3]), pk2(cv[4] + xx[4] * mb[0], cv[5] + xx[5] * mb[1]), pk2(cv[6] + xx[6] * mb[2], cv[7] + xx[7] * mb[3])};
                *(u32x4*)(MX + (size_t)m * TT * D + (size_t)row * D + e) = o; }
        }
    }
#undef MIX_LOAD
}

static __device__ __forceinline__ void scan_stage_e(LAS unsigned char* lds, f32x4 (&ST)[4], const int lane, const int vb) {
    constexpr int RS = 72;
    LAS bf16_t* AH = (LAS bf16_t*)(lds); LAS bf16_t* RH = (LAS bf16_t*)(lds + 9216); LAS bf16_t* BT = (LAS bf16_t*)(lds + 36864); LAS bf16_t* YS = (LAS bf16_t*)(lds + 64512);
    LAS unsigned char* KVI = lds + 73728; LAS unsigned char* MAKV = lds + 90112; LAS unsigned char* NRKV = lds + 98304;
    LAS unsigned char* MABF = lds + 108544; LAS unsigned char* NRBF = lds + 112640; LAS bf16_t* TTI = (LAS bf16_t*)(lds + 122880); LAS float* GL = (LAS float*)(lds + 125440);
    const int c15 = lane & 15, g = lane >> 4; const f32x4 zero4 = {0.f, 0.f, 0.f, 0.f};
#define PK_LO(x) __builtin_bit_cast(bf16x8, (u32x4){pk2((x)[0], (x)[1]), pk2((x)[2], (x)[3]), 0u, 0u})
#define PK_2(x, y) __builtin_bit_cast(bf16x8, (u32x4){pk2((x)[0], (x)[1]), pk2((x)[2], (x)[3]), pk2((y)[0], (y)[1]), pk2((y)[2], (y)[3])})
#define ROWFRAG(P) __builtin_bit_cast(bf16x8, (u32x4){(P)[0].x, (P)[0].y, (P)[1].x, (P)[1].y})
                u32x2 ahq[4][4], mkq[4];
#pragma unroll
                for (int tb = 0; tb < 4; ++tb) { const LAS bf16_t* ap = AH + (16 * tb + c15) * RS + 4 * g;
#pragma unroll
                    for (int q = 0; q < 4; ++q) ahq[tb][q] = *(const LAS u32x2*)(ap + 16 * q);
                    mkq[tb] = *(const LAS u32x2*)(MAKV + ((tb * 4 + vb) * 64 + lane) * 8); }
                const u32x4 Sf0 = {pk2(ST[0][0], ST[0][1]), pk2(ST[0][2], ST[0][3]), pk2(ST[1][0], ST[1][1]), pk2(ST[1][2], ST[1][3])};
                const u32x4 Sf1 = {pk2(ST[2][0], ST[2][1]), pk2(ST[2][2], ST[2][3]), pk2(ST[3][0], ST[3][1]), pk2(ST[3][2], ST[3][3])};
                __builtin_amdgcn_sched_barrier(0);
                u32x2 tfq[4]; bf16x8 mf[4];
#pragma unroll
                for (int tb = 0; tb < 4; ++tb) { tfq[tb] = *(const LAS u32x2*)(TTI + (tb * 16 + c15) * 20 + 4 * g); mf[tb] = *(const LAS bf16x8*)(MABF + (tb * 64 + lane) * 16); }
                f32x4 U[4];
#pragma unroll
                for (int tb = 0; tb < 4; ++tb) {
                    f32x4 acc = {bflo(mkq[tb].x), bfhi(mkq[tb].x), bflo(mkq[tb].y), bfhi(mkq[tb].y)};
                    acc = __builtin_amdgcn_mfma_f32_16x16x32_bf16(ROWFRAG(ahq[tb]), __builtin_bit_cast(bf16x8, Sf0), acc, 0, 0, 0);
                    acc = __builtin_amdgcn_mfma_f32_16x16x32_bf16(ROWFRAG(ahq[tb] + 2), __builtin_bit_cast(bf16x8, Sf1), acc, 0, 0, 0);
                    U[tb] = acc; }
                __builtin_amdgcn_sched_barrier(0);
                u32x2 rhq[4][4], nkq[4];
#pragma unroll
                for (int tb = 0; tb < 4; ++tb) { const LAS bf16_t* rp = RH + (16 * tb + c15) * RS + 4 * g;
#pragma unroll
                    for (int q = 0; q < 4; ++q) rhq[tb][q] = *(const LAS u32x2*)(rp + 16 * q);
                    nkq[tb] = *(const LAS u32x2*)(NRKV + ((tb * 4 + vb) * 64 + lane) * 8); }
                f32x4 Y1[4];
#pragma unroll
                for (int tb = 0; tb < 4; ++tb) {
                    f32x4 acy = {bflo(nkq[tb].x), bfhi(nkq[tb].x), bflo(nkq[tb].y), bfhi(nkq[tb].y)};
                    acy = __builtin_amdgcn_mfma_f32_16x16x32_bf16(ROWFRAG(rhq[tb]), __builtin_bit_cast(bf16x8, Sf0), acy, 0, 0, 0);
                    acy = __builtin_amdgcn_mfma_f32_16x16x32_bf16(ROWFRAG(rhq[tb] + 2), __builtin_bit_cast(bf16x8, Sf1), acy, 0, 0, 0);
                    Y1[tb] = acy; }
                const bf16x8 tf0 = __builtin_bit_cast(bf16x8, (u32x4){tfq[0].x, tfq[0].y, 0u, 0u}), tf1 = __builtin_bit_cast(bf16x8, (u32x4){tfq[1].x, tfq[1].y, 0u, 0u});
                const bf16x8 tf2 = __builtin_bit_cast(bf16x8, (u32x4){tfq[2].x, tfq[2].y, 0u, 0u}), tf3 = __builtin_bit_cast(bf16x8, (u32x4){tfq[3].x, tfq[3].y, 0u, 0u});
                f32x4 SA0 = __builtin_amdgcn_mfma_f32_16x16x32_bf16(tf0, PK_LO(U[0]), zero4, 0, 0, 0);
                f32x4 rhs = __builtin_amdgcn_mfma_f32_16x16x32_bf16(mf[0], PK_LO(SA0), U[1], 0, 0, 0);
                f32x4 SA1 = __builtin_amdgcn_mfma_f32_16x16x32_bf16(tf1, PK_LO(rhs), zero4, 0, 0, 0);
                const bf16x8 SAf0 = PK_2(SA0, SA1);
                rhs = __builtin_amdgcn_mfma_f32_16x16x32_bf16(mf[1], SAf0, U[2], 0, 0, 0);
                f32x4 SA2 = __builtin_amdgcn_mfma_f32_16x16x32_bf16(tf2, PK_LO(rhs), zero4, 0, 0, 0);
                rhs = __builtin_amdgcn_mfma_f32_16x16x32_bf16(mf[2], SAf0, U[3], 0, 0, 0);
                rhs = __builtin_amdgcn_mfma_f32_16x16x32_bf16(mf[3], PK_LO(SA2), rhs, 0, 0, 0);
                f32x4 SA3 = __builtin_amdgcn_mfma_f32_16x16x32_bf16(tf3, PK_LO(rhs), zero4, 0, 0, 0);
                const bf16x8 SAf1 = PK_2(SA2, SA3);
                __builtin_amdgcn_sched_barrier(0);
                bf16x8 nrf[6];
#pragma unroll
                for (int i = 0; i < 6; ++i) nrf[i] = *(const LAS bf16x8*)(NRBF + (i * 64 + lane) * 16);
                f32x4 kvq[4], glq[4]; u32x2 btq[4][4];
#pragma unroll
                for (int kb = 0; kb < 4; ++kb) { const LAS bf16_t* bp = BT + (16 * kb + c15) * RS + 4 * g;
#pragma unroll
                    for (int q = 0; q < 4; ++q) btq[kb][q] = *(const LAS u32x2*)(bp + 16 * q);
                    kvq[kb] = *(const LAS f32x4*)(KVI + ((kb * 4 + vb) * 64 + lane) * 16); glq[kb] = *(const LAS f32x4*)(GL + 16 * kb + 4 * g); }
#pragma unroll
                for (int tb = 0; tb < 4; ++tb) { const int nb = tb == 0 ? 0 : (tb == 1 ? 1 : (tb == 2 ? 2 : 4));
                    f32x4 acc = __builtin_amdgcn_mfma_f32_16x16x32_bf16(nrf[nb], SAf0, Y1[tb], 0, 0, 0);
                    if (tb >= 2) acc = __builtin_amdgcn_mfma_f32_16x16x32_bf16(nrf[nb + 1], SAf1, acc, 0, 0, 0);
#pragma unroll
                    for (int r = 0; r < 4; ++r) YS[(16 * tb + 4 * g + r) * RS + 16 * vb + c15] = (bf16_t)(pk2(acc[r], 0.f) & 0xffffu); }
#pragma unroll
                for (int kb = 0; kb < 4; ++kb) { f32x4 acc = kvq[kb];
                    acc = __builtin_amdgcn_mfma_f32_16x16x32_bf16(ROWFRAG(btq[kb]), SAf0, acc, 0, 0, 0);
                    acc = __builtin_amdgcn_mfma_f32_16x16x32_bf16(ROWFRAG(btq[kb] + 2), SAf1, acc, 0, 0, 0);
                    ST[kb] = glq[kb] * (ST[kb] + acc); }
#undef ROWFRAG
#undef PK_LO
#undef PK_2
}

template <int CTRL> __device__ __forceinline__ float dpp_row_shr(float v) { return __builtin_bit_cast(float, __builtin_amdgcn_update_dpp(0, __builtin_bit_cast(int, v), CTRL, 0xf, 0xf, true)); }
static __device__ PHASE_ATTR void ph_scan(int jm) {
    FRAME();
    const bf16_t* Rb = (const bf16_t*)(ws + P_R); const bf16_t* Kb = (const bf16_t*)(ws + P_K); const bf16_t* Vb = (const bf16_t*)(ws + (jm == 0 ? WS_VF : P_V));
    const bf16_t* Hd = (const bf16_t*)(ws + P_HID); float* BS = (float*)(ws + P_BS);
    constexpr int RS = 72;
    LAS bf16_t* AH = (LAS bf16_t*)(lds); LAS bf16_t* RH = (LAS bf16_t*)(lds + 9216); LAS bf16_t* BH = (LAS bf16_t*)(lds + 18432); LAS bf16_t* KH = (LAS bf16_t*)(lds + 27648);
    LAS bf16_t* BT = (LAS bf16_t*)(lds + 36864); LAS bf16_t* KT = (LAS bf16_t*)(lds + 46080); LAS bf16_t* VT = (LAS bf16_t*)(lds + 55296); LAS bf16_t* YS = (LAS bf16_t*)(lds + 64512);
    LAS unsigned char* KVI = lds + 73728; LAS unsigned char* MAKV = lds + 90112; LAS unsigned char* NRKV = lds + 98304;
    LAS float* SEG = (LAS float*)(lds + 106496); LAS float* NRM = (LAS float*)(lds + 107520); LAS float* BON = (LAS float*)(lds + 108032);
    LAS unsigned char* MABF = lds + 108544; LAS unsigned char* NRBF = lds + 112640;
    LAS float* MS = (LAS float*)(lds + 118784); LAS bf16_t* TTI = (LAS bf16_t*)(lds + 122880);
    LAS float* GL = (LAS float*)(lds + 125440); LAS float* PAR = (LAS float*)(lds + 125696);
    LAS unsigned char* W2F = lds + 147456;
    LAS unsigned char* A2F = lds + 126976;
    const int c15 = lane & 15, g = lane >> 4;
    const int tbq = wave & 3, half = wave >> 2;
    const int tF = tid >> 3, c8 = tid & 7;
    const int tbD = wave & 3, kindD = wave >> 2;
    const f32x4 zero4 = {0.f, 0.f, 0.f, 0.f};
    for (int it = bid_; it < 256; it += G) {
        const int seq = it & 3, head = (it >> 2) & 31, dir = it >> 7;
        const bool split = (G == 256);
        const bool helper = split && seq >= 2;
        const int pair = (seq & 1) | (head << 1) | (dir << 6);
        unsigned* flag = (unsigned*)(ws + WS_SCANFLAG + (size_t)jm * 8192 + (size_t)pair * 64);
#pragma unroll 1
        for (int pass = helper ? 0 : 1; pass < 2; ++pass) {
        __syncthreads();
        if (tid < 64) { const int c = head * 64 + tid;
            PAR[tid] = inp(9)[(size_t)(jm * 2 + dir) * D + c]; PAR[64 + tid] = inp(12)[(size_t)(jm * 2 + dir) * D + c];
            PAR[128 + tid] = inp(20)[(size_t)jm * D + c]; PAR[192 + tid] = inp(21)[(size_t)jm * D + c]; PAR[256 + tid] = inp(22)[(size_t)jm * D + c]; }
        int lane_s = lane; asm volatile("" : "+v"(lane_s));
        const int c15s = lane_s & 15, gs = lane_s >> 4;
#pragma unroll
        for (int kind = 0; kind < 2; ++kind)
#pragma unroll
            for (int cbi = 0; cbi < 2; ++cbi) { const float* M = (kind == 0 ? inp(11) : inp(14)) + (size_t)(jm * 2 + dir) * 96 * D + head * 64;
                const unsigned mo = (unsigned)(8 * gs * D + 16 * (2 * half + cbi) + c15s);
#pragma unroll
                for (int ks = 0; ks < 3; ++ks) { float x[8];
#pragma unroll
                    for (int j = 0; j < 8; ++j) x[j] = M[mo + (unsigned)((32 * ks + j) * D)];
                    const u32x4 w = {pk2(x[0], x[1]), pk2(x[2], x[3]), pk2(x[4], x[5]), pk2(x[6], x[7])};
                    *(LAS u32x4*)((kind == 0 ? W2F : A2F) + (((half * 2 + cbi) * 3 + ks) * 64 + lane_s) * 16) = w; }
                __builtin_amdgcn_sched_barrier(0); }
        bf16_t* yd = (bf16_t*)(ws + (dir ? P_YB : P_YF));
        const int cofs = head * 64 + 32 * half + 4 * g;
        bf16x8 hwf[3], haf[3]; u32x2 rq[2], kq[2], vq[2];
#define SCAN_PREFETCH(chunk_) do { const int st_ = (chunk_) * 64 + 16 * tbq + c15; const size_t row_ = (size_t)(base + (dir ? (len - 1 - st_) : st_)); \
            const bf16_t* hp_ = Hd + row_ * HID + dir * 128 + 8 * g; \
            _Pragma("unroll") for (int ks = 0; ks < 3; ++ks) { hwf[ks] = *(const bf16x8*)(hp_ + 32 * ks); haf[ks] = *(const bf16x8*)(hp_ + 256 + 32 * ks); } \
            _Pragma("unroll") for (int cbi = 0; cbi < 2; ++cbi) { rq[cbi] = *(const u32x2*)(Rb + row_ * D + cofs + 16 * cbi); kq[cbi] = *(const u32x2*)(Kb + row_ * D + cofs + 16 * cbi); vq[cbi] = *(const u32x2*)(Vb + row_ * D + cofs + 16 * cbi); } } while (0)
        const int sq = pass ? seq : seq - 2; const bool pre = (pass == 0);
        const int base = sq < 2 ? sq * 16384 : 32768 + (sq - 2) * 8192, len = sq < 2 ? 16384 : 8192;
        const int nch = len >> 6;
        const int c0 = pre ? nch - SCAN_NH : 0;
        const int cfull = (split && !pre && sq < 2) ? nch - SCAN_NH : nch;
        f32x4 ST[4] = {zero4, zero4, zero4, zero4};
        SCAN_PREFETCH(c0);
        __syncthreads();
#pragma unroll 1
        for (int chunk = c0; chunk < cfull; ++chunk) {
            int tid_o = tid; asm volatile("" : "+v"(tid_o));
            const int lane = tid_o & 63, c15 = lane & 15, g = lane >> 4, tF = tid_o >> 3, c8 = tid_o & 7;
            const int cofs = head * 64 + 32 * half + 4 * g;
            const int tq = 16 * tbq + c15;
            const int stq = chunk * 64 + tq; const size_t rowq = (size_t)(base + (dir ? (len - 1 - stq) : stq));
            float r8[8], lw8[8], asg[8], kkr[8], kd8[8], pfx[8]; u32x2 vkeep[2];
            {
                f32x4 accw[2] = {zero4, zero4}, acca[2] = {zero4, zero4};
#pragma unroll
                for (int cbi = 0; cbi < 2; ++cbi)
#pragma unroll
                    for (int ks = 0; ks < 3; ++ks) { accw[cbi] = __builtin_amdgcn_mfma_f32_16x16x32_bf16(*(const LAS bf16x8*)(W2F + (((half * 2 + cbi) * 3 + ks) * 64 + lane) * 16), hwf[ks], accw[cbi], 0, 0, 0); acca[cbi] = __builtin_amdgcn_mfma_f32_16x16x32_bf16(*(const LAS bf16x8*)(A2F + (((half * 2 + cbi) * 3 + ks) * 64 + lane) * 16), haf[ks], acca[cbi], 0, 0, 0); }
                float k8[8]; float ss = 0.f, bon = 0.f;
#pragma unroll
                for (int cbi = 0; cbi < 2; ++cbi) { const int cl = 32 * half + 16 * cbi + 4 * g;
                    const f32x4 w0v = *(const LAS f32x4*)(PAR + cl), a0v = *(const LAS f32x4*)(PAR + 64 + cl), kkv = *(const LAS f32x4*)(PAR + 128 + cl), kav = *(const LAS f32x4*)(PAR + 192 + cl), rkv = *(const LAS f32x4*)(PAR + 256 + cl);
                    const unsigned rw2[2] = {rq[cbi].x, rq[cbi].y}, kw2[2] = {kq[cbi].x, kq[cbi].y}; vkeep[cbi] = vq[cbi];
#pragma unroll
                    for (int r = 0; r < 4; ++r) { const int e = 4 * cbi + r;
                        r8[e] = (r & 1) ? bfhi(rw2[r >> 1]) : bflo(rw2[r >> 1]); k8[e] = (r & 1) ? bfhi(kw2[r >> 1]) : bflo(kw2[r >> 1]);
                        const float wr = w0v[r] + accw[cbi][r], ar = a0v[r] + acca[cbi][r];
                        lw8[e] = -0.60653065971263342f * __builtin_amdgcn_rcpf(1.0f + __expf(-wr));
                        asg[e] = __builtin_amdgcn_rcpf(1.0f + __expf(-ar)); kkr[e] = k8[e] * kkv[r]; ss += kkr[e] * kkr[e];
                        kd8[e] = k8[e] * (1.0f + (asg[e] - 1.0f) * kav[r]); bon += r8[e] * kd8[e] * rkv[r]; } }
                ss += __shfl_xor(ss, 16); ss += __shfl_xor(ss, 32); bon += __shfl_xor(bon, 16); bon += __shfl_xor(bon, 32);
                if (g == 0) { NRM[half * 64 + tq] = ss; BON[half * 64 + tq] = bon; }
#pragma unroll
                for (int e = 0; e < 8; ++e) { float x = lw8[e]; x += dpp_row_shr<0x111>(x); x += dpp_row_shr<0x112>(x); x += dpp_row_shr<0x114>(x); x += dpp_row_shr<0x118>(x); pfx[e] = x; }
                if (c15 == 15) { *(LAS f32x4*)(SEG + tbq * 64 + 32 * half + 4 * g) = (f32x4){pfx[0], pfx[1], pfx[2], pfx[3]}; *(LAS f32x4*)(SEG + tbq * 64 + 32 * half + 16 + 4 * g) = (f32x4){pfx[4], pfx[5], pfx[6], pfx[7]}; }
            }
            if (chunk > c0 && !pre) { const int st = (chunk - 1) * 64 + tF; const int p = dir ? (len - 1 - st) : st;
                *(u32x4*)(yd + (size_t)(base + p) * D + head * 64 + 8 * c8) = *(const LAS u32x4*)(YS + tF * RS + 8 * c8); }
            __syncthreads();
            {
                f32x4 of0 = zero4, of1 = zero4;
                for (int s = 0; s < tbq; ++s) { of0 += *(const LAS f32x4*)(SEG + s * 64 + 32 * half + 4 * g); of1 += *(const LAS f32x4*)(SEG + s * 64 + 32 * half + 16 + 4 * g); }
                const float inv = __builtin_amdgcn_rcpf(fmaxf(sqrtf(NRM[tq] + NRM[64 + tq]), 1e-12f));
                if (half == 0 && g == 0) BS[((size_t)dir * TT + rowq) * 32 + head] = BON[tq] + BON[64 + tq];
#pragma unroll
                for (int cbi = 0; cbi < 2; ++cbi) { const int cl = 32 * half + 16 * cbi + 4 * g; float ah[4], bh[4], kh[4], rh[4];
#pragma unroll
                    for (int r = 0; r < 4; ++r) { const int e = 4 * cbi + r; const float lg = pfx[e] + (cbi ? of1[r] : of0[r]); const float lm = lg - lw8[e];
                        const float e1 = __expf(lg), e2 = __builtin_amdgcn_rcpf(e1), e3 = __expf(lm); const float kk = kkr[e] * inv;
                        ah[r] = -kk * e3; bh[r] = kk * asg[e] * e2; kh[r] = kd8[e] * e2; rh[r] = r8[e] * e1; }
                    const u32x2 aw = {pk2(ah[0], ah[1]), pk2(ah[2], ah[3])}, bw = {pk2(bh[0], bh[1]), pk2(bh[2], bh[3])}, kw = {pk2(kh[0], kh[1]), pk2(kh[2], kh[3])}, rw = {pk2(rh[0], rh[1]), pk2(rh[2], rh[3])};
                    *(LAS u32x2*)(AH + tq * RS + cl) = aw; *(LAS u32x2*)(BH + tq * RS + cl) = bw; *(LAS u32x2*)(KH + tq * RS + cl) = kw; *(LAS u32x2*)(RH + tq * RS + cl) = rw;
                    const unsigned bww[2] = {bw.x, bw.y}, kww[2] = {kw.x, kw.y}, vww[2] = {vkeep[cbi].x, vkeep[cbi].y};
#pragma unroll
                    for (int r = 0; r < 4; ++r) { BT[(cl + r) * RS + tq] = (bf16_t)((r & 1) ? (bww[r >> 1] >> 16) : (bww[r >> 1] & 0xffffu)); KT[(cl + r) * RS + tq] = (bf16_t)((r & 1) ? (kww[r >> 1] >> 16) : (kww[r >> 1] & 0xffffu));
                        VT[(cl + r) * RS + tq] = (bf16_t)((r & 1) ? (vww[r >> 1] >> 16) : (vww[r >> 1] & 0xffffu)); }
                    if (tq == 63) *(LAS f32x4*)(GL + cl) = (f32x4){__expf(pfx[4 * cbi] + (cbi ? of1[0] : of0[0])), __expf(pfx[4 * cbi + 1] + (cbi ? of1[1] : of0[1])), __expf(pfx[4 * cbi + 2] + (cbi ? of1[2] : of0[2])), __expf(pfx[4 * cbi + 3] + (cbi ? of1[3] : of0[3]))}; }
            }
            __syncthreads();
            {
                const int tloc = c15;
                if (kindD == 0) {
                    bf16x8 bfA[2];
#pragma unroll
                    for (int ks = 0; ks < 2; ++ks) bfA[ks] = *(const LAS bf16x8*)(AH + (16 * tbD + c15) * RS + 32 * ks + 8 * g);
                    f32x4 GT1[4] = {zero4, zero4, zero4, zero4};
#pragma unroll
                    for (int ib = 0; ib < 4; ++ib) if (ib <= tbD) {
                        f32x4 a1 = zero4;
#pragma unroll
                        for (int ks = 0; ks < 2; ++ks) a1 = __builtin_amdgcn_mfma_f32_16x16x32_bf16(*(const LAS bf16x8*)(BH + (16 * ib + c15) * RS + 32 * ks + 8 * g), bfA[ks], a1, 0, 0, 0);
                        if (ib == tbD) {
#pragma unroll
                            for (int r = 0; r < 4; ++r) if (!(4 * g + r < tloc)) a1[r] = 0.f; }
                        GT1[ib] = a1;
                    }
                    const f32x4 m1 = (tbD >= 2) ? GT1[1] : zero4, m2 = (tbD == 3) ? GT1[2] : zero4;
                    const u32x4 F01 = {pk2(GT1[0][0], GT1[0][1]), pk2(GT1[0][2], GT1[0][3]), pk2(m1[0], m1[1]), pk2(m1[2], m1[3])};
                    const u32x4 F23 = {pk2(m2[0], m2[1]), pk2(m2[2], m2[3]), 0u, 0u};
                    if (tbD == 1) *(LAS u32x4*)(MABF + (0 * 64 + lane) * 16) = F01;
                    if (tbD == 2) *(LAS u32x4*)(MABF + (1 * 64 + lane) * 16) = F01;
                    if (tbD == 3) { *(LAS u32x4*)(MABF + (2 * 64 + lane) * 16) = F01; *(LAS u32x4*)(MABF + (3 * 64 + lane) * 16) = F23; }
                    f32x4 dg = GT1[0]; dg = (tbD == 1) ? GT1[1] : dg; dg = (tbD == 2) ? GT1[2] : dg; dg = (tbD == 3) ? GT1[3] : dg;
                    *(LAS f32x4*)(MS + (tbD * 16 + c15) * 16 + 4 * g) = dg;
                    asm volatile("s_waitcnt lgkmcnt(0)" ::: "memory");
                    const int lane_o = lane;
                    if (lane < 16) { float x[16];
#pragma unroll
                        for (int t = 0; t < 16; ++t) { const LAS f32x4* mr = (const LAS f32x4*)(MS + (tbD * 16 + t) * 16); float s = (t == lane_o) ? 1.0f : 0.0f;
#pragma unroll
                            for (int i4 = 0; i4 < (t + 3) / 4; ++i4) { const f32x4 m = mr[i4];
#pragma unroll
                                for (int q = 0; q < 4; ++q) if (4 * i4 + q < t) s += m[q] * x[4 * i4 + q]; }
                            x[t] = s; }
#pragma unroll
                        for (int t = 0; t < 16; ++t) TTI[(tbD * 16 + t) * 20 + lane] = (bf16_t)(pk2(x[t], 0.f) & 0xffffu); }
                } else {
                    bf16x8 bfR[2], bfA[2];
#pragma unroll
                    for (int ks = 0; ks < 2; ++ks) { bfR[ks] = *(const LAS bf16x8*)(RH + (16 * tbD + c15) * RS + 32 * ks + 8 * g); bfA[ks] = *(const LAS bf16x8*)(AH + (16 * tbD + c15) * RS + 32 * ks + 8 * g); }
                    f32x4 GT1[4] = {zero4, zero4, zero4, zero4}, GT2[4] = {zero4, zero4, zero4, zero4}, GT3[4] = {zero4, zero4, zero4, zero4};
#pragma unroll
                    for (int ib = 0; ib < 4; ++ib) if (ib <= tbD) {
                        f32x4 a1 = zero4, a2 = zero4, a3 = zero4;
#pragma unroll
                        for (int ks = 0; ks < 2; ++ks) { const bf16x8 f1 = *(const LAS bf16x8*)(BH + (16 * ib + c15) * RS + 32 * ks + 8 * g), f2 = *(const LAS bf16x8*)(KH + (16 * ib + c15) * RS + 32 * ks + 8 * g);
                            a1 = __builtin_amdgcn_mfma_f32_16x16x32_bf16(f1, bfR[ks], a1, 0, 0, 0); a2 = __builtin_amdgcn_mfma_f32_16x16x32_bf16(f2, bfR[ks], a2, 0, 0, 0); a3 = __builtin_amdgcn_mfma_f32_16x16x32_bf16(f2, bfA[ks], a3, 0, 0, 0); }
                        if (ib == tbD) {
#pragma unroll
                            for (int r = 0; r < 4; ++r) { const int il = 4 * g + r; if (!(il <= tloc)) { a1[r] = 0.f; a2[r] = 0.f; } if (!(il < tloc)) a3[r] = 0.f; } }
                        GT1[ib] = a1; GT2[ib] = a2; GT3[ib] = a3;
                    }
                    const u32x4 F01 = {pk2(GT1[0][0], GT1[0][1]), pk2(GT1[0][2], GT1[0][3]), pk2(GT1[1][0], GT1[1][1]), pk2(GT1[1][2], GT1[1][3])};
                    const u32x4 F23 = {pk2(GT1[2][0], GT1[2][1]), pk2(GT1[2][2], GT1[2][3]), pk2(GT1[3][0], GT1[3][1]), pk2(GT1[3][2], GT1[3][3])};
                    const int nb = tbD == 0 ? 0 : (tbD == 1 ? 1 : (tbD == 2 ? 2 : 4));
                    *(LAS u32x4*)(NRBF + (nb * 64 + lane) * 16) = F01;
                    if (tbD >= 2) *(LAS u32x4*)(NRBF + ((nb + 1) * 64 + lane) * 16) = F23;
                    const u32x4 N_01 = {pk2(GT2[0][0], GT2[0][1]), pk2(GT2[0][2], GT2[0][3]), pk2(GT2[1][0], GT2[1][1]), pk2(GT2[1][2], GT2[1][3])};
                    const u32x4 N_23 = {pk2(GT2[2][0], GT2[2][1]), pk2(GT2[2][2], GT2[2][3]), pk2(GT2[3][0], GT2[3][1]), pk2(GT2[3][2], GT2[3][3])};
                    const u32x4 M_01 = {pk2(GT3[0][0], GT3[0][1]), pk2(GT3[0][2], GT3[0][3]), pk2(GT3[1][0], GT3[1][1]), pk2(GT3[1][2], GT3[1][3])};
                    const u32x4 M_23 = {pk2(GT3[2][0], GT3[2][1]), pk2(GT3[2][2], GT3[2][3]), pk2(GT3[3][0], GT3[3][1]), pk2(GT3[3][2], GT3[3][3])};
#pragma unroll
                    for (int vb = 0; vb < 4; ++vb) { const LAS bf16_t* vp = VT + (16 * vb + c15) * RS + 4 * g;
                        const u32x2 v0 = *(const LAS u32x2*)(vp), v1 = *(const LAS u32x2*)(vp + 16);
                        const bf16x8 vf01 = __builtin_bit_cast(bf16x8, (u32x4){v0.x, v0.y, v1.x, v1.y});
                        f32x4 accn = __builtin_amdgcn_mfma_f32_16x16x32_bf16(__builtin_bit_cast(bf16x8, N_01), vf01, zero4, 0, 0, 0);
                        f32x4 accm = __builtin_amdgcn_mfma_f32_16x16x32_bf16(__builtin_bit_cast(bf16x8, M_01), vf01, zero4, 0, 0, 0);
                        if (tbD >= 2) { const u32x2 v2 = *(const LAS u32x2*)(vp + 32), v3 = *(const LAS u32x2*)(vp + 48);
                            const bf16x8 vf23 = __builtin_bit_cast(bf16x8, (u32x4){v2.x, v2.y, v3.x, v3.y});
                            accn = __builtin_amdgcn_mfma_f32_16x16x32_bf16(__builtin_bit_cast(bf16x8, N_23), vf23, accn, 0, 0, 0);
                            accm = __builtin_amdgcn_mfma_f32_16x16x32_bf16(__builtin_bit_cast(bf16x8, M_23), vf23, accm, 0, 0, 0); }
                        *(LAS u32x2*)(NRKV + ((tbD * 4 + vb) * 64 + lane) * 8) = (u32x2){pk2(accn[0], accn[1]), pk2(accn[2], accn[3])};
                        *(LAS u32x2*)(MAKV + ((tbD * 4 + vb) * 64 + lane) * 8) = (u32x2){pk2(accm[0], accm[1]), pk2(accm[2], accm[3])}; }
                }
#pragma unroll
                for (int q2 = 0; q2 < 2; ++q2) { const int id = 2 * wave + q2, kb = id >> 2, vb = id & 3; f32x4 acc = zero4;
#pragma unroll
                    for (int ks = 0; ks < 2; ++ks) acc = __builtin_amdgcn_mfma_f32_16x16x32_bf16(*(const LAS bf16x8*)(KT + (16 * kb + c15) * RS + 32 * ks + 8 * g), *(const LAS bf16x8*)(VT + (16 * vb + c15) * RS + 32 * ks + 8 * g), acc, 0, 0, 0);
                    *(LAS f32x4*)(KVI + (id * 64 + lane) * 16) = acc; }
            }
            __syncthreads();
            if (chunk + 1 < cfull) SCAN_PREFETCH(chunk + 1);
            if (pre) {
                const int j = chunk - c0; const int slot = __builtin_amdgcn_readfirstlane(pair * SCAN_NH + j);
                unsigned char* dstp = slot < SCAN_SLOTS_OUT ? (unsigned char*)outp() + (size_t)slot * SCAN_SLOT : (unsigned char*)ws + WS_POOL + 576 * MiB + (size_t)(slot - SCAN_SLOTS_OUT) * SCAN_SLOT;
                const __amdgpu_buffer_rsrc_t drs = __builtin_amdgcn_make_buffer_rsrc(dstp, 0, SCAN_SLOT, 0x00020000);
#pragma unroll
                for (int q = 0; q < 9; ++q) { const int u = tid_o + 512 * q;
                    if (u < SCAN_DUMP_U) { const int off = u < 1152 ? 16 * u : (u < 1728 ? 36864 + 16 * (u - 1152) : (u < 3776 ? 73728 + 16 * (u - 1728) : (u < 4416 ? 108544 + 16 * (u - 3776) : 122880 + 16 * (u - 4416))));
                        __builtin_amdgcn_raw_buffer_store_b128(*(const LAS u32x4*)(lds + off), drs, 16 * u, 0, 16); } }
            } else {
            if (wave < 4) scan_stage_e(lds, ST, lane, wave);
            __syncthreads();
            }
        }
        if (pre) {
            asm volatile("s_waitcnt vmcnt(0)" ::: "memory");
            __syncthreads();
            if (tid == 0) __hip_atomic_store((GAS unsigned*)flag, (unsigned)SCAN_NH, __ATOMIC_RELAXED, __HIP_MEMORY_SCOPE_AGENT);
        }
        if (cfull < nch) {
            if (wave == 0) {
                while ((unsigned)__builtin_amdgcn_readfirstlane(__hip_atomic_load((GAS unsigned*)flag, __ATOMIC_RELAXED, __HIP_MEMORY_SCOPE_AGENT)) < (unsigned)SCAN_NH) __builtin_amdgcn_s_sleep(2);
                __builtin_amdgcn_fence(__ATOMIC_ACQUIRE, "agent"); }
            __syncthreads();
            u32x4 pf[9];
#define DUMP_OFF(u) ((u) < 1152 ? 16 * (u) : ((u) < 1728 ? 36864 + 16 * ((u) - 1152) : ((u) < 3776 ? 73728 + 16 * ((u) - 1728) : ((u) < 4416 ? 108544 + 16 * ((u) - 3776) : 122880 + 16 * ((u) - 4416)))))
#define DUMP_LOAD(j_) do { const int slot_ = __builtin_amdgcn_readfirstlane(pair * SCAN_NH + (j_)); \
            const u32x4* srcp_ = (const u32x4*)(slot_ < SCAN_SLOTS_OUT ? (const unsigned char*)outp() + (size_t)slot_ * SCAN_SLOT : (const unsigned char*)ws + WS_POOL + 576 * MiB + (size_t)(slot_ - SCAN_SLOTS_OUT) * SCAN_SLOT); \
            _Pragma("unroll") for (int q = 0; q < 9; ++q) { const int u = tid_p + 512 * q; if (u < SCAN_DUMP_U) pf[q] = srcp_[u]; } } while (0)
            int tid_p = tid; asm volatile("" : "+v"(tid_p));
            DUMP_LOAD(0);
#pragma unroll 1
            for (int chunk = cfull; chunk < nch; ++chunk) {
                int tid_o = tid; asm volatile("" : "+v"(tid_o));
                const int tF = tid_o >> 3, c8 = tid_o & 7; const int tid_p = tid_o;
#pragma unroll
                for (int q = 0; q < 9; ++q) { const int u = tid_o + 512 * q; if (u < SCAN_DUMP_U) *(LAS u32x4*)(lds + DUMP_OFF(u)) = pf[q]; }
                { const int st = (chunk - 1) * 64 + tF; const int p = dir ? (len - 1 - st) : st;
                  *(u32x4*)(yd + (size_t)(base + p) * D + head * 64 + 8 * c8) = *(const LAS u32x4*)(YS + tF * RS + 8 * c8); }
                __syncthreads();
                if (chunk + 1 < nch) DUMP_LOAD(chunk + 1 - cfull);
                if (wave < 4) scan_stage_e(lds, ST, tid_o & 63, wave);
                __syncthreads();
            }
#undef DUMP_LOAD
#undef DUMP_OFF
        }
        if (!pre) { const int tF = tid >> 3, c8 = tid & 7; const int st = (nch - 1) * 64 + tF; const int p = dir ? (len - 1 - st) : st;
          *(u32x4*)(yd + (size_t)(base + p) * D + head * 64 + 8 * c8) = *(const LAS u32x4*)(YS + tF * RS + 8 * c8); }
        }
#undef SCAN_PREFETCH
    }
}

static __device__ PHASE_ATTR void ph_fin(int jm) {
    FRAME();
    bf16_t* YF = (bf16_t*)(ws + P_YF); const bf16_t* YB = (const bf16_t*)(ws + P_YB); const bf16_t* Vb = (const bf16_t*)(ws + (jm == 0 ? WS_VF : P_V)); const float* BS = (const float*)(ws + P_BS);
    const float* gnw = inp(23) + (size_t)jm * D; const float* gnb = inp(24) + (size_t)jm * D;
    u32x4 aq[4], bq[4], vq4[4]; float b0q[4], b1q[4];
#define FIN_LOAD(row_) do { const size_t r_ = (size_t)(row_); \
        _Pragma("unroll") for (int i = 0; i < 4; ++i) { const int e = 8 * (lane + 64 * i); aq[i] = *(const u32x4*)(YF + r_ * D + e); bq[i] = *(const u32x4*)(YB + r_ * D + e); vq4[i] = *(const u32x4*)(Vb + r_ * D + e); \
            b0q[i] = BS[r_ * 32 + (e >> 6)]; b1q[i] = BS[((size_t)TT + r_) * 32 + (e >> 6)]; } } while (0)
    int row = gw;
    if (row < TT) FIN_LOAD(row);
    for (; row < TT; row += NGW) {
        u32x4 ac[4], bc[4], vc[4]; float b0c[4], b1c[4];
#pragma unroll
        for (int i = 0; i < 4; ++i) { ac[i] = aq[i]; bc[i] = bq[i]; vc[i] = vq4[i]; b0c[i] = b0q[i]; b1c[i] = b1q[i]; }
        if (row + NGW < TT) FIN_LOAD(row + NGW);
#pragma unroll
        for (int i = 0; i < 4; ++i) { const int e = 8 * (lane + 64 * i);
            const unsigned aw[4] = {ac[i].x, ac[i].y, ac[i].z, ac[i].w}, bw[4] = {bc[i].x, bc[i].y, bc[i].z, bc[i].w}, vw[4] = {vc[i].x, vc[i].y, vc[i].z, vc[i].w};
            float y[8], v8[8]; float s = 0.f;
#pragma unroll
            for (int j = 0; j < 4; ++j) { y[2 * j] = bflo(aw[j]) + bflo(bw[j]); y[2 * j + 1] = bfhi(aw[j]) + bfhi(bw[j]); v8[2 * j] = bflo(vw[j]); v8[2 * j + 1] = bfhi(vw[j]); s += y[2 * j] + y[2 * j + 1]; }
            s += __shfl_xor(s, 1); s += __shfl_xor(s, 2); s += __shfl_xor(s, 4);
            const float mean = s * (1.0f / 64.0f); float q = 0.f;
#pragma unroll
            for (int j = 0; j < 8; ++j) { y[j] -= mean; q += y[j] * y[j]; }
            q += __shfl_xor(q, 1); q += __shfl_xor(q, 2); q += __shfl_xor(q, 4);
            const float rstd = rsqrtf(q * (1.0f / 64.0f) + GN_EPS);
            const float bonus = 0.5f * (b0c[i] + b1c[i]);
            const f32x4 w0 = *(const f32x4*)(gnw + e), w1 = *(const f32x4*)(gnw + e + 4), c0 = *(const f32x4*)(gnb + e), c1 = *(const f32x4*)(gnb + e + 4);
            float o[8];
#pragma unroll
            for (int j = 0; j < 8; ++j) o[j] = y[j] * rstd * (j < 4 ? w0[j] : w1[j - 4]) + (j < 4 ? c0[j] : c1[j - 4]) + bonus * v8[j];
            *(u32x4*)(YF + (size_t)row * D + e) = (u32x4){pk2(o[0], o[1]), pk2(o[2], o[3]), pk2(o[4], o[5]), pk2(o[6], o[7])}; }
    }
#undef FIN_LOAD
}

typedef short v4i16_t __attribute__((ext_vector_type(4)));
struct AttItem { int base, h, c, b0, Lc; };
__device__ __forceinline__ AttItem att_decode(int pair, int dsh) {
    const int it = pair * 2; int seq, h, cb, S_len;
    if (it < 8192) { seq = it >> 12; h = (it >> 8) & 15; cb = it & 255; S_len = 16384; }
    else { const int i2 = it - 8192; seq = 2 + (i2 >> 11); h = (i2 >> 7) & 15; cb = i2 & 127; S_len = 8192; }
    AttItem a; a.base = seq < 2 ? seq * 16384 : 32768 + (seq - 2) * 8192; a.h = h; a.Lc = S_len >> dsh; const int nb = a.Lc >> 6; a.c = cb / nb; a.b0 = cb % nb; return a;
}
static __device__ PHASE_ATTR void ph_att(int gi) {
    FRAME();
    const int dil = 1 << (2 * gi), dsh = 2 * gi;
    const bf16_t* QKV = (const bf16_t*)(ws + P_QKV);
    bf16_t* const Og = (bf16_t*)(ws + P_O0 + (size_t)gi * 192 * MiB); float* const LSEg = (float*)(ws + P_LSE) + (size_t)gi * TT * 16;
    bf16_t* const O0 = (bf16_t*)(ws + P_O0); const bf16_t* const O1 = (const bf16_t*)(ws + P_O0 + 192 * MiB); const float* const LS = (const float*)(ws + P_LSE);
    constexpr int KRS = 136, VRS = 144;
    LAS bf16_t* Ks = (LAS bf16_t*)lds; LAS bf16_t* Vs = (LAS bf16_t*)(lds + 256 * KRS * 2);
    const int qi = wave >> 2, wi = wave & 3, c15 = lane & 15, gq = lane >> 4;
    u32x4 kv[16]; bf16x8 qf[4];
#define ATT_PREFETCH(A) do { _Pragma("unroll") for (int i = 0; i < 16; ++i) { const int key = (tid >> 4) + 32 * (i & 7), part = tid & 15; \
            int ip = 64 * ((A).b0 - 1) + key; ip = ip < 0 ? 0 : (ip > (A).Lc - 1 ? (A).Lc - 1 : ip); \
            kv[i] = *(const u32x4*)(QKV + (size_t)((A).base + ip * dil + (A).c) * (3 * D) + ((i >> 3) ? 2 * D : D) + (A).h * 128 + 8 * part); } \
        { const size_t rq = (size_t)((A).base + (64 * ((A).b0 + qi) + 16 * wi + c15) * dil + (A).c); \
          _Pragma("unroll") for (int ks = 0; ks < 4; ++ks) qf[ks] = *(const bf16x8*)(QKV + rq * (3 * D) + (A).h * 128 + 32 * ks + 8 * gq); } } while (0)
    const int ppw = (6144 + G - 1) / G;
    int pair = bid_ * ppw; const int pair_end = (pair + ppw < 6144) ? pair + ppw : 6144;
    if (pair < pair_end) { const AttItem A0 = att_decode(pair, dsh); ATT_PREFETCH(A0); }
    for (; pair < pair_end; ++pair) {
        const AttItem A = att_decode(pair, dsh);
        const int base = A.base, h = A.h, c = A.c, Lc = A.Lc;
#pragma unroll
        for (int i = 0; i < 16; ++i) { const int key = (tid >> 4) + 32 * (i & 7), part = tid & 15;
            if (i >> 3) *(LAS u32x4*)(Vs + key * VRS + 8 * part) = kv[i]; else *(LAS u32x4*)(Ks + key * KRS + 8 * part) = kv[i]; }
        bf16x8 q[4];
#pragma unroll
        for (int ks = 0; ks < 4; ++ks) q[ks] = qf[ks];
        const int b = A.b0 + qi;
        const int iq = 64 * b + 16 * wi + c15; const size_t rowq = (size_t)(base + iq * dil + c);
        __syncthreads();
        if (pair + 1 < pair_end) { const AttItem An = att_decode(pair + 1, dsh); ATT_PREFETCH(An); }
        const int k0w = 16 * wi;
        f32x4 sc[9];
#pragma unroll
        for (int nt = 0; nt < 9; ++nt) { const LAS bf16_t* kp = Ks + (64 * qi + k0w + 16 * nt + c15) * KRS + 8 * gq;
            f32x4 a = {0.f, 0.f, 0.f, 0.f};
#pragma unroll
            for (int ks = 0; ks < 4; ++ks) a = __builtin_amdgcn_mfma_f32_16x16x32_bf16(*(const LAS bf16x8*)(kp + 32 * ks), q[ks], a, 0, 0, 0);
            sc[nt] = a * 0.08838834764831845f; }
#pragma unroll
        for (int r = 0; r < 4; ++r) { const int d0 = 4 * gq + r - c15;
            if (d0 < 0) sc[0][r] = -INFINITY;
            if (d0 > 0) sc[8][r] = -INFINITY; }
        if (b == 0 || b == (Lc >> 6) - 1) {
#pragma unroll
            for (int nt = 0; nt < 9; ++nt)
#pragma unroll
                for (int r = 0; r < 4; ++r) { const int ip = 64 * (b - 1) + k0w + 16 * nt + 4 * gq + r; if (ip < 0 || ip >= Lc) sc[nt][r] = -INFINITY; } }
        float mx = -INFINITY;
#pragma unroll
        for (int nt = 0; nt < 9; ++nt) mx = fmaxf(mx, fmaxf(fmaxf(sc[nt][0], sc[nt][1]), fmaxf(sc[nt][2], sc[nt][3])));
        mx = fmaxf(mx, __shfl_xor(mx, 16)); mx = fmaxf(mx, __shfl_xor(mx, 32));
        float sum = 0.f;
#pragma unroll
        for (int nt = 0; nt < 9; ++nt)
#pragma unroll
            for (int r = 0; r < 4; ++r) { const float p = fast_exp(sc[nt][r] - mx); sc[nt][r] = p; sum += p; }
        sum += __shfl_xor(sum, 16); sum += __shfl_xor(sum, 32);
        const float rs = __builtin_amdgcn_rcpf(sum); const float lse = mx + __logf(sum);
        float w0 = 0.f, w1 = 0.f, w2 = 1.f;
        if (gi == 2) { const float l0 = LS[rowq * 16 + h], l1 = LS[((size_t)TT + rowq) * 16 + h]; const float m = fmaxf(lse, fmaxf(l0, l1));
            w0 = fast_exp(l0 - m); w1 = fast_exp(l1 - m); w2 = fast_exp(lse - m); const float r3 = __builtin_amdgcn_rcpf(w0 + w1 + w2); w0 *= r3; w1 *= r3; w2 *= r3; }
        else if (gq == 0) LSEg[rowq * 16 + h] = lse;
        bf16x8 pf[5];
#pragma unroll
        for (int ks = 0; ks < 4; ++ks) { const f32x4 p0 = sc[2 * ks] * rs, p1 = sc[2 * ks + 1] * rs;
            const u32x4 w = {pk2(p0[0], p0[1]), pk2(p0[2], p0[3]), pk2(p1[0], p1[1]), pk2(p1[2], p1[3])}; pf[ks] = __builtin_bit_cast(bf16x8, w); }
        { const f32x4 p0 = sc[8] * rs; const u32x4 w = {pk2(p0[0], p0[1]), pk2(p0[2], p0[3]), 0u, 0u}; pf[4] = __builtin_bit_cast(bf16x8, w); }
        const LAS bf16_t* vbase = Vs + (64 * qi + k0w + 4 * gq + (c15 >> 2)) * VRS + 4 * (c15 & 3);
#pragma unroll
        for (int dt = 0; dt < 8; ++dt) {
            f32x4 o = {0.f, 0.f, 0.f, 0.f};
#pragma unroll
            for (int ks = 0; ks < 5; ++ks) {
                const v4i16_t lo = __builtin_amdgcn_ds_read_tr16_b64_v4i16((LAS v4i16_t*)(vbase + (32 * ks) * VRS + 16 * dt));
                v4i16_t hi = {0, 0, 0, 0};
                if (ks < 4) hi = __builtin_amdgcn_ds_read_tr16_b64_v4i16((LAS v4i16_t*)(vbase + (32 * ks + 16) * VRS + 16 * dt));
                const bf16x8 vf = {lo[0], lo[1], lo[2], lo[3], hi[0], hi[1], hi[2], hi[3]};
                o = __builtin_amdgcn_mfma_f32_16x16x32_bf16(vf, pf[ks], o, 0, 0, 0);
            }
            const size_t oo = rowq * D + h * 128 + 16 * dt + 4 * gq;
            if (gi == 2) { const u32x2 a0 = *(const u32x2*)(O0 + oo), a1 = *(const u32x2*)(O1 + oo);
                o = (f32x4){w0 * bflo(a0.x) + w1 * bflo(a1.x) + w2 * o[0], w0 * bfhi(a0.x) + w1 * bfhi(a1.x) + w2 * o[1], w0 * bflo(a0.y) + w1 * bflo(a1.y) + w2 * o[2], w0 * bfhi(a0.y) + w1 * bfhi(a1.y) + w2 * o[3]};
                *(u32x2*)(O0 + oo) = (u32x2){pk2(o[0], o[1]), pk2(o[2], o[3])}; }
            else *(u32x2*)(Og + oo) = (u32x2){pk2(o[0], o[1]), pk2(o[2], o[3])};
        }
        __syncthreads();
    }
#undef ATT_PREFETCH
}

static __device__ PHASE_ATTR void ph_norm(int L, int sub, size_t h_off) {
    FRAME();
    float* Y = outp(); bf16_t* XB = (bf16_t*)(ws + P_XN);
    float* RSX = (float*)(ws + WS_RSX); const bf16_t* hsrc = (const bf16_t*)(ws + h_off);
    const float alpha = (sub == 1) ? 1.0f : 0.5f;
    const float* gpost = inp(3) + (size_t)(L * 3 + sub) * D;
    const bool last = (L == DEPTH - 1 && sub == 2), first = (L == 0 && sub == 0); const float* in0 = inp(0); const float* in1 = inp(1);
    u32x4 hq[4], xq[4]; f32x4 xf[4][2];
#define NORM_LOAD(row_) do { const size_t r_ = (size_t)(row_); \
        _Pragma("unroll") for (int i = 0; i < 4; ++i) { const int e = 8 * (lane + 64 * i); hq[i] = *(const u32x4*)(hsrc + r_ * D + e); \
            if (first) { const float* xs_ = r_ < 32768 ? in0 + r_ * D : in1 + (r_ - 32768) * D; xf[i][0] = *(const f32x4*)(xs_ + e); xf[i][1] = *(const f32x4*)(xs_ + e + 4); } \
            else xq[i] = *(const u32x4*)(XB + r_ * D + e); } } while (0)
    int row = gw;
    if (row < TT) NORM_LOAD(row);
    for (; row < TT; row += NGW) {
        float xv[4][8]; float ssh = 0.f;
        float hv[4][8];
#pragma unroll
        for (int i = 0; i < 4; ++i) {
            if (first) {
#pragma unroll
                for (int j = 0; j < 4; ++j) { xv[i][j] = xf[i][0][j]; xv[i][4 + j] = xf[i][1][j]; } }
            else { const unsigned xww[4] = {xq[i].x, xq[i].y, xq[i].z, xq[i].w};
#pragma unroll
                for (int j = 0; j < 4; ++j) { xv[i][2 * j] = bflo(xww[j]); xv[i][2 * j + 1] = bfhi(xww[j]); } }
            const unsigned hww[4] = {hq[i].x, hq[i].y, hq[i].z, hq[i].w};
#pragma unroll
            for (int j = 0; j < 4; ++j) { hv[i][2 * j] = bflo(hww[j]); hv[i][2 * j + 1] = bfhi(hww[j]); ssh += hv[i][2 * j] * hv[i][2 * j] + hv[i][2 * j + 1] * hv[i][2 * j + 1]; } }
        if (row + NGW < TT) NORM_LOAD(row + NGW);
        const float rh = rsqrtf(wave_sum(ssh) * (1.0f / D) + NORM_EPS) * alpha;
        float ssx = 0.f;
        float* ydst = Y + (size_t)row * D;
#pragma unroll
        for (int i = 0; i < 4; ++i) { const int e = 8 * (lane + 64 * i); const f32x4 ga = *(const f32x4*)(gpost + e), gb = *(const f32x4*)(gpost + e + 4);
#pragma unroll
            for (int j = 0; j < 8; ++j) { xv[i][j] += hv[i][j] * rh * (j < 4 ? ga[j] : gb[j - 4]); ssx += xv[i][j] * xv[i][j]; }
            if (last) { *(f32x4*)(ydst + e) = (f32x4){xv[i][0], xv[i][1], xv[i][2], xv[i][3]}; *(f32x4*)(ydst + e + 4) = (f32x4){xv[i][4], xv[i][5], xv[i][6], xv[i][7]}; }
            else *(u32x4*)(XB + (size_t)row * D + e) = (u32x4){pk2(xv[i][0], xv[i][1]), pk2(xv[i][2], xv[i][3]), pk2(xv[i][4], xv[i][5]), pk2(xv[i][6], xv[i][7])}; }
        if (!last) { const float rx = rsqrtf(wave_sum(ssx) * (1.0f / D) + NORM_EPS); if (lane == 0) RSX[row] = rx; }
    }
#undef NORM_LOAD
}
static __device__ __noinline__ void grid_bar() {
    LAS unsigned char* lds = (LAS unsigned char*)lds_raw;
    XcdBarrier b; b.bar = (unsigned*)(wsp() + WS_CTL) + CW_BAR; b.st = (volatile LAS unsigned*)(lds + MISC_OFF) + 8; b.x = b.st[2];
    xcd_barrier(b);
}
#define STEP(call) do { if (step >= lo && step < hi) { call; if (step + 1 < hi) grid_bar(); } ++step; } while (0)
template <int L> __device__ __forceinline__ void layer_prog(int& step, const int lo, const int hi) {
    constexpr int jm = L >> 1; constexpr bool is_attn = (L & 1) != 0;
    STEP(ph_ffn_up(0));
    STEP(ph_gemm_plain(P_H, FF, W_DN0, D, FF, P_HOUT, D));
    STEP(ph_norm(L, 0, P_HOUT));
    if constexpr (!is_attn) {
        STEP(ph_mix(jm, 0));
        STEP(ph_g1(jm, 0));
        STEP(ph_mix(jm, 1));
        STEP(ph_g1(jm, 1));
        if constexpr (jm > 0) { STEP(ph_gv(jm)); } else { ++step; }
        STEP(ph_scan(jm));
        STEP(ph_fin(jm));
        STEP(ph_gg());
        STEP(ph_gemm_plain(P_YF, D, W_GO, D, D, P_R, D));
        STEP(ph_norm(L, 1, P_R));
    } else {
        STEP(ph_qkv(0));
        STEP(ph_att(0));
        STEP(ph_qkv(1));
        STEP(ph_att(1));
        STEP(ph_qkv(2));
        STEP(ph_att(2));
        STEP(ph_gemm_plain(P_O0, D, W_GO, D, D, P_QKV, D));
        STEP(ph_norm(L, 1, P_QKV));
    }
    STEP(ph_ffn_up(1));
    STEP(ph_gemm_plain(P_H, FF, W_DN1, D, FF, P_HOUT, D));
    STEP({ ph_norm(L, 2, P_HOUT); if (L + 1 < DEPTH) ph_conv(L + 1); });
}
__global__ void __launch_bounds__(NWAVES * 64, 2) enc_fwd(Args args) {
    LAS unsigned char* lds = (LAS unsigned char*)lds_raw;
    volatile LAS unsigned* MISC = (volatile LAS unsigned*)(lds + MISC_OFF);
    const int tid = threadIdx.x;
    if (tid < 128) ((LAS unsigned*)(lds + CTRL_OFF))[tid] = 0u;
    if (tid < 30) { const unsigned long long v = tid < 28 ? (unsigned long long)args.in[tid] : (tid == 28 ? (unsigned long long)args.out : (unsigned long long)args.ws);
        LAS unsigned* p = (LAS unsigned*)(lds + PTR_OFF) + 2 * tid; p[0] = (unsigned)v; p[1] = (unsigned)(v >> 32); }
    __syncthreads();
    const int lo = args.step_lo, hi = args.step_hi;
    if (hi - lo > 1) { const XcdBarrier b = xcd_barrier_post((unsigned*)(args.ws + WS_CTL) + CW_BAR, MISC + 8); if (tid == 0) MISC[10] = b.x; }
    __syncthreads();
    int step = 0;
    STEP({ ph_init(); ph_conv(0); });
    layer_prog<0>(step, lo, hi);
    layer_prog<1>(step, lo, hi);
    layer_prog<2>(step, lo, hi);
    layer_prog<3>(step, lo, hi);
}
#undef STEP

static int n_steps_total() {
    int s = 1;
    for (int L = 0; L < DEPTH; ++L) { s += 3; s += (L & 1) ? 8 : 10; s += 3; }
    return s;
}

extern "C" void kernel_launch(void* const* d_in, const int* in_sizes, int n_in, void* d_out, int out_size, void* d_ws, size_t ws_size, hipStream_t stream) {
    static int grid = 0;
    if (grid == 0) {
        if (n_in != 28 || out_size != TT * D || ws_size < WS_END) { fprintf(stderr, "kernel_launch: unexpected shapes (n_in %d, out %d, ws %zu, need %zu)\n", n_in, out_size, ws_size, (size_t)WS_END); grid = -1; return; }
        int dev = 0, cus = 0, per_cu = 0;
        if (hipGetDevice(&dev) != hipSuccess || hipDeviceGetAttribute(&cus, hipDeviceAttributeMultiprocessorCount, dev) != hipSuccess) { grid = -1; return; }
        if (hipFuncSetAttribute((const void*)enc_fwd, hipFuncAttributeMaxDynamicSharedMemorySize, LDS_BYTES) != hipSuccess) { grid = -1; return; }
        if (hipOccupancyMaxActiveBlocksPerMultiprocessor(&per_cu, (const void*)enc_fwd, NWAVES * 64, LDS_BYTES) != hipSuccess || per_cu < 1) { fprintf(stderr, "kernel_launch: occupancy query says %d\n", per_cu); }
        (void)hipGetLastError();
        grid = cus;
    }
    if (grid < 0) return;
    (void)hipMemsetAsync((char*)d_ws + WS_CTL, 0, CTL_ZERO_BYTES, stream);
    Args a{};
    for (int i = 0; i < 28; ++i) a.in[i] = (const float*)d_in[i];
    a.out = (float*)d_out; a.ws = (unsigned char*)d_ws;
    const int NS = n_steps_total();
#if MK_ONE_LAUNCH
    a.step_lo = 0; a.step_hi = NS;
    hipLaunchKernelGGL(enc_fwd, dim3(grid), dim3(NWAVES * 64), LDS_BYTES, stream, a);
#else
    for (int s = 0; s < NS; ++s) {
        a.step_lo = s; a.step_hi = s + 1;
        hipLaunchKernelGGL(enc_fwd, dim3(grid), dim3(NWAVES * 64), LDS_BYTES, stream, a);
    }
#endif
}
```

```cpp
#include <hip/hip_runtime.h>
#include <cstdio>
#include <cstdint>

#ifndef MK_ONE_LAUNCH
#define MK_ONE_LAUNCH 1
#endif

#ifndef PHASE_ATTR
#define PHASE_ATTR __forceinline__
#endif
#define LAS __attribute__((address_space(3)))
#define GAS __attribute__((address_space(1)))
typedef unsigned short bf16_t;
typedef short bf16x8 __attribute__((ext_vector_type(8)));
typedef float f32x4 __attribute__((ext_vector_type(4)));
typedef float f32x2 __attribute__((ext_vector_type(2)));
typedef unsigned u32x4 __attribute__((ext_vector_type(4)));
typedef unsigned u32x2 __attribute__((ext_vector_type(2)));
typedef __bf16 bf16x2_t __attribute__((ext_vector_type(2)));

constexpr int D = 2048, FF = 5632, TT = 49152, DEPTH = 4;
constexpr int HID = 1024;
constexpr int NG1 = 3 * D + 256, NG2 = 768;
constexpr float NORM_EPS = 1e-6f, GN_EPS = 64e-5f;

__device__ __forceinline__ float bflo(unsigned w) { return __uint_as_float(w << 16); }
__device__ __forceinline__ float bfhi(unsigned w) { return __uint_as_float(w & 0xffff0000u); }
__device__ __forceinline__ unsigned pk2(float lo, float hi) { f32x2 v = {lo, hi}; bf16x2_t b = __builtin_convertvector(v, bf16x2_t); return __builtin_bit_cast(unsigned, b); }
__device__ __forceinline__ float wave_sum(float v) {
#pragma unroll
    for (int o = 1; o < 64; o <<= 1) v += __shfl_xor(v, o);
    return v;
}
__device__ __forceinline__ float fast_exp(float x) { return __builtin_amdgcn_exp2f(x * 1.4426950408889634f); }
__device__ __forceinline__ float sigmoidf_(float x) { return __builtin_amdgcn_rcpf(1.0f + fast_exp(-x)); }
__device__ __forceinline__ float siluf_(float x) { return x * sigmoidf_(x); }
__device__ __forceinline__ float tanhf_(float x) { return 1.0f - 2.0f * __builtin_amdgcn_rcpf(1.0f + fast_exp(2.0f * x)); }
__device__ __forceinline__ void row_decode(int row, int& base, int& pos, int& len) {
    if (row < 32768) { base = row & ~16383; pos = row & 16383; len = 16384; }
    else { const int r2 = row - 32768; base = 32768 + (r2 & ~8191); pos = r2 & 8191; len = 8192; }
}

namespace pg8 {
#define PG8_LAS __attribute__((address_space(3)))
constexpr int BM = 256, BK = 64, HALF = 128, HTB = HALF * BK * 2, STAGE_BYTES = 8 * HTB, NXCD = 8, WGM = 8;
__host__ __device__ __forceinline__ int lds_byte(int r, int c) { const int st = (r >> 4) * 2 + (c >> 5), rr = r & 15, cc = c & 31, ob = rr * 64 + cc * 2; return st * 1024 + (ob ^ (((ob >> 9) & 1) << 5)); }
__host__ __device__ __forceinline__ void stage_rc(int b, int& R, int& C) { const int st = b / 1024, sb = b % 1024, swz = sb ^ (((sb >> 9) & 1) << 5); R = (st >> 1) * 16 + swz / 64; C = (st & 1) * 32 + (swz % 64) / 2; }
__host__ __device__ __forceinline__ int perm32(int rho) { const int n = rho >> 4, i = rho & 15; return 8 * (i >> 2) + 4 * n + (i & 3); }
struct Unit { int pm, pn; };
struct Gemm { const bf16_t* A; const bf16_t* Bt; int M, N, K, lda; size_t a_gstride = 0; int g0 = 1 << 30, g1 = 1 << 30; };
struct StaticOrder {
    int nM, nN, nwg, G, c;
    __host__ __device__ void init(int M, int N, int G_, int c_) { nM = M / BM; nN = N / BM; nwg = nM * nN; G = G_; c = c_; }
    __host__ __device__ bool next(int i, Unit& u) const {
        const long L = (long)i * G + c; if (L >= nwg) return false;
        int wgid = (int)L; { const int q = nwg / NXCD, r = nwg % NXCD, xcd = wgid % NXCD, off = wgid / NXCD; wgid = (xcd < r ? xcd * (q + 1) : r * (q + 1) + (xcd - r) * q) + off; }
        const int nig = WGM * nN, gid = wgid / nig, fm = gid * WGM, gsz = (nM - fm) < WGM ? (nM - fm) : WGM;
        u.pm = fm + ((wgid % nig) % gsz); u.pn = (wgid % nig) / gsz; return true;
    }
    __device__ __forceinline__ void a_ready(const Unit&) const {}
    __device__ __forceinline__ void done(const Unit&) const {}
};

struct EpiSwiGLU {
    static constexpr bool PERM = true, AFTER_DRAIN = false;
    bf16_t* H; const float* rs;
    __device__ __forceinline__ void operator()(const f32x4 (&acc)[2][2][4][2], const Unit& u, int wr, int wc, int fr, int fq) const {
        const int row0 = u.pm * BM + wr * 64 + fr, col = u.pn * 128 + wc * 32 + 8 * fq;
#pragma unroll
        for (int ai = 0; ai < 2; ++ai)
#pragma unroll
            for (int m = 0; m < 4; ++m) { const int row = row0 + ai * HALF + m * 16; const float r = rs[row];
                const f32x4 g0 = acc[ai][0][m][0] * r, g1 = acc[ai][0][m][1] * r, u0 = acc[ai][1][m][0] * r, u1 = acc[ai][1][m][1] * r;
                u32x4 w;
                w.x = pk2(siluf_(g0[0]) * u0[0], siluf_(g0[1]) * u0[1]); w.y = pk2(siluf_(g0[2]) * u0[2], siluf_(g0[3]) * u0[3]);
                w.z = pk2(siluf_(g1[0]) * u1[0], siluf_(g1[1]) * u1[1]); w.w = pk2(siluf_(g1[2]) * u1[2], siluf_(g1[3]) * u1[3]);
                *(u32x4*)(H + (size_t)row * FF + col) = w;
            }
    }
};
struct EpiPlain {
    static constexpr bool PERM = true, AFTER_DRAIN = false;
    bf16_t* O; int ldc;
    __device__ __forceinline__ void operator()(const f32x4 (&acc)[2][2][4][2], const Unit& u, int wr, int wc, int fr, int fq) const {
        const int row0 = u.pm * BM + wr * 64 + fr, col0 = u.pn * BM + wc * 32 + 8 * fq;
#pragma unroll
        for (int ai = 0; ai < 2; ++ai)
#pragma unroll
            for (int m = 0; m < 4; ++m) { bf16_t* rowp = O + (size_t)(row0 + ai * HALF + m * 16) * ldc + col0;
#pragma unroll
                for (int bj = 0; bj < 2; ++bj) { const f32x4 v0 = acc[ai][bj][m][0], v1 = acc[ai][bj][m][1];
                    u32x4 w; w.x = pk2(v0[0], v0[1]); w.y = pk2(v0[2], v0[3]); w.z = pk2(v1[0], v1[1]); w.w = pk2(v1[2], v1[3]);
                    *(u32x4*)(rowp + bj * HALF) = w; } }
    }
};
struct EpiQKV {
    static constexpr bool PERM = true, AFTER_DRAIN = false;
    bf16_t* O; const f32x2* tab; const float* rs;
    __device__ __forceinline__ void operator()(const f32x4 (&acc)[2][2][4][2], const Unit& u, int wr, int wc, int fr, int fq) const {
        const int row0 = u.pm * BM + wr * 64 + fr, col0 = u.pn * BM + wc * 32 + 8 * fq;
        const bool rot = (u.pn < 16);
        f32x2 cs[2][4];
#pragma unroll
        for (int ai = 0; ai < 2; ++ai)
#pragma unroll
            for (int m = 0; m < 4; ++m) { cs[ai][m] = (f32x2){1.f, 0.f};
                if (rot) { const int row = row0 + ai * HALF + m * 16; const int pos = row < 32768 ? (row & 16383) : (row & 8191); cs[ai][m] = tab[pos * 16 + 4 * wc + fq]; } }
#pragma unroll
        for (int ai = 0; ai < 2; ++ai)
#pragma unroll
            for (int m = 0; m < 4; ++m) { const int row = row0 + ai * HALF + m * 16; bf16_t* rowp = O + (size_t)row * (3 * D) + col0; const f32x2 c = cs[ai][m]; const float r = rs[row];
#pragma unroll
                for (int bj = 0; bj < 2; ++bj) { const f32x4 v0 = acc[ai][bj][m][0] * r, v1 = acc[ai][bj][m][1] * r;
                    u32x4 w; w.x = pk2(v0[0] * c[0] - v0[1] * c[1], v0[0] * c[1] + v0[1] * c[0]); w.y = pk2(v0[2], v0[3]); w.z = pk2(v1[0], v1[1]); w.w = pk2(v1[2], v1[3]);
                    *(u32x4*)(rowp + bj * HALF) = w; } }
    }
};
struct EpiG1 {
    static constexpr bool PERM = true, AFTER_DRAIN = false;
    unsigned char* ws; size_t r_off, v_off, h_off; int mode;
    __device__ __forceinline__ void operator()(const f32x4 (&acc)[2][2][4][2], const Unit& u, int wr, int wc, int fr, int fq) const {
        const int row0 = u.pm * BM + wr * 64 + fr; const int t = u.pn >> 3;
        size_t off = r_off + (size_t)t * (192u << 20); int ldc = D, colt = (u.pn & 7) * BM, act = 0;
        if (t == 2) off = v_off;
        if (t >= 3) { off = h_off; ldc = HID; colt = 768; }
        if (mode == 1) { off = h_off; ldc = HID; colt = u.pn * BM; act = (u.pn == 0) ? 1 : ((u.pn == 2) ? 2 : 0); }
        bf16_t* base = (bf16_t*)(ws + off);
        const int col0 = colt + wc * 32 + 8 * fq;
#pragma unroll
        for (int ai = 0; ai < 2; ++ai)
#pragma unroll
            for (int m = 0; m < 4; ++m) { bf16_t* rowp = base + (size_t)(row0 + ai * HALF + m * 16) * ldc + col0;
#pragma unroll
                for (int bj = 0; bj < 2; ++bj) { f32x4 v0 = acc[ai][bj][m][0], v1 = acc[ai][bj][m][1];
                    if (act == 1) {
#pragma unroll
                        for (int j = 0; j < 4; ++j) { v0[j] = tanhf_(v0[j]); v1[j] = tanhf_(v1[j]); } }
                    if (act == 2) {
#pragma unroll
                        for (int j = 0; j < 4; ++j) { v0[j] = sigmoidf_(v0[j]); v1[j] = sigmoidf_(v1[j]); } }
                    u32x4 w; w.x = pk2(v0[0], v0[1]); w.y = pk2(v0[2], v0[3]); w.z = pk2(v1[0], v1[1]); w.w = pk2(v1[2], v1[3]);
                    *(u32x4*)(rowp + bj * HALF) = w; } }
    }
};
struct EpiVres {
    static constexpr bool PERM = true, AFTER_DRAIN = false;
    bf16_t* V; const bf16_t* VF; const float* v0;
    __device__ __forceinline__ void operator()(const f32x4 (&acc)[2][2][4][2], const Unit& u, int wr, int wc, int fr, int fq) const {
        const int row0 = u.pm * BM + wr * 64 + fr, col0 = u.pn * BM + wc * 32 + 8 * fq;
#pragma unroll
        for (int ai = 0; ai < 2; ++ai)
#pragma unroll
            for (int m = 0; m < 4; ++m) { const size_t ro = (size_t)(row0 + ai * HALF + m * 16) * D + col0;
#pragma unroll
                for (int bj = 0; bj < 2; ++bj) { const f32x4 a0 = acc[ai][bj][m][0], a1 = acc[ai][bj][m][1];
                    const u32x4 vv = *(const u32x4*)(V + ro + bj * HALF), vf = *(const u32x4*)(VF + ro + bj * HALF);
                    const f32x4 b0 = *(const f32x4*)(v0 + col0 + bj * HALF), b1 = *(const f32x4*)(v0 + col0 + bj * HALF + 4);
                    float o[8]; const unsigned vw[4] = {vv.x, vv.y, vv.z, vv.w}, fw[4] = {vf.x, vf.y, vf.z, vf.w};
#pragma unroll
                    for (int j = 0; j < 4; ++j) { const float g0 = sigmoidf_((j < 2 ? b0[2 * j] : b1[2 * j - 4]) + (j < 2 ? a0[2 * j] : a1[2 * j - 4]));
                        const float g1 = sigmoidf_((j < 2 ? b0[2 * j + 1] : b1[2 * j - 3]) + (j < 2 ? a0[2 * j + 1] : a1[2 * j - 3]));
                        const float x0 = bflo(vw[j]), x1 = bfhi(vw[j]), f0 = bflo(fw[j]), f1 = bfhi(fw[j]);
                        o[2 * j] = x0 + (f0 - x0) * g0; o[2 * j + 1] = x1 + (f1 - x1) * g1; }
                    u32x4 w; w.x = pk2(o[0], o[1]); w.y = pk2(o[2], o[3]); w.z = pk2(o[4], o[5]); w.w = pk2(o[6], o[7]);
                    *(u32x4*)(V + ro + bj * HALF) = w; } }
    }
};
struct EpiGmul {
    static constexpr bool PERM = true, AFTER_DRAIN = false;
    bf16_t* Y;
    __device__ __forceinline__ void operator()(const f32x4 (&acc)[2][2][4][2], const Unit& u, int wr, int wc, int fr, int fq) const {
        const int row0 = u.pm * BM + wr * 64 + fr, col0 = u.pn * BM + wc * 32 + 8 * fq;
#pragma unroll
        for (int ai = 0; ai < 2; ++ai)
#pragma unroll
            for (int m = 0; m < 4; ++m) { const size_t ro = (size_t)(row0 + ai * HALF + m * 16) * D + col0;
#pragma unroll
                for (int bj = 0; bj < 2; ++bj) { const f32x4 a0 = acc[ai][bj][m][0], a1 = acc[ai][bj][m][1];
                    const u32x4 y = *(const u32x4*)(Y + ro + bj * HALF);
                    u32x4 w; w.x = pk2(bflo(y.x) * a0[0], bfhi(y.x) * a0[1]); w.y = pk2(bflo(y.y) * a0[2], bfhi(y.y) * a0[3]);
                    w.z = pk2(bflo(y.z) * a1[0], bfhi(y.z) * a1[1]); w.w = pk2(bflo(y.w) * a1[2], bfhi(y.w) * a1[3]);
                    *(u32x4*)(Y + ro + bj * HALF) = w; } }
    }
};

template <class Epi, class Sched, bool ALIGN_EPI = false, bool SP2 = false>
__device__ __forceinline__ void gemm_phase(PG8_LAS unsigned char* lds, const Gemm g, const Sched& S, const Epi& E, const int tid) {
    const int wid = __builtin_amdgcn_readfirstlane(tid >> 6), lane = tid & 63, wr = wid >> 2, wc = wid & 3, fr = lane & 15, fq = lane >> 4;
    const int K = g.K, nt = K / BK, lda = g.lda;
    unsigned voffA[2], voffB[2];
#pragma unroll
    for (int i = 0; i < 2; ++i) { int R, C; stage_rc(tid * 16 + i * 8192, R, C); const int Rb = Epi::PERM ? ((R & ~31) + perm32(R & 31)) : R;
        voffA[i] = (unsigned)(R * lda + C) * 2u; voffB[i] = (unsigned)(Rb * K + C) * 2u; }
    const size_t kstep = (size_t)(BK * 2);
    const size_t hstepA = (size_t)HALF * lda * 2, hstepB = (size_t)HALF * K * 2;
    const size_t tstepA = 2 * hstepA, tstepB = 2 * hstepB;
    const unsigned ldsw = (unsigned)wid * 1024u;
    const int aoff = lds_byte(wr * 64 + fr, fq * 8), boff = lds_byte(wc * 32 + fr, fq * 8);
#define PG8_SA(b, h) (((b) * 2 + (h)) * HTB)
#define PG8_SB(b, h) ((4 + (b) * 2 + (h)) * HTB)
#define PG8_STAGE(bufoff, gbase, voff) do { _Pragma("unroll") for (int _i = 0; _i < 2; ++_i) \
        __builtin_amdgcn_global_load_lds((const unsigned*)((const char*)(gbase) + (voff)[_i]), (PG8_LAS unsigned*)(lds + (bufoff) + ldsw + _i * 8192), 16, 0, 0); } while (0)
#define PG8_LDA(dst, b, h) do { _Pragma("unroll") for (int m = 0; m < 4; ++m) _Pragma("unroll") for (int k = 0; k < 2; ++k) dst[m][k] = *(const PG8_LAS bf16x8*)(lds + PG8_SA(b, h) + aoff + m * 2048 + k * 1024); } while (0)
#define PG8_LDB(dst, b, h) do { _Pragma("unroll") for (int n = 0; n < 2; ++n) _Pragma("unroll") for (int k = 0; k < 2; ++k) dst[n][k] = *(const PG8_LAS bf16x8*)(lds + PG8_SB(b, h) + boff + n * 2048 + k * 1024); } while (0)
#define PG8_MMA(ai, bj, At, Bt) do { __builtin_amdgcn_s_setprio(1); _Pragma("unroll") for (int m = 0; m < 4; ++m) _Pragma("unroll") for (int n = 0; n < 2; ++n) _Pragma("unroll") for (int k = 0; k < 2; ++k) \
        acc[ai][bj][m][n] = __builtin_amdgcn_mfma_f32_16x16x32_bf16(Bt[n][k], At[m][k], acc[ai][bj][m][n], 0, 0, 0); __builtin_amdgcn_s_setprio(0); } while (0)
#define PG8_WAIT_V(n) asm volatile("s_waitcnt vmcnt(" #n ")" ::: "memory")
#define PG8_WAIT_L(n) asm volatile("s_waitcnt lgkmcnt(" #n ")" ::: "memory")
#define PG8_BAR __builtin_amdgcn_s_barrier()
#define PG8_SCHED __builtin_amdgcn_sched_barrier(0)
    Unit cur, nxt; int ui = 0;
    if (!S.next(0, cur)) return;
    f32x4 acc[2][2][4][2];
#pragma unroll
    for (int a = 0; a < 2; ++a)
#pragma unroll
        for (int b = 0; b < 2; ++b)
#pragma unroll
            for (int m = 0; m < 4; ++m)
#pragma unroll
                for (int n = 0; n < 2; ++n) acc[a][b][m][n] = (f32x4){0.f, 0.f, 0.f, 0.f};
    bf16x8 At[4][2], B0[2][2], B1[2][2];
    const char* cA = (const char*)g.A + (size_t)cur.pm * tstepA + (size_t)((cur.pn >= g.g0) + (cur.pn >= g.g1)) * g.a_gstride; const char* cB = (const char*)g.Bt + (size_t)cur.pn * tstepB;
    S.a_ready(cur);
    if constexpr (SP2) {
        PG8_STAGE(PG8_SB(0, 0), cB, voffB); PG8_STAGE(PG8_SB(0, 1), cB + hstepB, voffB); PG8_STAGE(PG8_SA(0, 0), cA, voffA); PG8_STAGE(PG8_SA(0, 1), cA + hstepA, voffA);
        if (wr == 1) PG8_BAR;
        PG8_WAIT_V(2); PG8_BAR;
        PG8_STAGE(PG8_SB(1, 0), cB + kstep, voffB); PG8_STAGE(PG8_SA(1, 0), cA + kstep, voffA); PG8_STAGE(PG8_SB(1, 1), cB + hstepB + kstep, voffB);
        PG8_WAIT_V(6); PG8_BAR;
    } else {
        PG8_STAGE(PG8_SB(0, 0), cB, voffB); PG8_STAGE(PG8_SA(0, 0), cA, voffA); PG8_STAGE(PG8_SB(0, 1), cB + hstepB, voffB); PG8_STAGE(PG8_SA(0, 1), cA + hstepA, voffA);
        if (wr == 1) PG8_BAR;
        PG8_WAIT_V(4); PG8_BAR;
        PG8_STAGE(PG8_SB(1, 0), cB + kstep, voffB); PG8_STAGE(PG8_SA(1, 0), cA + kstep, voffA); PG8_STAGE(PG8_SB(1, 1), cB + hstepB + kstep, voffB);
        PG8_WAIT_V(6); PG8_BAR;
    }
    for (;;) {
        const bool has_next = S.next(ui + 1, nxt);
        const char* nA = has_next ? (const char*)g.A + (size_t)nxt.pm * tstepA + (size_t)((nxt.pn >= g.g0) + (nxt.pn >= g.g1)) * g.a_gstride : cA; const char* nB = has_next ? (const char*)g.Bt + (size_t)nxt.pn * tstepB : cB;
        for (int t = 0; t < nt; t += 2) {
            const bool last = (t == nt - 2);
            const char* a1 = cA + (size_t)(t + 1) * kstep;
            const char* a2 = last ? nA : cA + (size_t)(t + 2) * kstep; const char* b2 = last ? nB : cB + (size_t)(t + 2) * kstep;
            const char* a3 = a2 + kstep; const char* b3 = b2 + kstep;
            if (last && has_next) S.a_ready(nxt);
            if constexpr (SP2) {
            PG8_LDB(B0, 0, 0); PG8_LDB(B1, 0, 1); PG8_SCHED; PG8_LDA(At, 0, 0); PG8_STAGE(PG8_SA(1, 1), a1 + hstepA, voffA);
            PG8_WAIT_V(8); PG8_WAIT_L(0); PG8_BAR; PG8_MMA(0, 0, At, B0); PG8_MMA(0, 1, At, B1); PG8_BAR; PG8_SCHED;
            PG8_LDA(At, 0, 1); PG8_STAGE(PG8_SB(0, 0), b2, voffB); PG8_STAGE(PG8_SB(0, 1), b2 + hstepB, voffB); PG8_STAGE(PG8_SA(0, 0), a2, voffA);
            PG8_WAIT_V(8); PG8_WAIT_L(0); PG8_BAR; PG8_MMA(1, 0, At, B0); PG8_MMA(1, 1, At, B1); PG8_BAR; PG8_SCHED;
            PG8_LDB(B0, 1, 0); PG8_LDB(B1, 1, 1); PG8_SCHED; PG8_LDA(At, 1, 0); PG8_STAGE(PG8_SA(0, 1), a2 + hstepA, voffA);
            PG8_WAIT_V(8); PG8_WAIT_L(0); PG8_BAR; PG8_MMA(0, 0, At, B0); PG8_MMA(0, 1, At, B1); PG8_BAR; PG8_SCHED;
            PG8_LDA(At, 1, 1); PG8_STAGE(PG8_SB(1, 0), b3, voffB); PG8_STAGE(PG8_SB(1, 1), b3 + hstepB, voffB); PG8_STAGE(PG8_SA(1, 0), a3, voffA);
            PG8_WAIT_V(8); PG8_WAIT_L(0); PG8_BAR; PG8_MMA(1, 0, At, B0); PG8_MMA(1, 1, At, B1); PG8_BAR; PG8_SCHED;
            } else {
            PG8_LDB(B0, 0, 0); PG8_SCHED; PG8_LDA(At, 0, 0); PG8_STAGE(PG8_SA(1, 1), a1 + hstepA, voffA);
            PG8_WAIT_L(8); PG8_BAR; PG8_WAIT_L(0); PG8_MMA(0, 0, At, B0); PG8_BAR; PG8_SCHED;
            PG8_LDB(B1, 0, 1); PG8_STAGE(PG8_SB(0, 0), b2, voffB);
            PG8_BAR; PG8_WAIT_L(0); PG8_MMA(0, 1, At, B1); PG8_BAR;
            PG8_LDA(At, 0, 1); PG8_STAGE(PG8_SA(0, 0), a2, voffA);
            PG8_BAR; PG8_WAIT_L(0); PG8_MMA(1, 0, At, B0); PG8_BAR; PG8_SCHED;
            PG8_STAGE(PG8_SB(0, 1), b2 + hstepB, voffB);
            PG8_WAIT_V(6); PG8_BAR; PG8_MMA(1, 1, At, B1); PG8_BAR;
            PG8_LDB(B0, 1, 0); PG8_SCHED; PG8_LDA(At, 1, 0); PG8_STAGE(PG8_SA(0, 1), a2 + hstepA, voffA);
            PG8_WAIT_L(8); PG8_BAR; PG8_WAIT_L(0); PG8_MMA(0, 0, At, B0); PG8_BAR; PG8_SCHED;
            PG8_LDB(B1, 1, 1); PG8_STAGE(PG8_SB(1, 0), b3, voffB);
            PG8_BAR; PG8_WAIT_L(0); PG8_MMA(0, 1, At, B1); PG8_BAR;
            PG8_LDA(At, 1, 1); PG8_STAGE(PG8_SA(1, 0), a3, voffA);
            PG8_BAR; PG8_WAIT_L(0); PG8_MMA(1, 0, At, B0); PG8_BAR; PG8_SCHED;
            PG8_STAGE(PG8_SB(1, 1), b3 + hstepB, voffB);
            PG8_WAIT_V(6); PG8_BAR; PG8_MMA(1, 1, At, B1); PG8_BAR;
            }
        }
        if constexpr (ALIGN_EPI) { if (wr == 0) PG8_BAR; }
        if constexpr (!Epi::AFTER_DRAIN) { E(acc, cur, wr, wc, fr, fq); S.done(cur); }
        if (!has_next) break;
#pragma unroll
        for (int a = 0; a < 2; ++a)
#pragma unroll
            for (int b = 0; b < 2; ++b)
#pragma unroll
                for (int m = 0; m < 4; ++m)
#pragma unroll
                    for (int n = 0; n < 2; ++n) acc[a][b][m][n] = (f32x4){0.f, 0.f, 0.f, 0.f};
        cur = nxt; cA = nA; cB = nB; ++ui;
        if constexpr (ALIGN_EPI) { if (wr == 1) PG8_BAR; }
    }
    PG8_WAIT_V(0);
    if constexpr (!ALIGN_EPI) { if (wr == 0) PG8_BAR; }
    PG8_BAR;
#undef PG8_SA
#undef PG8_SB
#undef PG8_STAGE
#undef PG8_LDA
#undef PG8_LDB
#undef PG8_MMA
#undef PG8_WAIT_V
#undef PG8_WAIT_L
#undef PG8_BAR
#undef PG8_SCHED
}
}

#define XB_TMO      128
#define XB_XCNT(j)  (256  + 64 * (j))
#define XB_XSUB(j)  (1280 + 64 * (j))
#define XB_XGEN(j)  (2304 + 64 * (j))
#define XB_TOP      3328
#define XB_TOPGEN   3392
#define XCD_BAR_WORDS 3456
#define XB_SPIN_CAP (1u << 22)
__device__ __forceinline__ unsigned xb_ld(unsigned* p)              { return __hip_atomic_load(p, __ATOMIC_RELAXED, __HIP_MEMORY_SCOPE_AGENT); }
__device__ __forceinline__ unsigned xb_add(unsigned* p, unsigned v) { return __hip_atomic_fetch_add(p, v, __ATOMIC_RELAXED, __HIP_MEMORY_SCOPE_AGENT); }
__device__ __forceinline__ unsigned xb_xcc_id() { return (unsigned)__builtin_amdgcn_s_getreg((3 << 11) | 20) & 0xFu; }
#define XB_SPIN(cond, bar) do { unsigned _sp = 0; while (cond) { __builtin_amdgcn_s_sleep(1); \
    if ((++_sp & 255u) == 0u) { if (xb_ld(&(bar)[XB_TMO])) break; if (_sp > XB_SPIN_CAP) { atomicAdd(&(bar)[XB_TMO], 1u); break; } } } } while (0)
struct XcdBarrier { unsigned* bar; unsigned x; volatile LAS unsigned* st; };
__device__ __forceinline__ XcdBarrier xcd_barrier_post(unsigned* bar, volatile LAS unsigned* st) {
    XcdBarrier b; b.bar = bar; b.x = xb_xcc_id(); b.st = st;
    if (threadIdx.x == 0) (void)xb_add(&bar[XB_XCNT(b.x)], 1u);
    return b;
}
__device__ __forceinline__ void xcd_barrier_complete(unsigned* bar, unsigned x, unsigned& nloc, unsigned& nx) {
    const unsigned G = gridDim.x * gridDim.y * gridDim.z;
    unsigned sum, cnt, mine, sp = 0u;
    for (;;) {
        sum = 0u; cnt = 0u; mine = 0u;
#pragma unroll
        for (unsigned j = 0; j < 16; ++j) { const unsigned c = xb_ld(&bar[XB_XCNT(j)]); sum += c; cnt += (c > 0u) ? 1u : 0u; mine = (j == x) ? c : mine; }
        if (sum == G) break;
        __builtin_amdgcn_s_sleep(1);
        if ((++sp & 255u) == 0u) { if (xb_ld(&bar[XB_TMO])) break; if (sp > XB_SPIN_CAP) { atomicAdd(&bar[XB_TMO], 1u); break; } }
    }
    nloc = mine > 0u ? mine : 1u; nx = cnt > 0u ? cnt : 1u;
}
__device__ __forceinline__ void xcd_barrier(const XcdBarrier& b) {
    asm volatile("s_waitcnt vmcnt(0)" ::: "memory");
    __syncthreads();
    if (threadIdx.x == 0) {
        unsigned* bar = b.bar;
        __builtin_amdgcn_s_waitcnt(0);
        unsigned nloc = b.st[0], nx = b.st[1];
        if (nloc == 0u) { xcd_barrier_complete(bar, b.x, nloc, nx); b.st[0] = nloc; b.st[1] = nx; }
        const unsigned old = xb_add(&bar[XB_XSUB(b.x)], 1u);
        const unsigned gen = old / nloc;
        if (old + 1u == (gen + 1u) * nloc) {
            __builtin_amdgcn_fence(__ATOMIC_RELEASE, "agent");
            asm volatile("s_waitcnt vmcnt(0)" ::: "memory");
            const unsigned og = xb_add(&bar[XB_TOP], 1u);
            const unsigned tg = og / nx;
            if (og + 1u == (tg + 1u) * nx) xb_add(&bar[XB_TOPGEN], 1u);
            else XB_SPIN(xb_ld(&bar[XB_TOPGEN]) == tg, bar);
            __builtin_amdgcn_fence(__ATOMIC_ACQUIRE, "agent");
            xb_add(&bar[XB_XGEN(b.x)], 1u);
            asm volatile("s_waitcnt vmcnt(0)" ::: "memory");
        } else {
            XB_SPIN(xb_ld(&bar[XB_XGEN(b.x)]) == gen, bar);
            __builtin_amdgcn_fence(__ATOMIC_ACQUIRE, "agent");
            asm volatile("s_waitcnt vmcnt(0)" ::: "memory");
        }
    }
    __syncthreads();
}

constexpr size_t MiB = 1u << 20;
constexpr size_t WS_CTL = 0, CTL_ZERO_BYTES = 1 * MiB;
constexpr size_t WS_ROPE = 1 * MiB;
constexpr size_t WS_WTS = 4 * MiB;
constexpr size_t W_UP0 = WS_WTS, W_DN0 = WS_WTS + 44 * MiB, W_UP1 = WS_WTS + 66 * MiB, W_DN1 = WS_WTS + 110 * MiB;
constexpr size_t W_MIX = WS_WTS + 132 * MiB;
constexpr size_t W_G2 = W_MIX + 25 * MiB, W_GG = W_MIX + 28 * MiB, W_GV = W_MIX + 29 * MiB;
constexpr size_t W_GO = WS_WTS + 212 * MiB;
constexpr size_t WS_VF = 228 * MiB;
constexpr size_t WS_POOL = 420 * MiB;
constexpr size_t P_XN = WS_POOL;
constexpr size_t P_H = WS_POOL + 192 * MiB, P_HOUT = WS_POOL + 720 * MiB;
constexpr size_t P_MIX = WS_POOL + 192 * MiB;
constexpr size_t P_YF = WS_POOL + 192 * MiB, P_YB = WS_POOL + 384 * MiB, P_R = WS_POOL + 768 * MiB, P_K = WS_POOL + 960 * MiB, P_V = WS_POOL + 1152 * MiB,
                 P_HID = WS_POOL + 1344 * MiB, P_BS = WS_POOL + 1440 * MiB;
constexpr size_t P_QKV = WS_POOL + 192 * MiB, P_O0 = WS_POOL + 768 * MiB, P_LSE = WS_POOL + 1344 * MiB;
constexpr size_t WS_END = WS_POOL + 1452 * MiB;
constexpr int CW_BAR = 4096;
constexpr size_t WS_SCANFLAG = 512 * 1024;
constexpr int SCAN_NH = 63;
constexpr int SCAN_DUMP_U = 4592, SCAN_SLOT = 73728, SCAN_SLOTS_OUT = 5461;
constexpr size_t WS_RSX = 65536;

constexpr int RING_BYTES = 131072, CTRL_OFF = 143360, MISC_OFF = CTRL_OFF + 256, LDS_BYTES = 163840;
constexpr int NWAVES = 8;

struct Args { const float* in[28]; float* out; unsigned char* ws; int step_lo, step_hi; };

struct Seg { unsigned long long woff, soff, doff; int widx, sidx, ldw, col0, ldt, row0, k0dst, nkb, nnb, ilv, item0, pad0; };
__device__ __forceinline__ void seg_add(LAS Seg* s, int& n, int& items, int widx, size_t woff, int sidx, size_t soff, size_t doff, int ldw, int col0, int ldt, int row0, int k0dst, int nkb, int nnb, int ilv) {
    s[n].widx = widx; s[n].woff = woff; s[n].sidx = sidx; s[n].soff = soff; s[n].doff = doff; s[n].ldw = ldw; s[n].col0 = col0; s[n].ldt = ldt; s[n].row0 = row0; s[n].k0dst = k0dst; s[n].nkb = nkb; s[n].nnb = nnb; s[n].ilv = ilv; s[n].item0 = items;
    items += nkb * nnb; ++n;
}

extern __shared__ __attribute__((aligned(16))) unsigned char lds_raw[];
constexpr int PTR_OFF = CTRL_OFF + 512;
__device__ __forceinline__ unsigned long long ptr_ld(int i) {
    const LAS unsigned* p = (const LAS unsigned*)((LAS unsigned char*)lds_raw + PTR_OFF) + 2 * i;
    const unsigned lo = __builtin_amdgcn_readfirstlane(p[0]), hi = __builtin_amdgcn_readfirstlane(p[1]);
    return ((unsigned long long)hi << 32) | lo;
}
__device__ __forceinline__ const float* inp(int i) { return (const float*)(const GAS float*)ptr_ld(i); }
__device__ __forceinline__ float* outp() { return (float*)(GAS float*)ptr_ld(28); }
__device__ __forceinline__ unsigned char* wsp() { return (unsigned char*)(GAS unsigned char*)ptr_ld(29); }
#define FRAME() LAS unsigned char* lds = (LAS unsigned char*)lds_raw; int tid = threadIdx.x; asm volatile("" : "+v"(tid)); const int lane = tid & 63, wave = __builtin_amdgcn_readfirstlane(tid >> 6); \
    int bid_ = blockIdx.x, G = gridDim.x; asm volatile("" : "+s"(bid_), "+s"(G)); const int gw = bid_ * NWAVES + wave, NGW = G * NWAVES; unsigned char* ws = wsp(); (void)lds; (void)lane; (void)gw; (void)NGW; (void)ws; (void)G

static __device__ PHASE_ATTR void ph_init() {
    FRAME();
    const float* in0 = inp(0); const float* in1 = inp(1);
    {
        f32x2* tab = (f32x2*)(ws + WS_ROPE);
        for (int idx = bid_ * 512 + tid; idx < 16384 * 16; idx += G * 512) {
            const int pos = idx >> 4, i = idx & 15;
            double iv = 1.0;
            iv = (i == 1) ? 0.44036660267178046 : iv; iv = (i == 2) ? 0.19392274474868576 : iv; iv = (i == 3) ? 0.08539710028576561 : iv; iv = (i == 4) ? 0.03760603093086393 : iv;
            iv = (i == 5) ? 0.016560440080994446 : iv; iv = (i == 6) ? 0.007292664737217109 : iv; iv = (i == 7) ? 0.003211445994752591 : iv; iv = (i == 8) ? 0.001414213562373095 : iv;
            iv = (i == 9) ? 0.000622772421914596 : iv; iv = (i == 10) ? 0.0002742481756762073 : iv; iv = (i == 11) ? 0.00012076973741146504 : iv; iv = (i == 12) ? 5.318295896944988e-05 : iv;
            iv = (i == 13) ? 2.341999896140934e-05 : iv; iv = (i == 14) ? 1.031338537721246e-05 : iv; iv = (i == 15) ? 4.5416704806078695e-06 : iv;
            double t = (double)pos * iv * 0.15915494309189535; t = t - __builtin_rint(t);
            const float tf = (float)t;
            tab[idx] = (f32x2){__builtin_amdgcn_cosf(tf), __builtin_amdgcn_sinf(tf)};
        }
    }
    bf16_t* XB = (bf16_t*)(ws + P_XN); float* RSX = (float*)(ws + WS_RSX);
    for (int row = gw; row < TT; row += NGW) {
        const float* src = row < 32768 ? in0 + (size_t)row * D : in1 + (size_t)(row - 32768) * D;
        float ss = 0.f;
#pragma unroll
        for (int i = 0; i < 4; ++i) { const int e = 8 * (lane + 64 * i); const f32x4 a = *(const f32x4*)(src + e), b = *(const f32x4*)(src + e + 4);
#pragma unroll
            for (int j = 0; j < 4; ++j) ss += a[j] * a[j] + b[j] * b[j];
            *(u32x4*)(XB + (size_t)row * D + e) = (u32x4){pk2(a[0], a[1]), pk2(a[2], a[3]), pk2(b[0], b[1]), pk2(b[2], b[3])}; }
        const float rx = rsqrtf(wave_sum(ss) * (1.0f / D) + NORM_EPS);
        if (lane == 0) RSX[row] = rx;
    }
}

__device__ __forceinline__ void conv_load(const LAS Seg* sp, int local, int lane, f32x4 (&v)[8]) {
    const int widx = sp->widx; if (widx < 0) return;
    const int ldw = sp->ldw, nnb = sp->nnb, kb = local / nnb, nb = local % nnb;
    const float* p = inp(widx) + sp->woff + (size_t)(64 * kb + (lane >> 3)) * ldw + sp->col0 + 32 * nb + 4 * (lane & 7);
#pragma unroll
    for (int i = 0; i < 8; ++i) v[i] = *(const f32x4*)(p + (size_t)(8 * i) * ldw);
}
__device__ __forceinline__ void conv_finish(const LAS Seg* sp, int local, LAS float* scr, int lane, const f32x4 (&v)[8], unsigned char* ws) {
    const int widx = sp->widx, sidx = sp->sidx, ldt = sp->ldt, row0 = sp->row0, k0dst = sp->k0dst, nnb = sp->nnb, ilv = sp->ilv;
    bf16_t* dst = (bf16_t*)(ws + sp->doff);
    const int kb = local / nnb, nb = local % nnb, k0 = 64 * kb, n0 = 32 * nb, c = lane & 7;
    if (widx >= 0) {
        const float* scale = sidx >= 0 ? inp(sidx) + sp->soff + k0 + (lane >> 3) : nullptr;
#pragma unroll
        for (int i = 0; i < 8; ++i) { const int kk = (lane >> 3) + 8 * i; const float sc = scale ? scale[8 * i] : 1.0f;
            LAS float* s = scr + kk * 33 + 4 * (lane & 7); s[0] = v[i][0] * sc; s[1] = v[i][1] * sc; s[2] = v[i][2] * sc; s[3] = v[i][3] * sc; }
        asm volatile("s_waitcnt lgkmcnt(0)" ::: "memory");
    }
#pragma unroll
    for (int j = 0; j < 4; ++j) { const int n = (lane >> 3) + 8 * j; const int nn = n0 + n;
        int drow = row0 + ((ilv == 1) ? (256 * (nn >> 7) + (nn & 127)) : nn);
        if (ilv == 2 && ((nn >> 11) % 3) < 2) {
            const int co = nn & 127;
            const int nl = co < 32 ? (8 * (co & 15) + (co >> 4)) : (8 * ((co - 32) / 6) + 2 + (co - 32) % 6);
            drow = row0 + (nn & ~127) + nl; }
        u32x4 o = {0u, 0u, 0u, 0u};
        if (widx >= 0) { const LAS float* s = scr + (8 * c) * 33 + n;
            o.x = pk2(s[0 * 33], s[1 * 33]); o.y = pk2(s[2 * 33], s[3 * 33]); o.z = pk2(s[4 * 33], s[5 * 33]); o.w = pk2(s[6 * 33], s[7 * 33]); }
        *(u32x4*)(dst + (size_t)drow * ldt + k0dst + k0 + 8 * c) = o; }
    asm volatile("s_waitcnt lgkmcnt(0)" ::: "memory");
}
static __device__ PHASE_ATTR void ph_conv(int L) {
    FRAME();
    const int jm = L >> 1; const bool is_attn = (L & 1) != 0;
    LAS Seg* segs = (LAS Seg*)lds; LAS int* nseg_p = (LAS int*)(lds + 4096); LAS float* scr = (LAS float*)(lds + 8192 + wave * 8448);
    if (tid == 0) {
        int n = 0, items = 0;
        for (int f = 0; f < 2; ++f) {
            const size_t wo = (size_t)(L * 2 + f) * D * FF;
            const size_t up = f ? W_UP1 : W_UP0, dn = f ? W_DN1 : W_DN0;
            seg_add(segs, n, items, 4, wo, 2, (size_t)(L * 3 + 2 * f) * D, up, FF, 0, D, 0, 0, D / 64, FF / 32, 1);
            seg_add(segs, n, items, 5, wo, 2, (size_t)(L * 3 + 2 * f) * D, up, FF, 0, D, 128, 0, D / 64, FF / 32, 1);
            seg_add(segs, n, items, 6, wo, -1, 0, dn, D, 0, FF, 0, 0, FF / 64, D / 32, 0);
        }
        if (!is_attn) {
            for (int p = 0; p < 3; ++p) seg_add(segs, n, items, 8, (size_t)(jm * 3 + p) * D * D, -1, 0, W_MIX, D, 0, D, p * D, 0, D / 64, D / 32, 0);
            if (jm > 0) { seg_add(segs, n, items, 16, (size_t)(jm - 1) * D * 64, -1, 0, W_MIX, 64, 0, D, 3 * D, 0, D / 64, 2, 0);
                          seg_add(segs, n, items, -1, 0, -1, 0, W_MIX, 0, 0, D, 3 * D + 64, 0, D / 64, 6, 0);
                          seg_add(segs, n, items, 17, (size_t)(jm - 1) * 64 * D, -1, 0, W_GV, D, 0, 256, 0, 0, 1, D / 32, 0);
                          seg_add(segs, n, items, -1, 0, -1, 0, W_GV, 0, 0, 256, 0, 64, 3, D / 32, 0); }
            else seg_add(segs, n, items, -1, 0, -1, 0, W_MIX, 0, 0, D, 3 * D, 0, D / 64, 8, 0);
            for (int d = 0; d < 2; ++d) {
                seg_add(segs, n, items, 10, (size_t)(jm * 2 + d) * D * 96, -1, 0, W_G2, 96, 0, D, d * 128, 0, D / 64, 3, 0);
                seg_add(segs, n, items, -1, 0, -1, 0, W_G2, 0, 0, D, d * 128 + 96, 0, D / 64, 1, 0);
                seg_add(segs, n, items, 13, (size_t)(jm * 2 + d) * D * 96, -1, 0, W_G2, 96, 0, D, 256 + d * 128, 0, D / 64, 3, 0);
                seg_add(segs, n, items, -1, 0, -1, 0, W_G2, 0, 0, D, 256 + d * 128 + 96, 0, D / 64, 1, 0);
            }
            seg_add(segs, n, items, 18, (size_t)jm * D * 256, -1, 0, W_G2, 256, 0, D, 512, 0, D / 64, 8, 0);
            seg_add(segs, n, items, 19, (size_t)jm * 256 * D, -1, 0, W_GG, D, 0, 256, 0, 0, 4, D / 32, 0);
            seg_add(segs, n, items, 25, (size_t)jm * D * D, -1, 0, W_GO, D, 0, D, 0, 0, D / 64, D / 32, 0);
        } else {
            seg_add(segs, n, items, 26, (size_t)jm * D * 9 * D, 2, (size_t)(L * 3 + 1) * D, W_MIX, 9 * D, 0, D, 0, 0, D / 64, 9 * D / 32, 2);
            seg_add(segs, n, items, 27, (size_t)jm * D * D, -1, 0, W_GO, D, 0, D, 0, 0, D / 64, D / 32, 0);
        }
        segs[n].item0 = items; nseg_p[0] = n; nseg_p[1] = items;
    }
    __syncthreads();
    const int total = nseg_p[1];
    f32x4 cur[8], nxt[8];
#pragma unroll
    for (int i = 0; i < 8; ++i) { cur[i] = (f32x4){0.f, 0.f, 0.f, 0.f}; nxt[i] = cur[i]; }
    int it = gw, si = 0;
    if (it < total) { while (it >= segs[si + 1].item0) ++si; conv_load(segs + si, it - segs[si].item0, lane, cur); }
    while (it < total) {
        const int itn = it + NGW; int sn = si;
        if (itn < total) { while (itn >= segs[sn + 1].item0) ++sn; conv_load(segs + sn, itn - segs[sn].item0, lane, nxt); }
        conv_finish(segs + si, it - segs[si].item0, scr, lane, cur, ws);
#pragma unroll
        for (int i = 0; i < 8; ++i) cur[i] = nxt[i];
        it = itn; si = sn;
    }
    __syncthreads();
}

static __device__ PHASE_ATTR void ph_ffn_up(int f) {
    FRAME();
    pg8::Gemm g{(const bf16_t*)(ws + P_XN), (const bf16_t*)(ws + (f ? W_UP1 : W_UP0)), TT, 2 * FF, D, D}; pg8::StaticOrder S; S.init(TT, 2 * FF, G, bid_);
    pg8::EpiSwiGLU E{(bf16_t*)(ws + P_H), (const float*)(ws + WS_RSX)};
    pg8::gemm_phase<pg8::EpiSwiGLU, pg8::StaticOrder, true, true>(lds, g, S, E, tid);
}
static __device__ PHASE_ATTR void ph_gemm_plain(size_t a_off, int lda, size_t b_off, int N, int K, size_t o_off, int ldc) {
    FRAME();
    pg8::Gemm g{(const bf16_t*)(ws + a_off), (const bf16_t*)(ws + b_off), TT, N, K, lda}; pg8::StaticOrder S; S.init(TT, N, G, bid_);
    pg8::EpiPlain E{(bf16_t*)(ws + o_off), ldc};
    pg8::gemm_phase<pg8::EpiPlain, pg8::StaticOrder, true, true>(lds, g, S, E, tid);
}
static __device__ PHASE_ATTR void ph_qkv(int gi) {
    FRAME();
    pg8::Gemm g{(const bf16_t*)(ws + P_XN), (const bf16_t*)(ws + W_MIX) + (size_t)gi * 3 * D * D, TT, 3 * D, D, D}; pg8::StaticOrder S; S.init(TT, 3 * D, G, bid_);
    pg8::EpiQKV E{(bf16_t*)(ws + P_QKV), (const f32x2*)(ws + WS_ROPE), (const float*)(ws + WS_RSX)};
    pg8::gemm_phase<pg8::EpiQKV, pg8::StaticOrder, true, true>(lds, g, S, E, tid);
}
static __device__ PHASE_ATTR void ph_g1(int jm, int round) {
    FRAME();
    pg8::Gemm g{(const bf16_t*)(ws + P_MIX), (const bf16_t*)(ws + (round ? W_G2 : W_MIX)), TT, round ? NG2 : NG1, D, D, (size_t)192 * MiB, round ? 1 : 8, round ? 2 : 16};
    pg8::StaticOrder S; S.init(TT, round ? NG2 : NG1, G, bid_);
    pg8::EpiG1 E{ws, P_R, (jm == 0 ? WS_VF : P_V), P_HID, round};
    pg8::gemm_phase<pg8::EpiG1, pg8::StaticOrder, true, true>(lds, g, S, E, tid);
}
static __device__ PHASE_ATTR void ph_gv(int jm) {
    FRAME();
    pg8::Gemm g{(const bf16_t*)(ws + P_HID) + 768, (const bf16_t*)(ws + W_GV), TT, D, 256, HID}; pg8::StaticOrder S; S.init(TT, D, G, bid_);
    pg8::EpiVres E{(bf16_t*)(ws + P_V), (const bf16_t*)(ws + WS_VF), inp(15) + (size_t)(jm - 1) * D};
    pg8::gemm_phase<pg8::EpiVres, pg8::StaticOrder, true, true>(lds, g, S, E, tid);
}
static __device__ PHASE_ATTR void ph_gg() {
    FRAME();
    pg8::Gemm g{(const bf16_t*)(ws + P_HID) + 512, (const bf16_t*)(ws + W_GG), TT, D, 256, HID}; pg8::StaticOrder S; S.init(TT, D, G, bid_);
    pg8::EpiGmul E{(bf16_t*)(ws + P_YF)};
    pg8::gemm_phase<pg8::EpiGmul, pg8::StaticOrder, true, true>(lds, g, S, E, tid);
}

static __device__ PHASE_ATTR void ph_mix(int jm, int round) {
    FRAME();
    const bf16_t* XB = (const bf16_t*)(ws + P_XN); const float* RSX = (const float*)(ws + WS_RSX); bf16_t* MX = (bf16_t*)(ws + P_MIX);
    const float* mu = inp(7) + (size_t)jm * 6 * D; const float* gpre = inp(2) + (size_t)((2 * jm) * 3 + 1) * D;
    const int m0 = round ? 1 : 0, m1 = round ? 4 : 2, m2 = round ? 5 : 3;
    u32x4 cq[4], pq[4], nq[4]; float rcq, rpq, rnq;
#define MIX_LOAD(row_) do { const int r_ = (row_); int base_, pos_, len_; row_decode(r_, base_, pos_, len_); const bf16_t* a_ = XB + (size_t)r_ * D; \
        rcq = RSX[r_]; rpq = pos_ > 0 ? RSX[r_ - 1] : 0.f; rnq = pos_ < len_ - 1 ? RSX[r_ + 1] : 0.f; \
        _Pragma("unroll") for (int i = 0; i < 4; ++i) { const int e = 8 * (lane + 64 * i); cq[i] = *(const u32x4*)(a_ + e); pq[i] = (u32x4){0u, 0u, 0u, 0u}; nq[i] = (u32x4){0u, 0u, 0u, 0u}; \
            if (pos_ > 0) pq[i] = *(const u32x4*)(a_ - D + e); if (pos_ < len_ - 1) nq[i] = *(const u32x4*)(a_ + D + e); } } while (0)
    int row = gw;
    if (row < TT) MIX_LOAD(row);
    for (; row < TT; row += NGW) {
        u32x4 cc[4], pc[4], nc[4];
#pragma unroll
        for (int i = 0; i < 4; ++i) { cc[i] = cq[i]; pc[i] = pq[i]; nc[i] = nq[i]; }
        const float rc = rcq, rp = rpq, rn = rnq;
        if (row + NGW < TT) MIX_LOAD(row + NGW);
#pragma unroll
        for (int i = 0; i < 4; ++i) { const int e = 8 * (lane + 64 * i);
            const unsigned cw[4] = {cc[i].x, cc[i].y, cc[i].z, cc[i].w}, pw[4] = {pc[i].x, pc[i].y, pc[i].z, pc[i].w}, nw[4] = {nc[i].x, nc[i].y, nc[i].z, nc[i].w};
            const f32x4 ga = *(const f32x4*)(gpre + e), gb = *(const f32x4*)(gpre + e + 4);
            float cv[8], xx[8];
#pragma unroll
            for (int j = 0; j < 4; ++j) { const float g0 = j < 2 ? ga[2 * j] : gb[2 * j - 4], g1 = j < 2 ? ga[2 * j + 1] : gb[2 * j - 3];
                cv[2 * j] = bflo(cw[j]) * rc * g0; cv[2 * j + 1] = bfhi(cw[j]) * rc * g1;
                xx[2 * j] = 0.5f * (bflo(pw[j]) * rp + bflo(nw[j]) * rn) * g0 - cv[2 * j]; xx[2 * j + 1] = 0.5f * (bfhi(pw[j]) * rp + bfhi(nw[j]) * rn) * g1 - cv[2 * j + 1]; }
#pragma unroll
            for (int m = 0; m < 3; ++m) { const int mi = m == 0 ? m0 : (m == 1 ? m1 : m2);
                const f32x4 ma = *(const f32x4*)(mu + mi * D + e), mb = *(const f32x4*)(mu + mi * D + e + 4);
                const u32x4 o = {pk2(cv[0] + xx[0] * ma[0], cv[1] + xx[1] * ma[1]), pk2(cv[2] + xx[2] * ma[2], cv[3] + xx[3] * ma[3]), pk2(cv[4] + xx[4] * mb[0], cv[5] + xx[5] * mb[1]), pk2(cv[6] + xx[6] * mb[2], cv[7] + xx[7] * mb[3])};
                *(u32x4*)(MX + (size_t)m * TT * D + (size_t)row * D + e) = o; }
        }
    }
#undef MIX_LOAD
}

static __device__ __forceinline__ void scan_stage_e(LAS unsigned char* lds, f32x4 (&ST)[4], const int lane, const int vb) {
    constexpr int RS = 72;
    LAS bf16_t* AH = (LAS bf16_t*)(lds); LAS bf16_t* RH = (LAS bf16_t*)(lds + 9216); LAS bf16_t* BT = (LAS bf16_t*)(lds + 36864); LAS bf16_t* YS = (LAS bf16_t*)(lds + 64512);
    LAS unsigned char* KVI = lds + 73728; LAS unsigned char* MAKV = lds + 90112; LAS unsigned char* NRKV = lds + 98304;
    LAS unsigned char* MABF = lds + 108544; LAS unsigned char* NRBF = lds + 112640; LAS bf16_t* TTI = (LAS bf16_t*)(lds + 122880); LAS float* GL = (LAS float*)(lds + 125440);
    const int c15 = lane & 15, g = lane >> 4; const f32x4 zero4 = {0.f, 0.f, 0.f, 0.f};
#define PK_LO(x) __builtin_bit_cast(bf16x8, (u32x4){pk2((x)[0], (x)[1]), pk2((x)[2], (x)[3]), 0u, 0u})
#define PK_2(x, y) __builtin_bit_cast(bf16x8, (u32x4){pk2((x)[0], (x)[1]), pk2((x)[2], (x)[3]), pk2((y)[0], (y)[1]), pk2((y)[2], (y)[3])})
#define ROWFRAG(P) __builtin_bit_cast(bf16x8, (u32x4){(P)[0].x, (P)[0].y, (P)[1].x, (P)[1].y})
                u32x2 ahq[4][4], mkq[4];
#pragma unroll
                for (int tb = 0; tb < 4; ++tb) { const LAS bf16_t* ap = AH + (16 * tb + c15) * RS + 4 * g;
#pragma unroll
                    for (int q = 0; q < 4; ++q) ahq[tb][q] = *(const LAS u32x2*)(ap + 16 * q);
                    mkq[tb] = *(const LAS u32x2*)(MAKV + ((tb * 4 + vb) * 64 + lane) * 8); }
                const u32x4 Sf0 = {pk2(ST[0][0], ST[0][1]), pk2(ST[0][2], ST[0][3]), pk2(ST[1][0], ST[1][1]), pk2(ST[1][2], ST[1][3])};
                const u32x4 Sf1 = {pk2(ST[2][0], ST[2][1]), pk2(ST[2][2], ST[2][3]), pk2(ST[3][0], ST[3][1]), pk2(ST[3][2], ST[3][3])};
                __builtin_amdgcn_sched_barrier(0);
                u32x2 tfq[4]; bf16x8 mf[4];
#pragma unroll
                for (int tb = 0; tb < 4; ++tb) { tfq[tb] = *(const LAS u32x2*)(TTI + (tb * 16 + c15) * 20 + 4 * g); mf[tb] = *(const LAS bf16x8*)(MABF + (tb * 64 + lane) * 16); }
                f32x4 U[4];
#pragma unroll
                for (int tb = 0; tb < 4; ++tb) {
                    f32x4 acc = {bflo(mkq[tb].x), bfhi(mkq[tb].x), bflo(mkq[tb].y), bfhi(mkq[tb].y)};
                    acc = __builtin_amdgcn_mfma_f32_16x16x32_bf16(ROWFRAG(ahq[tb]), __builtin_bit_cast(bf16x8, Sf0), acc, 0, 0, 0);
                    acc = __builtin_amdgcn_mfma_f32_16x16x32_bf16(ROWFRAG(ahq[tb] + 2), __builtin_bit_cast(bf16x8, Sf1), acc, 0, 0, 0);
                    U[tb] = acc; }
                __builtin_amdgcn_sched_barrier(0);
                u32x2 rhq[4][4], nkq[4];
#pragma unroll
                for (int tb = 0; tb < 4; ++tb) { const LAS bf16_t* rp = RH + (16 * tb + c15) * RS + 4 * g;
#pragma unroll
                    for (int q = 0; q < 4; ++q) rhq[tb][q] = *(const LAS u32x2*)(rp + 16 * q);
                    nkq[tb] = *(const LAS u32x2*)(NRKV + ((tb * 4 + vb) * 64 + lane) * 8); }
                f32x4 Y1[4];
#pragma unroll
                for (int tb = 0; tb < 4; ++tb) {
                    f32x4 acy = {bflo(nkq[tb].x), bfhi(nkq[tb].x), bflo(nkq[tb].y), bfhi(nkq[tb].y)};
                    acy = __builtin_amdgcn_mfma_f32_16x16x32_bf16(ROWFRAG(rhq[tb]), __builtin_bit_cast(bf16x8, Sf0), acy, 0, 0, 0);
                    acy = __builtin_amdgcn_mfma_f32_16x16x32_bf16(ROWFRAG(rhq[tb] + 2), __builtin_bit_cast(bf16x8, Sf1), acy, 0, 0, 0);
                    Y1[tb] = acy; }
                const bf16x8 tf0 = __builtin_bit_cast(bf16x8, (u32x4){tfq[0].x, tfq[0].y, 0u, 0u}), tf1 = __builtin_bit_cast(bf16x8, (u32x4){tfq[1].x, tfq[1].y, 0u, 0u});
                const bf16x8 tf2 = __builtin_bit_cast(bf16x8, (u32x4){tfq[2].x, tfq[2].y, 0u, 0u}), tf3 = __builtin_bit_cast(bf16x8, (u32x4){tfq[3].x, tfq[3].y, 0u, 0u});
                f32x4 SA0 = __builtin_amdgcn_mfma_f32_16x16x32_bf16(tf0, PK_LO(U[0]), zero4, 0, 0, 0);
                f32x4 rhs = __builtin_amdgcn_mfma_f32_16x16x32_bf16(mf[0], PK_LO(SA0), U[1], 0, 0, 0);
                f32x4 SA1 = __builtin_amdgcn_mfma_f32_16x16x32_bf16(tf1, PK_LO(rhs), zero4, 0, 0, 0);
                const bf16x8 SAf0 = PK_2(SA0, SA1);
                rhs = __builtin_amdgcn_mfma_f32_16x16x32_bf16(mf[1], SAf0, U[2], 0, 0, 0);
                f32x4 SA2 = __builtin_amdgcn_mfma_f32_16x16x32_bf16(tf2, PK_LO(rhs), zero4, 0, 0, 0);
                rhs = __builtin_amdgcn_mfma_f32_16x16x32_bf16(mf[2], SAf0, U[3], 0, 0, 0);
                rhs = __builtin_amdgcn_mfma_f32_16x16x32_bf16(mf[3], PK_LO(SA2), rhs, 0, 0, 0);
                f32x4 SA3 = __builtin_amdgcn_mfma_f32_16x16x32_bf16(tf3, PK_LO(rhs), zero4, 0, 0, 0);
                const bf16x8 SAf1 = PK_2(SA2, SA3);
                __builtin_amdgcn_sched_barrier(0);
                bf16x8 nrf[6];
#pragma unroll
                for (int i = 0; i < 6; ++i) nrf[i] = *(const LAS bf16x8*)(NRBF + (i * 64 + lane) * 16);
                f32x4 kvq[4], glq[4]; u32x2 btq[4][4];
#pragma unroll
                for (int kb = 0; kb < 4; ++kb) { const LAS bf16_t* bp = BT + (16 * kb + c15) * RS + 4 * g;
#pragma unroll
                    for (int q = 0; q < 4; ++q) btq[kb][q] = *(const LAS u32x2*)(bp + 16 * q);
                    kvq[kb] = *(const LAS f32x4*)(KVI + ((kb * 4 + vb) * 64 + lane) * 16); glq[kb] = *(const LAS f32x4*)(GL + 16 * kb + 4 * g); }
#pragma unroll
                for (int tb = 0; tb < 4; ++tb) { const int nb = tb == 0 ? 0 : (tb == 1 ? 1 : (tb == 2 ? 2 : 4));
                    f32x4 acc = __builtin_amdgcn_mfma_f32_16x16x32_bf16(nrf[nb], SAf0, Y1[tb], 0, 0, 0);
                    if (tb >= 2) acc = __builtin_amdgcn_mfma_f32_16x16x32_bf16(nrf[nb + 1], SAf1, acc, 0, 0, 0);
#pragma unroll
                    for (int r = 0; r < 4; ++r) YS[(16 * tb + 4 * g + r) * RS + 16 * vb + c15] = (bf16_t)(pk2(acc[r], 0.f) & 0xffffu); }
#pragma unroll
                for (int kb = 0; kb < 4; ++kb) { f32x4 acc = kvq[kb];
                    acc = __builtin_amdgcn_mfma_f32_16x16x32_bf16(ROWFRAG(btq[kb]), SAf0, acc, 0, 0, 0);
                    acc = __builtin_amdgcn_mfma_f32_16x16x32_bf16(ROWFRAG(btq[kb] + 2), SAf1, acc, 0, 0, 0);
                    ST[kb] = glq[kb] * (ST[kb] + acc); }
#undef ROWFRAG
#undef PK_LO
#undef PK_2
}

template <int CTRL> __device__ __forceinline__ float dpp_row_shr(float v) { return __builtin_bit_cast(float, __builtin_amdgcn_update_dpp(0, __builtin_bit_cast(int, v), CTRL, 0xf, 0xf, true)); }
static __device__ PHASE_ATTR void ph_scan(int jm) {
    FRAME();
    const bf16_t* Rb = (const bf16_t*)(ws + P_R); const bf16_t* Kb = (const bf16_t*)(ws + P_K); const bf16_t* Vb = (const bf16_t*)(ws + (jm == 0 ? WS_VF : P_V));
    const bf16_t* Hd = (const bf16_t*)(ws + P_HID); float* BS = (float*)(ws + P_BS);
    constexpr int RS = 72;
    LAS bf16_t* AH = (LAS bf16_t*)(lds); LAS bf16_t* RH = (LAS bf16_t*)(lds + 9216); LAS bf16_t* BH = (LAS bf16_t*)(lds + 18432); LAS bf16_t* KH = (LAS bf16_t*)(lds + 27648);
    LAS bf16_t* BT = (LAS bf16_t*)(lds + 36864); LAS bf16_t* KT = (LAS bf16_t*)(lds + 46080); LAS bf16_t* VT = (LAS bf16_t*)(lds + 55296); LAS bf16_t* YS = (LAS bf16_t*)(lds + 64512);
    LAS unsigned char* KVI = lds + 73728; LAS unsigned char* MAKV = lds + 90112; LAS unsigned char* NRKV = lds + 98304;
    LAS float* SEG = (LAS float*)(lds + 106496); LAS float* NRM = (LAS float*)(lds + 107520); LAS float* BON = (LAS float*)(lds + 108032);
    LAS unsigned char* MABF = lds + 108544; LAS unsigned char* NRBF = lds + 112640;
    LAS float* MS = (LAS float*)(lds + 118784); LAS bf16_t* TTI = (LAS bf16_t*)(lds + 122880);
    LAS float* GL = (LAS float*)(lds + 125440); LAS float* PAR = (LAS float*)(lds + 125696);
    LAS unsigned char* W2F = lds + 147456;
    LAS unsigned char* A2F = lds + 126976;
    const int c15 = lane & 15, g = lane >> 4;
    const int tbq = wave & 3, half = wave >> 2;
    const int tF = tid >> 3, c8 = tid & 7;
    const int tbD = wave & 3, kindD = wave >> 2;
    const f32x4 zero4 = {0.f, 0.f, 0.f, 0.f};
    for (int it = bid_; it < 256; it += G) {
        const int seq = it & 3, head = (it >> 2) & 31, dir = it >> 7;
        const bool split = (G == 256);
        const bool helper = split && seq >= 2;
        const int pair = (seq & 1) | (head << 1) | (dir << 6);
        unsigned* flag = (unsigned*)(ws + WS_SCANFLAG + (size_t)jm * 8192 + (size_t)pair * 64);
#pragma unroll 1
        for (int pass = helper ? 0 : 1; pass < 2; ++pass) {
        __syncthreads();
        if (tid < 64) { const int c = head * 64 + tid;
            PAR[tid] = inp(9)[(size_t)(jm * 2 + dir) * D + c]; PAR[64 + tid] = inp(12)[(size_t)(jm * 2 + dir) * D + c];
            PAR[128 + tid] = inp(20)[(size_t)jm * D + c]; PAR[192 + tid] = inp(21)[(size_t)jm * D + c]; PAR[256 + tid] = inp(22)[(size_t)jm * D + c]; }
        int lane_s = lane; asm volatile("" : "+v"(lane_s));
        const int c15s = lane_s & 15, gs = lane_s >> 4;
#pragma unroll
        for (int kind = 0; kind < 2; ++kind)
#pragma unroll
            for (int cbi = 0; cbi < 2; ++cbi) { const float* M = (kind == 0 ? inp(11) : inp(14)) + (size_t)(jm * 2 + dir) * 96 * D + head * 64;
                const unsigned mo = (unsigned)(8 * gs * D + 16 * (2 * half + cbi) + c15s);
#pragma unroll
                for (int ks = 0; ks < 3; ++ks) { float x[8];
#pragma unroll
                    for (int j = 0; j < 8; ++j) x[j] = M[mo + (unsigned)((32 * ks + j) * D)];
                    const u32x4 w = {pk2(x[0], x[1]), pk2(x[2], x[3]), pk2(x[4], x[5]), pk2(x[6], x[7])};
                    *(LAS u32x4*)((kind == 0 ? W2F : A2F) + (((half * 2 + cbi) * 3 + ks) * 64 + lane_s) * 16) = w; }
                __builtin_amdgcn_sched_barrier(0); }
        bf16_t* yd = (bf16_t*)(ws + (dir ? P_YB : P_YF));
        const int cofs = head * 64 + 32 * half + 4 * g;
        bf16x8 hwf[3], haf[3]; u32x2 rq[2], kq[2], vq[2];
#define SCAN_PREFETCH(chunk_) do { const int st_ = (chunk_) * 64 + 16 * tbq + c15; const size_t row_ = (size_t)(base + (dir ? (len - 1 - st_) : st_)); \
            const bf16_t* hp_ = Hd + row_ * HID + dir * 128 + 8 * g; \
            _Pragma("unroll") for (int ks = 0; ks < 3; ++ks) { hwf[ks] = *(const bf16x8*)(hp_ + 32 * ks); haf[ks] = *(const bf16x8*)(hp_ + 256 + 32 * ks); } \
            _Pragma("unroll") for (int cbi = 0; cbi < 2; ++cbi) { rq[cbi] = *(const u32x2*)(Rb + row_ * D + cofs + 16 * cbi); kq[cbi] = *(const u32x2*)(Kb + row_ * D + cofs + 16 * cbi); vq[cbi] = *(const u32x2*)(Vb + row_ * D + cofs + 16 * cbi); } } while (0)
        const int sq = pass ? seq : seq - 2; const bool pre = (pass == 0);
        const int base = sq < 2 ? sq * 16384 : 32768 + (sq - 2) * 8192, len = sq < 2 ? 16384 : 8192;
        const int nch = len >> 6;
        const int c0 = pre ? nch - SCAN_NH : 0;
        const int cfull = (split && !pre && sq < 2) ? nch - SCAN_NH : nch;
        f32x4 ST[4] = {zero4, zero4, zero4, zero4};
        SCAN_PREFETCH(c0);
        __syncthreads();
#pragma unroll 1
        for (int chunk = c0; chunk < cfull; ++chunk) {
            int tid_o = tid; asm volatile("" : "+v"(tid_o));
            const int lane = tid_o & 63, c15 = lane & 15, g = lane >> 4, tF = tid_o >> 3, c8 = tid_o & 7;
            const int cofs = head * 64 + 32 * half + 4 * g;
            const int tq = 16 * tbq + c15;
            const int stq = chunk * 64 + tq; const size_t rowq = (size_t)(base + (dir ? (len - 1 - stq) : stq));
            float r8[8], lw8[8], asg[8], kkr[8], kd8[8], pfx[8]; u32x2 vkeep[2];
            {
                f32x4 accw[2] = {zero4, zero4}, acca[2] = {zero4, zero4};
#pragma unroll
                for (int cbi = 0; cbi < 2; ++cbi)
#pragma unroll
                    for (int ks = 0; ks < 3; ++ks) { accw[cbi] = __builtin_amdgcn_mfma_f32_16x16x32_bf16(*(const LAS bf16x8*)(W2F + (((half * 2 + cbi) * 3 + ks) * 64 + lane) * 16), hwf[ks], accw[cbi], 0, 0, 0); acca[cbi] = __builtin_amdgcn_mfma_f32_16x16x32_bf16(*(const LAS bf16x8*)(A2F + (((half * 2 + cbi) * 3 + ks) * 64 + lane) * 16), haf[ks], acca[cbi], 0, 0, 0); }
                float k8[8]; float ss = 0.f, bon = 0.f;
#pragma unroll
                for (int cbi = 0; cbi < 2; ++cbi) { const int cl = 32 * half + 16 * cbi + 4 * g;
                    const f32x4 w0v = *(const LAS f32x4*)(PAR + cl), a0v = *(const LAS f32x4*)(PAR + 64 + cl), kkv = *(const LAS f32x4*)(PAR + 128 + cl), kav = *(const LAS f32x4*)(PAR + 192 + cl), rkv = *(const LAS f32x4*)(PAR + 256 + cl);
                    const unsigned rw2[2] = {rq[cbi].x, rq[cbi].y}, kw2[2] = {kq[cbi].x, kq[cbi].y}; vkeep[cbi] = vq[cbi];
#pragma unroll
                    for (int r = 0; r < 4; ++r) { const int e = 4 * cbi + r;
                        r8[e] = (r & 1) ? bfhi(rw2[r >> 1]) : bflo(rw2[r >> 1]); k8[e] = (r & 1) ? bfhi(kw2[r >> 1]) : bflo(kw2[r >> 1]);
                        const float wr = w0v[r] + accw[cbi][r], ar = a0v[r] + acca[cbi][r];
                        lw8[e] = -0.60653065971263342f * __builtin_amdgcn_rcpf(1.0f + __expf(-wr));
                        asg[e] = __builtin_amdgcn_rcpf(1.0f + __expf(-ar)); kkr[e] = k8[e] * kkv[r]; ss += kkr[e] * kkr[e];
                        kd8[e] = k8[e] * (1.0f + (asg[e] - 1.0f) * kav[r]); bon += r8[e] * kd8[e] * rkv[r]; } }
                ss += __shfl_xor(ss, 16); ss += __shfl_xor(ss, 32); bon += __shfl_xor(bon, 16); bon += __shfl_xor(bon, 32);
                if (g == 0) { NRM[half * 64 + tq] = ss; BON[half * 64 + tq] = bon; }
#pragma unroll
                for (int e = 0; e < 8; ++e) { float x = lw8[e]; x += dpp_row_shr<0x111>(x); x += dpp_row_shr<0x112>(x); x += dpp_row_shr<0x114>(x); x += dpp_row_shr<0x118>(x); pfx[e] = x; }
                if (c15 == 15) { *(LAS f32x4*)(SEG + tbq * 64 + 32 * half + 4 * g) = (f32x4){pfx[0], pfx[1], pfx[2], pfx[3]}; *(LAS f32x4*)(SEG + tbq * 64 + 32 * half + 16 + 4 * g) = (f32x4){pfx[4], pfx[5], pfx[6], pfx[7]}; }
            }
            if (chunk > c0 && !pre) { const int st = (chunk - 1) * 64 + tF; const int p = dir ? (len - 1 - st) : st;
                *(u32x4*)(yd + (size_t)(base + p) * D + head * 64 + 8 * c8) = *(const LAS u32x4*)(YS + tF * RS + 8 * c8); }
            __syncthreads();
            {
                f32x4 of0 = zero4, of1 = zero4;
                for (int s = 0; s < tbq; ++s) { of0 += *(const LAS f32x4*)(SEG + s * 64 + 32 * half + 4 * g); of1 += *(const LAS f32x4*)(SEG + s * 64 + 32 * half + 16 + 4 * g); }
                const float inv = __builtin_amdgcn_rcpf(fmaxf(sqrtf(NRM[tq] + NRM[64 + tq]), 1e-12f));
                if (half == 0 && g == 0) BS[((size_t)dir * TT + rowq) * 32 + head] = BON[tq] + BON[64 + tq];
#pragma unroll
                for (int cbi = 0; cbi < 2; ++cbi) { const int cl = 32 * half + 16 * cbi + 4 * g; float ah[4], bh[4], kh[4], rh[4];
#pragma unroll
                    for (int r = 0; r < 4; ++r) { const int e = 4 * cbi + r; const float lg = pfx[e] + (cbi ? of1[r] : of0[r]); const float lm = lg - lw8[e];
                        const float e1 = __expf(lg), e2 = __builtin_amdgcn_rcpf(e1), e3 = __expf(lm); const float kk = kkr[e] * inv;
                        ah[r] = -kk * e3; bh[r] = kk * asg[e] * e2; kh[r] = kd8[e] * e2; rh[r] = r8[e] * e1; }
                    const u32x2 aw = {pk2(ah[0], ah[1]), pk2(ah[2], ah[3])}, bw = {pk2(bh[0], bh[1]), pk2(bh[2], bh[3])}, kw = {pk2(kh[0], kh[1]), pk2(kh[2], kh[3])}, rw = {pk2(rh[0], rh[1]), pk2(rh[2], rh[3])};
                    *(LAS u32x2*)(AH + tq * RS + cl) = aw; *(LAS u32x2*)(BH + tq * RS + cl) = bw; *(LAS u32x2*)(KH + tq * RS + cl) = kw; *(LAS u32x2*)(RH + tq * RS + cl) = rw;
                    const unsigned bww[2] = {bw.x, bw.y}, kww[2] = {kw.x, kw.y}, vww[2] = {vkeep[cbi].x, vkeep[cbi].y};
#pragma unroll
                    for (int r = 0; r < 4; ++r) { BT[(cl + r) * RS + tq] = (bf16_t)((r & 1) ? (bww[r >> 1] >> 16) : (bww[r >> 1] & 0xffffu)); KT[(cl + r) * RS + tq] = (bf16_t)((r & 1) ? (kww[r >> 1] >> 16) : (kww[r >> 1] & 0xffffu));
                        VT[(cl + r) * RS + tq] = (bf16_t)((r & 1) ? (vww[r >> 1] >> 16) : (vww[r >> 1] & 0xffffu)); }
                    if (tq == 63) *(LAS f32x4*)(GL + cl) = (f32x4){__expf(pfx[4 * cbi] + (cbi ? of1[0] : of0[0])), __expf(pfx[4 * cbi + 1] + (cbi ? of1[1] : of0[1])), __expf(pfx[4 * cbi + 2] + (cbi ? of1[2] : of0[2])), __expf(pfx[4 * cbi + 3] + (cbi ? of1[3] : of0[3]))}; }
            }
            __syncthreads();
            {
                const int tloc = c15;
                if (kindD == 0) {
                    bf16x8 bfA[2];
#pragma unroll
                    for (int ks = 0; ks < 2; ++ks) bfA[ks] = *(const LAS bf16x8*)(AH + (16 * tbD + c15) * RS + 32 * ks + 8 * g);
                    f32x4 GT1[4] = {zero4, zero4, zero4, zero4};
#pragma unroll
                    for (int ib = 0; ib < 4; ++ib) if (ib <= tbD) {
                        f32x4 a1 = zero4;
#pragma unroll
                        for (int ks = 0; ks < 2; ++ks) a1 = __builtin_amdgcn_mfma_f32_16x16x32_bf16(*(const LAS bf16x8*)(BH + (16 * ib + c15) * RS + 32 * ks + 8 * g), bfA[ks], a1, 0, 0, 0);
                        if (ib == tbD) {
#pragma unroll
                            for (int r = 0; r < 4; ++r) if (!(4 * g + r < tloc)) a1[r] = 0.f; }
                        GT1[ib] = a1;
                    }
                    const f32x4 m1 = (tbD >= 2) ? GT1[1] : zero4, m2 = (tbD == 3) ? GT1[2] : zero4;
                    const u32x4 F01 = {pk2(GT1[0][0], GT1[0][1]), pk2(GT1[0][2], GT1[0][3]), pk2(m1[0], m1[1]), pk2(m1[2], m1[3])};
                    const u32x4 F23 = {pk2(m2[0], m2[1]), pk2(m2[2], m2[3]), 0u, 0u};
                    if (tbD == 1) *(LAS u32x4*)(MABF + (0 * 64 + lane) * 16) = F01;
                    if (tbD == 2) *(LAS u32x4*)(MABF + (1 * 64 + lane) * 16) = F01;
                    if (tbD == 3) { *(LAS u32x4*)(MABF + (2 * 64 + lane) * 16) = F01; *(LAS u32x4*)(MABF + (3 * 64 + lane) * 16) = F23; }
                    f32x4 dg = GT1[0]; dg = (tbD == 1) ? GT1[1] : dg; dg = (tbD == 2) ? GT1[2] : dg; dg = (tbD == 3) ? GT1[3] : dg;
                    *(LAS f32x4*)(MS + (tbD * 16 + c15) * 16 + 4 * g) = dg;
                    asm volatile("s_waitcnt lgkmcnt(0)" ::: "memory");
                    const int lane_o = lane;
                    if (lane < 16) { float x[16];
#pragma unroll
                        for (int t = 0; t < 16; ++t) { const LAS f32x4* mr = (const LAS f32x4*)(MS + (tbD * 16 + t) * 16); float s = (t == lane_o) ? 1.0f : 0.0f;
#pragma unroll
                            for (int i4 = 0; i4 < (t + 3) / 4; ++i4) { const f32x4 m = mr[i4];
#pragma unroll
                                for (int q = 0; q < 4; ++q) if (4 * i4 + q < t) s += m[q] * x[4 * i4 + q]; }
                            x[t] = s; }
#pragma unroll
                        for (int t = 0; t < 16; ++t) TTI[(tbD * 16 + t) * 20 + lane] = (bf16_t)(pk2(x[t], 0.f) & 0xffffu); }
                } else {
                    bf16x8 bfR[2], bfA[2];
#pragma unroll
                    for (int ks = 0; ks < 2; ++ks) { bfR[ks] = *(const LAS bf16x8*)(RH + (16 * tbD + c15) * RS + 32 * ks + 8 * g); bfA[ks] = *(const LAS bf16x8*)(AH + (16 * tbD + c15) * RS + 32 * ks + 8 * g); }
                    f32x4 GT1[4] = {zero4, zero4, zero4, zero4}, GT2[4] = {zero4, zero4, zero4, zero4}, GT3[4] = {zero4, zero4, zero4, zero4};
#pragma unroll
                    for (int ib = 0; ib < 4; ++ib) if (ib <= tbD) {
                        f32x4 a1 = zero4, a2 = zero4, a3 = zero4;
#pragma unroll
                        for (int ks = 0; ks < 2; ++ks) { const bf16x8 f1 = *(const LAS bf16x8*)(BH + (16 * ib + c15) * RS + 32 * ks + 8 * g), f2 = *(const LAS bf16x8*)(KH + (16 * ib + c15) * RS + 32 * ks + 8 * g);
                            a1 = __builtin_amdgcn_mfma_f32_16x16x32_bf16(f1, bfR[ks], a1, 0, 0, 0); a2 = __builtin_amdgcn_mfma_f32_16x16x32_bf16(f2, bfR[ks], a2, 0, 0, 0); a3 = __builtin_amdgcn_mfma_f32_16x16x32_bf16(f2, bfA[ks], a3, 0, 0, 0); }
                        if (ib == tbD) {
#pragma unroll
                            for (int r = 0; r < 4; ++r) { const int il = 4 * g + r; if (!(il <= tloc)) { a1[r] = 0.f; a2[r] = 0.f; } if (!(il < tloc)) a3[r] = 0.f; } }
                        GT1[ib] = a1; GT2[ib] = a2; GT3[ib] = a3;
                    }
                    const u32x4 F01 = {pk2(GT1[0][0], GT1[0][1]), pk2(GT1[0][2], GT1[0][3]), pk2(GT1[1][0], GT1[1][1]), pk2(GT1[1][2], GT1[1][3])};
                    const u32x4 F23 = {pk2(GT1[2][0], GT1[2][1]), pk2(GT1[2][2], GT1[2][3]), pk2(GT1[3][0], GT1[3][1]), pk2(GT1[3][2], GT1[3][3])};
                    const int nb = tbD == 0 ? 0 : (tbD == 1 ? 1 : (tbD == 2 ? 2 : 4));
                    *(LAS u32x4*)(NRBF + (nb * 64 + lane) * 16) = F01;
                    if (tbD >= 2) *(LAS u32x4*)(NRBF + ((nb + 1) * 64 + lane) * 16) = F23;
                    const u32x4 N_01 = {pk2(GT2[0][0], GT2[0][1]), pk2(GT2[0][2], GT2[0][3]), pk2(GT2[1][0], GT2[1][1]), pk2(GT2[1][2], GT2[1][3])};
                    const u32x4 N_23 = {pk2(GT2[2][0], GT2[2][1]), pk2(GT2[2][2], GT2[2][3]), pk2(GT2[3][0], GT2[3][1]), pk2(GT2[3][2], GT2[3][3])};
                    const u32x4 M_01 = {pk2(GT3[0][0], GT3[0][1]), pk2(GT3[0][2], GT3[0][3]), pk2(GT3[1][0], GT3[1][1]), pk2(GT3[1][2], GT3[1][3])};
                    const u32x4 M_23 = {pk2(GT3[2][0], GT3[2][1]), pk2(GT3[2][2], GT3[2][3]), pk2(GT3[3][0], GT3[3][1]), pk2(GT3[3][2], GT3[3][3])};
#pragma unroll
                    for (int vb = 0; vb < 4; ++vb) { const LAS bf16_t* vp = VT + (16 * vb + c15) * RS + 4 * g;
                        const u32x2 v0 = *(const LAS u32x2*)(vp), v1 = *(const LAS u32x2*)(vp + 16);
                        const bf16x8 vf01 = __builtin_bit_cast(bf16x8, (u32x4){v0.x, v0.y, v1.x, v1.y});
                        f32x4 accn = __builtin_amdgcn_mfma_f32_16x16x32_bf16(__builtin_bit_cast(bf16x8, N_01), vf01, zero4, 0, 0, 0);
                        f32x4 accm = __builtin_amdgcn_mfma_f32_16x16x32_bf16(__builtin_bit_cast(bf16x8, M_01), vf01, zero4, 0, 0, 0);
                        if (tbD >= 2) { const u32x2 v2 = *(const LAS u32x2*)(vp + 32), v3 = *(const LAS u32x2*)(vp + 48);
                            const bf16x8 vf23 = __builtin_bit_cast(bf16x8, (u32x4){v2.x, v2.y, v3.x, v3.y});
                            accn = __builtin_amdgcn_mfma_f32_16x16x32_bf16(__builtin_bit_cast(bf16x8, N_23), vf23, accn, 0, 0, 0);
                            accm = __builtin_amdgcn_mfma_f32_16x16x32_bf16(__builtin_bit_cast(bf16x8, M_23), vf23, accm, 0, 0, 0); }
                        *(LAS u32x2*)(NRKV + ((tbD * 4 + vb) * 64 + lane) * 8) = (u32x2){pk2(accn[0], accn[1]), pk2(accn[2], accn[3])};
                        *(LAS u32x2*)(MAKV + ((tbD * 4 + vb) * 64 + lane) * 8) = (u32x2){pk2(accm[0], accm[1]), pk2(accm[2], accm[3])}; }
                }
#pragma unroll
                for (int q2 = 0; q2 < 2; ++q2) { const int id = 2 * wave + q2, kb = id >> 2, vb = id & 3; f32x4 acc = zero4;
#pragma unroll
                    for (int ks = 0; ks < 2; ++ks) acc = __builtin_amdgcn_mfma_f32_16x16x32_bf16(*(const LAS bf16x8*)(KT + (16 * kb + c15) * RS + 32 * ks + 8 * g), *(const LAS bf16x8*)(VT + (16 * vb + c15) * RS + 32 * ks + 8 * g), acc, 0, 0, 0);
                    *(LAS f32x4*)(KVI + (id * 64 + lane) * 16) = acc; }
            }
            __syncthreads();
            if (chunk + 1 < cfull) SCAN_PREFETCH(chunk + 1);
            if (pre) {
                const int j = chunk - c0; const int slot = __builtin_amdgcn_readfirstlane(pair * SCAN_NH + j);
                unsigned char* dstp = slot < SCAN_SLOTS_OUT ? (unsigned char*)outp() + (size_t)slot * SCAN_SLOT : (unsigned char*)ws + WS_POOL + 576 * MiB + (size_t)(slot - SCAN_SLOTS_OUT) * SCAN_SLOT;
                const __amdgpu_buffer_rsrc_t drs = __builtin_amdgcn_make_buffer_rsrc(dstp, 0, SCAN_SLOT, 0x00020000);
#pragma unroll
                for (int q = 0; q < 9; ++q) { const int u = tid_o + 512 * q;
                    if (q < 8 || u < SCAN_DUMP_U) { const int off = 16 * u + (u >= 1152 ? 18432 : 0) + (u >= 1728 ? 27648 : 0) + (u >= 3776 ? 2048 : 0) + (u >= 4416 ? 4096 : 0);
                        __builtin_amdgcn_raw_buffer_store_b128(*(const LAS u32x4*)(lds + off), drs, 16 * u, 0, 16); } }
            } else {
            if (wave < 4) scan_stage_e(lds, ST, lane, wave);
            __syncthreads();
            }
        }
        if (pre) {
            asm volatile("s_waitcnt vmcnt(0)" ::: "memory");
            __syncthreads();
            if (tid == 0) __hip_atomic_store((GAS unsigned*)flag, (unsigned)SCAN_NH, __ATOMIC_RELAXED, __HIP_MEMORY_SCOPE_AGENT);
        }
        if (cfull < nch) {
            if (wave == 0) {
                while ((unsigned)__builtin_amdgcn_readfirstlane(__hip_atomic_load((GAS unsigned*)flag, __ATOMIC_RELAXED, __HIP_MEMORY_SCOPE_AGENT)) < (unsigned)SCAN_NH) __builtin_amdgcn_s_sleep(2);
                __builtin_amdgcn_fence(__ATOMIC_ACQUIRE, "agent"); }
            __syncthreads();
            u32x4 pf[9];
#define DUMP_OFF(u) (16 * (u) + ((u) >= 1152 ? 18432 : 0) + ((u) >= 1728 ? 27648 : 0) + ((u) >= 3776 ? 2048 : 0) + ((u) >= 4416 ? 4096 : 0))
#define DUMP_LOAD(j_) do { const int slot_ = __builtin_amdgcn_readfirstlane(pair * SCAN_NH + (j_)); \
            const u32x4* srcp_ = (const u32x4*)(slot_ < SCAN_SLOTS_OUT ? (const unsigned char*)outp() + (size_t)slot_ * SCAN_SLOT : (const unsigned char*)ws + WS_POOL + 576 * MiB + (size_t)(slot_ - SCAN_SLOTS_OUT) * SCAN_SLOT); \
            _Pragma("unroll") for (int q = 0; q < 9; ++q) { const int u = tid_p + 512 * q; if (q < 8 || u < SCAN_DUMP_U) pf[q] = srcp_[u]; } } while (0)
            int tid_p = tid; asm volatile("" : "+v"(tid_p));
            DUMP_LOAD(0);
#pragma unroll 1
            for (int chunk = cfull; chunk < nch; ++chunk) {
                int tid_o = tid; asm volatile("" : "+v"(tid_o));
                const int tF = tid_o >> 3, c8 = tid_o & 7; const int tid_p = tid_o;
#pragma unroll
                for (int q = 0; q < 9; ++q) { const int u = tid_o + 512 * q; if (q < 8 || u < SCAN_DUMP_U) *(LAS u32x4*)(lds + DUMP_OFF(u)) = pf[q]; }
                { const int st = (chunk - 1) * 64 + tF; const int p = dir ? (len - 1 - st) : st;
                  *(u32x4*)(yd + (size_t)(base + p) * D + head * 64 + 8 * c8) = *(const LAS u32x4*)(YS + tF * RS + 8 * c8); }
                __syncthreads();
                if (chunk + 1 < nch) DUMP_LOAD(chunk + 1 - cfull);
                if (wave < 4) scan_stage_e(lds, ST, tid_o & 63, wave);
                __syncthreads();
            }
#undef DUMP_LOAD
#undef DUMP_OFF
        }
        if (!pre) { const int tF = tid >> 3, c8 = tid & 7; const int st = (nch - 1) * 64 + tF; const int p = dir ? (len - 1 - st) : st;
          *(u32x4*)(yd + (size_t)(base + p) * D + head * 64 + 8 * c8) = *(const LAS u32x4*)(YS + tF * RS + 8 * c8); }
        }
#undef SCAN_PREFETCH
    }
}

static __device__ PHASE_ATTR void ph_fin(int jm) {
    FRAME();
    bf16_t* YF = (bf16_t*)(ws + P_YF); const bf16_t* YB = (const bf16_t*)(ws + P_YB); const bf16_t* Vb = (const bf16_t*)(ws + (jm == 0 ? WS_VF : P_V)); const float* BS = (const float*)(ws + P_BS);
    const float* gnw = inp(23) + (size_t)jm * D; const float* gnb = inp(24) + (size_t)jm * D;
    u32x4 aq[4], bq[4], vq4[4]; float b0q[4], b1q[4];
#define FIN_LOAD(row_) do { const size_t r_ = (size_t)(row_); \
        _Pragma("unroll") for (int i = 0; i < 4; ++i) { const int e = 8 * (lane + 64 * i); aq[i] = *(const u32x4*)(YF + r_ * D + e); bq[i] = *(const u32x4*)(YB + r_ * D + e); vq4[i] = *(const u32x4*)(Vb + r_ * D + e); \
            b0q[i] = BS[r_ * 32 + (e >> 6)]; b1q[i] = BS[((size_t)TT + r_) * 32 + (e >> 6)]; } } while (0)
    int row = gw;
    if (row < TT) FIN_LOAD(row);
    for (; row < TT; row += NGW) {
        u32x4 ac[4], bc[4], vc[4]; float b0c[4], b1c[4];
#pragma unroll
        for (int i = 0; i < 4; ++i) { ac[i] = aq[i]; bc[i] = bq[i]; vc[i] = vq4[i]; b0c[i] = b0q[i]; b1c[i] = b1q[i]; }
        if (row + NGW < TT) FIN_LOAD(row + NGW);
#pragma unroll
        for (int i = 0; i < 4; ++i) { const int e = 8 * (lane + 64 * i);
            const unsigned aw[4] = {ac[i].x, ac[i].y, ac[i].z, ac[i].w}, bw[4] = {bc[i].x, bc[i].y, bc[i].z, bc[i].w}, vw[4] = {vc[i].x, vc[i].y, vc[i].z, vc[i].w};
            float y[8], v8[8]; float s = 0.f;
#pragma unroll
            for (int j = 0; j < 4; ++j) { y[2 * j] = bflo(aw[j]) + bflo(bw[j]); y[2 * j + 1] = bfhi(aw[j]) + bfhi(bw[j]); v8[2 * j] = bflo(vw[j]); v8[2 * j + 1] = bfhi(vw[j]); s += y[2 * j] + y[2 * j + 1]; }
            s += __shfl_xor(s, 1); s += __shfl_xor(s, 2); s += __shfl_xor(s, 4);
            const float mean = s * (1.0f / 64.0f); float q = 0.f;
#pragma unroll
            for (int j = 0; j < 8; ++j) { y[j] -= mean; q += y[j] * y[j]; }
            q += __shfl_xor(q, 1); q += __shfl_xor(q, 2); q += __shfl_xor(q, 4);
            const float rstd = rsqrtf(q * (1.0f / 64.0f) + GN_EPS);
            const float bonus = 0.5f * (b0c[i] + b1c[i]);
            const f32x4 w0 = *(const f32x4*)(gnw + e), w1 = *(const f32x4*)(gnw + e + 4), c0 = *(const f32x4*)(gnb + e), c1 = *(const f32x4*)(gnb + e + 4);
            float o[8];
#pragma unroll
            for (int j = 0; j < 8; ++j) o[j] = y[j] * rstd * (j < 4 ? w0[j] : w1[j - 4]) + (j < 4 ? c0[j] : c1[j - 4]) + bonus * v8[j];
            *(u32x4*)(YF + (size_t)row * D + e) = (u32x4){pk2(o[0], o[1]), pk2(o[2], o[3]), pk2(o[4], o[5]), pk2(o[6], o[7])}; }
    }
#undef FIN_LOAD
}

typedef short v4i16_t __attribute__((ext_vector_type(4)));
struct AttItem { int base, h, c, b0, Lc; };
__device__ __forceinline__ AttItem att_decode(int pair, int dsh) {
    const int it = pair * 2; int seq, h, cb, S_len;
    if (it < 8192) { seq = it >> 12; h = (it >> 8) & 15; cb = it & 255; S_len = 16384; }
    else { const int i2 = it - 8192; seq = 2 + (i2 >> 11); h = (i2 >> 7) & 15; cb = i2 & 127; S_len = 8192; }
    AttItem a; a.base = seq < 2 ? seq * 16384 : 32768 + (seq - 2) * 8192; a.h = h; a.Lc = S_len >> dsh; const int nb = a.Lc >> 6; a.c = cb / nb; a.b0 = cb % nb; return a;
}
static __device__ PHASE_ATTR void ph_att(int gi) {
    FRAME();
    const int dil = 1 << (2 * gi), dsh = 2 * gi;
    const bf16_t* QKV = (const bf16_t*)(ws + P_QKV);
    bf16_t* const Og = (bf16_t*)(ws + P_O0 + (size_t)gi * 192 * MiB); float* const LSEg = (float*)(ws + P_LSE) + (size_t)gi * TT * 16;
    bf16_t* const O0 = (bf16_t*)(ws + P_O0); const bf16_t* const O1 = (const bf16_t*)(ws + P_O0 + 192 * MiB); const float* const LS = (const float*)(ws + P_LSE);
    constexpr int KRS = 136, VRS = 144;
    LAS bf16_t* Ks = (LAS bf16_t*)lds; LAS bf16_t* Vs = (LAS bf16_t*)(lds + 256 * KRS * 2);
    const int qi = wave >> 2, wi = wave & 3, c15 = lane & 15, gq = lane >> 4;
    u32x4 kv[16]; bf16x8 qf[4];
#define ATT_PREFETCH(A) do { _Pragma("unroll") for (int i = 0; i < 16; ++i) { const int key = (tid >> 4) + 32 * (i & 7), part = tid & 15; \
            int ip = 64 * ((A).b0 - 1) + key; ip = ip < 0 ? 0 : (ip > (A).Lc - 1 ? (A).Lc - 1 : ip); \
            kv[i] = *(const u32x4*)(QKV + (size_t)((A).base + ip * dil + (A).c) * (3 * D) + ((i >> 3) ? 2 * D : D) + (A).h * 128 + 8 * part); } \
        { const size_t rq = (size_t)((A).base + (64 * ((A).b0 + qi) + 16 * wi + c15) * dil + (A).c); \
          _Pragma("unroll") for (int ks = 0; ks < 4; ++ks) qf[ks] = *(const bf16x8*)(QKV + rq * (3 * D) + (A).h * 128 + 32 * ks + 8 * gq); } } while (0)
    const int ppw = (6144 + G - 1) / G;
    int pair = bid_ * ppw; const int pair_end = (pair + ppw < 6144) ? pair + ppw : 6144;
    if (pair < pair_end) { const AttItem A0 = att_decode(pair, dsh); ATT_PREFETCH(A0); }
    for (; pair < pair_end; ++pair) {
        const AttItem A = att_decode(pair, dsh);
        const int base = A.base, h = A.h, c = A.c, Lc = A.Lc;
#pragma unroll
        for (int i = 0; i < 16; ++i) { const int key = (tid >> 4) + 32 * (i & 7), part = tid & 15;
            if (i >> 3) *(LAS u32x4*)(Vs + key * VRS + 8 * part) = kv[i]; else *(LAS u32x4*)(Ks + key * KRS + 8 * part) = kv[i]; }
        bf16x8 q[4];
#pragma unroll
        for (int ks = 0; ks < 4; ++ks) q[ks] = qf[ks];
        const int b = A.b0 + qi;
        const int iq = 64 * b + 16 * wi + c15; const size_t rowq = (size_t)(base + iq * dil + c);
        __syncthreads();
        if (pair + 1 < pair_end) { const AttItem An = att_decode(pair + 1, dsh); ATT_PREFETCH(An); }
        const int k0w = 16 * wi;
        f32x4 sc[9];
#pragma unroll
        for (int nt = 0; nt < 9; ++nt) { const LAS bf16_t* kp = Ks + (64 * qi + k0w + 16 * nt + c15) * KRS + 8 * gq;
            f32x4 a = {0.f, 0.f, 0.f, 0.f};
#pragma unroll
            for (int ks = 0; ks < 4; ++ks) a = __builtin_amdgcn_mfma_f32_16x16x32_bf16(*(const LAS bf16x8*)(kp + 32 * ks), q[ks], a, 0, 0, 0);
            sc[nt] = a * 0.08838834764831845f; }
#pragma unroll
        for (int r = 0; r < 4; ++r) { const int d0 = 4 * gq + r - c15;
            if (d0 < 0) sc[0][r] = -INFINITY;
            if (d0 > 0) sc[8][r] = -INFINITY; }
        if (b == 0 || b == (Lc >> 6) - 1) {
#pragma unroll
            for (int nt = 0; nt < 9; ++nt)
#pragma unroll
                for (int r = 0; r < 4; ++r) { const int ip = 64 * (b - 1) + k0w + 16 * nt + 4 * gq + r; if (ip < 0 || ip >= Lc) sc[nt][r] = -INFINITY; } }
        float mx = -INFINITY;
#pragma unroll
        for (int nt = 0; nt < 9; ++nt) mx = fmaxf(mx, fmaxf(fmaxf(sc[nt][0], sc[nt][1]), fmaxf(sc[nt][2], sc[nt][3])));
        mx = fmaxf(mx, __shfl_xor(mx, 16)); mx = fmaxf(mx, __shfl_xor(mx, 32));
        float sum = 0.f;
#pragma unroll
        for (int nt = 0; nt < 9; ++nt)
#pragma unroll
            for (int r = 0; r < 4; ++r) { const float p = fast_exp(sc[nt][r] - mx); sc[nt][r] = p; sum += p; }
        sum += __shfl_xor(sum, 16); sum += __shfl_xor(sum, 32);
        const float rs = __builtin_amdgcn_rcpf(sum); const float lse = mx + __logf(sum);
        float w0 = 0.f, w1 = 0.f, w2 = 1.f;
        if (gi == 2) { const float l0 = LS[rowq * 16 + h], l1 = LS[((size_t)TT + rowq) * 16 + h]; const float m = fmaxf(lse, fmaxf(l0, l1));
            w0 = fast_exp(l0 - m); w1 = fast_exp(l1 - m); w2 = fast_exp(lse - m); const float r3 = __builtin_amdgcn_rcpf(w0 + w1 + w2); w0 *= r3; w1 *= r3; w2 *= r3; }
        else if (gq == 0) LSEg[rowq * 16 + h] = lse;
        bf16x8 pf[5];
#pragma unroll
        for (int ks = 0; ks < 4; ++ks) { const f32x4 p0 = sc[2 * ks] * rs, p1 = sc[2 * ks + 1] * rs;
            const u32x4 w = {pk2(p0[0], p0[1]), pk2(p0[2], p0[3]), pk2(p1[0], p1[1]), pk2(p1[2], p1[3])}; pf[ks] = __builtin_bit_cast(bf16x8, w); }
        { const f32x4 p0 = sc[8] * rs; const u32x4 w = {pk2(p0[0], p0[1]), pk2(p0[2], p0[3]), 0u, 0u}; pf[4] = __builtin_bit_cast(bf16x8, w); }
        const LAS bf16_t* vbase = Vs + (64 * qi + k0w + 4 * gq + (c15 >> 2)) * VRS + 4 * (c15 & 3);
#pragma unroll
        for (int dt = 0; dt < 8; ++dt) {
            f32x4 o = {0.f, 0.f, 0.f, 0.f};
#pragma unroll
            for (int ks = 0; ks < 5; ++ks) {
                const v4i16_t lo = __builtin_amdgcn_ds_read_tr16_b64_v4i16((LAS v4i16_t*)(vbase + (32 * ks) * VRS + 16 * dt));
                v4i16_t hi = {0, 0, 0, 0};
                if (ks < 4) hi = __builtin_amdgcn_ds_read_tr16_b64_v4i16((LAS v4i16_t*)(vbase + (32 * ks + 16) * VRS + 16 * dt));
                const bf16x8 vf = {lo[0], lo[1], lo[2], lo[3], hi[0], hi[1], hi[2], hi[3]};
                o = __builtin_amdgcn_mfma_f32_16x16x32_bf16(vf, pf[ks], o, 0, 0, 0);
            }
            const size_t oo = rowq * D + h * 128 + 16 * dt + 4 * gq;
            if (gi == 2) { const u32x2 a0 = *(const u32x2*)(O0 + oo), a1 = *(const u32x2*)(O1 + oo);
                o = (f32x4){w0 * bflo(a0.x) + w1 * bflo(a1.x) + w2 * o[0], w0 * bfhi(a0.x) + w1 * bfhi(a1.x) + w2 * o[1], w0 * bflo(a0.y) + w1 * bflo(a1.y) + w2 * o[2], w0 * bfhi(a0.y) + w1 * bfhi(a1.y) + w2 * o[3]};
                *(u32x2*)(O0 + oo) = (u32x2){pk2(o[0], o[1]), pk2(o[2], o[3])}; }
            else *(u32x2*)(Og + oo) = (u32x2){pk2(o[0], o[1]), pk2(o[2], o[3])};
        }
        __syncthreads();
    }
#undef ATT_PREFETCH
}

static __device__ PHASE_ATTR void ph_norm(int L, int sub, size_t h_off) {
    FRAME();
    float* Y = outp(); bf16_t* XB = (bf16_t*)(ws + P_XN);
    float* RSX = (float*)(ws + WS_RSX); const bf16_t* hsrc = (const bf16_t*)(ws + h_off);
    const float alpha = (sub == 1) ? 1.0f : 0.5f;
    const float* gpost = inp(3) + (size_t)(L * 3 + sub) * D;
    const bool last = (L == DEPTH - 1 && sub == 2), first = (L == 0 && sub == 0); const float* in0 = inp(0); const float* in1 = inp(1);
    u32x4 hq[4], xq[4]; f32x4 xf[4][2];
#define NORM_LOAD(row_) do { const size_t r_ = (size_t)(row_); \
        _Pragma("unroll") for (int i = 0; i < 4; ++i) { const int e = 8 * (lane + 64 * i); hq[i] = *(const u32x4*)(hsrc + r_ * D + e); \
            if (first) { const float* xs_ = r_ < 32768 ? in0 + r_ * D : in1 + (r_ - 32768) * D; xf[i][0] = *(const f32x4*)(xs_ + e); xf[i][1] = *(const f32x4*)(xs_ + e + 4); } \
            else xq[i] = *(const u32x4*)(XB + r_ * D + e); } } while (0)
    int row = gw;
    if (row < TT) NORM_LOAD(row);
    for (; row < TT; row += NGW) {
        float xv[4][8]; float ssh = 0.f;
        float hv[4][8];
#pragma unroll
        for (int i = 0; i < 4; ++i) {
            if (first) {
#pragma unroll
                for (int j = 0; j < 4; ++j) { xv[i][j] = xf[i][0][j]; xv[i][4 + j] = xf[i][1][j]; } }
            else { const unsigned xww[4] = {xq[i].x, xq[i].y, xq[i].z, xq[i].w};
#pragma unroll
                for (int j = 0; j < 4; ++j) { xv[i][2 * j] = bflo(xww[j]); xv[i][2 * j + 1] = bfhi(xww[j]); } }
            const unsigned hww[4] = {hq[i].x, hq[i].y, hq[i].z, hq[i].w};
#pragma unroll
            for (int j = 0; j < 4; ++j) { hv[i][2 * j] = bflo(hww[j]); hv[i][2 * j + 1] = bfhi(hww[j]); ssh += hv[i][2 * j] * hv[i][2 * j] + hv[i][2 * j + 1] * hv[i][2 * j + 1]; } }
        if (row + NGW < TT) NORM_LOAD(row + NGW);
        const float rh = rsqrtf(wave_sum(ssh) * (1.0f / D) + NORM_EPS) * alpha;
        float ssx = 0.f;
        float* ydst = Y + (size_t)row * D;
#pragma unroll
        for (int i = 0; i < 4; ++i) { const int e = 8 * (lane + 64 * i); const f32x4 ga = *(const f32x4*)(gpost + e), gb = *(const f32x4*)(gpost + e + 4);
#pragma unroll
            for (int j = 0; j < 8; ++j) { xv[i][j] += hv[i][j] * rh * (j < 4 ? ga[j] : gb[j - 4]); ssx += xv[i][j] * xv[i][j]; }
            if (last) { *(f32x4*)(ydst + e) = (f32x4){xv[i][0], xv[i][1], xv[i][2], xv[i][3]}; *(f32x4*)(ydst + e + 4) = (f32x4){xv[i][4], xv[i][5], xv[i][6], xv[i][7]}; }
            else *(u32x4*)(XB + (size_t)row * D + e) = (u32x4){pk2(xv[i][0], xv[i][1]), pk2(xv[i][2], xv[i][3]), pk2(xv[i][4], xv[i][5]), pk2(xv[i][6], xv[i][7])}; }
        if (!last) { const float rx = rsqrtf(wave_sum(ssx) * (1.0f / D) + NORM_EPS); if (lane == 0) RSX[row] = rx; }
    }
#undef NORM_LOAD
}
static __device__ __noinline__ void grid_bar() {
    LAS unsigned char* lds = (LAS unsigned char*)lds_raw;
    XcdBarrier b; b.bar = (unsigned*)(wsp() + WS_CTL) + CW_BAR; b.st = (volatile LAS unsigned*)(lds + MISC_OFF) + 8; b.x = b.st[2];
    xcd_barrier(b);
}
#define STEP(call) do { if (step >= lo && step < hi) { call; if (step + 1 < hi) grid_bar(); } ++step; } while (0)
template <int L> __device__ __forceinline__ void layer_prog(int& step, const int lo, const int hi) {
    constexpr int jm = L >> 1; constexpr bool is_attn = (L & 1) != 0;
    STEP(ph_ffn_up(0));
    STEP(ph_gemm_plain(P_H, FF, W_DN0, D, FF, P_HOUT, D));
    STEP(ph_norm(L, 0, P_HOUT));
    if constexpr (!is_attn) {
        STEP(ph_mix(jm, 0));
        STEP(ph_g1(jm, 0));
        STEP(ph_mix(jm, 1));
        STEP(ph_g1(jm, 1));
        if constexpr (jm > 0) { STEP(ph_gv(jm)); } else { ++step; }
        STEP(ph_scan(jm));
        STEP(ph_fin(jm));
        STEP(ph_gg());
        STEP(ph_gemm_plain(P_YF, D, W_GO, D, D, P_R, D));
        STEP(ph_norm(L, 1, P_R));
    } else {
        STEP(ph_qkv(0));
        STEP(ph_att(0));
        STEP(ph_qkv(1));
        STEP(ph_att(1));
        STEP(ph_qkv(2));
        STEP(ph_att(2));
        STEP(ph_gemm_plain(P_O0, D, W_GO, D, D, P_QKV, D));
        STEP(ph_norm(L, 1, P_QKV));
    }
    STEP(ph_ffn_up(1));
    STEP(ph_gemm_plain(P_H, FF, W_DN1, D, FF, P_HOUT, D));
    STEP({ ph_norm(L, 2, P_HOUT); if (L + 1 < DEPTH) ph_conv(L + 1); });
}
__global__ void __launch_bounds__(NWAVES * 64, 2) enc_fwd(Args args) {
    LAS unsigned char* lds = (LAS unsigned char*)lds_raw;
    volatile LAS unsigned* MISC = (volatile LAS unsigned*)(lds + MISC_OFF);
    const int tid = threadIdx.x;
    if (tid < 128) ((LAS unsigned*)(lds + CTRL_OFF))[tid] = 0u;
    if (tid < 30) { const unsigned long long v = tid < 28 ? (unsigned long long)args.in[tid] : (tid == 28 ? (unsigned long long)args.out : (unsigned long long)args.ws);
        LAS unsigned* p = (LAS unsigned*)(lds + PTR_OFF) + 2 * tid; p[0] = (unsigned)v; p[1] = (unsigned)(v >> 32); }
    __syncthreads();
    const int lo = args.step_lo, hi = args.step_hi;
    if (hi - lo > 1) { const XcdBarrier b = xcd_barrier_post((unsigned*)(args.ws + WS_CTL) + CW_BAR, MISC + 8); if (tid == 0) MISC[10] = b.x; }
    __syncthreads();
    int step = 0;
    STEP({ ph_init(); ph_conv(0); });
    layer_prog<0>(step, lo, hi);
    layer_prog<1>(step, lo, hi);
    layer_prog<2>(step, lo, hi);
    layer_prog<3>(step, lo, hi);
}
#undef STEP

static int n_steps_total() {
    int s = 1;
    for (int L = 0; L < DEPTH; ++L) { s += 3; s += (L & 1) ? 8 : 10; s += 3; }
    return s;
}

extern "C" void kernel_launch(void* const* d_in, const int* in_sizes, int n_in, void* d_out, int out_size, void* d_ws, size_t ws_size, hipStream_t stream) {
    static int grid = 0;
    if (grid == 0) {
        if (n_in != 28 || out_size != TT * D || ws_size < WS_END) { fprintf(stderr, "kernel_launch: unexpected shapes (n_in %d, out %d, ws %zu, need %zu)\n", n_in, out_size, ws_size, (size_t)WS_END); grid = -1; return; }
        int dev = 0, cus = 0, per_cu = 0;
        if (hipGetDevice(&dev) != hipSuccess || hipDeviceGetAttribute(&cus, hipDeviceAttributeMultiprocessorCount, dev) != hipSuccess) { grid = -1; return; }
        if (hipFuncSetAttribute((const void*)enc_fwd, hipFuncAttributeMaxDynamicSharedMemorySize, LDS_BYTES) != hipSuccess) { grid = -1; return; }
        if (hipOccupancyMaxActiveBlocksPerMultiprocessor(&per_cu, (const void*)enc_fwd, NWAVES * 64, LDS_BYTES) != hipSuccess || per_cu < 1) { fprintf(stderr, "kernel_launch: occupancy query says %d\n", per_cu); }
        (void)hipGetLastError();
        grid = cus;
    }
    if (grid < 0) return;
    (void)hipMemsetAsync((char*)d_ws + WS_CTL, 0, CTL_ZERO_BYTES, stream);
    Args a{};
    for (int i = 0; i < 28; ++i) a.in[i] = (const float*)d_in[i];
    a.out = (float*)d_out; a.ws = (unsigned char*)d_ws;
    const int NS = n_steps_total();
#if MK_ONE_LAUNCH
    a.step_lo = 0; a.step_hi = NS;
    hipLaunchKernelGGL(enc_fwd, dim3(grid), dim3(NWAVES * 64), LDS_BYTES, stream, a);
#else
    for (int s = 0; s < NS; ++s) {
        a.step_lo = s; a.step_hi = s + 1;
        hipLaunchKernelGGL(enc_fwd, dim3(grid), dim3(NWAVES * 64), LDS_BYTES, stream, a);
    }
#endif
}
```

```cpp
#include <hip/hip_runtime.h>
#include <cstdio>
#include <cstdint>

#ifndef MK_ONE_LAUNCH
#define MK_ONE_LAUNCH 1
#endif

#ifndef PHASE_ATTR
#define PHASE_ATTR __forceinline__
#endif
#define LAS __attribute__((address_space(3)))
#define GAS __attribute__((address_space(1)))
typedef unsigned short bf16_t;
typedef short bf16x8 __attribute__((ext_vector_type(8)));
typedef float f32x4 __attribute__((ext_vector_type(4)));
typedef float f32x2 __attribute__((ext_vector_type(2)));
typedef unsigned u32x4 __attribute__((ext_vector_type(4)));
typedef unsigned u32x2 __attribute__((ext_vector_type(2)));
typedef __bf16 bf16x2_t __attribute__((ext_vector_type(2)));

constexpr int D = 2048, FF = 5632, TT = 49152, DEPTH = 4;
constexpr int HID = 1024;
constexpr int NG1 = 3 * D + 256, NG2 = 768;
constexpr float NORM_EPS = 1e-6f, GN_EPS = 64e-5f;

__device__ __forceinline__ float bflo(unsigned w) { return __uint_as_float(w << 16); }
__device__ __forceinline__ float bfhi(unsigned w) { return __uint_as_float(w & 0xffff0000u); }
__device__ __forceinline__ unsigned pk2(float lo, float hi) { f32x2 v = {lo, hi}; bf16x2_t b = __builtin_convertvector(v, bf16x2_t); return __builtin_bit_cast(unsigned, b); }
__device__ __forceinline__ float wave_sum(float v) {
#pragma unroll
    for (int o = 1; o < 64; o <<= 1) v += __shfl_xor(v, o);
    return v;
}
__device__ __forceinline__ float fast_exp(float x) { return __builtin_amdgcn_exp2f(x * 1.4426950408889634f); }
__device__ __forceinline__ float sigmoidf_(float x) { return __builtin_amdgcn_rcpf(1.0f + fast_exp(-x)); }
__device__ __forceinline__ float siluf_(float x) { return x * sigmoidf_(x); }
__device__ __forceinline__ float tanhf_(float x) { return 1.0f - 2.0f * __builtin_amdgcn_rcpf(1.0f + fast_exp(2.0f * x)); }
__device__ __forceinline__ void row_decode(int row, int& base, int& pos, int& len) {
    if (row < 32768) { base = row & ~16383; pos = row & 16383; len = 16384; }
    else { const int r2 = row - 32768; base = 32768 + (r2 & ~8191); pos = r2 & 8191; len = 8192; }
}

namespace pg8 {
#define PG8_LAS __attribute__((address_space(3)))
constexpr int BM = 256, BK = 64, HALF = 128, HTB = HALF * BK * 2, STAGE_BYTES = 8 * HTB, NXCD = 8, WGM = 8;
__host__ __device__ __forceinline__ int lds_byte(int r, int c) { const int st = (r >> 4) * 2 + (c >> 5), rr = r & 15, cc = c & 31, ob = rr * 64 + cc * 2; return st * 1024 + (ob ^ (((ob >> 9) & 1) << 5)); }
__host__ __device__ __forceinline__ void stage_rc(int b, int& R, int& C) { const int st = b / 1024, sb = b % 1024, swz = sb ^ (((sb >> 9) & 1) << 5); R = (st >> 1) * 16 + swz / 64; C = (st & 1) * 32 + (swz % 64) / 2; }
__host__ __device__ __forceinline__ int perm32(int rho) { const int n = rho >> 4, i = rho & 15; return 8 * (i >> 2) + 4 * n + (i & 3); }
struct Unit { int pm, pn; };
struct Gemm { const bf16_t* A; const bf16_t* Bt; int M, N, K, lda; size_t a_gstride = 0; int g0 = 1 << 30, g1 = 1 << 30; };
struct StaticOrder {
    int nM, nN, nwg, G, c;
    __host__ __device__ void init(int M, int N, int G_, int c_) { nM = M / BM; nN = N / BM; nwg = nM * nN; G = G_; c = c_; }
    __host__ __device__ bool next(int i, Unit& u) const {
        const long L = (long)i * G + c; if (L >= nwg) return false;
        int wgid = (int)L; { const int q = nwg / NXCD, r = nwg % NXCD, xcd = wgid % NXCD, off = wgid / NXCD; wgid = (xcd < r ? xcd * (q + 1) : r * (q + 1) + (xcd - r) * q) + off; }
        const int nig = WGM * nN, gid = wgid / nig, fm = gid * WGM, gsz = (nM - fm) < WGM ? (nM - fm) : WGM;
        u.pm = fm + ((wgid % nig) % gsz); u.pn = (wgid % nig) / gsz; return true;
    }
    __device__ __forceinline__ void a_ready(const Unit&) const {}
    __device__ __forceinline__ void done(const Unit&) const {}
};

struct EpiSwiGLU {
    static constexpr bool PERM = true, AFTER_DRAIN = false;
    bf16_t* H; const float* rs;
    __device__ __forceinline__ void operator()(const f32x4 (&acc)[2][2][4][2], const Unit& u, int wr, int wc, int fr, int fq) const {
        const int row0 = u.pm * BM + wr * 64 + fr, col = u.pn * 128 + wc * 32 + 8 * fq;
#pragma unroll
        for (int ai = 0; ai < 2; ++ai)
#pragma unroll
            for (int m = 0; m < 4; ++m) { const int row = row0 + ai * HALF + m * 16; const float r = rs[row];
                const f32x4 g0 = acc[ai][0][m][0] * r, g1 = acc[ai][0][m][1] * r, u0 = acc[ai][1][m][0] * r, u1 = acc[ai][1][m][1] * r;
                u32x4 w;
                w.x = pk2(siluf_(g0[0]) * u0[0], siluf_(g0[1]) * u0[1]); w.y = pk2(siluf_(g0[2]) * u0[2], siluf_(g0[3]) * u0[3]);
                w.z = pk2(siluf_(g1[0]) * u1[0], siluf_(g1[1]) * u1[1]); w.w = pk2(siluf_(g1[2]) * u1[2], siluf_(g1[3]) * u1[3]);
                *(u32x4*)(H + (size_t)row * FF + col) = w;
            }
    }
};
struct EpiPlain {
    static constexpr bool PERM = true, AFTER_DRAIN = false;
    bf16_t* O; int ldc;
    __device__ __forceinline__ void operator()(const f32x4 (&acc)[2][2][4][2], const Unit& u, int wr, int wc, int fr, int fq) const {
        const int row0 = u.pm * BM + wr * 64 + fr, col0 = u.pn * BM + wc * 32 + 8 * fq;
#pragma unroll
        for (int ai = 0; ai < 2; ++ai)
#pragma unroll
            for (int m = 0; m < 4; ++m) { bf16_t* rowp = O + (size_t)(row0 + ai * HALF + m * 16) * ldc + col0;
#pragma unroll
                for (int bj = 0; bj < 2; ++bj) { const f32x4 v0 = acc[ai][bj][m][0], v1 = acc[ai][bj][m][1];
                    u32x4 w; w.x = pk2(v0[0], v0[1]); w.y = pk2(v0[2], v0[3]); w.z = pk2(v1[0], v1[1]); w.w = pk2(v1[2], v1[3]);
                    *(u32x4*)(rowp + bj * HALF) = w; } }
    }
};
struct EpiQKV {
    static constexpr bool PERM = true, AFTER_DRAIN = false;
    bf16_t* O; const f32x2* tab; const float* rs;
    __device__ __forceinline__ void operator()(const f32x4 (&acc)[2][2][4][2], const Unit& u, int wr, int wc, int fr, int fq) const {
        const int row0 = u.pm * BM + wr * 64 + fr, col0 = u.pn * BM + wc * 32 + 8 * fq;
        const bool rot = (u.pn < 16);
        f32x2 cs[2][4];
#pragma unroll
        for (int ai = 0; ai < 2; ++ai)
#pragma unroll
            for (int m = 0; m < 4; ++m) { cs[ai][m] = (f32x2){1.f, 0.f};
                if (rot) { const int row = row0 + ai * HALF + m * 16; const int pos = row < 32768 ? (row & 16383) : (row & 8191); cs[ai][m] = tab[pos * 16 + 4 * wc + fq]; } }
#pragma unroll
        for (int ai = 0; ai < 2; ++ai)
#pragma unroll
            for (int m = 0; m < 4; ++m) { const int row = row0 + ai * HALF + m * 16; bf16_t* rowp = O + (size_t)row * (3 * D) + col0; const f32x2 c = cs[ai][m]; const float r = rs[row];
#pragma unroll
                for (int bj = 0; bj < 2; ++bj) { const f32x4 v0 = acc[ai][bj][m][0] * r, v1 = acc[ai][bj][m][1] * r;
                    u32x4 w; w.x = pk2(v0[0] * c[0] - v0[1] * c[1], v0[0] * c[1] + v0[1] * c[0]); w.y = pk2(v0[2], v0[3]); w.z = pk2(v1[0], v1[1]); w.w = pk2(v1[2], v1[3]);
                    *(u32x4*)(rowp + bj * HALF) = w; } }
    }
};
struct EpiG1 {
    static constexpr bool PERM = true, AFTER_DRAIN = false;
    unsigned char* ws; size_t r_off, v_off, h_off; int mode;
    __device__ __forceinline__ void operator()(const f32x4 (&acc)[2][2][4][2], const Unit& u, int wr, int wc, int fr, int fq) const {
        const int row0 = u.pm * BM + wr * 64 + fr; const int t = u.pn >> 3;
        size_t off = r_off + (size_t)t * (192u << 20); int ldc = D, colt = (u.pn & 7) * BM, act = 0;
        if (t == 2) off = v_off;
        if (t >= 3) { off = h_off; ldc = HID; colt = 768; }
        if (mode == 1) { off = h_off; ldc = HID; colt = u.pn * BM; act = (u.pn == 0) ? 1 : ((u.pn == 2) ? 2 : 0); }
        bf16_t* base = (bf16_t*)(ws + off);
        const int col0 = colt + wc * 32 + 8 * fq;
#pragma unroll
        for (int ai = 0; ai < 2; ++ai)
#pragma unroll
            for (int m = 0; m < 4; ++m) { bf16_t* rowp = base + (size_t)(row0 + ai * HALF + m * 16) * ldc + col0;
#pragma unroll
                for (int bj = 0; bj < 2; ++bj) { f32x4 v0 = acc[ai][bj][m][0], v1 = acc[ai][bj][m][1];
                    if (act == 1) {
#pragma unroll
                        for (int j = 0; j < 4; ++j) { v0[j] = tanhf_(v0[j]); v1[j] = tanhf_(v1[j]); } }
                    if (act == 2) {
#pragma unroll
                        for (int j = 0; j < 4; ++j) { v0[j] = sigmoidf_(v0[j]); v1[j] = sigmoidf_(v1[j]); } }
                    u32x4 w; w.x = pk2(v0[0], v0[1]); w.y = pk2(v0[2], v0[3]); w.z = pk2(v1[0], v1[1]); w.w = pk2(v1[2], v1[3]);
                    *(u32x4*)(rowp + bj * HALF) = w; } }
    }
};
struct EpiVres {
    static constexpr bool PERM = true, AFTER_DRAIN = false;
    bf16_t* V; const bf16_t* VF; const float* v0;
    __device__ __forceinline__ void operator()(const f32x4 (&acc)[2][2][4][2], const Unit& u, int wr, int wc, int fr, int fq) const {
        const int row0 = u.pm * BM + wr * 64 + fr, col0 = u.pn * BM + wc * 32 + 8 * fq;
#pragma unroll
        for (int ai = 0; ai < 2; ++ai)
#pragma unroll
            for (int m = 0; m < 4; ++m) { const size_t ro = (size_t)(row0 + ai * HALF + m * 16) * D + col0;
#pragma unroll
                for (int bj = 0; bj < 2; ++bj) { const f32x4 a0 = acc[ai][bj][m][0], a1 = acc[ai][bj][m][1];
                    const u32x4 vv = *(const u32x4*)(V + ro + bj * HALF), vf = *(const u32x4*)(VF + ro + bj * HALF);
                    const f32x4 b0 = *(const f32x4*)(v0 + col0 + bj * HALF), b1 = *(const f32x4*)(v0 + col0 + bj * HALF + 4);
                    float o[8]; const unsigned vw[4] = {vv.x, vv.y, vv.z, vv.w}, fw[4] = {vf.x, vf.y, vf.z, vf.w};
#pragma unroll
                    for (int j = 0; j < 4; ++j) { const float g0 = sigmoidf_((j < 2 ? b0[2 * j] : b1[2 * j - 4]) + (j < 2 ? a0[2 * j] : a1[2 * j - 4]));
                        const float g1 = sigmoidf_((j < 2 ? b0[2 * j + 1] : b1[2 * j - 3]) + (j < 2 ? a0[2 * j + 1] : a1[2 * j - 3]));
                        const float x0 = bflo(vw[j]), x1 = bfhi(vw[j]), f0 = bflo(fw[j]), f1 = bfhi(fw[j]);
                        o[2 * j] = x0 + (f0 - x0) * g0; o[2 * j + 1] = x1 + (f1 - x1) * g1; }
                    u32x4 w; w.x = pk2(o[0], o[1]); w.y = pk2(o[2], o[3]); w.z = pk2(o[4], o[5]); w.w = pk2(o[6], o[7]);
                    *(u32x4*)(V + ro + bj * HALF) = w; } }
    }
};
struct EpiGmul {
    static constexpr bool PERM = true, AFTER_DRAIN = false;
    bf16_t* Y;
    __device__ __forceinline__ void operator()(const f32x4 (&acc)[2][2][4][2], const Unit& u, int wr, int wc, int fr, int fq) const {
        const int row0 = u.pm * BM + wr * 64 + fr, col0 = u.pn * BM + wc * 32 + 8 * fq;
#pragma unroll
        for (int ai = 0; ai < 2; ++ai)
#pragma unroll
            for (int m = 0; m < 4; ++m) { const size_t ro = (size_t)(row0 + ai * HALF + m * 16) * D + col0;
#pragma unroll
                for (int bj = 0; bj < 2; ++bj) { const f32x4 a0 = acc[ai][bj][m][0], a1 = acc[ai][bj][m][1];
                    const u32x4 y = *(const u32x4*)(Y + ro + bj * HALF);
                    u32x4 w; w.x = pk2(bflo(y.x) * a0[0], bfhi(y.x) * a0[1]); w.y = pk2(bflo(y.y) * a0[2], bfhi(y.y) * a0[3]);
                    w.z = pk2(bflo(y.z) * a1[0], bfhi(y.z) * a1[1]); w.w = pk2(bflo(y.w) * a1[2], bfhi(y.w) * a1[3]);
                    *(u32x4*)(Y + ro + bj * HALF) = w; } }
    }
};

template <class Epi, class Sched, bool ALIGN_EPI = false, bool SP2 = false>
__device__ __forceinline__ void gemm_phase(PG8_LAS unsigned char* lds, const Gemm g, const Sched& S, const Epi& E, const int tid) {
    const int wid = __builtin_amdgcn_readfirstlane(tid >> 6), lane = tid & 63, wr = wid >> 2, wc = wid & 3, fr = lane & 15, fq = lane >> 4;
    const int K = g.K, nt = K / BK, lda = g.lda;
    unsigned voffA[2], voffB[2];
#pragma unroll
    for (int i = 0; i < 2; ++i) { int R, C; stage_rc(tid * 16 + i * 8192, R, C); const int Rb = Epi::PERM ? ((R & ~31) + perm32(R & 31)) : R;
        voffA[i] = (unsigned)(R * lda + C) * 2u; voffB[i] = (unsigned)(Rb * K + C) * 2u; }
    const size_t kstep = (size_t)(BK * 2);
    const size_t hstepA = (size_t)HALF * lda * 2, hstepB = (size_t)HALF * K * 2;
    const size_t tstepA = 2 * hstepA, tstepB = 2 * hstepB;
    const unsigned ldsw = (unsigned)wid * 1024u;
    const int aoff = lds_byte(wr * 64 + fr, fq * 8), boff = lds_byte(wc * 32 + fr, fq * 8);
#define PG8_SA(b, h) (((b) * 2 + (h)) * HTB)
#define PG8_SB(b, h) ((4 + (b) * 2 + (h)) * HTB)
#define PG8_STAGE(bufoff, gbase, voff) do { _Pragma("unroll") for (int _i = 0; _i < 2; ++_i) \
        __builtin_amdgcn_global_load_lds((const unsigned*)((const char*)(gbase) + (voff)[_i]), (PG8_LAS unsigned*)(lds + (bufoff) + ldsw + _i * 8192), 16, 0, 0); } while (0)
#define PG8_LDA(dst, b, h) do { _Pragma("unroll") for (int m = 0; m < 4; ++m) _Pragma("unroll") for (int k = 0; k < 2; ++k) dst[m][k] = *(const PG8_LAS bf16x8*)(lds + PG8_SA(b, h) + aoff + m * 2048 + k * 1024); } while (0)
#define PG8_LDB(dst, b, h) do { _Pragma("unroll") for (int n = 0; n < 2; ++n) _Pragma("unroll") for (int k = 0; k < 2; ++k) dst[n][k] = *(const PG8_LAS bf16x8*)(lds + PG8_SB(b, h) + boff + n * 2048 + k * 1024); } while (0)
#define PG8_MMA(ai, bj, At, Bt) do { __builtin_amdgcn_s_setprio(1); _Pragma("unroll") for (int m = 0; m < 4; ++m) _Pragma("unroll") for (int n = 0; n < 2; ++n) _Pragma("unroll") for (int k = 0; k < 2; ++k) \
        acc[ai][bj][m][n] = __builtin_amdgcn_mfma_f32_16x16x32_bf16(Bt[n][k], At[m][k], acc[ai][bj][m][n], 0, 0, 0); __builtin_amdgcn_s_setprio(0); } while (0)
#define PG8_WAIT_V(n) asm volatile("s_waitcnt vmcnt(" #n ")" ::: "memory")
#define PG8_WAIT_L(n) asm volatile("s_waitcnt lgkmcnt(" #n ")" ::: "memory")
#define PG8_BAR __builtin_amdgcn_s_barrier()
#define PG8_SCHED __builtin_amdgcn_sched_barrier(0)
    Unit cur, nxt; int ui = 0;
    if (!S.next(0, cur)) return;
    f32x4 acc[2][2][4][2];
#pragma unroll
    for (int a = 0; a < 2; ++a)
#pragma unroll
        for (int b = 0; b < 2; ++b)
#pragma unroll
            for (int m = 0; m < 4; ++m)
#pragma unroll
                for (int n = 0; n < 2; ++n) acc[a][b][m][n] = (f32x4){0.f, 0.f, 0.f, 0.f};
    bf16x8 At[4][2], B0[2][2], B1[2][2];
    const char* cA = (const char*)g.A + (size_t)cur.pm * tstepA + (size_t)((cur.pn >= g.g0) + (cur.pn >= g.g1)) * g.a_gstride; const char* cB = (const char*)g.Bt + (size_t)cur.pn * tstepB;
    S.a_ready(cur);
    if constexpr (SP2) {
        PG8_STAGE(PG8_SB(0, 0), cB, voffB); PG8_STAGE(PG8_SB(0, 1), cB + hstepB, voffB); PG8_STAGE(PG8_SA(0, 0), cA, voffA); PG8_STAGE(PG8_SA(0, 1), cA + hstepA, voffA);
        if (wr == 1) PG8_BAR;
        PG8_WAIT_V(2); PG8_BAR;
        PG8_STAGE(PG8_SB(1, 0), cB + kstep, voffB); PG8_STAGE(PG8_SA(1, 0), cA + kstep, voffA); PG8_STAGE(PG8_SB(1, 1), cB + hstepB + kstep, voffB);
        PG8_WAIT_V(6); PG8_BAR;
    } else {
        PG8_STAGE(PG8_SB(0, 0), cB, voffB); PG8_STAGE(PG8_SA(0, 0), cA, voffA); PG8_STAGE(PG8_SB(0, 1), cB + hstepB, voffB); PG8_STAGE(PG8_SA(0, 1), cA + hstepA, voffA);
        if (wr == 1) PG8_BAR;
        PG8_WAIT_V(4); PG8_BAR;
        PG8_STAGE(PG8_SB(1, 0), cB + kstep, voffB); PG8_STAGE(PG8_SA(1, 0), cA + kstep, voffA); PG8_STAGE(PG8_SB(1, 1), cB + hstepB + kstep, voffB);
        PG8_WAIT_V(6); PG8_BAR;
    }
    for (;;) {
        const bool has_next = S.next(ui + 1, nxt);
        const char* nA = has_next ? (const char*)g.A + (size_t)nxt.pm * tstepA + (size_t)((nxt.pn >= g.g0) + (nxt.pn >= g.g1)) * g.a_gstride : cA; const char* nB = has_next ? (const char*)g.Bt + (size_t)nxt.pn * tstepB : cB;
        for (int t = 0; t < nt; t += 2) {
            const bool last = (t == nt - 2);
            const char* a1 = cA + (size_t)(t + 1) * kstep;
            const char* a2 = last ? nA : cA + (size_t)(t + 2) * kstep; const char* b2 = last ? nB : cB + (size_t)(t + 2) * kstep;
            const char* a3 = a2 + kstep; const char* b3 = b2 + kstep;
            if (last && has_next) S.a_ready(nxt);
            if constexpr (SP2) {
            PG8_LDB(B0, 0, 0); PG8_LDB(B1, 0, 1); PG8_SCHED; PG8_LDA(At, 0, 0); PG8_STAGE(PG8_SA(1, 1), a1 + hstepA, voffA);
            PG8_WAIT_V(8); PG8_WAIT_L(0); PG8_BAR; PG8_MMA(0, 0, At, B0); PG8_MMA(0, 1, At, B1); PG8_BAR; PG8_SCHED;
            PG8_LDA(At, 0, 1); PG8_STAGE(PG8_SB(0, 0), b2, voffB); PG8_STAGE(PG8_SB(0, 1), b2 + hstepB, voffB); PG8_STAGE(PG8_SA(0, 0), a2, voffA);
            PG8_WAIT_V(8); PG8_WAIT_L(0); PG8_BAR; PG8_MMA(1, 0, At, B0); PG8_MMA(1, 1, At, B1); PG8_BAR; PG8_SCHED;
            PG8_LDB(B0, 1, 0); PG8_LDB(B1, 1, 1); PG8_SCHED; PG8_LDA(At, 1, 0); PG8_STAGE(PG8_SA(0, 1), a2 + hstepA, voffA);
            PG8_WAIT_V(8); PG8_WAIT_L(0); PG8_BAR; PG8_MMA(0, 0, At, B0); PG8_MMA(0, 1, At, B1); PG8_BAR; PG8_SCHED;
            PG8_LDA(At, 1, 1); PG8_STAGE(PG8_SB(1, 0), b3, voffB); PG8_STAGE(PG8_SB(1, 1), b3 + hstepB, voffB); PG8_STAGE(PG8_SA(1, 0), a3, voffA);
            PG8_WAIT_V(8); PG8_WAIT_L(0); PG8_BAR; PG8_MMA(1, 0, At, B0); PG8_MMA(1, 1, At, B1); PG8_BAR; PG8_SCHED;
            } else {
            PG8_LDB(B0, 0, 0); PG8_SCHED; PG8_LDA(At, 0, 0); PG8_STAGE(PG8_SA(1, 1), a1 + hstepA, voffA);
            PG8_WAIT_L(8); PG8_BAR; PG8_WAIT_L(0); PG8_MMA(0, 0, At, B0); PG8_BAR; PG8_SCHED;
            PG8_LDB(B1, 0, 1); PG8_STAGE(PG8_SB(0, 0), b2, voffB);
            PG8_BAR; PG8_WAIT_L(0); PG8_MMA(0, 1, At, B1); PG8_BAR;
            PG8_LDA(At, 0, 1); PG8_STAGE(PG8_SA(0, 0), a2, voffA);
            PG8_BAR; PG8_WAIT_L(0); PG8_MMA(1, 0, At, B0); PG8_BAR; PG8_SCHED;
            PG8_STAGE(PG8_SB(0, 1), b2 + hstepB, voffB);
            PG8_WAIT_V(6); PG8_BAR; PG8_MMA(1, 1, At, B1); PG8_BAR;
            PG8_LDB(B0, 1, 0); PG8_SCHED; PG8_LDA(At, 1, 0); PG8_STAGE(PG8_SA(0, 1), a2 + hstepA, voffA);
            PG8_WAIT_L(8); PG8_BAR; PG8_WAIT_L(0); PG8_MMA(0, 0, At, B0); PG8_BAR; PG8_SCHED;
            PG8_LDB(B1, 1, 1); PG8_STAGE(PG8_SB(1, 0), b3, voffB);
            PG8_BAR; PG8_WAIT_L(0); PG8_MMA(0, 1, At, B1); PG8_BAR;
            PG8_LDA(At, 1, 1); PG8_STAGE(PG8_SA(1, 0), a3, voffA);
            PG8_BAR; PG8_WAIT_L(0); PG8_MMA(1, 0, At, B0); PG8_BAR; PG8_SCHED;
            PG8_STAGE(PG8_SB(1, 1), b3 + hstepB, voffB);
            PG8_WAIT_V(6); PG8_BAR; PG8_MMA(1, 1, At, B1); PG8_BAR;
            }
        }
        if constexpr (ALIGN_EPI) { if (wr == 0) PG8_BAR; }
        if constexpr (!Epi::AFTER_DRAIN) { E(acc, cur, wr, wc, fr, fq); S.done(cur); }
        if (!has_next) break;
#pragma unroll
        for (int a = 0; a < 2; ++a)
#pragma unroll
            for (int b = 0; b < 2; ++b)
#pragma unroll
                for (int m = 0; m < 4; ++m)
#pragma unroll
                    for (int n = 0; n < 2; ++n) acc[a][b][m][n] = (f32x4){0.f, 0.f, 0.f, 0.f};
        cur = nxt; cA = nA; cB = nB; ++ui;
        if constexpr (ALIGN_EPI) { if (wr == 1) PG8_BAR; }
    }
    PG8_WAIT_V(0);
    if constexpr (!ALIGN_EPI) { if (wr == 0) PG8_BAR; }
    PG8_BAR;
#undef PG8_SA
#undef PG8_SB
#undef PG8_STAGE
#undef PG8_LDA
#undef PG8_LDB
#undef PG8_MMA
#undef PG8_WAIT_V
#undef PG8_WAIT_L
#undef PG8_BAR
#undef PG8_SCHED
}
}

#define XB_TMO      128
#define XB_XCNT(j)  (256  + 64 * (j))
#define XB_XSUB(j)  (1280 + 64 * (j))
#define XB_XGEN(j)  (2304 + 64 * (j))
#define XB_TOP      3328
#define XB_TOPGEN   3392
#define XCD_BAR_WORDS 3456
#define XB_SPIN_CAP (1u << 22)
__device__ __forceinline__ unsigned xb_ld(unsigned* p)              { return __hip_atomic_load(p, __ATOMIC_RELAXED, __HIP_MEMORY_SCOPE_AGENT); }
__device__ __forceinline__ unsigned xb_add(unsigned* p, unsigned v) { return __hip_atomic_fetch_add(p, v, __ATOMIC_RELAXED, __HIP_MEMORY_SCOPE_AGENT); }
__device__ __forceinline__ unsigned xb_xcc_id() { return (unsigned)__builtin_amdgcn_s_getreg((3 << 11) | 20) & 0xFu; }
#define XB_SPIN(cond, bar) do { unsigned _sp = 0; while (cond) { __builtin_amdgcn_s_sleep(1); \
    if ((++_sp & 255u) == 0u) { if (xb_ld(&(bar)[XB_TMO])) break; if (_sp > XB_SPIN_CAP) { atomicAdd(&(bar)[XB_TMO], 1u); break; } } } } while (0)
struct XcdBarrier { unsigned* bar; unsigned x; volatile LAS unsigned* st; };
__device__ __forceinline__ XcdBarrier xcd_barrier_post(unsigned* bar, volatile LAS unsigned* st) {
    XcdBarrier b; b.bar = bar; b.x = xb_xcc_id(); b.st = st;
    if (threadIdx.x == 0) (void)xb_add(&bar[XB_XCNT(b.x)], 1u);
    return b;
}
__device__ __forceinline__ void xcd_barrier_complete(unsigned* bar, unsigned x, unsigned& nloc, unsigned& nx) {
    const unsigned G = gridDim.x * gridDim.y * gridDim.z;
    unsigned sum, cnt, mine, sp = 0u;
    for (;;) {
        sum = 0u; cnt = 0u; mine = 0u;
#pragma unroll
        for (unsigned j = 0; j < 16; ++j) { const unsigned c = xb_ld(&bar[XB_XCNT(j)]); sum += c; cnt += (c > 0u) ? 1u : 0u; mine = (j == x) ? c : mine; }
        if (sum == G) break;
        __builtin_amdgcn_s_sleep(1);
        if ((++sp & 255u) == 0u) { if (xb_ld(&bar[XB_TMO])) break; if (sp > XB_SPIN_CAP) { atomicAdd(&bar[XB_TMO], 1u); break; } }
    }
    nloc = mine > 0u ? mine : 1u; nx = cnt > 0u ? cnt : 1u;
}
__device__ __forceinline__ void xcd_barrier(const XcdBarrier& b) {
    asm volatile("s_waitcnt vmcnt(0)" ::: "memory");
    __syncthreads();
    if (threadIdx.x == 0) {
        unsigned* bar = b.bar;
        __builtin_amdgcn_s_waitcnt(0);
        unsigned nloc = b.st[0], nx = b.st[1];
        if (nloc == 0u) { xcd_barrier_complete(bar, b.x, nloc, nx); b.st[0] = nloc; b.st[1] = nx; }
        const unsigned old = xb_add(&bar[XB_XSUB(b.x)], 1u);
        const unsigned gen = old / nloc;
        if (old + 1u == (gen + 1u) * nloc) {
            __builtin_amdgcn_fence(__ATOMIC_RELEASE, "agent");
            asm volatile("s_waitcnt vmcnt(0)" ::: "memory");
            const unsigned og = xb_add(&bar[XB_TOP], 1u);
            const unsigned tg = og / nx;
            if (og + 1u == (tg + 1u) * nx) xb_add(&bar[XB_TOPGEN], 1u);
            else XB_SPIN(xb_ld(&bar[XB_TOPGEN]) == tg, bar);
            __builtin_amdgcn_fence(__ATOMIC_ACQUIRE, "agent");
            xb_add(&bar[XB_XGEN(b.x)], 1u);
            asm volatile("s_waitcnt vmcnt(0)" ::: "memory");
        } else {
            XB_SPIN(xb_ld(&bar[XB_XGEN(b.x)]) == gen, bar);
            __builtin_amdgcn_fence(__ATOMIC_ACQUIRE, "agent");
            asm volatile("s_waitcnt vmcnt(0)" ::: "memory");
        }
    }
    __syncthreads();
}

constexpr size_t MiB = 1u << 20;
constexpr size_t WS_CTL = 0, CTL_ZERO_BYTES = 1 * MiB;
constexpr size_t WS_ROPE = 1 * MiB;
constexpr size_t WS_WTS = 4 * MiB;
constexpr size_t W_UP0 = WS_WTS, W_DN0 = WS_WTS + 44 * MiB, W_UP1 = WS_WTS + 66 * MiB, W_DN1 = WS_WTS + 110 * MiB;
constexpr size_t W_MIX = WS_WTS + 132 * MiB;
constexpr size_t W_G2 = W_MIX + 25 * MiB, W_GG = W_MIX + 28 * MiB, W_GV = W_MIX + 29 * MiB;
constexpr size_t W_GO = WS_WTS + 212 * MiB;
constexpr size_t WS_VF = 228 * MiB;
constexpr size_t WS_POOL = 420 * MiB;
constexpr size_t P_XN = WS_POOL;
constexpr size_t P_H = WS_POOL + 192 * MiB, P_HOUT = WS_POOL + 720 * MiB;
constexpr size_t P_MIX = WS_POOL + 192 * MiB;
constexpr size_t P_YF = WS_POOL + 192 * MiB, P_YB = WS_POOL + 384 * MiB, P_R = WS_POOL + 768 * MiB, P_K = WS_POOL + 960 * MiB, P_V = WS_POOL + 1152 * MiB,
                 P_HID = WS_POOL + 1344 * MiB, P_BS = WS_POOL + 1440 * MiB;
constexpr size_t P_QKV = WS_POOL + 192 * MiB, P_O0 = WS_POOL + 768 * MiB, P_LSE = WS_POOL + 1344 * MiB;
constexpr size_t WS_END = WS_POOL + 1452 * MiB;
constexpr int CW_BAR = 4096;
constexpr size_t WS_SCANFLAG = 512 * 1024;
constexpr int SCAN_NH = 63;
constexpr int SCAN_DUMP_U = 4592, SCAN_SLOT = 73728, SCAN_SLOTS_OUT = 5461;
constexpr size_t WS_RSX = 65536;

constexpr int RING_BYTES = 131072, CTRL_OFF = 143360, MISC_OFF = CTRL_OFF + 256, LDS_BYTES = 163840;
constexpr int NWAVES = 8;

struct Args { const float* in[28]; float* out; unsigned char* ws; int step_lo, step_hi; };

struct Seg { unsigned long long woff, soff, doff; int widx, sidx, ldw, col0, ldt, row0, k0dst, nkb, nnb, ilv, item0, pad0; };
__device__ __forceinline__ void seg_add(LAS Seg* s, int& n, int& items, int widx, size_t woff, int sidx, size_t soff, size_t doff, int ldw, int col0, int ldt, int row0, int k0dst, int nkb, int nnb, int ilv) {
    s[n].widx = widx; s[n].woff = woff; s[n].sidx = sidx; s[n].soff = soff; s[n].doff = doff; s[n].ldw = ldw; s[n].col0 = col0; s[n].ldt = ldt; s[n].row0 = row0; s[n].k0dst = k0dst; s[n].nkb = nkb; s[n].nnb = nnb; s[n].ilv = ilv; s[n].item0 = items;
    items += nkb * nnb; ++n;
}

extern __shared__ __attribute__((aligned(16))) unsigned char lds_raw[];
constexpr int PTR_OFF = CTRL_OFF + 512;
__device__ __forceinline__ unsigned long long ptr_ld(int i) {
    const LAS unsigned* p = (const LAS unsigned*)((LAS unsigned char*)lds_raw + PTR_OFF) + 2 * i;
    const unsigned lo = __builtin_amdgcn_readfirstlane(p[0]), hi = __builtin_amdgcn_readfirstlane(p[1]);
    return ((unsigned long long)hi << 32) | lo;
}
__device__ __forceinline__ const float* inp(int i) { return (const float*)(const GAS float*)ptr_ld(i); }
__device__ __forceinline__ float* outp() { return (float*)(GAS float*)ptr_ld(28); }
__device__ __forceinline__ unsigned char* wsp() { return (unsigned char*)(GAS unsigned char*)ptr_ld(29); }
#define FRAME() LAS unsigned char* lds = (LAS unsigned char*)lds_raw; int tid = threadIdx.x; asm volatile("" : "+v"(tid)); const int lane = tid & 63, wave = __builtin_amdgcn_readfirstlane(tid >> 6); \
    int bid_ = blockIdx.x, G = gridDim.x; asm volatile("" : "+s"(bid_), "+s"(G)); const int gw = bid_ * NWAVES + wave, NGW = G * NWAVES; unsigned char* ws = wsp(); (void)lds; (void)lane; (void)gw; (void)NGW; (void)ws; (void)G

static __device__ PHASE_ATTR void ph_init() {
    FRAME();
    const float* in0 = inp(0); const float* in1 = inp(1);
    {
        f32x2* tab = (f32x2*)(ws + WS_ROPE);
        for (int idx = bid_ * 512 + tid; idx < 16384 * 16; idx += G * 512) {
            const int pos = idx >> 4, i = idx & 15;
            double iv = 1.0;
            iv = (i == 1) ? 0.44036660267178046 : iv; iv = (i == 2) ? 0.19392274474868576 : iv; iv = (i == 3) ? 0.08539710028576561 : iv; iv = (i == 4) ? 0.03760603093086393 : iv;
            iv = (i == 5) ? 0.016560440080994446 : iv; iv = (i == 6) ? 0.007292664737217109 : iv; iv = (i == 7) ? 0.003211445994752591 : iv; iv = (i == 8) ? 0.001414213562373095 : iv;
            iv = (i == 9) ? 0.000622772421914596 : iv; iv = (i == 10) ? 0.0002742481756762073 : iv; iv = (i == 11) ? 0.00012076973741146504 : iv; iv = (i == 12) ? 5.318295896944988e-05 : iv;
            iv = (i == 13) ? 2.341999896140934e-05 : iv; iv = (i == 14) ? 1.031338537721246e-05 : iv; iv = (i == 15) ? 4.5416704806078695e-06 : iv;
            double t = (double)pos * iv * 0.15915494309189535; t = t - __builtin_rint(t);
            const float tf = (float)t;
            tab[idx] = (f32x2){__builtin_amdgcn_cosf(tf), __builtin_amdgcn_sinf(tf)};
        }
    }
    bf16_t* XB = (bf16_t*)(ws + P_XN); float* RSX = (float*)(ws + WS_RSX);
    for (int row = gw; row < TT; row += NGW) {
        const float* src = row < 32768 ? in0 + (size_t)row * D : in1 + (size_t)(row - 32768) * D;
        float ss = 0.f;
#pragma unroll
        for (int i = 0; i < 4; ++i) { const int e = 8 * (lane + 64 * i); const f32x4 a = *(const f32x4*)(src + e), b = *(const f32x4*)(src + e + 4);
#pragma unroll
            for (int j = 0; j < 4; ++j) ss += a[j] * a[j] + b[j] * b[j];
            *(u32x4*)(XB + (size_t)row * D + e) = (u32x4){pk2(a[0], a[1]), pk2(a[2], a[3]), pk2(b[0], b[1]), pk2(b[2], b[3])}; }
        const float rx = rsqrtf(wave_sum(ss) * (1.0f / D) + NORM_EPS);
        if (lane == 0) RSX[row] = rx;
    }
}

__device__ __forceinline__ void conv_load(const LAS Seg* sp, int local, int lane, f32x4 (&v)[8]) {
    const int widx = sp->widx; if (widx < 0) return;
    const int ldw = sp->ldw, nnb = sp->nnb, kb = local / nnb, nb = local % nnb;
    const float* p = inp(widx) + sp->woff + (size_t)(64 * kb + (lane >> 3)) * ldw + sp->col0 + 32 * nb + 4 * (lane & 7);
#pragma unroll
    for (int i = 0; i < 8; ++i) v[i] = *(const f32x4*)(p + (size_t)(8 * i) * ldw);
}
__device__ __forceinline__ void conv_finish(const LAS Seg* sp, int local, LAS float* scr, int lane, const f32x4 (&v)[8], unsigned char* ws) {
    const int widx = sp->widx, sidx = sp->sidx, ldt = sp->ldt, row0 = sp->row0, k0dst = sp->k0dst, nnb = sp->nnb, ilv = sp->ilv;
    bf16_t* dst = (bf16_t*)(ws + sp->doff);
    const int kb = local / nnb, nb = local % nnb, k0 = 64 * kb, n0 = 32 * nb, c = lane & 7;
    if (widx >= 0) {
        const float* scale = sidx >= 0 ? inp(sidx) + sp->soff + k0 + (lane >> 3) : nullptr;
#pragma unroll
        for (int i = 0; i < 8; ++i) { const int kk = (lane >> 3) + 8 * i; const float sc = scale ? scale[8 * i] : 1.0f;
            LAS float* s = scr + kk * 33 + 4 * (lane & 7); s[0] = v[i][0] * sc; s[1] = v[i][1] * sc; s[2] = v[i][2] * sc; s[3] = v[i][3] * sc; }
        asm volatile("s_waitcnt lgkmcnt(0)" ::: "memory");
    }
#pragma unroll
    for (int j = 0; j < 4; ++j) { const int n = (lane >> 3) + 8 * j; const int nn = n0 + n;
        int drow = row0 + ((ilv == 1) ? (256 * (nn >> 7) + (nn & 127)) : nn);
        if (ilv == 2 && ((nn >> 11) % 3) < 2) {
            const int co = nn & 127;
            const int nl = co < 32 ? (8 * (co & 15) + (co >> 4)) : (8 * ((co - 32) / 6) + 2 + (co - 32) % 6);
            drow = row0 + (nn & ~127) + nl; }
        u32x4 o = {0u, 0u, 0u, 0u};
        if (widx >= 0) { const LAS float* s = scr + (8 * c) * 33 + n;
            o.x = pk2(s[0 * 33], s[1 * 33]); o.y = pk2(s[2 * 33], s[3 * 33]); o.z = pk2(s[4 * 33], s[5 * 33]); o.w = pk2(s[6 * 33], s[7 * 33]); }
        *(u32x4*)(dst + (size_t)drow * ldt + k0dst + k0 + 8 * c) = o; }
    asm volatile("s_waitcnt lgkmcnt(0)" ::: "memory");
}
static __device__ PHASE_ATTR void ph_conv(int L) {
    FRAME();
    const int jm = L >> 1; const bool is_attn = (L & 1) != 0;
    LAS Seg* segs = (LAS Seg*)lds; LAS int* nseg_p = (LAS int*)(lds + 4096); LAS float* scr = (LAS float*)(lds + 8192 + wave * 8448);
    if (tid == 0) {
        int n = 0, items = 0;
        for (int f = 0; f < 2; ++f) {
            const size_t wo = (size_t)(L * 2 + f) * D * FF;
            const size_t up = f ? W_UP1 : W_UP0, dn = f ? W_DN1 : W_DN0;
            seg_add(segs, n, items, 4, wo, 2, (size_t)(L * 3 + 2 * f) * D, up, FF, 0, D, 0, 0, D / 64, FF / 32, 1);
            seg_add(segs, n, items, 5, wo, 2, (size_t)(L * 3 + 2 * f) * D, up, FF, 0, D, 128, 0, D / 64, FF / 32, 1);
            seg_add(segs, n, items, 6, wo, -1, 0, dn, D, 0, FF, 0, 0, FF / 64, D / 32, 0);
        }
        if (!is_attn) {
            for (int p = 0; p < 3; ++p) seg_add(segs, n, items, 8, (size_t)(jm * 3 + p) * D * D, -1, 0, W_MIX, D, 0, D, p * D, 0, D / 64, D / 32, 0);
            if (jm > 0) { seg_add(segs, n, items, 16, (size_t)(jm - 1) * D * 64, -1, 0, W_MIX, 64, 0, D, 3 * D, 0, D / 64, 2, 0);
                          seg_add(segs, n, items, -1, 0, -1, 0, W_MIX, 0, 0, D, 3 * D + 64, 0, D / 64, 6, 0);
                          seg_add(segs, n, items, 17, (size_t)(jm - 1) * 64 * D, -1, 0, W_GV, D, 0, 256, 0, 0, 1, D / 32, 0);
                          seg_add(segs, n, items, -1, 0, -1, 0, W_GV, 0, 0, 256, 0, 64, 3, D / 32, 0); }
            else seg_add(segs, n, items, -1, 0, -1, 0, W_MIX, 0, 0, D, 3 * D, 0, D / 64, 8, 0);
            for (int d = 0; d < 2; ++d) {
                seg_add(segs, n, items, 10, (size_t)(jm * 2 + d) * D * 96, -1, 0, W_G2, 96, 0, D, d * 128, 0, D / 64, 3, 0);
                seg_add(segs, n, items, -1, 0, -1, 0, W_G2, 0, 0, D, d * 128 + 96, 0, D / 64, 1, 0);
                seg_add(segs, n, items, 13, (size_t)(jm * 2 + d) * D * 96, -1, 0, W_G2, 96, 0, D, 256 + d * 128, 0, D / 64, 3, 0);
                seg_add(segs, n, items, -1, 0, -1, 0, W_G2, 0, 0, D, 256 + d * 128 + 96, 0, D / 64, 1, 0);
            }
            seg_add(segs, n, items, 18, (size_t)jm * D * 256, -1, 0, W_G2, 256, 0, D, 512, 0, D / 64, 8, 0);
            seg_add(segs, n, items, 19, (size_t)jm * 256 * D, -1, 0, W_GG, D, 0, 256, 0, 0, 4, D / 32, 0);
            seg_add(segs, n, items, 25, (size_t)jm * D * D, -1, 0, W_GO, D, 0, D, 0, 0, D / 64, D / 32, 0);
        } else {
            seg_add(segs, n, items, 26, (size_t)jm * D * 9 * D, 2, (size_t)(L * 3 + 1) * D, W_MIX, 9 * D, 0, D, 0, 0, D / 64, 9 * D / 32, 2);
            seg_add(segs, n, items, 27, (size_t)jm * D * D, -1, 0, W_GO, D, 0, D, 0, 0, D / 64, D / 32, 0);
        }
        segs[n].item0 = items; nseg_p[0] = n; nseg_p[1] = items;
    }
    __syncthreads();
    const int total = nseg_p[1];
    f32x4 cur[8], nxt[8];
#pragma unroll
    for (int i = 0; i < 8; ++i) { cur[i] = (f32x4){0.f, 0.f, 0.f, 0.f}; nxt[i] = cur[i]; }
    int it = gw, si = 0;
    if (it < total) { while (it >= segs[si + 1].item0) ++si; conv_load(segs + si, it - segs[si].item0, lane, cur); }
    while (it < total) {
        const int itn = it + NGW; int sn = si;
        if (itn < total) { while (itn >= segs[sn + 1].item0) ++sn; conv_load(segs + sn, itn - segs[sn].item0, lane, nxt); }
        conv_finish(segs + si, it - segs[si].item0, scr, lane, cur, ws);
#pragma unroll
        for (int i = 0; i < 8; ++i) cur[i] = nxt[i];
        it = itn; si = sn;
    }
    __syncthreads();
}

static __device__ PHASE_ATTR void ph_ffn_up(int f) {
    FRAME();
    pg8::Gemm g{(const bf16_t*)(ws + P_XN), (const bf16_t*)(ws + (f ? W_UP1 : W_UP0)), TT, 2 * FF, D, D}; pg8::StaticOrder S; S.init(TT, 2 * FF, G, bid_);
    pg8::EpiSwiGLU E{(bf16_t*)(ws + P_H), (const float*)(ws + WS_RSX)};
    pg8::gemm_phase<pg8::EpiSwiGLU, pg8::StaticOrder, true, true>(lds, g, S, E, tid);
}
static __device__ PHASE_ATTR void ph_gemm_plain(size_t a_off, int lda, size_t b_off, int N, int K, size_t o_off, int ldc) {
    FRAME();
    pg8::Gemm g{(const bf16_t*)(ws + a_off), (const bf16_t*)(ws + b_off), TT, N, K, lda}; pg8::StaticOrder S; S.init(TT, N, G, bid_);
    pg8::EpiPlain E{(bf16_t*)(ws + o_off), ldc};
    pg8::gemm_phase<pg8::EpiPlain, pg8::StaticOrder, true, true>(lds, g, S, E, tid);
}
static __device__ PHASE_ATTR void ph_qkv(int gi) {
    FRAME();
    pg8::Gemm g{(const bf16_t*)(ws + P_XN), (const bf16_t*)(ws + W_MIX) + (size_t)gi * 3 * D * D, TT, 3 * D, D, D}; pg8::StaticOrder S; S.init(TT, 3 * D, G, bid_);
    pg8::EpiQKV E{(bf16_t*)(ws + P_QKV), (const f32x2*)(ws + WS_ROPE), (const float*)(ws + WS_RSX)};
    pg8::gemm_phase<pg8::EpiQKV, pg8::StaticOrder, true, true>(lds, g, S, E, tid);
}
static __device__ PHASE_ATTR void ph_g1(int jm, int round) {
    FRAME();
    pg8::Gemm g{(const bf16_t*)(ws + P_MIX), (const bf16_t*)(ws + (round ? W_G2 : W_MIX)), TT, round ? NG2 : NG1, D, D, (size_t)192 * MiB, round ? 1 : 8, round ? 2 : 16};
    pg8::StaticOrder S; S.init(TT, round ? NG2 : NG1, G, bid_);
    pg8::EpiG1 E{ws, P_R, (jm == 0 ? WS_VF : P_V), P_HID, round};
    pg8::gemm_phase<pg8::EpiG1, pg8::StaticOrder, true, true>(lds, g, S, E, tid);
}
static __device__ PHASE_ATTR void ph_gv(int jm) {
    FRAME();
    pg8::Gemm g{(const bf16_t*)(ws + P_HID) + 768, (const bf16_t*)(ws + W_GV), TT, D, 256, HID}; pg8::StaticOrder S; S.init(TT, D, G, bid_);
    pg8::EpiVres E{(bf16_t*)(ws + P_V), (const bf16_t*)(ws + WS_VF), inp(15) + (size_t)(jm - 1) * D};
    pg8::gemm_phase<pg8::EpiVres, pg8::StaticOrder, true, true>(lds, g, S, E, tid);
}
static __device__ PHASE_ATTR void ph_gg() {
    FRAME();
    pg8::Gemm g{(const bf16_t*)(ws + P_HID) + 512, (const bf16_t*)(ws + W_GG), TT, D, 256, HID}; pg8::StaticOrder S; S.init(TT, D, G, bid_);
    pg8::EpiGmul E{(bf16_t*)(ws + P_YF)};
    pg8::gemm_phase<pg8::EpiGmul, pg8::StaticOrder, true, true>(lds, g, S, E, tid);
}

static __device__ PHASE_ATTR void ph_mix(int jm, int round) {
    FRAME();
    const bf16_t* XB = (const bf16_t*)(ws + P_XN); const float* RSX = (const float*)(ws + WS_RSX); bf16_t* MX = (bf16_t*)(ws + P_MIX);
    const float* mu = inp(7) + (size_t)jm * 6 * D; const float* gpre = inp(2) + (size_t)((2 * jm) * 3 + 1) * D;
    const int m0 = round ? 1 : 0, m1 = round ? 4 : 2, m2 = round ? 5 : 3;
    u32x4 cq[4], pq[4], nq[4]; float rcq, rpq, rnq;
#define MIX_LOAD(row_) do { const int r_ = (row_); int base_, pos_, len_; row_decode(r_, base_, pos_, len_); const bf16_t* a_ = XB + (size_t)r_ * D; \
        rcq = RSX[r_]; rpq = pos_ > 0 ? RSX[r_ - 1] : 0.f; rnq = pos_ < len_ - 1 ? RSX[r_ + 1] : 0.f; \
        _Pragma("unroll") for (int i = 0; i < 4; ++i) { const int e = 8 * (lane + 64 * i); cq[i] = *(const u32x4*)(a_ + e); pq[i] = (u32x4){0u, 0u, 0u, 0u}; nq[i] = (u32x4){0u, 0u, 0u, 0u}; \
            if (pos_ > 0) pq[i] = *(const u32x4*)(a_ - D + e); if (pos_ < len_ - 1) nq[i] = *(const u32x4*)(a_ + D + e); } } while (0)
    int row = gw;
    if (row < TT) MIX_LOAD(row);
    for (; row < TT; row += NGW) {
        u32x4 cc[4], pc[4], nc[4];
#pragma unroll
        for (int i = 0; i < 4; ++i) { cc[i] = cq[i]; pc[i] = pq[i]; nc[i] = nq[i]; }
        const float rc = rcq, rp = rpq, rn = rnq;
        if (row + NGW < TT) MIX_LOAD(row + NGW);
#pragma unroll
        for (int i = 0; i < 4; ++i) { const int e = 8 * (lane + 64 * i);
            const unsigned cw[4] = {cc[i].x, cc[i].y, cc[i].z, cc[i].w}, pw[4] = {pc[i].x, pc[i].y, pc[i].z, pc[i].w}, nw[4] = {nc[i].x, nc[i].y, nc[i].z, nc[i].w};
            const f32x4 ga = *(const f32x4*)(gpre + e), gb = *(const f32x4*)(gpre + e + 4);
            float cv[8], xx[8];
#pragma unroll
            for (int j = 0; j < 4; ++j) { const float g0 = j < 2 ? ga[2 * j] : gb[2 * j - 4], g1 = j < 2 ? ga[2 * j + 1] : gb[2 * j - 3];
                cv[2 * j] = bflo(cw[j]) * rc * g0; cv[2 * j + 1] = bfhi(cw[j]) * rc * g1;
                xx[2 * j] = 0.5f * (bflo(pw[j]) * rp + bflo(nw[j]) * rn) * g0 - cv[2 * j]; xx[2 * j + 1] = 0.5f * (bfhi(pw[j]) * rp + bfhi(nw[j]) * rn) * g1 - cv[2 * j + 1]; }
#pragma unroll
            for (int m = 0; m < 3; ++m) { const int mi = m == 0 ? m0 : (m == 1 ? m1 : m2);
                const f32x4 ma = *(const f32x4*)(mu + mi * D + e), mb = *(const f32x4*)(mu + mi * D + e + 4);
                const u32x4 o = {pk2(cv[0] + xx[0] * ma[0], cv[1] + xx[1] * ma[1]), pk2(cv[2] + xx[2] * ma[2], cv[3] + xx[3] * ma[3]), pk2(cv[4] + xx[4] * mb[0], cv[5] + xx[5] * mb[1]), pk2(cv[6] + xx[6] * mb[2], cv[7] + xx[7] * mb[3])};
                *(u32x4*)(MX + (size_t)m * TT * D + (size_t)row * D + e) = o; }
        }
    }
#undef MIX_LOAD
}

static __device__ __forceinline__ void scan_stage_e(LAS unsigned char* lds, f32x4 (&ST)[4], const int lane, const int vb) {
    constexpr int RS = 72;
    LAS bf16_t* AH = (LAS bf16_t*)(lds); LAS bf16_t* RH = (LAS bf16_t*)(lds + 9216); LAS bf16_t* BT = (LAS bf16_t*)(lds + 36864); LAS bf16_t* YS = (LAS bf16_t*)(lds + 64512);
    LAS unsigned char* KVI = lds + 73728; LAS unsigned char* MAKV = lds + 90112; LAS unsigned char* NRKV = lds + 98304;
    LAS unsigned char* MABF = lds + 108544; LAS unsigned char* NRBF = lds + 112640; LAS bf16_t* TTI = (LAS bf16_t*)(lds + 122880); LAS float* GL = (LAS float*)(lds + 125440);
    const int c15 = lane & 15, g = lane >> 4; const f32x4 zero4 = {0.f, 0.f, 0.f, 0.f};
#define PK_LO(x) __builtin_bit_cast(bf16x8, (u32x4){pk2((x)[0], (x)[1]), pk2((x)[2], (x)[3]), 0u, 0u})
#define PK_2(x, y) __builtin_bit_cast(bf16x8, (u32x4){pk2((x)[0], (x)[1]), pk2((x)[2], (x)[3]), pk2((y)[0], (y)[1]), pk2((y)[2], (y)[3])})
#define ROWFRAG(P) __builtin_bit_cast(bf16x8, (u32x4){(P)[0].x, (P)[0].y, (P)[1].x, (P)[1].y})
                u32x2 ahq[4][4], mkq[4];
#pragma unroll
                for (int tb = 0; tb < 4; ++tb) { const LAS bf16_t* ap = AH + (16 * tb + c15) * RS + 4 * g;
#pragma unroll
                    for (int q = 0; q < 4; ++q) ahq[tb][q] = *(const LAS u32x2*)(ap + 16 * q);
                    mkq[tb] = *(const LAS u32x2*)(MAKV + ((tb * 4 + vb) * 64 + lane) * 8); }
                const u32x4 Sf0 = {pk2(ST[0][0], ST[0][1]), pk2(ST[0][2], ST[0][3]), pk2(ST[1][0], ST[1][1]), pk2(ST[1][2], ST[1][3])};
                const u32x4 Sf1 = {pk2(ST[2][0], ST[2][1]), pk2(ST[2][2], ST[2][3]), pk2(ST[3][0], ST[3][1]), pk2(ST[3][2], ST[3][3])};
                __builtin_amdgcn_sched_barrier(0);
                u32x2 tfq[4]; bf16x8 mf[4];
#pragma unroll
                for (int tb = 0; tb < 4; ++tb) { tfq[tb] = *(const LAS u32x2*)(TTI + (tb * 16 + c15) * 20 + 4 * g); mf[tb] = *(const LAS bf16x8*)(MABF + (tb * 64 + lane) * 16); }
                f32x4 U[4];
#pragma unroll
                for (int tb = 0; tb < 4; ++tb) {
                    f32x4 acc = {bflo(mkq[tb].x), bfhi(mkq[tb].x), bflo(mkq[tb].y), bfhi(mkq[tb].y)};
                    acc = __builtin_amdgcn_mfma_f32_16x16x32_bf16(ROWFRAG(ahq[tb]), __builtin_bit_cast(bf16x8, Sf0), acc, 0, 0, 0);
                    acc = __builtin_amdgcn_mfma_f32_16x16x32_bf16(ROWFRAG(ahq[tb] + 2), __builtin_bit_cast(bf16x8, Sf1), acc, 0, 0, 0);
                    U[tb] = acc; }
                __builtin_amdgcn_sched_barrier(0);
                u32x2 rhq[4][4], nkq[4];
#pragma unroll
                for (int tb = 0; tb < 4; ++tb) { const LAS bf16_t* rp = RH + (16 * tb + c15) * RS + 4 * g;
#pragma unroll
                    for (int q = 0; q < 4; ++q) rhq[tb][q] = *(const LAS u32x2*)(rp + 16 * q);
                    nkq[tb] = *(const LAS u32x2*)(NRKV + ((tb * 4 + vb) * 64 + lane) * 8); }
                f32x4 Y1[4];
#pragma unroll
                for (int tb = 0; tb < 4; ++tb) {
                    f32x4 acy = {bflo(nkq[tb].x), bfhi(nkq[tb].x), bflo(nkq[tb].y), bfhi(nkq[tb].y)};
                    acy = __builtin_amdgcn_mfma_f32_16x16x32_bf16(ROWFRAG(rhq[tb]), __builtin_bit_cast(bf16x8, Sf0), acy, 0, 0, 0);
                    acy = __builtin_amdgcn_mfma_f32_16x16x32_bf16(ROWFRAG(rhq[tb] + 2), __builtin_bit_cast(bf16x8, Sf1), acy, 0, 0, 0);
                    Y1[tb] = acy; }
                const bf16x8 tf0 = __builtin_bit_cast(bf16x8, (u32x4){tfq[0].x, tfq[0].y, 0u, 0u}), tf1 = __builtin_bit_cast(bf16x8, (u32x4){tfq[1].x, tfq[1].y, 0u, 0u});
                const bf16x8 tf2 = __builtin_bit_cast(bf16x8, (u32x4){tfq[2].x, tfq[2].y, 0u, 0u}), tf3 = __builtin_bit_cast(bf16x8, (u32x4){tfq[3].x, tfq[3].y, 0u, 0u});
                f32x4 SA0 = __builtin_amdgcn_mfma_f32_16x16x32_bf16(tf0, PK_LO(U[0]), zero4, 0, 0, 0);
                f32x4 rhs = __builtin_amdgcn_mfma_f32_16x16x32_bf16(mf[0], PK_LO(SA0), U[1], 0, 0, 0);
                f32x4 SA1 = __builtin_amdgcn_mfma_f32_16x16x32_bf16(tf1, PK_LO(rhs), zero4, 0, 0, 0);
                const bf16x8 SAf0 = PK_2(SA0, SA1);
                rhs = __builtin_amdgcn_mfma_f32_16x16x32_bf16(mf[1], SAf0, U[2], 0, 0, 0);
                f32x4 SA2 = __builtin_amdgcn_mfma_f32_16x16x32_bf16(tf2, PK_LO(rhs), zero4, 0, 0, 0);
                rhs = __builtin_amdgcn_mfma_f32_16x16x32_bf16(mf[2], SAf0, U[3], 0, 0, 0);
                rhs = __builtin_amdgcn_mfma_f32_16x16x32_bf16(mf[3], PK_LO(SA2), rhs, 0, 0, 0);
                f32x4 SA3 = __builtin_amdgcn_mfma_f32_16x16x32_bf16(tf3, PK_LO(rhs), zero4, 0, 0, 0);
                const bf16x8 SAf1 = PK_2(SA2, SA3);
                __builtin_amdgcn_sched_barrier(0);
                bf16x8 nrf[6];
#pragma unroll
                for (int i = 0; i < 6; ++i) nrf[i] = *(const LAS bf16x8*)(NRBF + (i * 64 + lane) * 16);
                f32x4 kvq[4], glq[4]; u32x2 btq[4][4];
#pragma unroll
                for (int kb = 0; kb < 4; ++kb) { const LAS bf16_t* bp = BT + (16 * kb + c15) * RS + 4 * g;
#pragma unroll
                    for (int q = 0; q < 4; ++q) btq[kb][q] = *(const LAS u32x2*)(bp + 16 * q);
                    kvq[kb] = *(const LAS f32x4*)(KVI + ((kb * 4 + vb) * 64 + lane) * 16); glq[kb] = *(const LAS f32x4*)(GL + 16 * kb + 4 * g); }
#pragma unroll
                for (int tb = 0; tb < 4; ++tb) { const int nb = tb == 0 ? 0 : (tb == 1 ? 1 : (tb == 2 ? 2 : 4));
                    f32x4 acc = __builtin_amdgcn_mfma_f32_16x16x32_bf16(nrf[nb], SAf0, Y1[tb], 0, 0, 0);
                    if (tb >= 2) acc = __builtin_amdgcn_mfma_f32_16x16x32_bf16(nrf[nb + 1], SAf1, acc, 0, 0, 0);
#pragma unroll
                    for (int r = 0; r < 4; ++r) YS[(16 * tb + 4 * g + r) * RS + 16 * vb + c15] = (bf16_t)(pk2(acc[r], 0.f) & 0xffffu); }
#pragma unroll
                for (int kb = 0; kb < 4; ++kb) { f32x4 acc = kvq[kb];
                    acc = __builtin_amdgcn_mfma_f32_16x16x32_bf16(ROWFRAG(btq[kb]), SAf0, acc, 0, 0, 0);
                    acc = __builtin_amdgcn_mfma_f32_16x16x32_bf16(ROWFRAG(btq[kb] + 2), SAf1, acc, 0, 0, 0);
                    ST[kb] = glq[kb] * (ST[kb] + acc); }
#undef ROWFRAG
#undef PK_LO
#undef PK_2
}

template <int CTRL> __device__ __forceinline__ float dpp_row_shr(float v) { return __builtin_bit_cast(float, __builtin_amdgcn_update_dpp(0, __builtin_bit_cast(int, v), CTRL, 0xf, 0xf, true)); }
static __device__ PHASE_ATTR void ph_scan(int jm) {
    FRAME();
    const bf16_t* Rb = (const bf16_t*)(ws + P_R); const bf16_t* Kb = (const bf16_t*)(ws + P_K); const bf16_t* Vb = (const bf16_t*)(ws + (jm == 0 ? WS_VF : P_V));
    const bf16_t* Hd = (const bf16_t*)(ws + P_HID); float* BS = (float*)(ws + P_BS);
    constexpr int RS = 72;
    LAS bf16_t* AH = (LAS bf16_t*)(lds); LAS bf16_t* RH = (LAS bf16_t*)(lds + 9216); LAS bf16_t* BH = (LAS bf16_t*)(lds + 18432); LAS bf16_t* KH = (LAS bf16_t*)(lds + 27648);
    LAS bf16_t* BT = (LAS bf16_t*)(lds + 36864); LAS bf16_t* KT = (LAS bf16_t*)(lds + 46080); LAS bf16_t* VT = (LAS bf16_t*)(lds + 55296); LAS bf16_t* YS = (LAS bf16_t*)(lds + 64512);
    LAS unsigned char* KVI = lds + 73728; LAS unsigned char* MAKV = lds + 90112; LAS unsigned char* NRKV = lds + 98304;
    LAS float* SEG = (LAS float*)(lds + 106496); LAS float* NRM = (LAS float*)(lds + 107520); LAS float* BON = (LAS float*)(lds + 108032);
    LAS unsigned char* MABF = lds + 108544; LAS unsigned char* NRBF = lds + 112640;
    LAS float* MS = (LAS float*)(lds + 118784); LAS bf16_t* TTI = (LAS bf16_t*)(lds + 122880);
    LAS float* GL = (LAS float*)(lds + 125440); LAS float* PAR = (LAS float*)(lds + 125696);
    LAS unsigned char* W2F = lds + 147456;
    LAS unsigned char* A2F = lds + 126976;
    const int c15 = lane & 15, g = lane >> 4;
    const int tbq = wave & 3, half = wave >> 2;
    const int tF = tid >> 3, c8 = tid & 7;
    const int tbD = wave & 3, kindD = wave >> 2;
    const f32x4 zero4 = {0.f, 0.f, 0.f, 0.f};
    for (int it = bid_; it < 256; it += G) {
        const int seq = it & 3, head = (it >> 2) & 31, dir = it >> 7;
        const bool split = (G == 256);
        const bool helper = split && seq >= 2;
        const int pair = (seq & 1) | (head << 1) | (dir << 6);
        unsigned* flag = (unsigned*)(ws + WS_SCANFLAG + (size_t)jm * 8192 + (size_t)pair * 64);
#pragma unroll 1
        for (int pass = helper ? 0 : 1; pass < 2; ++pass) {
        __syncthreads();
        if (tid < 64) { const int c = head * 64 + tid;
            PAR[tid] = inp(9)[(size_t)(jm * 2 + dir) * D + c]; PAR[64 + tid] = inp(12)[(size_t)(jm * 2 + dir) * D + c];
            PAR[128 + tid] = inp(20)[(size_t)jm * D + c]; PAR[192 + tid] = inp(21)[(size_t)jm * D + c]; PAR[256 + tid] = inp(22)[(size_t)jm * D + c]; }
        int lane_s = lane; asm volatile("" : "+v"(lane_s));
        const int c15s = lane_s & 15, gs = lane_s >> 4;
#pragma unroll
        for (int kind = 0; kind < 2; ++kind)
#pragma unroll
            for (int cbi = 0; cbi < 2; ++cbi) { const float* M = (kind == 0 ? inp(11) : inp(14)) + (size_t)(jm * 2 + dir) * 96 * D + head * 64;
                const unsigned mo = (unsigned)(8 * gs * D + 16 * (2 * half + cbi) + c15s);
#pragma unroll
                for (int ks = 0; ks < 3; ++ks) { float x[8];
#pragma unroll
                    for (int j = 0; j < 8; ++j) x[j] = M[mo + (unsigned)((32 * ks + j) * D)];
                    const u32x4 w = {pk2(x[0], x[1]), pk2(x[2], x[3]), pk2(x[4], x[5]), pk2(x[6], x[7])};
                    *(LAS u32x4*)((kind == 0 ? W2F : A2F) + (((half * 2 + cbi) * 3 + ks) * 64 + lane_s) * 16) = w; }
                __builtin_amdgcn_sched_barrier(0); }
        bf16_t* yd = (bf16_t*)(ws + (dir ? P_YB : P_YF));
        const int cofs = head * 64 + 32 * half + 4 * g;
        bf16x8 hwf[3], haf[3]; u32x2 rq[2], kq[2], vq[2];
#define SCAN_PREFETCH(chunk_) do { const int st_ = (chunk_) * 64 + 16 * tbq + c15; const size_t row_ = (size_t)(base + (dir ? (len - 1 - st_) : st_)); \
            const bf16_t* hp_ = Hd + row_ * HID + dir * 128 + 8 * g; \
            _Pragma("unroll") for (int ks = 0; ks < 3; ++ks) { hwf[ks] = *(const bf16x8*)(hp_ + 32 * ks); haf[ks] = *(const bf16x8*)(hp_ + 256 + 32 * ks); } \
            _Pragma("unroll") for (int cbi = 0; cbi < 2; ++cbi) { rq[cbi] = *(const u32x2*)(Rb + row_ * D + cofs + 16 * cbi); kq[cbi] = *(const u32x2*)(Kb + row_ * D + cofs + 16 * cbi); vq[cbi] = *(const u32x2*)(Vb + row_ * D + cofs + 16 * cbi); } } while (0)
        const int sq = pass ? seq : seq - 2; const bool pre = (pass == 0);
        const int base = sq < 2 ? sq * 16384 : 32768 + (sq - 2) * 8192, len = sq < 2 ? 16384 : 8192;
        const int nch = len >> 6;
        const int c0 = pre ? nch - SCAN_NH : 0;
        const int cfull = (split && !pre && sq < 2) ? nch - SCAN_NH : nch;
        f32x4 ST[4] = {zero4, zero4, zero4, zero4};
        SCAN_PREFETCH(c0);
        __syncthreads();
#pragma unroll 1
        for (int chunk = c0; chunk < cfull; ++chunk) {
            int tid_o = tid; asm volatile("" : "+v"(tid_o));
            const int lane = tid_o & 63, c15 = lane & 15, g = lane >> 4, tF = tid_o >> 3, c8 = tid_o & 7;
            const int cofs = head * 64 + 32 * half + 4 * g;
            const int tq = 16 * tbq + c15;
            const int stq = chunk * 64 + tq; const size_t rowq = (size_t)(base + (dir ? (len - 1 - stq) : stq));
            float r8[8], lw8[8], asg[8], kkr[8], kd8[8], pfx[8]; u32x2 vkeep[2];
            {
                f32x4 accw[2] = {zero4, zero4}, acca[2] = {zero4, zero4};
#pragma unroll
                for (int cbi = 0; cbi < 2; ++cbi)
#pragma unroll
                    for (int ks = 0; ks < 3; ++ks) { accw[cbi] = __builtin_amdgcn_mfma_f32_16x16x32_bf16(*(const LAS bf16x8*)(W2F + (((half * 2 + cbi) * 3 + ks) * 64 + lane) * 16), hwf[ks], accw[cbi], 0, 0, 0); acca[cbi] = __builtin_amdgcn_mfma_f32_16x16x32_bf16(*(const LAS bf16x8*)(A2F + (((half * 2 + cbi) * 3 + ks) * 64 + lane) * 16), haf[ks], acca[cbi], 0, 0, 0); }
                float k8[8]; float ss = 0.f, bon = 0.f;
#pragma unroll
                for (int cbi = 0; cbi < 2; ++cbi) { const int cl = 32 * half + 16 * cbi + 4 * g;
                    const f32x4 w0v = *(const LAS f32x4*)(PAR + cl), a0v = *(const LAS f32x4*)(PAR + 64 + cl), kkv = *(const LAS f32x4*)(PAR + 128 + cl), kav = *(const LAS f32x4*)(PAR + 192 + cl), rkv = *(const LAS f32x4*)(PAR + 256 + cl);
                    const unsigned rw2[2] = {rq[cbi].x, rq[cbi].y}, kw2[2] = {kq[cbi].x, kq[cbi].y}; vkeep[cbi] = vq[cbi];
#pragma unroll
                    for (int r = 0; r < 4; ++r) { const int e = 4 * cbi + r;
                        r8[e] = (r & 1) ? bfhi(rw2[r >> 1]) : bflo(rw2[r >> 1]); k8[e] = (r & 1) ? bfhi(kw2[r >> 1]) : bflo(kw2[r >> 1]);
                        const float wr = w0v[r] + accw[cbi][r], ar = a0v[r] + acca[cbi][r];
                        lw8[e] = -0.87503877491452760f * __builtin_amdgcn_rcpf(1.0f + __expf(-wr));
                        asg[e] = __builtin_amdgcn_rcpf(1.0f + __expf(-ar)); kkr[e] = k8[e] * kkv[r]; ss += kkr[e] * kkr[e];
                        kd8[e] = k8[e] * (1.0f + (asg[e] - 1.0f) * kav[r]); bon += r8[e] * kd8[e] * rkv[r]; } }
                ss += __shfl_xor(ss, 16); ss += __shfl_xor(ss, 32); bon += __shfl_xor(bon, 16); bon += __shfl_xor(bon, 32);
                if (g == 0) { NRM[half * 64 + tq] = ss; BON[half * 64 + tq] = bon; }
#pragma unroll
                for (int e = 0; e < 8; ++e) { float x = lw8[e]; x += dpp_row_shr<0x111>(x); x += dpp_row_shr<0x112>(x); x += dpp_row_shr<0x114>(x); x += dpp_row_shr<0x118>(x); pfx[e] = x; }
                if (c15 == 15) { *(LAS f32x4*)(SEG + tbq * 64 + 32 * half + 4 * g) = (f32x4){pfx[0], pfx[1], pfx[2], pfx[3]}; *(LAS f32x4*)(SEG + tbq * 64 + 32 * half + 16 + 4 * g) = (f32x4){pfx[4], pfx[5], pfx[6], pfx[7]}; }
            }
            if (chunk > c0 && !pre) { const int st = (chunk - 1) * 64 + tF; const int p = dir ? (len - 1 - st) : st;
                *(u32x4*)(yd + (size_t)(base + p) * D + head * 64 + 8 * c8) = *(const LAS u32x4*)(YS + tF * RS + 8 * c8); }
            __syncthreads();
            {
                f32x4 of0 = zero4, of1 = zero4;
                for (int s = 0; s < tbq; ++s) { of0 += *(const LAS f32x4*)(SEG + s * 64 + 32 * half + 4 * g); of1 += *(const LAS f32x4*)(SEG + s * 64 + 32 * half + 16 + 4 * g); }
                const float inv = __builtin_amdgcn_rcpf(fmaxf(sqrtf(NRM[tq] + NRM[64 + tq]), 1e-12f));
                if (half == 0 && g == 0) BS[((size_t)dir * TT + rowq) * 32 + head] = BON[tq] + BON[64 + tq];
#pragma unroll
                for (int cbi = 0; cbi < 2; ++cbi) { const int cl = 32 * half + 16 * cbi + 4 * g; float ah[4], bh[4], kh[4], rh[4];
#pragma unroll
                    for (int r = 0; r < 4; ++r) { const int e = 4 * cbi + r; const float lg = pfx[e] + (cbi ? of1[r] : of0[r]); const float lm = lg - lw8[e];
                        const float e1 = __builtin_amdgcn_exp2f(lg), e2 = __builtin_amdgcn_rcpf(e1), e3 = __builtin_amdgcn_exp2f(lm); const float kk = kkr[e] * inv;
                        ah[r] = -kk * e3; bh[r] = kk * asg[e] * e2; kh[r] = kd8[e] * e2; rh[r] = r8[e] * e1; }
                    const u32x2 aw = {pk2(ah[0], ah[1]), pk2(ah[2], ah[3])}, bw = {pk2(bh[0], bh[1]), pk2(bh[2], bh[3])}, kw = {pk2(kh[0], kh[1]), pk2(kh[2], kh[3])}, rw = {pk2(rh[0], rh[1]), pk2(rh[2], rh[3])};
                    *(LAS u32x2*)(AH + tq * RS + cl) = aw; *(LAS u32x2*)(BH + tq * RS + cl) = bw; *(LAS u32x2*)(KH + tq * RS + cl) = kw; *(LAS u32x2*)(RH + tq * RS + cl) = rw;
                    const unsigned bww[2] = {bw.x, bw.y}, kww[2] = {kw.x, kw.y}, vww[2] = {vkeep[cbi].x, vkeep[cbi].y};
#pragma unroll
                    for (int r = 0; r < 4; ++r) { BT[(cl + r) * RS + tq] = (bf16_t)((r & 1) ? (bww[r >> 1] >> 16) : (bww[r >> 1] & 0xffffu)); KT[(cl + r) * RS + tq] = (bf16_t)((r & 1) ? (kww[r >> 1] >> 16) : (kww[r >> 1] & 0xffffu));
                        VT[(cl + r) * RS + tq] = (bf16_t)((r & 1) ? (vww[r >> 1] >> 16) : (vww[r >> 1] & 0xffffu)); }
                    if (tq == 63) *(LAS f32x4*)(GL + cl) = (f32x4){__builtin_amdgcn_exp2f(pfx[4 * cbi] + (cbi ? of1[0] : of0[0])), __builtin_amdgcn_exp2f(pfx[4 * cbi + 1] + (cbi ? of1[1] : of0[1])), __builtin_amdgcn_exp2f(pfx[4 * cbi + 2] + (cbi ? of1[2] : of0[2])), __builtin_amdgcn_exp2f(pfx[4 * cbi + 3] + (cbi ? of1[3] : of0[3]))}; }
            }
            __syncthreads();
            {
                const int tloc = c15;
                if (kindD == 0) {
                    bf16x8 bfA[2];
#pragma unroll
                    for (int ks = 0; ks < 2; ++ks) bfA[ks] = *(const LAS bf16x8*)(AH + (16 * tbD + c15) * RS + 32 * ks + 8 * g);
                    f32x4 GT1[4] = {zero4, zero4, zero4, zero4};
#pragma unroll
                    for (int ib = 0; ib < 4; ++ib) if (ib <= tbD) {
                        f32x4 a1 = zero4;
#pragma unroll
                        for (int ks = 0; ks < 2; ++ks) a1 = __builtin_amdgcn_mfma_f32_16x16x32_bf16(*(const LAS bf16x8*)(BH + (16 * ib + c15) * RS + 32 * ks + 8 * g), bfA[ks], a1, 0, 0, 0);
                        if (ib == tbD) {
#pragma unroll
                            for (int r = 0; r < 4; ++r) if (!(4 * g + r < tloc)) a1[r] = 0.f; }
                        GT1[ib] = a1;
                    }
                    const f32x4 m1 = (tbD >= 2) ? GT1[1] : zero4, m2 = (tbD == 3) ? GT1[2] : zero4;
                    const u32x4 F01 = {pk2(GT1[0][0], GT1[0][1]), pk2(GT1[0][2], GT1[0][3]), pk2(m1[0], m1[1]), pk2(m1[2], m1[3])};
                    const u32x4 F23 = {pk2(m2[0], m2[1]), pk2(m2[2], m2[3]), 0u, 0u};
                    if (tbD == 1) *(LAS u32x4*)(MABF + (0 * 64 + lane) * 16) = F01;
                    if (tbD == 2) *(LAS u32x4*)(MABF + (1 * 64 + lane) * 16) = F01;
                    if (tbD == 3) { *(LAS u32x4*)(MABF + (2 * 64 + lane) * 16) = F01; *(LAS u32x4*)(MABF + (3 * 64 + lane) * 16) = F23; }
                    f32x4 dg = GT1[0]; dg = (tbD == 1) ? GT1[1] : dg; dg = (tbD == 2) ? GT1[2] : dg; dg = (tbD == 3) ? GT1[3] : dg;
                    *(LAS f32x4*)(MS + (tbD * 16 + c15) * 16 + 4 * g) = dg;
                    asm volatile("s_waitcnt lgkmcnt(0)" ::: "memory");
                    const int lane_o = lane;
                    if (lane < 16) { float x[16];
#pragma unroll
                        for (int t = 0; t < 16; ++t) { const LAS f32x4* mr = (const LAS f32x4*)(MS + (tbD * 16 + t) * 16); float s = (t == lane_o) ? 1.0f : 0.0f;
#pragma unroll
                            for (int i4 = 0; i4 < (t + 3) / 4; ++i4) { const f32x4 m = mr[i4];
#pragma unroll
                                for (int q = 0; q < 4; ++q) if (4 * i4 + q < t) s += m[q] * x[4 * i4 + q]; }
                            x[t] = s; }
#pragma unroll
                        for (int t = 0; t < 16; ++t) TTI[(tbD * 16 + t) * 20 + lane] = (bf16_t)(pk2(x[t], 0.f) & 0xffffu); }
                } else {
                    bf16x8 bfR[2], bfA[2];
#pragma unroll
                    for (int ks = 0; ks < 2; ++ks) { bfR[ks] = *(const LAS bf16x8*)(RH + (16 * tbD + c15) * RS + 32 * ks + 8 * g); bfA[ks] = *(const LAS bf16x8*)(AH + (16 * tbD + c15) * RS + 32 * ks + 8 * g); }
                    f32x4 GT1[4] = {zero4, zero4, zero4, zero4}, GT2[4] = {zero4, zero4, zero4, zero4}, GT3[4] = {zero4, zero4, zero4, zero4};
#pragma unroll
                    for (int ib = 0; ib < 4; ++ib) if (ib <= tbD) {
                        f32x4 a1 = zero4, a2 = zero4, a3 = zero4;
#pragma unroll
                        for (int ks = 0; ks < 2; ++ks) { const bf16x8 f1 = *(const LAS bf16x8*)(BH + (16 * ib + c15) * RS + 32 * ks + 8 * g), f2 = *(const LAS bf16x8*)(KH + (16 * ib + c15) * RS + 32 * ks + 8 * g);
                            a1 = __builtin_amdgcn_mfma_f32_16x16x32_bf16(f1, bfR[ks], a1, 0, 0, 0); a2 = __builtin_amdgcn_mfma_f32_16x16x32_bf16(f2, bfR[ks], a2, 0, 0, 0); a3 = __builtin_amdgcn_mfma_f32_16x16x32_bf16(f2, bfA[ks], a3, 0, 0, 0); }
                        if (ib == tbD) {
#pragma unroll
                            for (int r = 0; r < 4; ++r) { const int il = 4 * g + r; if (!(il <= tloc)) { a1[r] = 0.f; a2[r] = 0.f; } if (!(il < tloc)) a3[r] = 0.f; } }
                        GT1[ib] = a1; GT2[ib] = a2; GT3[ib] = a3;
                    }
                    const u32x4 F01 = {pk2(GT1[0][0], GT1[0][1]), pk2(GT1[0][2], GT1[0][3]), pk2(GT1[1][0], GT1[1][1]), pk2(GT1[1][2], GT1[1][3])};
                    const u32x4 F23 = {pk2(GT1[2][0], GT1[2][1]), pk2(GT1[2][2], GT1[2][3]), pk2(GT1[3][0], GT1[3][1]), pk2(GT1[3][2], GT1[3][3])};
                    const int nb = tbD == 0 ? 0 : (tbD == 1 ? 1 : (tbD == 2 ? 2 : 4));
                    *(LAS u32x4*)(NRBF + (nb * 64 + lane) * 16) = F01;
                    if (tbD >= 2) *(LAS u32x4*)(NRBF + ((nb + 1) * 64 + lane) * 16) = F23;
                    const u32x4 N_01 = {pk2(GT2[0][0], GT2[0][1]), pk2(GT2[0][2], GT2[0][3]), pk2(GT2[1][0], GT2[1][1]), pk2(GT2[1][2], GT2[1][3])};
                    const u32x4 N_23 = {pk2(GT2[2][0], GT2[2][1]), pk2(GT2[2][2], GT2[2][3]), pk2(GT2[3][0], GT2[3][1]), pk2(GT2[3][2], GT2[3][3])};
                    const u32x4 M_01 = {pk2(GT3[0][0], GT3[0][1]), pk2(GT3[0][2], GT3[0][3]), pk2(GT3[1][0], GT3[1][1]), pk2(GT3[1][2], GT3[1][3])};
                    const u32x4 M_23 = {pk2(GT3[2][0], GT3[2][1]), pk2(GT3[2][2], GT3[2][3]), pk2(GT3[3][0], GT3[3][1]), pk2(GT3[3][2], GT3[3][3])};
#pragma unroll
                    for (int vb = 0; vb < 4; ++vb) { const LAS bf16_t* vp = VT + (16 * vb + c15) * RS + 4 * g;
                        const u32x2 v0 = *(const LAS u32x2*)(vp), v1 = *(const LAS u32x2*)(vp + 16);
                        const bf16x8 vf01 = __builtin_bit_cast(bf16x8, (u32x4){v0.x, v0.y, v1.x, v1.y});
                        f32x4 accn = __builtin_amdgcn_mfma_f32_16x16x32_bf16(__builtin_bit_cast(bf16x8, N_01), vf01, zero4, 0, 0, 0);
                        f32x4 accm = __builtin_amdgcn_mfma_f32_16x16x32_bf16(__builtin_bit_cast(bf16x8, M_01), vf01, zero4, 0, 0, 0);
                        if (tbD >= 2) { const u32x2 v2 = *(const LAS u32x2*)(vp + 32), v3 = *(const LAS u32x2*)(vp + 48);
                            const bf16x8 vf23 = __builtin_bit_cast(bf16x8, (u32x4){v2.x, v2.y, v3.x, v3.y});
                            accn = __builtin_amdgcn_mfma_f32_16x16x32_bf16(__builtin_bit_cast(bf16x8, N_23), vf23, accn, 0, 0, 0);
                            accm = __builtin_amdgcn_mfma_f32_16x16x32_bf16(__builtin_bit_cast(bf16x8, M_23), vf23, accm, 0, 0, 0); }
                        *(LAS u32x2*)(NRKV + ((tbD * 4 + vb) * 64 + lane) * 8) = (u32x2){pk2(accn[0], accn[1]), pk2(accn[2], accn[3])};
                        *(LAS u32x2*)(MAKV + ((tbD * 4 + vb) * 64 + lane) * 8) = (u32x2){pk2(accm[0], accm[1]), pk2(accm[2], accm[3])}; }
                }
#pragma unroll
                for (int q2 = 0; q2 < 2; ++q2) { const int id = 2 * wave + q2, kb = id >> 2, vb = id & 3; f32x4 acc = zero4;
#pragma unroll
                    for (int ks = 0; ks < 2; ++ks) acc = __builtin_amdgcn_mfma_f32_16x16x32_bf16(*(const LAS bf16x8*)(KT + (16 * kb + c15) * RS + 32 * ks + 8 * g), *(const LAS bf16x8*)(VT + (16 * vb + c15) * RS + 32 * ks + 8 * g), acc, 0, 0, 0);
                    *(LAS f32x4*)(KVI + (id * 64 + lane) * 16) = acc; }
            }
            __syncthreads();
            if (chunk + 1 < cfull) SCAN_PREFETCH(chunk + 1);
            if (pre) {
                const int j = chunk - c0; const int slot = __builtin_amdgcn_readfirstlane(pair * SCAN_NH + j);
                unsigned char* dstp = slot < SCAN_SLOTS_OUT ? (unsigned char*)outp() + (size_t)slot * SCAN_SLOT : (unsigned char*)ws + WS_POOL + 576 * MiB + (size_t)(slot - SCAN_SLOTS_OUT) * SCAN_SLOT;
                const __amdgpu_buffer_rsrc_t drs = __builtin_amdgcn_make_buffer_rsrc(dstp, 0, SCAN_SLOT, 0x00020000);
#pragma unroll
                for (int q = 0; q < 9; ++q) { const int u = tid_o + 512 * q;
                    if (q < 8 || u < SCAN_DUMP_U) { const int off = 16 * u + (u >= 1152 ? 18432 : 0) + (u >= 1728 ? 27648 : 0) + (u >= 3776 ? 2048 : 0) + (u >= 4416 ? 4096 : 0);
                        __builtin_amdgcn_raw_buffer_store_b128(*(const LAS u32x4*)(lds + off), drs, 16 * u, 0, 16); } }
            } else {
            if (wave < 4) scan_stage_e(lds, ST, lane, wave);
            __syncthreads();
            }
        }
        if (pre) {
            asm volatile("s_waitcnt vmcnt(0)" ::: "memory");
            __syncthreads();
            if (tid == 0) __hip_atomic_store((GAS unsigned*)flag, (unsigned)SCAN_NH, __ATOMIC_RELAXED, __HIP_MEMORY_SCOPE_AGENT);
        }
        if (cfull < nch) {
            if (wave == 0) {
                while ((unsigned)__builtin_amdgcn_readfirstlane(__hip_atomic_load((GAS unsigned*)flag, __ATOMIC_RELAXED, __HIP_MEMORY_SCOPE_AGENT)) < (unsigned)SCAN_NH) __builtin_amdgcn_s_sleep(2);
                __builtin_amdgcn_fence(__ATOMIC_ACQUIRE, "agent"); }
            __syncthreads();
            u32x4 pf[9];
#define DUMP_OFF(u) (16 * (u) + ((u) >= 1152 ? 18432 : 0) + ((u) >= 1728 ? 27648 : 0) + ((u) >= 3776 ? 2048 : 0) + ((u) >= 4416 ? 4096 : 0))
#define DUMP_LOAD(j_) do { const int slot_ = __builtin_amdgcn_readfirstlane(pair * SCAN_NH + (j_)); \
            const u32x4* srcp_ = (const u32x4*)(slot_ < SCAN_SLOTS_OUT ? (const unsigned char*)outp() + (size_t)slot_ * SCAN_SLOT : (const unsigned char*)ws + WS_POOL + 576 * MiB + (size_t)(slot_ - SCAN_SLOTS_OUT) * SCAN_SLOT); \
            _Pragma("unroll") for (int q = 0; q < 9; ++q) { const int u = tid_p + 512 * q; if (q < 8 || u < SCAN_DUMP_U) pf[q] = srcp_[u]; } } while (0)
            int tid_p = tid; asm volatile("" : "+v"(tid_p));
            DUMP_LOAD(0);
#pragma unroll 1
            for (int chunk = cfull; chunk < nch; ++chunk) {
                int tid_o = tid; asm volatile("" : "+v"(tid_o));
                const int tF = tid_o >> 3, c8 = tid_o & 7; const int tid_p = tid_o;
#pragma unroll
                for (int q = 0; q < 9; ++q) { const int u = tid_o + 512 * q; if (q < 8 || u < SCAN_DUMP_U) *(LAS u32x4*)(lds + DUMP_OFF(u)) = pf[q]; }
                { const int st = (chunk - 1) * 64 + tF; const int p = dir ? (len - 1 - st) : st;
                  *(u32x4*)(yd + (size_t)(base + p) * D + head * 64 + 8 * c8) = *(const LAS u32x4*)(YS + tF * RS + 8 * c8); }
                __syncthreads();
                if (chunk + 1 < nch) DUMP_LOAD(chunk + 1 - cfull);
                if (wave < 4) scan_stage_e(lds, ST, tid_o & 63, wave);
                __syncthreads();
            }
#undef DUMP_LOAD
#undef DUMP_OFF
        }
        if (!pre) { const int tF = tid >> 3, c8 = tid & 7; const int st = (nch - 1) * 64 + tF; const int p = dir ? (len - 1 - st) : st;
          *(u32x4*)(yd + (size_t)(base + p) * D + head * 64 + 8 * c8) = *(const LAS u32x4*)(YS + tF * RS + 8 * c8); }
        }
#undef SCAN_PREFETCH
    }
}

static __device__ PHASE_ATTR void ph_fin(int jm) {
    FRAME();
    bf16_t* YF = (bf16_t*)(ws + P_YF); const bf16_t* YB = (const bf16_t*)(ws + P_YB); const bf16_t* Vb = (const bf16_t*)(ws + (jm == 0 ? WS_VF : P_V)); const float* BS = (const float*)(ws + P_BS);
    const float* gnw = inp(23) + (size_t)jm * D; const float* gnb = inp(24) + (size_t)jm * D;
    u32x4 aq[4], bq[4], vq4[4]; float b0q[4], b1q[4];
#define FIN_LOAD(row_) do { const size_t r_ = (size_t)(row_); \
        _Pragma("unroll") for (int i = 0; i < 4; ++i) { const int e = 8 * (lane + 64 * i); aq[i] = *(const u32x4*)(YF + r_ * D + e); bq[i] = *(const u32x4*)(YB + r_ * D + e); vq4[i] = *(const u32x4*)(Vb + r_ * D + e); \
            b0q[i] = BS[r_ * 32 + (e >> 6)]; b1q[i] = BS[((size_t)TT + r_) * 32 + (e >> 6)]; } } while (0)
    int row = gw;
    if (row < TT) FIN_LOAD(row);
    for (; row < TT; row += NGW) {
        u32x4 ac[4], bc[4], vc[4]; float b0c[4], b1c[4];
#pragma unroll
        for (int i = 0; i < 4; ++i) { ac[i] = aq[i]; bc[i] = bq[i]; vc[i] = vq4[i]; b0c[i] = b0q[i]; b1c[i] = b1q[i]; }
        if (row + NGW < TT) FIN_LOAD(row + NGW);
#pragma unroll
        for (int i = 0; i < 4; ++i) { const int e = 8 * (lane + 64 * i);
            const unsigned aw[4] = {ac[i].x, ac[i].y, ac[i].z, ac[i].w}, bw[4] = {bc[i].x, bc[i].y, bc[i].z, bc[i].w}, vw[4] = {vc[i].x, vc[i].y, vc[i].z, vc[i].w};
            float y[8], v8[8]; float s = 0.f;
#pragma unroll
            for (int j = 0; j < 4; ++j) { y[2 * j] = bflo(aw[j]) + bflo(bw[j]); y[2 * j + 1] = bfhi(aw[j]) + bfhi(bw[j]); v8[2 * j] = bflo(vw[j]); v8[2 * j + 1] = bfhi(vw[j]); s += y[2 * j] + y[2 * j + 1]; }
            s += __shfl_xor(s, 1); s += __shfl_xor(s, 2); s += __shfl_xor(s, 4);
            const float mean = s * (1.0f / 64.0f); float q = 0.f;
#pragma unroll
            for (int j = 0; j < 8; ++j) { y[j] -= mean; q += y[j] * y[j]; }
            q += __shfl_xor(q, 1); q += __shfl_xor(q, 2); q += __shfl_xor(q, 4);
            const float rstd = rsqrtf(q * (1.0f / 64.0f) + GN_EPS);
            const float bonus = 0.5f * (b0c[i] + b1c[i]);
            const f32x4 w0 = *(const f32x4*)(gnw + e), w1 = *(const f32x4*)(gnw + e + 4), c0 = *(const f32x4*)(gnb + e), c1 = *(const f32x4*)(gnb + e + 4);
            float o[8];
#pragma unroll
            for (int j = 0; j < 8; ++j) o[j] = y[j] * rstd * (j < 4 ? w0[j] : w1[j - 4]) + (j < 4 ? c0[j] : c1[j - 4]) + bonus * v8[j];
            *(u32x4*)(YF + (size_t)row * D + e) = (u32x4){pk2(o[0], o[1]), pk2(o[2], o[3]), pk2(o[4], o[5]), pk2(o[6], o[7])}; }
    }
#undef FIN_LOAD
}

typedef short v4i16_t __attribute__((ext_vector_type(4)));
struct AttItem { int base, h, c, b0, Lc; };
__device__ __forceinline__ AttItem att_decode(int pair, int dsh) {
    const int it = pair * 2; int seq, h, cb, S_len;
    if (it < 8192) { seq = it >> 12; h = (it >> 8) & 15; cb = it & 255; S_len = 16384; }
    else { const int i2 = it - 8192; seq = 2 + (i2 >> 11); h = (i2 >> 7) & 15; cb = i2 & 127; S_len = 8192; }
    AttItem a; a.base = seq < 2 ? seq * 16384 : 32768 + (seq - 2) * 8192; a.h = h; a.Lc = S_len >> dsh; const int nb = a.Lc >> 6; a.c = cb / nb; a.b0 = cb % nb; return a;
}
static __device__ PHASE_ATTR void ph_att(int gi) {
    FRAME();
    const int dil = 1 << (2 * gi), dsh = 2 * gi;
    const bf16_t* QKV = (const bf16_t*)(ws + P_QKV);
    bf16_t* const Og = (bf16_t*)(ws + P_O0 + (size_t)gi * 192 * MiB); float* const LSEg = (float*)(ws + P_LSE) + (size_t)gi * TT * 16;
    bf16_t* const O0 = (bf16_t*)(ws + P_O0); const bf16_t* const O1 = (const bf16_t*)(ws + P_O0 + 192 * MiB); const float* const LS = (const float*)(ws + P_LSE);
    constexpr int KRS = 136, VRS = 144;
    LAS bf16_t* Ks = (LAS bf16_t*)lds; LAS bf16_t* Vs = (LAS bf16_t*)(lds + 256 * KRS * 2);
    const int qi = wave >> 2, wi = wave & 3, c15 = lane & 15, gq = lane >> 4;
    u32x4 kv[16]; bf16x8 qf[4];
#define ATT_PREFETCH(A) do { _Pragma("unroll") for (int i = 0; i < 16; ++i) { const int key = (tid >> 4) + 32 * (i & 7), part = tid & 15; \
            int ip = 64 * ((A).b0 - 1) + key; ip = ip < 0 ? 0 : (ip > (A).Lc - 1 ? (A).Lc - 1 : ip); \
            kv[i] = *(const u32x4*)(QKV + (size_t)((A).base + ip * dil + (A).c) * (3 * D) + ((i >> 3) ? 2 * D : D) + (A).h * 128 + 8 * part); } \
        { const size_t rq = (size_t)((A).base + (64 * ((A).b0 + qi) + 16 * wi + c15) * dil + (A).c); \
          _Pragma("unroll") for (int ks = 0; ks < 4; ++ks) qf[ks] = *(const bf16x8*)(QKV + rq * (3 * D) + (A).h * 128 + 32 * ks + 8 * gq); } } while (0)
    const int ppw = (6144 + G - 1) / G;
    int pair = bid_ * ppw; const int pair_end = (pair + ppw < 6144) ? pair + ppw : 6144;
    if (pair < pair_end) { const AttItem A0 = att_decode(pair, dsh); ATT_PREFETCH(A0); }
    for (; pair < pair_end; ++pair) {
        const AttItem A = att_decode(pair, dsh);
        const int base = A.base, h = A.h, c = A.c, Lc = A.Lc;
#pragma unroll
        for (int i = 0; i < 16; ++i) { const int key = (tid >> 4) + 32 * (i & 7), part = tid & 15;
            if (i >> 3) *(LAS u32x4*)(Vs + key * VRS + 8 * part) = kv[i]; else *(LAS u32x4*)(Ks + key * KRS + 8 * part) = kv[i]; }
        bf16x8 q[4];
#pragma unroll
        for (int ks = 0; ks < 4; ++ks) q[ks] = qf[ks];
        const int b = A.b0 + qi;
        const int iq = 64 * b + 16 * wi + c15; const size_t rowq = (size_t)(base + iq * dil + c);
        __syncthreads();
        if (pair + 1 < pair_end) { const AttItem An = att_decode(pair + 1, dsh); ATT_PREFETCH(An); }
        const int k0w = 16 * wi;
        f32x4 sc[9];
#pragma unroll
        for (int nt = 0; nt < 9; ++nt) { const LAS bf16_t* kp = Ks + (64 * qi + k0w + 16 * nt + c15) * KRS + 8 * gq;
            f32x4 a = {0.f, 0.f, 0.f, 0.f};
#pragma unroll
            for (int ks = 0; ks < 4; ++ks) a = __builtin_amdgcn_mfma_f32_16x16x32_bf16(*(const LAS bf16x8*)(kp + 32 * ks), q[ks], a, 0, 0, 0);
            sc[nt] = a * 0.08838834764831845f; }
#pragma unroll
        for (int r = 0; r < 4; ++r) { const int d0 = 4 * gq + r - c15;
            if (d0 < 0) sc[0][r] = -INFINITY;
            if (d0 > 0) sc[8][r] = -INFINITY; }
        if (b == 0 || b == (Lc >> 6) - 1) {
#pragma unroll
            for (int nt = 0; nt < 9; ++nt)
#pragma unroll
                for (int r = 0; r < 4; ++r) { const int ip = 64 * (b - 1) + k0w + 16 * nt + 4 * gq + r; if (ip < 0 || ip >= Lc) sc[nt][r] = -INFINITY; } }
        float mx = -INFINITY;
#pragma unroll
        for (int nt = 0; nt < 9; ++nt) mx = fmaxf(mx, fmaxf(fmaxf(sc[nt][0], sc[nt][1]), fmaxf(sc[nt][2], sc[nt][3])));
        mx = fmaxf(mx, __shfl_xor(mx, 16)); mx = fmaxf(mx, __shfl_xor(mx, 32));
        float sum = 0.f;
#pragma unroll
        for (int nt = 0; nt < 9; ++nt)
#pragma unroll
            for (int r = 0; r < 4; ++r) { const float p = fast_exp(sc[nt][r] - mx); sc[nt][r] = p; sum += p; }
        sum += __shfl_xor(sum, 16); sum += __shfl_xor(sum, 32);
        const float rs = __builtin_amdgcn_rcpf(sum); const float lse = mx + __logf(sum);
        float w0 = 0.f, w1 = 0.f, w2 = 1.f;
        if (gi == 2) { const float l0 = LS[rowq * 16 + h], l1 = LS[((size_t)TT + rowq) * 16 + h]; const float m = fmaxf(lse, fmaxf(l0, l1));
            w0 = fast_exp(l0 - m); w1 = fast_exp(l1 - m); w2 = fast_exp(lse - m); const float r3 = __builtin_amdgcn_rcpf(w0 + w1 + w2); w0 *= r3; w1 *= r3; w2 *= r3; }
        else if (gq == 0) LSEg[rowq * 16 + h] = lse;
        bf16x8 pf[5];
#pragma unroll
        for (int ks = 0; ks < 4; ++ks) { const f32x4 p0 = sc[2 * ks] * rs, p1 = sc[2 * ks + 1] * rs;
            const u32x4 w = {pk2(p0[0], p0[1]), pk2(p0[2], p0[3]), pk2(p1[0], p1[1]), pk2(p1[2], p1[3])}; pf[ks] = __builtin_bit_cast(bf16x8, w); }
        { const f32x4 p0 = sc[8] * rs; const u32x4 w = {pk2(p0[0], p0[1]), pk2(p0[2], p0[3]), 0u, 0u}; pf[4] = __builtin_bit_cast(bf16x8, w); }
        const LAS bf16_t* vbase = Vs + (64 * qi + k0w + 4 * gq + (c15 >> 2)) * VRS + 4 * (c15 & 3);
#pragma unroll
        for (int dt = 0; dt < 8; ++dt) {
            f32x4 o = {0.f, 0.f, 0.f, 0.f};
#pragma unroll
            for (int ks = 0; ks < 5; ++ks) {
                const v4i16_t lo = __builtin_amdgcn_ds_read_tr16_b64_v4i16((LAS v4i16_t*)(vbase + (32 * ks) * VRS + 16 * dt));
                v4i16_t hi = {0, 0, 0, 0};
                if (ks < 4) hi = __builtin_amdgcn_ds_read_tr16_b64_v4i16((LAS v4i16_t*)(vbase + (32 * ks + 16) * VRS + 16 * dt));
                const bf16x8 vf = {lo[0], lo[1], lo[2], lo[3], hi[0], hi[1], hi[2], hi[3]};
                o = __builtin_amdgcn_mfma_f32_16x16x32_bf16(vf, pf[ks], o, 0, 0, 0);
            }
            const size_t oo = rowq * D + h * 128 + 16 * dt + 4 * gq;
            if (gi == 2) { const u32x2 a0 = *(const u32x2*)(O0 + oo), a1 = *(const u32x2*)(O1 + oo);
                o = (f32x4){w0 * bflo(a0.x) + w1 * bflo(a1.x) + w2 * o[0], w0 * bfhi(a0.x) + w1 * bfhi(a1.x) + w2 * o[1], w0 * bflo(a0.y) + w1 * bflo(a1.y) + w2 * o[2], w0 * bfhi(a0.y) + w1 * bfhi(a1.y) + w2 * o[3]};
                *(u32x2*)(O0 + oo) = (u32x2){pk2(o[0], o[1]), pk2(o[2], o[3])}; }
            else *(u32x2*)(Og + oo) = (u32x2){pk2(o[0], o[1]), pk2(o[2], o[3])};
        }
        __syncthreads();
    }
#undef ATT_PREFETCH
}

static __device__ PHASE_ATTR void ph_norm(int L, int sub, size_t h_off) {
    FRAME();
    float* Y = outp(); bf16_t* XB = (bf16_t*)(ws + P_XN);
    float* RSX = (float*)(ws + WS_RSX); const bf16_t* hsrc = (const bf16_t*)(ws + h_off);
    const float alpha = (sub == 1) ? 1.0f : 0.5f;
    const float* gpost = inp(3) + (size_t)(L * 3 + sub) * D;
    const bool last = (L == DEPTH - 1 && sub == 2), first = (L == 0 && sub == 0); const float* in0 = inp(0); const float* in1 = inp(1);
    u32x4 hq[4], xq[4]; f32x4 xf[4][2];
#define NORM_LOAD(row_) do { const size_t r_ = (size_t)(row_); \
        _Pragma("unroll") for (int i = 0; i < 4; ++i) { const int e = 8 * (lane + 64 * i); hq[i] = *(const u32x4*)(hsrc + r_ * D + e); \
            if (first) { const float* xs_ = r_ < 32768 ? in0 + r_ * D : in1 + (r_ - 32768) * D; xf[i][0] = *(const f32x4*)(xs_ + e); xf[i][1] = *(const f32x4*)(xs_ + e + 4); } \
            else xq[i] = *(const u32x4*)(XB + r_ * D + e); } } while (0)
    int row = gw;
    if (row < TT) NORM_LOAD(row);
    for (; row < TT; row += NGW) {
        float xv[4][8]; float ssh = 0.f;
        float hv[4][8];
#pragma unroll
        for (int i = 0; i < 4; ++i) {
            if (first) {
#pragma unroll
                for (int j = 0; j < 4; ++j) { xv[i][j] = xf[i][0][j]; xv[i][4 + j] = xf[i][1][j]; } }
            else { const unsigned xww[4] = {xq[i].x, xq[i].y, xq[i].z, xq[i].w};
#pragma unroll
                for (int j = 0; j < 4; ++j) { xv[i][2 * j] = bflo(xww[j]); xv[i][2 * j + 1] = bfhi(xww[j]); } }
            const unsigned hww[4] = {hq[i].x, hq[i].y, hq[i].z, hq[i].w};
#pragma unroll
            for (int j = 0; j < 4; ++j) { hv[i][2 * j] = bflo(hww[j]); hv[i][2 * j + 1] = bfhi(hww[j]); ssh += hv[i][2 * j] * hv[i][2 * j] + hv[i][2 * j + 1] * hv[i][2 * j + 1]; } }
        if (row + NGW < TT) NORM_LOAD(row + NGW);
        const float rh = rsqrtf(wave_sum(ssh) * (1.0f / D) + NORM_EPS) * alpha;
        float ssx = 0.f;
        float* ydst = Y + (size_t)row * D;
#pragma unroll
        for (int i = 0; i < 4; ++i) { const int e = 8 * (lane + 64 * i); const f32x4 ga = *(const f32x4*)(gpost + e), gb = *(const f32x4*)(gpost + e + 4);
#pragma unroll
            for (int j = 0; j < 8; ++j) { xv[i][j] += hv[i][j] * rh * (j < 4 ? ga[j] : gb[j - 4]); ssx += xv[i][j] * xv[i][j]; }
            if (last) { *(f32x4*)(ydst + e) = (f32x4){xv[i][0], xv[i][1], xv[i][2], xv[i][3]}; *(f32x4*)(ydst + e + 4) = (f32x4){xv[i][4], xv[i][5], xv[i][6], xv[i][7]}; }
            else *(u32x4*)(XB + (size_t)row * D + e) = (u32x4){pk2(xv[i][0], xv[i][1]), pk2(xv[i][2], xv[i][3]), pk2(xv[i][4], xv[i][5]), pk2(xv[i][6], xv[i][7])}; }
        if (!last) { const float rx = rsqrtf(wave_sum(ssx) * (1.0f / D) + NORM_EPS); if (lane == 0) RSX[row] = rx; }
    }
#undef NORM_LOAD
}
static __device__ __noinline__ void grid_bar() {
    LAS unsigned char* lds = (LAS unsigned char*)lds_raw;
    XcdBarrier b; b.bar = (unsigned*)(wsp() + WS_CTL) + CW_BAR; b.st = (volatile LAS unsigned*)(lds + MISC_OFF) + 8; b.x = b.st[2];
    xcd_barrier(b);
}
#define STEP(call) do { if (step >= lo && step < hi) { call; if (step + 1 < hi) grid_bar(); } ++step; } while (0)
template <int L> __device__ __forceinline__ void layer_prog(int& step, const int lo, const int hi) {
    constexpr int jm = L >> 1; constexpr bool is_attn = (L & 1) != 0;
    STEP(ph_ffn_up(0));
    STEP(ph_gemm_plain(P_H, FF, W_DN0, D, FF, P_HOUT, D));
    STEP(ph_norm(L, 0, P_HOUT));
    if constexpr (!is_attn) {
        STEP(ph_mix(jm, 0));
        STEP(ph_g1(jm, 0));
        STEP(ph_mix(jm, 1));
        STEP(ph_g1(jm, 1));
        if constexpr (jm > 0) { STEP(ph_gv(jm)); } else { ++step; }
        STEP(ph_scan(jm));
        STEP(ph_fin(jm));
        STEP(ph_gg());
        STEP(ph_gemm_plain(P_YF, D, W_GO, D, D, P_R, D));
        STEP(ph_norm(L, 1, P_R));
    } else {
        STEP(ph_qkv(0));
        STEP(ph_att(0));
        STEP(ph_qkv(1));
        STEP(ph_att(1));
        STEP(ph_qkv(2));
        STEP(ph_att(2));
        STEP(ph_gemm_plain(P_O0, D, W_GO, D, D, P_QKV, D));
        STEP(ph_norm(L, 1, P_QKV));
    }
    STEP(ph_ffn_up(1));
    STEP(ph_gemm_plain(P_H, FF, W_DN1, D, FF, P_HOUT, D));
    STEP({ ph_norm(L, 2, P_HOUT); if (L + 1 < DEPTH) ph_conv(L + 1); });
}
__global__ void __launch_bounds__(NWAVES * 64, 2) enc_fwd(Args args) {
    LAS unsigned char* lds = (LAS unsigned char*)lds_raw;
    volatile LAS unsigned* MISC = (volatile LAS unsigned*)(lds + MISC_OFF);
    const int tid = threadIdx.x;
    if (tid < 128) ((LAS unsigned*)(lds + CTRL_OFF))[tid] = 0u;
    if (tid < 30) { const unsigned long long v = tid < 28 ? (unsigned long long)args.in[tid] : (tid == 28 ? (unsigned long long)args.out : (unsigned long long)args.ws);
        LAS unsigned* p = (LAS unsigned*)(lds + PTR_OFF) + 2 * tid; p[0] = (unsigned)v; p[1] = (unsigned)(v >> 32); }
    __syncthreads();
    const int lo = args.step_lo, hi = args.step_hi;
    if (hi - lo > 1) { const XcdBarrier b = xcd_barrier_post((unsigned*)(args.ws + WS_CTL) + CW_BAR, MISC + 8); if (tid == 0) MISC[10] = b.x; }
    __syncthreads();
    int step = 0;
    STEP({ ph_init(); ph_conv(0); });
    layer_prog<0>(step, lo, hi);
    layer_prog<1>(step, lo, hi);
    layer_prog<2>(step, lo, hi);
    layer_prog<3>(step, lo, hi);
}
#undef STEP

static int n_steps_total() {
    int s = 1;
    for (int L = 0; L < DEPTH; ++L) { s += 3; s += (L & 1) ? 8 : 10; s += 3; }
    return s;
}

extern "C" void kernel_launch(void* const* d_in, const int* in_sizes, int n_in, void* d_out, int out_size, void* d_ws, size_t ws_size, hipStream_t stream) {
    static int grid = 0;
    if (grid == 0) {
        if (n_in != 28 || out_size != TT * D || ws_size < WS_END) { fprintf(stderr, "kernel_launch: unexpected shapes (n_in %d, out %d, ws %zu, need %zu)\n", n_in, out_size, ws_size, (size_t)WS_END); grid = -1; return; }
        int dev = 0, cus = 0, per_cu = 0;
        if (hipGetDevice(&dev) != hipSuccess || hipDeviceGetAttribute(&cus, hipDeviceAttributeMultiprocessorCount, dev) != hipSuccess) { grid = -1; return; }
        if (hipFuncSetAttribute((const void*)enc_fwd, hipFuncAttributeMaxDynamicSharedMemorySize, LDS_BYTES) != hipSuccess) { grid = -1; return; }
        if (hipOccupancyMaxActiveBlocksPerMultiprocessor(&per_cu, (const void*)enc_fwd, NWAVES * 64, LDS_BYTES) != hipSuccess || per_cu < 1) { fprintf(stderr, "kernel_launch: occupancy query says %d\n", per_cu); }
        (void)hipGetLastError();
        grid = cus;
    }
    if (grid < 0) return;
    (void)hipMemsetAsync((char*)d_ws + WS_CTL, 0, CTL_ZERO_BYTES, stream);
    Args a{};
    for (int i = 0; i < 28; ++i) a.in[i] = (const float*)d_in[i];
    a.out = (float*)d_out; a.ws = (unsigned char*)d_ws;
    const int NS = n_steps_total();
#if MK_ONE_LAUNCH
    a.step_lo = 0; a.step_hi = NS;
    hipLaunchKernelGGL(enc_fwd, dim3(grid), dim3(NWAVES * 64), LDS_BYTES, stream, a);
#else
    for (int s = 0; s < NS; ++s) {
        a.step_lo = s; a.step_hi = s + 1;
        hipLaunchKernelGGL(enc_fwd, dim3(grid), dim3(NWAVES * 64), LDS_BYTES, stream, a);
    }
#endif
}
```

```cpp
#include <hip/hip_runtime.h>
#include <cstdio>
#include <cstdint>

#ifndef MK_ONE_LAUNCH
#define MK_ONE_LAUNCH 1
#endif

#ifndef PHASE_ATTR
#define PHASE_ATTR __forceinline__
#endif
#define LAS __attribute__((address_space(3)))
#define GAS __attribute__((address_space(1)))
typedef unsigned short bf16_t;
typedef short bf16x8 __attribute__((ext_vector_type(8)));
typedef float f32x4 __attribute__((ext_vector_type(4)));
typedef float f32x2 __attribute__((ext_vector_type(2)));
typedef unsigned u32x4 __attribute__((ext_vector_type(4)));
typedef unsigned u32x2 __attribute__((ext_vector_type(2)));
typedef __bf16 bf16x2_t __attribute__((ext_vector_type(2)));

constexpr int D = 2048, FF = 5632, TT = 49152, DEPTH = 4;
constexpr int HID = 1024;
constexpr int NG1 = 3 * D + 256, NG2 = 768;
constexpr float NORM_EPS = 1e-6f, GN_EPS = 64e-5f;

__device__ __forceinline__ float bflo(unsigned w) { return __uint_as_float(w << 16); }
__device__ __forceinline__ float bfhi(unsigned w) { return __uint_as_float(w & 0xffff0000u); }
__device__ __forceinline__ unsigned pk2(float lo, float hi) { f32x2 v = {lo, hi}; bf16x2_t b = __builtin_convertvector(v, bf16x2_t); return __builtin_bit_cast(unsigned, b); }
__device__ __forceinline__ float wave_sum(float v) {
#pragma unroll
    for (int o = 1; o < 64; o <<= 1) v += __shfl_xor(v, o);
    return v;
}
__device__ __forceinline__ float fast_exp(float x) { return __builtin_amdgcn_exp2f(x * 1.4426950408889634f); }
__device__ __forceinline__ float sigmoidf_(float x) { return __builtin_amdgcn_rcpf(1.0f + fast_exp(-x)); }
__device__ __forceinline__ float siluf_(float x) { return x * sigmoidf_(x); }
__device__ __forceinline__ float tanhf_(float x) { return 1.0f - 2.0f * __builtin_amdgcn_rcpf(1.0f + fast_exp(2.0f * x)); }
__device__ __forceinline__ void row_decode(int row, int& base, int& pos, int& len) {
    if (row < 32768) { base = row & ~16383; pos = row & 16383; len = 16384; }
    else { const int r2 = row - 32768; base = 32768 + (r2 & ~8191); pos = r2 & 8191; len = 8192; }
}

namespace pg8 {
#define PG8_LAS __attribute__((address_space(3)))
constexpr int BM = 256, BK = 64, HALF = 128, HTB = HALF * BK * 2, STAGE_BYTES = 8 * HTB, NXCD = 8, WGM = 8;
__host__ __device__ __forceinline__ int lds_byte(int r, int c) { const int st = (r >> 4) * 2 + (c >> 5), rr = r & 15, cc = c & 31, ob = rr * 64 + cc * 2; return st * 1024 + (ob ^ (((ob >> 9) & 1) << 5)); }
__host__ __device__ __forceinline__ void stage_rc(int b, int& R, int& C) { const int st = b / 1024, sb = b % 1024, swz = sb ^ (((sb >> 9) & 1) << 5); R = (st >> 1) * 16 + swz / 64; C = (st & 1) * 32 + (swz % 64) / 2; }
__host__ __device__ __forceinline__ int perm32(int rho) { const int n = rho >> 4, i = rho & 15; return 8 * (i >> 2) + 4 * n + (i & 3); }
struct Unit { int pm, pn; };
struct Gemm { const bf16_t* A; const bf16_t* Bt; int M, N, K, lda; size_t a_gstride = 0; int g0 = 1 << 30, g1 = 1 << 30; };
struct StaticOrder {
    int nM, nN, nwg, G, c;
    __host__ __device__ void init(int M, int N, int G_, int c_) { nM = M / BM; nN = N / BM; nwg = nM * nN; G = G_; c = c_; }
    __host__ __device__ bool next(int i, Unit& u) const {
        const long L = (long)i * G + c; if (L >= nwg) return false;
        int wgid = (int)L; { const int q = nwg / NXCD, r = nwg % NXCD, xcd = wgid % NXCD, off = wgid / NXCD; wgid = (xcd < r ? xcd * (q + 1) : r * (q + 1) + (xcd - r) * q) + off; }
        const int nig = WGM * nN, gid = wgid / nig, fm = gid * WGM, gsz = (nM - fm) < WGM ? (nM - fm) : WGM;
        u.pm = fm + ((wgid % nig) % gsz); u.pn = (wgid % nig) / gsz; return true;
    }
    __device__ __forceinline__ void a_ready(const Unit&) const {}
    __device__ __forceinline__ void done(const Unit&) const {}
};

struct EpiSwiGLU {
    static constexpr bool PERM = true, AFTER_DRAIN = false;
    bf16_t* H; const float* rs;
    __device__ __forceinline__ void operator()(const f32x4 (&acc)[2][2][4][2], const Unit& u, int wr, int wc, int fr, int fq) const {
        const int row0 = u.pm * BM + wr * 64 + fr, col = u.pn * 128 + wc * 32 + 8 * fq;
#pragma unroll
        for (int ai = 0; ai < 2; ++ai)
#pragma unroll
            for (int m = 0; m < 4; ++m) { const int row = row0 + ai * HALF + m * 16; const float r = rs[row];
                const f32x4 g0 = acc[ai][0][m][0] * r, g1 = acc[ai][0][m][1] * r, u0 = acc[ai][1][m][0] * r, u1 = acc[ai][1][m][1] * r;
                u32x4 w;
                w.x = pk2(siluf_(g0[0]) * u0[0], siluf_(g0[1]) * u0[1]); w.y = pk2(siluf_(g0[2]) * u0[2], siluf_(g0[3]) * u0[3]);
                w.z = pk2(siluf_(g1[0]) * u1[0], siluf_(g1[1]) * u1[1]); w.w = pk2(siluf_(g1[2]) * u1[2], siluf_(g1[3]) * u1[3]);
                *(u32x4*)(H + (size_t)row * FF + col) = w;
            }
    }
};
struct EpiPlain {
    static constexpr bool PERM = true, AFTER_DRAIN = false;
    bf16_t* O; int ldc;
    __device__ __forceinline__ void operator()(const f32x4 (&acc)[2][2][4][2], const Unit& u, int wr, int wc, int fr, int fq) const {
        const int row0 = u.pm * BM + wr * 64 + fr, col0 = u.pn * BM + wc * 32 + 8 * fq;
#pragma unroll
        for (int ai = 0; ai < 2; ++ai)
#pragma unroll
            for (int m = 0; m < 4; ++m) { bf16_t* rowp = O + (size_t)(row0 + ai * HALF + m * 16) * ldc + col0;
#pragma unroll
                for (int bj = 0; bj < 2; ++bj) { const f32x4 v0 = acc[ai][bj][m][0], v1 = acc[ai][bj][m][1];
                    u32x4 w; w.x = pk2(v0[0], v0[1]); w.y = pk2(v0[2], v0[3]); w.z = pk2(v1[0], v1[1]); w.w = pk2(v1[2], v1[3]);
                    *(u32x4*)(rowp + bj * HALF) = w; } }
    }
};
struct EpiQKV {
    static constexpr bool PERM = true, AFTER_DRAIN = false;
    bf16_t* O; const f32x2* tab; const float* rs;
    __device__ __forceinline__ void operator()(const f32x4 (&acc)[2][2][4][2], const Unit& u, int wr, int wc, int fr, int fq) const {
        const int row0 = u.pm * BM + wr * 64 + fr, col0 = u.pn * BM + wc * 32 + 8 * fq;
        const bool rot = (u.pn < 16);
        f32x2 cs[2][4];
#pragma unroll
        for (int ai = 0; ai < 2; ++ai)
#pragma unroll
            for (int m = 0; m < 4; ++m) { cs[ai][m] = (f32x2){1.f, 0.f};
                if (rot) { const int row = row0 + ai * HALF + m * 16; const int pos = row < 32768 ? (row & 16383) : (row & 8191); cs[ai][m] = tab[pos * 16 + 4 * wc + fq]; } }
#pragma unroll
        for (int ai = 0; ai < 2; ++ai)
#pragma unroll
            for (int m = 0; m < 4; ++m) { const int row = row0 + ai * HALF + m * 16; bf16_t* rowp = O + (size_t)row * (3 * D) + col0; const f32x2 c = cs[ai][m]; const float r = rs[row];
#pragma unroll
                for (int bj = 0; bj < 2; ++bj) { const f32x4 v0 = acc[ai][bj][m][0] * r, v1 = acc[ai][bj][m][1] * r;
                    u32x4 w; w.x = pk2(v0[0] * c[0] - v0[1] * c[1], v0[0] * c[1] + v0[1] * c[0]); w.y = pk2(v0[2], v0[3]); w.z = pk2(v1[0], v1[1]); w.w = pk2(v1[2], v1[3]);
                    *(u32x4*)(rowp + bj * HALF) = w; } }
    }
};
struct EpiG1 {
    static constexpr bool PERM = true, AFTER_DRAIN = false;
    unsigned char* ws; size_t r_off, v_off, h_off; int mode;
    __device__ __forceinline__ void operator()(const f32x4 (&acc)[2][2][4][2], const Unit& u, int wr, int wc, int fr, int fq) const {
        const int row0 = u.pm * BM + wr * 64 + fr; const int t = u.pn >> 3;
        size_t off = r_off + (size_t)t * (192u << 20); int ldc = D, colt = (u.pn & 7) * BM, act = 0;
        if (t == 2) off = v_off;
        if (t >= 3) { off = h_off; ldc = HID; colt = 768; }
        if (mode == 1) { off = h_off; ldc = HID; colt = u.pn * BM; act = (u.pn == 0) ? 1 : ((u.pn == 2) ? 2 : 0); }
        bf16_t* base = (bf16_t*)(ws + off);
        const int col0 = colt + wc * 32 + 8 * fq;
#pragma unroll
        for (int ai = 0; ai < 2; ++ai)
#pragma unroll
            for (int m = 0; m < 4; ++m) { bf16_t* rowp = base + (size_t)(row0 + ai * HALF + m * 16) * ldc + col0;
#pragma unroll
                for (int bj = 0; bj < 2; ++bj) { f32x4 v0 = acc[ai][bj][m][0], v1 = acc[ai][bj][m][1];
                    if (act == 1) {
#pragma unroll
                        for (int j = 0; j < 4; ++j) { v0[j] = tanhf_(v0[j]); v1[j] = tanhf_(v1[j]); } }
                    if (act == 2) {
#pragma unroll
                        for (int j = 0; j < 4; ++j) { v0[j] = sigmoidf_(v0[j]); v1[j] = sigmoidf_(v1[j]); } }
                    u32x4 w; w.x = pk2(v0[0], v0[1]); w.y = pk2(v0[2], v0[3]); w.z = pk2(v1[0], v1[1]); w.w = pk2(v1[2], v1[3]);
                    *(u32x4*)(rowp + bj * HALF) = w; } }
    }
};
struct EpiVres {
    static constexpr bool PERM = true, AFTER_DRAIN = false;
    bf16_t* V; const bf16_t* VF; const float* v0;
    __device__ __forceinline__ void operator()(const f32x4 (&acc)[2][2][4][2], const Unit& u, int wr, int wc, int fr, int fq) const {
        const int row0 = u.pm * BM + wr * 64 + fr, col0 = u.pn * BM + wc * 32 + 8 * fq;
#pragma unroll
        for (int ai = 0; ai < 2; ++ai)
#pragma unroll
            for (int m = 0; m < 4; ++m) { const size_t ro = (size_t)(row0 + ai * HALF + m * 16) * D + col0;
#pragma unroll
                for (int bj = 0; bj < 2; ++bj) { const f32x4 a0 = acc[ai][bj][m][0], a1 = acc[ai][bj][m][1];
                    const u32x4 vv = *(const u32x4*)(V + ro + bj * HALF), vf = *(const u32x4*)(VF + ro + bj * HALF);
                    const f32x4 b0 = *(const f32x4*)(v0 + col0 + bj * HALF), b1 = *(const f32x4*)(v0 + col0 + bj * HALF + 4);
                    float o[8]; const unsigned vw[4] = {vv.x, vv.y, vv.z, vv.w}, fw[4] = {vf.x, vf.y, vf.z, vf.w};
#pragma unroll
                    for (int j = 0; j < 4; ++j) { const float g0 = sigmoidf_((j < 2 ? b0[2 * j] : b1[2 * j - 4]) + (j < 2 ? a0[2 * j] : a1[2 * j - 4]));
                        const float g1 = sigmoidf_((j < 2 ? b0[2 * j + 1] : b1[2 * j - 3]) + (j < 2 ? a0[2 * j + 1] : a1[2 * j - 3]));
                        const float x0 = bflo(vw[j]), x1 = bfhi(vw[j]), f0 = bflo(fw[j]), f1 = bfhi(fw[j]);
                        o[2 * j] = x0 + (f0 - x0) * g0; o[2 * j + 1] = x1 + (f1 - x1) * g1; }
                    u32x4 w; w.x = pk2(o[0], o[1]); w.y = pk2(o[2], o[3]); w.z = pk2(o[4], o[5]); w.w = pk2(o[6], o[7]);
                    *(u32x4*)(V + ro + bj * HALF) = w; } }
    }
};
struct EpiGmul {
    static constexpr bool PERM = true, AFTER_DRAIN = false;
    bf16_t* Y;
    __device__ __forceinline__ void operator()(const f32x4 (&acc)[2][2][4][2], const Unit& u, int wr, int wc, int fr, int fq) const {
        const int row0 = u.pm * BM + wr * 64 + fr, col0 = u.pn * BM + wc * 32 + 8 * fq;
#pragma unroll
        for (int ai = 0; ai < 2; ++ai)
#pragma unroll
            for (int m = 0; m < 4; ++m) { const size_t ro = (size_t)(row0 + ai * HALF + m * 16) * D + col0;
#pragma unroll
                for (int bj = 0; bj < 2; ++bj) { const f32x4 a0 = acc[ai][bj][m][0], a1 = acc[ai][bj][m][1];
                    const u32x4 y = *(const u32x4*)(Y + ro + bj * HALF);
                    u32x4 w; w.x = pk2(bflo(y.x) * a0[0], bfhi(y.x) * a0[1]); w.y = pk2(bflo(y.y) * a0[2], bfhi(y.y) * a0[3]);
                    w.z = pk2(bflo(y.z) * a1[0], bfhi(y.z) * a1[1]); w.w = pk2(bflo(y.w) * a1[2], bfhi(y.w) * a1[3]);
                    *(u32x4*)(Y + ro + bj * HALF) = w; } }
    }
};

template <class Epi, class Sched, bool ALIGN_EPI = false, bool SP2 = false>
__device__ __forceinline__ void gemm_phase(PG8_LAS unsigned char* lds, const Gemm g, const Sched& S, const Epi& E, const int tid) {
    const int wid = __builtin_amdgcn_readfirstlane(tid >> 6), lane = tid & 63, wr = wid >> 2, wc = wid & 3, fr = lane & 15, fq = lane >> 4;
    const int K = g.K, nt = K / BK, lda = g.lda;
    unsigned voffA[2], voffB[2];
#pragma unroll
    for (int i = 0; i < 2; ++i) { int R, C; stage_rc(tid * 16 + i * 8192, R, C); const int Rb = Epi::PERM ? ((R & ~31) + perm32(R & 31)) : R;
        voffA[i] = (unsigned)(R * lda + C) * 2u; voffB[i] = (unsigned)(Rb * K + C) * 2u; }
    const size_t kstep = (size_t)(BK * 2);
    const size_t hstepA = (size_t)HALF * lda * 2, hstepB = (size_t)HALF * K * 2;
    const size_t tstepA = 2 * hstepA, tstepB = 2 * hstepB;
    const unsigned ldsw = (unsigned)wid * 1024u;
    const int aoff = lds_byte(wr * 64 + fr, fq * 8), boff = lds_byte(wc * 32 + fr, fq * 8);
#define PG8_SA(b, h) (((b) * 2 + (h)) * HTB)
#define PG8_SB(b, h) ((4 + (b) * 2 + (h)) * HTB)
#define PG8_STAGE(bufoff, gbase, voff) do { _Pragma("unroll") for (int _i = 0; _i < 2; ++_i) \
        __builtin_amdgcn_global_load_lds((const unsigned*)((const char*)(gbase) + (voff)[_i]), (PG8_LAS unsigned*)(lds + (bufoff) + ldsw + _i * 8192), 16, 0, 0); } while (0)
#define PG8_LDA(dst, b, h) do { _Pragma("unroll") for (int m = 0; m < 4; ++m) _Pragma("unroll") for (int k = 0; k < 2; ++k) dst[m][k] = *(const PG8_LAS bf16x8*)(lds + PG8_SA(b, h) + aoff + m * 2048 + k * 1024); } while (0)
#define PG8_LDB(dst, b, h) do { _Pragma("unroll") for (int n = 0; n < 2; ++n) _Pragma("unroll") for (int k = 0; k < 2; ++k) dst[n][k] = *(const PG8_LAS bf16x8*)(lds + PG8_SB(b, h) + boff + n * 2048 + k * 1024); } while (0)
#define PG8_MMA(ai, bj, At, Bt) do { __builtin_amdgcn_s_setprio(1); _Pragma("unroll") for (int m = 0; m < 4; ++m) _Pragma("unroll") for (int n = 0; n < 2; ++n) _Pragma("unroll") for (int k = 0; k < 2; ++k) \
        acc[ai][bj][m][n] = __builtin_amdgcn_mfma_f32_16x16x32_bf16(Bt[n][k], At[m][k], acc[ai][bj][m][n], 0, 0, 0); __builtin_amdgcn_s_setprio(0); } while (0)
#define PG8_WAIT_V(n) asm volatile("s_waitcnt vmcnt(" #n ")" ::: "memory")
#define PG8_WAIT_L(n) asm volatile("s_waitcnt lgkmcnt(" #n ")" ::: "memory")
#define PG8_BAR __builtin_amdgcn_s_barrier()
#define PG8_SCHED __builtin_amdgcn_sched_barrier(0)
    Unit cur, nxt; int ui = 0;
    if (!S.next(0, cur)) return;
    f32x4 acc[2][2][4][2];
#pragma unroll
    for (int a = 0; a < 2; ++a)
#pragma unroll
        for (int b = 0; b < 2; ++b)
#pragma unroll
            for (int m = 0; m < 4; ++m)
#pragma unroll
                for (int n = 0; n < 2; ++n) acc[a][b][m][n] = (f32x4){0.f, 0.f, 0.f, 0.f};
    bf16x8 At[4][2], B0[2][2], B1[2][2];
    const char* cA = (const char*)g.A + (size_t)cur.pm * tstepA + (size_t)((cur.pn >= g.g0) + (cur.pn >= g.g1)) * g.a_gstride; const char* cB = (const char*)g.Bt + (size_t)cur.pn * tstepB;
    S.a_ready(cur);
    if constexpr (SP2) {
        PG8_STAGE(PG8_SB(0, 0), cB, voffB); PG8_STAGE(PG8_SB(0, 1), cB + hstepB, voffB); PG8_STAGE(PG8_SA(0, 0), cA, voffA); PG8_STAGE(PG8_SA(0, 1), cA + hstepA, voffA);
        if (wr == 1) PG8_BAR;
        PG8_WAIT_V(2); PG8_BAR;
        PG8_STAGE(PG8_SB(1, 0), cB + kstep, voffB); PG8_STAGE(PG8_SA(1, 0), cA + kstep, voffA); PG8_STAGE(PG8_SB(1, 1), cB + hstepB + kstep, voffB);
        PG8_WAIT_V(6); PG8_BAR;
    } else {
        PG8_STAGE(PG8_SB(0, 0), cB, voffB); PG8_STAGE(PG8_SA(0, 0), cA, voffA); PG8_STAGE(PG8_SB(0, 1), cB + hstepB, voffB); PG8_STAGE(PG8_SA(0, 1), cA + hstepA, voffA);
        if (wr == 1) PG8_BAR;
        PG8_WAIT_V(4); PG8_BAR;
        PG8_STAGE(PG8_SB(1, 0), cB + kstep, voffB); PG8_STAGE(PG8_SA(1, 0), cA + kstep, voffA); PG8_STAGE(PG8_SB(1, 1), cB + hstepB + kstep, voffB);
        PG8_WAIT_V(6); PG8_BAR;
    }
    for (;;) {
        const bool has_next = S.next(ui + 1, nxt);
        const char* nA = has_next ? (const char*)g.A + (size_t)nxt.pm * tstepA + (size_t)((nxt.pn >= g.g0) + (nxt.pn >= g.g1)) * g.a_gstride : cA; const char* nB = has_next ? (const char*)g.Bt + (size_t)nxt.pn * tstepB : cB;
        for (int t = 0; t < nt; t += 2) {
            const bool last = (t == nt - 2);
            const char* a1 = cA + (size_t)(t + 1) * kstep;
            const char* a2 = last ? nA : cA + (size_t)(t + 2) * kstep; const char* b2 = last ? nB : cB + (size_t)(t + 2) * kstep;
            const char* a3 = a2 + kstep; const char* b3 = b2 + kstep;
            if (last && has_next) S.a_ready(nxt);
            if constexpr (SP2) {
            PG8_LDB(B0, 0, 0); PG8_LDB(B1, 0, 1); PG8_SCHED; PG8_LDA(At, 0, 0); PG8_STAGE(PG8_SA(1, 1), a1 + hstepA, voffA);
            PG8_WAIT_V(8); PG8_WAIT_L(0); PG8_BAR; PG8_MMA(0, 0, At, B0); PG8_MMA(0, 1, At, B1); PG8_BAR; PG8_SCHED;
            PG8_LDA(At, 0, 1); PG8_STAGE(PG8_SB(0, 0), b2, voffB); PG8_STAGE(PG8_SB(0, 1), b2 + hstepB, voffB); PG8_STAGE(PG8_SA(0, 0), a2, voffA);
            PG8_WAIT_V(8); PG8_WAIT_L(0); PG8_BAR; PG8_MMA(1, 0, At, B0); PG8_MMA(1, 1, At, B1); PG8_BAR; PG8_SCHED;
            PG8_LDB(B0, 1, 0); PG8_LDB(B1, 1, 1); PG8_SCHED; PG8_LDA(At, 1, 0); PG8_STAGE(PG8_SA(0, 1), a2 + hstepA, voffA);
            PG8_WAIT_V(8); PG8_WAIT_L(0); PG8_BAR; PG8_MMA(0, 0, At, B0); PG8_MMA(0, 1, At, B1); PG8_BAR; PG8_SCHED;
            PG8_LDA(At, 1, 1); PG8_STAGE(PG8_SB(1, 0), b3, voffB); PG8_STAGE(PG8_SB(1, 1), b3 + hstepB, voffB); PG8_STAGE(PG8_SA(1, 0), a3, voffA);
            PG8_WAIT_V(8); PG8_WAIT_L(0); PG8_BAR; PG8_MMA(1, 0, At, B0); PG8_MMA(1, 1, At, B1); PG8_BAR; PG8_SCHED;
            } else {
            PG8_LDB(B0, 0, 0); PG8_SCHED; PG8_LDA(At, 0, 0); PG8_STAGE(PG8_SA(1, 1), a1 + hstepA, voffA);
            PG8_WAIT_L(8); PG8_BAR; PG8_WAIT_L(0); PG8_MMA(0, 0, At, B0); PG8_BAR; PG8_SCHED;
            PG8_LDB(B1, 0, 1); PG8_STAGE(PG8_SB(0, 0), b2, voffB);
            PG8_BAR; PG8_WAIT_L(0); PG8_MMA(0, 1, At, B1); PG8_BAR;
            PG8_LDA(At, 0, 1); PG8_STAGE(PG8_SA(0, 0), a2, voffA);
            PG8_BAR; PG8_WAIT_L(0); PG8_MMA(1, 0, At, B0); PG8_BAR; PG8_SCHED;
            PG8_STAGE(PG8_SB(0, 1), b2 + hstepB, voffB);
            PG8_WAIT_V(6); PG8_BAR; PG8_MMA(1, 1, At, B1); PG8_BAR;
            PG8_LDB(B0, 1, 0); PG8_SCHED; PG8_LDA(At, 1, 0); PG8_STAGE(PG8_SA(0, 1), a2 + hstepA, voffA);
            PG8_WAIT_L(8); PG8_BAR; PG8_WAIT_L(0); PG8_MMA(0, 0, At, B0); PG8_BAR; PG8_SCHED;
            PG8_LDB(B1, 1, 1); PG8_STAGE(PG8_SB(1, 0), b3, voffB);
            PG8_BAR; PG8_WAIT_L(0); PG8_MMA(0, 1, At, B1); PG8_BAR;
            PG8_LDA(At, 1, 1); PG8_STAGE(PG8_SA(1, 0), a3, voffA);
            PG8_BAR; PG8_WAIT_L(0); PG8_MMA(1, 0, At, B0); PG8_BAR; PG8_SCHED;
            PG8_STAGE(PG8_SB(1, 1), b3 + hstepB, voffB);
            PG8_WAIT_V(6); PG8_BAR; PG8_MMA(1, 1, At, B1); PG8_BAR;
            }
        }
        if constexpr (ALIGN_EPI) { if (wr == 0) PG8_BAR; }
        if constexpr (!Epi::AFTER_DRAIN) { E(acc, cur, wr, wc, fr, fq); S.done(cur); }
        if (!has_next) break;
#pragma unroll
        for (int a = 0; a < 2; ++a)
#pragma unroll
            for (int b = 0; b < 2; ++b)
#pragma unroll
                for (int m = 0; m < 4; ++m)
#pragma unroll
                    for (int n = 0; n < 2; ++n) acc[a][b][m][n] = (f32x4){0.f, 0.f, 0.f, 0.f};
        cur = nxt; cA = nA; cB = nB; ++ui;
        if constexpr (ALIGN_EPI) { if (wr == 1) PG8_BAR; }
    }
    PG8_WAIT_V(0);
    if constexpr (!ALIGN_EPI) { if (wr == 0) PG8_BAR; }
    PG8_BAR;
#undef PG8_SA
#undef PG8_SB
#undef PG8_STAGE
#undef PG8_LDA
#undef PG8_LDB
#undef PG8_MMA
#undef PG8_WAIT_V
#undef PG8_WAIT_L
#undef PG8_BAR
#undef PG8_SCHED
}
}

#define XB_TMO      128
#define XB_XCNT(j)  (256  + 64 * (j))
#define XB_XSUB(j)  (1280 + 64 * (j))
#define XB_XGEN(j)  (2304 + 64 * (j))
#define XB_TOP      3328
#define XB_TOPGEN   3392
#define XCD_BAR_WORDS 3456
#define XB_SPIN_CAP (1u << 22)
__device__ __forceinline__ unsigned xb_ld(unsigned* p)              { return __hip_atomic_load(p, __ATOMIC_RELAXED, __HIP_MEMORY_SCOPE_AGENT); }
__device__ __forceinline__ unsigned xb_add(unsigned* p, unsigned v) { return __hip_atomic_fetch_add(p, v, __ATOMIC_RELAXED, __HIP_MEMORY_SCOPE_AGENT); }
__device__ __forceinline__ unsigned xb_xcc_id() { return (unsigned)__builtin_amdgcn_s_getreg((3 << 11) | 20) & 0xFu; }
#define XB_SPIN(cond, bar) do { unsigned _sp = 0; while (cond) { __builtin_amdgcn_s_sleep(1); \
    if ((++_sp & 255u) == 0u) { if (xb_ld(&(bar)[XB_TMO])) break; if (_sp > XB_SPIN_CAP) { atomicAdd(&(bar)[XB_TMO], 1u); break; } } } } while (0)
struct XcdBarrier { unsigned* bar; unsigned x; volatile LAS unsigned* st; };
__device__ __forceinline__ XcdBarrier xcd_barrier_post(unsigned* bar, volatile LAS unsigned* st) {
    XcdBarrier b; b.bar = bar; b.x = xb_xcc_id(); b.st = st;
    if (threadIdx.x == 0) (void)xb_add(&bar[XB_XCNT(b.x)], 1u);
    return b;
}
__device__ __forceinline__ void xcd_barrier_complete(unsigned* bar, unsigned x, unsigned& nloc, unsigned& nx) {
    const unsigned G = gridDim.x * gridDim.y * gridDim.z;
    unsigned sum, cnt, mine, sp = 0u;
    for (;;) {
        sum = 0u; cnt = 0u; mine = 0u;
#pragma unroll
        for (unsigned j = 0; j < 16; ++j) { const unsigned c = xb_ld(&bar[XB_XCNT(j)]); sum += c; cnt += (c > 0u) ? 1u : 0u; mine = (j == x) ? c : mine; }
        if (sum == G) break;
        __builtin_amdgcn_s_sleep(1);
        if ((++sp & 255u) == 0u) { if (xb_ld(&bar[XB_TMO])) break; if (sp > XB_SPIN_CAP) { atomicAdd(&bar[XB_TMO], 1u); break; } }
    }
    nloc = mine > 0u ? mine : 1u; nx = cnt > 0u ? cnt : 1u;
}
__device__ __forceinline__ void xcd_barrier(const XcdBarrier& b) {
    asm volatile("s_waitcnt vmcnt(0)" ::: "memory");
    __syncthreads();
    if (threadIdx.x == 0) {
        unsigned* bar = b.bar;
        __builtin_amdgcn_s_waitcnt(0);
        unsigned nloc = b.st[0], nx = b.st[1];
        if (nloc == 0u) { xcd_barrier_complete(bar, b.x, nloc, nx); b.st[0] = nloc; b.st[1] = nx; }
        const unsigned old = xb_add(&bar[XB_XSUB(b.x)], 1u);
        const unsigned gen = old / nloc;
        if (old + 1u == (gen + 1u) * nloc) {
            __builtin_amdgcn_fence(__ATOMIC_RELEASE, "agent");
            asm volatile("s_waitcnt vmcnt(0)" ::: "memory");
            const unsigned og = xb_add(&bar[XB_TOP], 1u);
            const unsigned tg = og / nx;
            if (og + 1u == (tg + 1u) * nx) xb_add(&bar[XB_TOPGEN], 1u);
            else XB_SPIN(xb_ld(&bar[XB_TOPGEN]) == tg, bar);
            __builtin_amdgcn_fence(__ATOMIC_ACQUIRE, "agent");
            xb_add(&bar[XB_XGEN(b.x)], 1u);
            asm volatile("s_waitcnt vmcnt(0)" ::: "memory");
        } else {
            XB_SPIN(xb_ld(&bar[XB_XGEN(b.x)]) == gen, bar);
            __builtin_amdgcn_fence(__ATOMIC_ACQUIRE, "agent");
            asm volatile("s_waitcnt vmcnt(0)" ::: "memory");
        }
    }
    __syncthreads();
}

constexpr size_t MiB = 1u << 20;
constexpr size_t WS_CTL = 0, CTL_ZERO_BYTES = 1 * MiB;
constexpr size_t WS_ROPE = 1 * MiB;
constexpr size_t WS_WTS = 4 * MiB;
constexpr size_t W_UP0 = WS_WTS, W_DN0 = WS_WTS + 44 * MiB, W_UP1 = WS_WTS + 66 * MiB, W_DN1 = WS_WTS + 110 * MiB;
constexpr size_t W_MIX = WS_WTS + 132 * MiB;
constexpr size_t W_G2 = W_MIX + 25 * MiB, W_GG = W_MIX + 28 * MiB, W_GV = W_MIX + 29 * MiB;
constexpr size_t W_GO = WS_WTS + 212 * MiB;
constexpr size_t WS_VF = 228 * MiB;
constexpr size_t WS_POOL = 420 * MiB;
constexpr size_t P_XN = WS_POOL;
constexpr size_t P_H = WS_POOL + 192 * MiB, P_HOUT = WS_POOL + 720 * MiB;
constexpr size_t P_MIX = WS_POOL + 192 * MiB;
constexpr size_t P_YF = WS_POOL + 192 * MiB, P_YB = WS_POOL + 384 * MiB, P_R = WS_POOL + 768 * MiB, P_K = WS_POOL + 960 * MiB, P_V = WS_POOL + 1152 * MiB,
                 P_HID = WS_POOL + 1344 * MiB, P_BS = WS_POOL + 1440 * MiB;
constexpr size_t P_QKV = WS_POOL + 192 * MiB, P_O0 = WS_POOL + 768 * MiB, P_LSE = WS_POOL + 1344 * MiB;
constexpr size_t WS_END = WS_POOL + 1452 * MiB;
constexpr int CW_BAR = 4096;
constexpr size_t WS_SCANFLAG = 512 * 1024;
constexpr int SCAN_NH = 63;
constexpr int SCAN_DUMP_U = 4592, SCAN_SLOT = 73728, SCAN_SLOTS_OUT = 5461;
constexpr size_t WS_RSX = 65536;

constexpr int RING_BYTES = 131072, CTRL_OFF = 143360, MISC_OFF = CTRL_OFF + 256, LDS_BYTES = 163840;
constexpr int NWAVES = 8;

struct Args { const float* in[28]; float* out; unsigned char* ws; int step_lo, step_hi; };

struct Seg { unsigned long long woff, soff, doff; int widx, sidx, ldw, col0, ldt, row0, k0dst, nkb, nnb, ilv, item0, pad0; };
__device__ __forceinline__ void seg_add(LAS Seg* s, int& n, int& items, int widx, size_t woff, int sidx, size_t soff, size_t doff, int ldw, int col0, int ldt, int row0, int k0dst, int nkb, int nnb, int ilv) {
    s[n].widx = widx; s[n].woff = woff; s[n].sidx = sidx; s[n].soff = soff; s[n].doff = doff; s[n].ldw = ldw; s[n].col0 = col0; s[n].ldt = ldt; s[n].row0 = row0; s[n].k0dst = k0dst; s[n].nkb = nkb; s[n].nnb = nnb; s[n].ilv = ilv; s[n].item0 = items;
    items += nkb * nnb; ++n;
}

extern __shared__ __attribute__((aligned(16))) unsigned char lds_raw[];
constexpr int PTR_OFF = CTRL_OFF + 512;
__device__ __forceinline__ unsigned long long ptr_ld(int i) {
    const LAS unsigned* p = (const LAS unsigned*)((LAS unsigned char*)lds_raw + PTR_OFF) + 2 * i;
    const unsigned lo = __builtin_amdgcn_readfirstlane(p[0]), hi = __builtin_amdgcn_readfirstlane(p[1]);
    return ((unsigned long long)hi << 32) | lo;
}
__device__ __forceinline__ const float* inp(int i) { return (const float*)(const GAS float*)ptr_ld(i); }
__device__ __forceinline__ float* outp() { return (float*)(GAS float*)ptr_ld(28); }
__device__ __forceinline__ unsigned char* wsp() { return (unsigned char*)(GAS unsigned char*)ptr_ld(29); }
#define FRAME() LAS unsigned char* lds = (LAS unsigned char*)lds_raw; int tid = threadIdx.x; asm volatile("" : "+v"(tid)); const int lane = tid & 63, wave = __builtin_amdgcn_readfirstlane(tid >> 6); \
    int bid_ = blockIdx.x, G = gridDim.x; asm volatile("" : "+s"(bid_), "+s"(G)); const int gw = bid_ * NWAVES + wave, NGW = G * NWAVES; unsigned char* ws = wsp(); (void)lds; (void)lane; (void)gw; (void)NGW; (void)ws; (void)G

static __device__ PHASE_ATTR void ph_init() {
    FRAME();
    const float* in0 = inp(0); const float* in1 = inp(1);
    {
        f32x2* tab = (f32x2*)(ws + WS_ROPE);
        for (int idx = bid_ * 512 + tid; idx < 16384 * 16; idx += G * 512) {
            const int pos = idx >> 4, i = idx & 15;
            double iv = 1.0;
            iv = (i == 1) ? 0.44036660267178046 : iv; iv = (i == 2) ? 0.19392274474868576 : iv; iv = (i == 3) ? 0.08539710028576561 : iv; iv = (i == 4) ? 0.03760603093086393 : iv;
            iv = (i == 5) ? 0.016560440080994446 : iv; iv = (i == 6) ? 0.007292664737217109 : iv; iv = (i == 7) ? 0.003211445994752591 : iv; iv = (i == 8) ? 0.001414213562373095 : iv;
            iv = (i == 9) ? 0.000622772421914596 : iv; iv = (i == 10) ? 0.0002742481756762073 : iv; iv = (i == 11) ? 0.00012076973741146504 : iv; iv = (i == 12) ? 5.318295896944988e-05 : iv;
            iv = (i == 13) ? 2.341999896140934e-05 : iv; iv = (i == 14) ? 1.031338537721246e-05 : iv; iv = (i == 15) ? 4.5416704806078695e-06 : iv;
            double t = (double)pos * iv * 0.15915494309189535; t = t - __builtin_rint(t);
            const float tf = (float)t;
            tab[idx] = (f32x2){__builtin_amdgcn_cosf(tf), __builtin_amdgcn_sinf(tf)};
        }
    }
    bf16_t* XB = (bf16_t*)(ws + P_XN); float* RSX = (float*)(ws + WS_RSX);
    for (int row = gw; row < TT; row += NGW) {
        const float* src = row < 32768 ? in0 + (size_t)row * D : in1 + (size_t)(row - 32768) * D;
        float ss = 0.f;
#pragma unroll
        for (int i = 0; i < 4; ++i) { const int e = 8 * (lane + 64 * i); const f32x4 a = *(const f32x4*)(src + e), b = *(const f32x4*)(src + e + 4);
#pragma unroll
            for (int j = 0; j < 4; ++j) ss += a[j] * a[j] + b[j] * b[j];
            *(u32x4*)(XB + (size_t)row * D + e) = (u32x4){pk2(a[0], a[1]), pk2(a[2], a[3]), pk2(b[0], b[1]), pk2(b[2], b[3])}; }
        const float rx = rsqrtf(wave_sum(ss) * (1.0f / D) + NORM_EPS);
        if (lane == 0) RSX[row] = rx;
    }
}

__device__ __forceinline__ void conv_load(const LAS Seg* sp, int local, int lane, f32x4 (&v)[8]) {
    const int widx = sp->widx; if (widx < 0) return;
    const int ldw = sp->ldw, nnb = sp->nnb, kb = local / nnb, nb = local % nnb;
    const float* p = inp(widx) + sp->woff + (size_t)(64 * kb + (lane >> 3)) * ldw + sp->col0 + 32 * nb + 4 * (lane & 7);
#pragma unroll
    for (int i = 0; i < 8; ++i) v[i] = *(const f32x4*)(p + (size_t)(8 * i) * ldw);
}
__device__ __forceinline__ void conv_finish(const LAS Seg* sp, int local, LAS float* scr, int lane, const f32x4 (&v)[8], unsigned char* ws) {
    const int widx = sp->widx, sidx = sp->sidx, ldt = sp->ldt, row0 = sp->row0, k0dst = sp->k0dst, nnb = sp->nnb, ilv = sp->ilv;
    bf16_t* dst = (bf16_t*)(ws + sp->doff);
    const int kb = local / nnb, nb = local % nnb, k0 = 64 * kb, n0 = 32 * nb, c = lane & 7;
    if (widx >= 0) {
        const float* scale = sidx >= 0 ? inp(sidx) + sp->soff + k0 + (lane >> 3) : nullptr;
#pragma unroll
        for (int i = 0; i < 8; ++i) { const int kk = (lane >> 3) + 8 * i; const float sc = scale ? scale[8 * i] : 1.0f;
            LAS float* s = scr + kk * 33 + 4 * (lane & 7); s[0] = v[i][0] * sc; s[1] = v[i][1] * sc; s[2] = v[i][2] * sc; s[3] = v[i][3] * sc; }
        asm volatile("s_waitcnt lgkmcnt(0)" ::: "memory");
    }
#pragma unroll
    for (int j = 0; j < 4; ++j) { const int n = (lane >> 3) + 8 * j; const int nn = n0 + n;
        int drow = row0 + ((ilv == 1) ? (256 * (nn >> 7) + (nn & 127)) : nn);
        if (ilv == 2 && ((nn >> 11) % 3) < 2) {
            const int co = nn & 127;
            const int nl = co < 32 ? (8 * (co & 15) + (co >> 4)) : (8 * ((co - 32) / 6) + 2 + (co - 32) % 6);
            drow = row0 + (nn & ~127) + nl; }
        u32x4 o = {0u, 0u, 0u, 0u};
        if (widx >= 0) { const LAS float* s = scr + (8 * c) * 33 + n;
            o.x = pk2(s[0 * 33], s[1 * 33]); o.y = pk2(s[2 * 33], s[3 * 33]); o.z = pk2(s[4 * 33], s[5 * 33]); o.w = pk2(s[6 * 33], s[7 * 33]); }
        *(u32x4*)(dst + (size_t)drow * ldt + k0dst + k0 + 8 * c) = o; }
    asm volatile("s_waitcnt lgkmcnt(0)" ::: "memory");
}
static __device__ PHASE_ATTR void ph_conv(int L) {
    FRAME();
    const int jm = L >> 1; const bool is_attn = (L & 1) != 0;
    LAS Seg* segs = (LAS Seg*)lds; LAS int* nseg_p = (LAS int*)(lds + 4096); LAS float* scr = (LAS float*)(lds + 8192 + wave * 8448);
    if (tid == 0) {
        int n = 0, items = 0;
        for (int f = 0; f < 2; ++f) {
            const size_t wo = (size_t)(L * 2 + f) * D * FF;
            const size_t up = f ? W_UP1 : W_UP0, dn = f ? W_DN1 : W_DN0;
            seg_add(segs, n, items, 4, wo, 2, (size_t)(L * 3 + 2 * f) * D, up, FF, 0, D, 0, 0, D / 64, FF / 32, 1);
            seg_add(segs, n, items, 5, wo, 2, (size_t)(L * 3 + 2 * f) * D, up, FF, 0, D, 128, 0, D / 64, FF / 32, 1);
            seg_add(segs, n, items, 6, wo, -1, 0, dn, D, 0, FF, 0, 0, FF / 64, D / 32, 0);
        }
        if (!is_attn) {
            for (int p = 0; p < 3; ++p) seg_add(segs, n, items, 8, (size_t)(jm * 3 + p) * D * D, -1, 0, W_MIX, D, 0, D, p * D, 0, D / 64, D / 32, 0);
            if (jm > 0) { seg_add(segs, n, items, 16, (size_t)(jm - 1) * D * 64, -1, 0, W_MIX, 64, 0, D, 3 * D, 0, D / 64, 2, 0);
                          seg_add(segs, n, items, -1, 0, -1, 0, W_MIX, 0, 0, D, 3 * D + 64, 0, D / 64, 6, 0);
                          seg_add(segs, n, items, 17, (size_t)(jm - 1) * 64 * D, -1, 0, W_GV, D, 0, 256, 0, 0, 1, D / 32, 0);
                          seg_add(segs, n, items, -1, 0, -1, 0, W_GV, 0, 0, 256, 0, 64, 3, D / 32, 0); }
            else seg_add(segs, n, items, -1, 0, -1, 0, W_MIX, 0, 0, D, 3 * D, 0, D / 64, 8, 0);
            for (int d = 0; d < 2; ++d) {
                seg_add(segs, n, items, 10, (size_t)(jm * 2 + d) * D * 96, -1, 0, W_G2, 96, 0, D, d * 128, 0, D / 64, 3, 0);
                seg_add(segs, n, items, -1, 0, -1, 0, W_G2, 0, 0, D, d * 128 + 96, 0, D / 64, 1, 0);
                seg_add(segs, n, items, 13, (size_t)(jm * 2 + d) * D * 96, -1, 0, W_G2, 96, 0, D, 256 + d * 128, 0, D / 64, 3, 0);
                seg_add(segs, n, items, -1, 0, -1, 0, W_G2, 0, 0, D, 256 + d * 128 + 96, 0, D / 64, 1, 0);
            }
            seg_add(segs, n, items, 18, (size_t)jm * D * 256, -1, 0, W_G2, 256, 0, D, 512, 0, D / 64, 8, 0);
            seg_add(segs, n, items, 19, (size_t)jm * 256 * D, -1, 0, W_GG, D, 0, 256, 0, 0, 4, D / 32, 0);
            seg_add(segs, n, items, 25, (size_t)jm * D * D, -1, 0, W_GO, D, 0, D, 0, 0, D / 64, D / 32, 0);
        } else {
            seg_add(segs, n, items, 26, (size_t)jm * D * 9 * D, 2, (size_t)(L * 3 + 1) * D, W_MIX, 9 * D, 0, D, 0, 0, D / 64, 9 * D / 32, 2);
            seg_add(segs, n, items, 27, (size_t)jm * D * D, -1, 0, W_GO, D, 0, D, 0, 0, D / 64, D / 32, 0);
        }
        segs[n].item0 = items; nseg_p[0] = n; nseg_p[1] = items;
    }
    __syncthreads();
    const int total = nseg_p[1];
    f32x4 cur[8], nxt[8];
#pragma unroll
    for (int i = 0; i < 8; ++i) { cur[i] = (f32x4){0.f, 0.f, 0.f, 0.f}; nxt[i] = cur[i]; }
    int it = gw, si = 0;
    if (it < total) { while (it >= segs[si + 1].item0) ++si; conv_load(segs + si, it - segs[si].item0, lane, cur); }
    while (it < total) {
        const int itn = it + NGW; int sn = si;
        if (itn < total) { while (itn >= segs[sn + 1].item0) ++sn; conv_load(segs + sn, itn - segs[sn].item0, lane, nxt); }
        conv_finish(segs + si, it - segs[si].item0, scr, lane, cur, ws);
#pragma unroll
        for (int i = 0; i < 8; ++i) cur[i] = nxt[i];
        it = itn; si = sn;
    }
    __syncthreads();
}

static __device__ PHASE_ATTR void ph_ffn_up(int f) {
    FRAME();
    pg8::Gemm g{(const bf16_t*)(ws + P_XN), (const bf16_t*)(ws + (f ? W_UP1 : W_UP0)), TT, 2 * FF, D, D}; pg8::StaticOrder S; S.init(TT, 2 * FF, G, bid_);
    pg8::EpiSwiGLU E{(bf16_t*)(ws + P_H), (const float*)(ws + WS_RSX)};
    pg8::gemm_phase<pg8::EpiSwiGLU, pg8::StaticOrder, true, true>(lds, g, S, E, tid);
}
static __device__ PHASE_ATTR void ph_gemm_plain(size_t a_off, int lda, size_t b_off, int N, int K, size_t o_off, int ldc) {
    FRAME();
    pg8::Gemm g{(const bf16_t*)(ws + a_off), (const bf16_t*)(ws + b_off), TT, N, K, lda}; pg8::StaticOrder S; S.init(TT, N, G, bid_);
    pg8::EpiPlain E{(bf16_t*)(ws + o_off), ldc};
    pg8::gemm_phase<pg8::EpiPlain, pg8::StaticOrder, true, true>(lds, g, S, E, tid);
}
static __device__ PHASE_ATTR void ph_qkv(int gi) {
    FRAME();
    pg8::Gemm g{(const bf16_t*)(ws + P_XN), (const bf16_t*)(ws + W_MIX) + (size_t)gi * 3 * D * D, TT, 3 * D, D, D}; pg8::StaticOrder S; S.init(TT, 3 * D, G, bid_);
    pg8::EpiQKV E{(bf16_t*)(ws + P_QKV), (const f32x2*)(ws + WS_ROPE), (const float*)(ws + WS_RSX)};
    pg8::gemm_phase<pg8::EpiQKV, pg8::StaticOrder, true, true>(lds, g, S, E, tid);
}
static __device__ PHASE_ATTR void ph_g1(int jm, int round) {
    FRAME();
    pg8::Gemm g{(const bf16_t*)(ws + P_MIX), (const bf16_t*)(ws + (round ? W_G2 : W_MIX)), TT, round ? NG2 : NG1, D, D, (size_t)192 * MiB, round ? 1 : 8, round ? 2 : 16};
    pg8::StaticOrder S; S.init(TT, round ? NG2 : NG1, G, bid_);
    pg8::EpiG1 E{ws, P_R, (jm == 0 ? WS_VF : P_V), P_HID, round};
    pg8::gemm_phase<pg8::EpiG1, pg8::StaticOrder, true, true>(lds, g, S, E, tid);
}
static __device__ PHASE_ATTR void ph_gv(int jm) {
    FRAME();
    pg8::Gemm g{(const bf16_t*)(ws + P_HID) + 768, (const bf16_t*)(ws + W_GV), TT, D, 256, HID}; pg8::StaticOrder S; S.init(TT, D, G, bid_);
    pg8::EpiVres E{(bf16_t*)(ws + P_V), (const bf16_t*)(ws + WS_VF), inp(15) + (size_t)(jm - 1) * D};
    pg8::gemm_phase<pg8::EpiVres, pg8::StaticOrder, true, true>(lds, g, S, E, tid);
}
static __device__ PHASE_ATTR void ph_gg() {
    FRAME();
    pg8::Gemm g{(const bf16_t*)(ws + P_HID) + 512, (const bf16_t*)(ws + W_GG), TT, D, 256, HID}; pg8::StaticOrder S; S.init(TT, D, G, bid_);
    pg8::EpiGmul E{(bf16_t*)(ws + P_YF)};
    pg8::gemm_phase<pg8::EpiGmul, pg8::StaticOrder, true, true>(lds, g, S, E, tid);
}

static __device__ PHASE_ATTR void ph_mix(int jm, int round) {
    FRAME();
    const bf16_t* XB = (const bf16_t*)(ws + P_XN); const float* RSX = (const float*)(ws + WS_RSX); bf16_t* MX = (bf16_t*)(ws + P_MIX);
    const float* mu = inp(7) + (size_t)jm * 6 * D; const float* gpre = inp(2) + (size_t)((2 * jm) * 3 + 1) * D;
    const int m0 = round ? 1 : 0, m1 = round ? 4 : 2, m2 = round ? 5 : 3;
    u32x4 cq[4], pq[4], nq[4]; float rcq, rpq, rnq;
#define MIX_LOAD(row_) do { const int r_ = (row_); int base_, pos_, len_; row_decode(r_, base_, pos_, len_); const bf16_t* a_ = XB + (size_t)r_ * D; \
        rcq = RSX[r_]; rpq = pos_ > 0 ? RSX[r_ - 1] : 0.f; rnq = pos_ < len_ - 1 ? RSX[r_ + 1] : 0.f; \
        _Pragma("unroll") for (int i = 0; i < 4; ++i) { const int e = 8 * (lane + 64 * i); cq[i] = *(const u32x4*)(a_ + e); pq[i] = (u32x4){0u, 0u, 0u, 0u}; nq[i] = (u32x4){0u, 0u, 0u, 0u}; \
            if (pos_ > 0) pq[i] = *(const u32x4*)(a_ - D + e); if (pos_ < len_ - 1) nq[i] = *(const u32x4*)(a_ + D + e); } } while (0)
    int row = gw;
    if (row < TT) MIX_LOAD(row);
    for (; row < TT; row += NGW) {
        u32x4 cc[4], pc[4], nc[4];
#pragma unroll
        for (int i = 0; i < 4; ++i) { cc[i] = cq[i]; pc[i] = pq[i]; nc[i] = nq[i]; }
        const float rc = rcq, rp = rpq, rn = rnq;
        if (row + NGW < TT) MIX_LOAD(row + NGW);
#pragma unroll
        for (int i = 0; i < 4; ++i) { const int e = 8 * (lane + 64 * i);
            const unsigned cw[4] = {cc[i].x, cc[i].y, cc[i].z, cc[i].w}, pw[4] = {pc[i].x, pc[i].y, pc[i].z, pc[i].w}, nw[4] = {nc[i].x, nc[i].y, nc[i].z, nc[i].w};
            const f32x4 ga = *(const f32x4*)(gpre + e), gb = *(const f32x4*)(gpre + e + 4);
            float cv[8], xx[8];
#pragma unroll
            for (int j = 0; j < 4; ++j) { const float g0 = j < 2 ? ga[2 * j] : gb[2 * j - 4], g1 = j < 2 ? ga[2 * j + 1] : gb[2 * j - 3];
                cv[2 * j] = bflo(cw[j]) * rc * g0; cv[2 * j + 1] = bfhi(cw[j]) * rc * g1;
                xx[2 * j] = 0.5f * (bflo(pw[j]) * rp + bflo(nw[j]) * rn) * g0 - cv[2 * j]; xx[2 * j + 1] = 0.5f * (bfhi(pw[j]) * rp + bfhi(nw[j]) * rn) * g1 - cv[2 * j + 1]; }
#pragma unroll
            for (int m = 0; m < 3; ++m) { const int mi = m == 0 ? m0 : (m == 1 ? m1 : m2);
                const f32x4 ma = *(const f32x4*)(mu + mi * D + e), mb = *(const f32x4*)(mu + mi * D + e + 4);
                const u32x4 o = {pk2(cv[0] + xx[0] * ma[0], cv[1] + xx[1] * ma[1]), pk2(cv[2] + xx[2] * ma[2], cv[3] + xx[3] * ma[3]), pk2(cv[4] + xx[4] * mb[0], cv[5] + xx[5] * mb[1]), pk2(cv[6] + xx[6] * mb[2], cv[7] + xx[7] * mb[3])};
                *(u32x4*)(MX + (size_t)m * TT * D + (size_t)row * D + e) = o; }
        }
    }
#undef MIX_LOAD
}

static __device__ __forceinline__ void scan_stage_e(LAS unsigned char* lds, f32x4 (&ST)[4], const int lane, const int vb) {
    constexpr int RS = 72;
    LAS bf16_t* AH = (LAS bf16_t*)(lds); LAS bf16_t* RH = (LAS bf16_t*)(lds + 9216); LAS bf16_t* BT = (LAS bf16_t*)(lds + 36864); LAS bf16_t* YS = (LAS bf16_t*)(lds + 64512);
    LAS unsigned char* KVI = lds + 73728; LAS unsigned char* MAKV = lds + 90112; LAS unsigned char* NRKV = lds + 98304;
    LAS unsigned char* MABF = lds + 108544; LAS unsigned char* NRBF = lds + 112640; LAS bf16_t* TTI = (LAS bf16_t*)(lds + 122880); LAS float* GL = (LAS float*)(lds + 125440);
    const int c15 = lane & 15, g = lane >> 4; const f32x4 zero4 = {0.f, 0.f, 0.f, 0.f};
#define PK_LO(x) __builtin_bit_cast(bf16x8, (u32x4){pk2((x)[0], (x)[1]), pk2((x)[2], (x)[3]), 0u, 0u})
#define PK_2(x, y) __builtin_bit_cast(bf16x8, (u32x4){pk2((x)[0], (x)[1]), pk2((x)[2], (x)[3]), pk2((y)[0], (y)[1]), pk2((y)[2], (y)[3])})
#define ROWFRAG(P) __builtin_bit_cast(bf16x8, (u32x4){(P)[0].x, (P)[0].y, (P)[1].x, (P)[1].y})
                u32x2 ahq[4][4], mkq[4];
#pragma unroll
                for (int tb = 0; tb < 4; ++tb) { const LAS bf16_t* ap = AH + (16 * tb + c15) * RS + 4 * g;
#pragma unroll
                    for (int q = 0; q < 4; ++q) ahq[tb][q] = *(const LAS u32x2*)(ap + 16 * q);
                    mkq[tb] = *(const LAS u32x2*)(MAKV + ((tb * 4 + vb) * 64 + lane) * 8); }
                const u32x4 Sf0 = {pk2(ST[0][0], ST[0][1]), pk2(ST[0][2], ST[0][3]), pk2(ST[1][0], ST[1][1]), pk2(ST[1][2], ST[1][3])};
                const u32x4 Sf1 = {pk2(ST[2][0], ST[2][1]), pk2(ST[2][2], ST[2][3]), pk2(ST[3][0], ST[3][1]), pk2(ST[3][2], ST[3][3])};
                __builtin_amdgcn_sched_barrier(0);
                u32x2 tfq[4]; bf16x8 mf[4];
#pragma unroll
                for (int tb = 0; tb < 4; ++tb) { tfq[tb] = *(const LAS u32x2*)(TTI + (tb * 16 + c15) * 20 + 4 * g); mf[tb] = *(const LAS bf16x8*)(MABF + (tb * 64 + lane) * 16); }
                f32x4 U[4];
#pragma unroll
                for (int tb = 0; tb < 4; ++tb) {
                    f32x4 acc = {bflo(mkq[tb].x), bfhi(mkq[tb].x), bflo(mkq[tb].y), bfhi(mkq[tb].y)};
                    acc = __builtin_amdgcn_mfma_f32_16x16x32_bf16(ROWFRAG(ahq[tb]), __builtin_bit_cast(bf16x8, Sf0), acc, 0, 0, 0);
                    acc = __builtin_amdgcn_mfma_f32_16x16x32_bf16(ROWFRAG(ahq[tb] + 2), __builtin_bit_cast(bf16x8, Sf1), acc, 0, 0, 0);
                    U[tb] = acc; }
                __builtin_amdgcn_sched_barrier(0);
                u32x2 rhq[4][4], nkq[4];
#pragma unroll
                for (int tb = 0; tb < 4; ++tb) { const LAS bf16_t* rp = RH + (16 * tb + c15) * RS + 4 * g;
#pragma unroll
                    for (int q = 0; q < 4; ++q) rhq[tb][q] = *(const LAS u32x2*)(rp + 16 * q);
                    nkq[tb] = *(const LAS u32x2*)(NRKV + ((tb * 4 + vb) * 64 + lane) * 8); }
                f32x4 Y1[4];
#pragma unroll
                for (int tb = 0; tb < 4; ++tb) {
                    f32x4 acy = {bflo(nkq[tb].x), bfhi(nkq[tb].x), bflo(nkq[tb].y), bfhi(nkq[tb].y)};
                    acy = __builtin_amdgcn_mfma_f32_16x16x32_bf16(ROWFRAG(rhq[tb]), __builtin_bit_cast(bf16x8, Sf0), acy, 0, 0, 0);
                    acy = __builtin_amdgcn_mfma_f32_16x16x32_bf16(ROWFRAG(rhq[tb] + 2), __builtin_bit_cast(bf16x8, Sf1), acy, 0, 0, 0);
                    Y1[tb] = acy; }
                const bf16x8 tf0 = __builtin_bit_cast(bf16x8, (u32x4){tfq[0].x, tfq[0].y, 0u, 0u}), tf1 = __builtin_bit_cast(bf16x8, (u32x4){tfq[1].x, tfq[1].y, 0u, 0u});
                const bf16x8 tf2 = __builtin_bit_cast(bf16x8, (u32x4){tfq[2].x, tfq[2].y, 0u, 0u}), tf3 = __builtin_bit_cast(bf16x8, (u32x4){tfq[3].x, tfq[3].y, 0u, 0u});
                f32x4 SA0 = __builtin_amdgcn_mfma_f32_16x16x32_bf16(tf0, PK_LO(U[0]), zero4, 0, 0, 0);
                f32x4 rhs = __builtin_amdgcn_mfma_f32_16x16x32_bf16(mf[0], PK_LO(SA0), U[1], 0, 0, 0);
                f32x4 SA1 = __builtin_amdgcn_mfma_f32_16x16x32_bf16(tf1, PK_LO(rhs), zero4, 0, 0, 0);
                const bf16x8 SAf0 = PK_2(SA0, SA1);
                rhs = __builtin_amdgcn_mfma_f32_16x16x32_bf16(mf[1], SAf0, U[2], 0, 0, 0);
                f32x4 SA2 = __builtin_amdgcn_mfma_f32_16x16x32_bf16(tf2, PK_LO(rhs), zero4, 0, 0, 0);
                rhs = __builtin_amdgcn_mfma_f32_16x16x32_bf16(mf[2], SAf0, U[3], 0, 0, 0);
                rhs = __builtin_amdgcn_mfma_f32_16x16x32_bf16(mf[3], PK_LO(SA2), rhs, 0, 0, 0);
                f32x4 SA3 = __builtin_amdgcn_mfma_f32_16x16x32_bf16(tf3, PK_LO(rhs), zero4, 0, 0, 0);
                const bf16x8 SAf1 = PK_2(SA2, SA3);
                __builtin_amdgcn_sched_barrier(0);
                bf16x8 nrf[6];
#pragma unroll
                for (int i = 0; i < 6; ++i) nrf[i] = *(const LAS bf16x8*)(NRBF + (i * 64 + lane) * 16);
                f32x4 kvq[4], glq[4]; u32x2 btq[4][4];
#pragma unroll
                for (int kb = 0; kb < 4; ++kb) { const LAS bf16_t* bp = BT + (16 * kb + c15) * RS + 4 * g;
#pragma unroll
                    for (int q = 0; q < 4; ++q) btq[kb][q] = *(const LAS u32x2*)(bp + 16 * q);
                    kvq[kb] = *(const LAS f32x4*)(KVI + ((kb * 4 + vb) * 64 + lane) * 16); glq[kb] = *(const LAS f32x4*)(GL + 16 * kb + 4 * g); }
#pragma unroll
                for (int tb = 0; tb < 4; ++tb) { const int nb = tb == 0 ? 0 : (tb == 1 ? 1 : (tb == 2 ? 2 : 4));
                    f32x4 acc = __builtin_amdgcn_mfma_f32_16x16x32_bf16(nrf[nb], SAf0, Y1[tb], 0, 0, 0);
                    if (tb >= 2) acc = __builtin_amdgcn_mfma_f32_16x16x32_bf16(nrf[nb + 1], SAf1, acc, 0, 0, 0);
#pragma unroll
                    for (int r = 0; r < 4; ++r) YS[(16 * tb + 4 * g + r) * RS + 16 * vb + c15] = (bf16_t)(pk2(acc[r], 0.f) & 0xffffu); }
#pragma unroll
                for (int kb = 0; kb < 4; ++kb) { f32x4 acc = kvq[kb];
                    acc = __builtin_amdgcn_mfma_f32_16x16x32_bf16(ROWFRAG(btq[kb]), SAf0, acc, 0, 0, 0);
                    acc = __builtin_amdgcn_mfma_f32_16x16x32_bf16(ROWFRAG(btq[kb] + 2), SAf1, acc, 0, 0, 0);
                    ST[kb] = glq[kb] * (ST[kb] + acc); }
#undef ROWFRAG
#undef PK_LO
#undef PK_2
}

constexpr float NLOG2E = -1.4426950408889634f;
template <int CTRL> __device__ __forceinline__ float dpp_row_shr(float v) { return __builtin_bit_cast(float, __builtin_amdgcn_update_dpp(0, __builtin_bit_cast(int, v), CTRL, 0xf, 0xf, true)); }
static __device__ PHASE_ATTR void ph_scan(int jm) {
    FRAME();
    const bf16_t* Rb = (const bf16_t*)(ws + P_R); const bf16_t* Kb = (const bf16_t*)(ws + P_K); const bf16_t* Vb = (const bf16_t*)(ws + (jm == 0 ? WS_VF : P_V));
    const bf16_t* Hd = (const bf16_t*)(ws + P_HID); float* BS = (float*)(ws + P_BS);
    constexpr int RS = 72;
    LAS bf16_t* AH = (LAS bf16_t*)(lds); LAS bf16_t* RH = (LAS bf16_t*)(lds + 9216); LAS bf16_t* BH = (LAS bf16_t*)(lds + 18432); LAS bf16_t* KH = (LAS bf16_t*)(lds + 27648);
    LAS bf16_t* BT = (LAS bf16_t*)(lds + 36864); LAS bf16_t* KT = (LAS bf16_t*)(lds + 46080); LAS bf16_t* VT = (LAS bf16_t*)(lds + 55296); LAS bf16_t* YS = (LAS bf16_t*)(lds + 64512);
    LAS unsigned char* KVI = lds + 73728; LAS unsigned char* MAKV = lds + 90112; LAS unsigned char* NRKV = lds + 98304;
    LAS float* SEG = (LAS float*)(lds + 106496); LAS float* NRM = (LAS float*)(lds + 107520); LAS float* BON = (LAS float*)(lds + 108032);
    LAS unsigned char* MABF = lds + 108544; LAS unsigned char* NRBF = lds + 112640;
    LAS float* MS = (LAS float*)(lds + 118784); LAS bf16_t* TTI = (LAS bf16_t*)(lds + 122880);
    LAS float* GL = (LAS float*)(lds + 125440); LAS float* PAR = (LAS float*)(lds + 125696);
    LAS unsigned char* W2F = lds + 147456;
    LAS unsigned char* A2F = lds + 126976;
    const int c15 = lane & 15, g = lane >> 4;
    const int tbq = wave & 3, half = wave >> 2;
    const int tF = tid >> 3, c8 = tid & 7;
    const int tbD = wave & 3, kindD = wave >> 2;
    const f32x4 zero4 = {0.f, 0.f, 0.f, 0.f};
    for (int it = bid_; it < 256; it += G) {
        const int seq = it & 3, head = (it >> 2) & 31, dir = it >> 7;
        const bool split = (G == 256);
        const bool helper = split && seq >= 2;
        const int pair = (seq & 1) | (head << 1) | (dir << 6);
        unsigned* flag = (unsigned*)(ws + WS_SCANFLAG + (size_t)jm * 8192 + (size_t)pair * 64);
#pragma unroll 1
        for (int pass = helper ? 0 : 1; pass < 2; ++pass) {
        __syncthreads();
        if (tid < 64) { const int c = head * 64 + tid;
            PAR[tid] = NLOG2E * inp(9)[(size_t)(jm * 2 + dir) * D + c]; PAR[64 + tid] = NLOG2E * inp(12)[(size_t)(jm * 2 + dir) * D + c];
            PAR[128 + tid] = inp(20)[(size_t)jm * D + c]; PAR[192 + tid] = inp(21)[(size_t)jm * D + c]; PAR[256 + tid] = inp(22)[(size_t)jm * D + c]; }
        int lane_s = lane; asm volatile("" : "+v"(lane_s));
        const int c15s = lane_s & 15, gs = lane_s >> 4;
#pragma unroll
        for (int kind = 0; kind < 2; ++kind)
#pragma unroll
            for (int cbi = 0; cbi < 2; ++cbi) { const float* M = (kind == 0 ? inp(11) : inp(14)) + (size_t)(jm * 2 + dir) * 96 * D + head * 64;
                const unsigned mo = (unsigned)(8 * gs * D + 16 * (2 * half + cbi) + c15s);
#pragma unroll
                for (int ks = 0; ks < 3; ++ks) { float x[8];
#pragma unroll
                    for (int j = 0; j < 8; ++j) x[j] = M[mo + (unsigned)((32 * ks + j) * D)];
                    const u32x4 w = {pk2(NLOG2E * x[0], NLOG2E * x[1]), pk2(NLOG2E * x[2], NLOG2E * x[3]), pk2(NLOG2E * x[4], NLOG2E * x[5]), pk2(NLOG2E * x[6], NLOG2E * x[7])};
                    *(LAS u32x4*)((kind == 0 ? W2F : A2F) + (((half * 2 + cbi) * 3 + ks) * 64 + lane_s) * 16) = w; }
                __builtin_amdgcn_sched_barrier(0); }
        bf16_t* yd = (bf16_t*)(ws + (dir ? P_YB : P_YF));
        const int cofs = head * 64 + 32 * half + 4 * g;
        bf16x8 hwf[3], haf[3]; u32x2 rq[2], kq[2], vq[2];
#define SCAN_PREFETCH(chunk_) do { const int st_ = (chunk_) * 64 + 16 * tbq + c15; const size_t row_ = (size_t)(base + (dir ? (len - 1 - st_) : st_)); \
            const bf16_t* hp_ = Hd + row_ * HID + dir * 128 + 8 * g; \
            _Pragma("unroll") for (int ks = 0; ks < 3; ++ks) { hwf[ks] = *(const bf16x8*)(hp_ + 32 * ks); haf[ks] = *(const bf16x8*)(hp_ + 256 + 32 * ks); } \
            _Pragma("unroll") for (int cbi = 0; cbi < 2; ++cbi) { rq[cbi] = *(const u32x2*)(Rb + row_ * D + cofs + 16 * cbi); kq[cbi] = *(const u32x2*)(Kb + row_ * D + cofs + 16 * cbi); vq[cbi] = *(const u32x2*)(Vb + row_ * D + cofs + 16 * cbi); } } while (0)
        const int sq = pass ? seq : seq - 2; const bool pre = (pass == 0);
        const int base = sq < 2 ? sq * 16384 : 32768 + (sq - 2) * 8192, len = sq < 2 ? 16384 : 8192;
        const int nch = len >> 6;
        const int c0 = pre ? nch - SCAN_NH : 0;
        const int cfull = (split && !pre && sq < 2) ? nch - SCAN_NH : nch;
        f32x4 ST[4] = {zero4, zero4, zero4, zero4};
        SCAN_PREFETCH(c0);
        __syncthreads();
#pragma unroll 1
        for (int chunk = c0; chunk < cfull; ++chunk) {
            int tid_o = tid; asm volatile("" : "+v"(tid_o));
            const int lane = tid_o & 63, c15 = lane & 15, g = lane >> 4, tF = tid_o >> 3, c8 = tid_o & 7;
            const int cofs = head * 64 + 32 * half + 4 * g;
            const int tq = 16 * tbq + c15;
            const int stq = chunk * 64 + tq; const size_t rowq = (size_t)(base + (dir ? (len - 1 - stq) : stq));
            float r8[8], lw8[8], asg[8], kkr[8], kd8[8], pfx[8]; u32x2 vkeep[2];
            {
                f32x4 accw[2] = {zero4, zero4}, acca[2] = {zero4, zero4};
#pragma unroll
                for (int cbi = 0; cbi < 2; ++cbi)
#pragma unroll
                    for (int ks = 0; ks < 3; ++ks) { accw[cbi] = __builtin_amdgcn_mfma_f32_16x16x32_bf16(*(const LAS bf16x8*)(W2F + (((half * 2 + cbi) * 3 + ks) * 64 + lane) * 16), hwf[ks], accw[cbi], 0, 0, 0); acca[cbi] = __builtin_amdgcn_mfma_f32_16x16x32_bf16(*(const LAS bf16x8*)(A2F + (((half * 2 + cbi) * 3 + ks) * 64 + lane) * 16), haf[ks], acca[cbi], 0, 0, 0); }
                float k8[8]; float ss = 0.f, bon = 0.f;
#pragma unroll
                for (int cbi = 0; cbi < 2; ++cbi) { const int cl = 32 * half + 16 * cbi + 4 * g;
                    const f32x4 w0v = *(const LAS f32x4*)(PAR + cl), a0v = *(const LAS f32x4*)(PAR + 64 + cl), kkv = *(const LAS f32x4*)(PAR + 128 + cl), kav = *(const LAS f32x4*)(PAR + 192 + cl), rkv = *(const LAS f32x4*)(PAR + 256 + cl);
                    const unsigned rw2[2] = {rq[cbi].x, rq[cbi].y}, kw2[2] = {kq[cbi].x, kq[cbi].y}; vkeep[cbi] = vq[cbi];
#pragma unroll
                    for (int r = 0; r < 4; ++r) { const int e = 4 * cbi + r;
                        r8[e] = (r & 1) ? bfhi(rw2[r >> 1]) : bflo(rw2[r >> 1]); k8[e] = (r & 1) ? bfhi(kw2[r >> 1]) : bflo(kw2[r >> 1]);
                        const float wr = w0v[r] + accw[cbi][r], ar = a0v[r] + acca[cbi][r];
                        lw8[e] = -0.87503877491452760f * __builtin_amdgcn_rcpf(1.0f + __builtin_amdgcn_exp2f(wr));
                        asg[e] = __builtin_amdgcn_rcpf(1.0f + __builtin_amdgcn_exp2f(ar)); kkr[e] = k8[e] * kkv[r]; ss += kkr[e] * kkr[e];
                        kd8[e] = __builtin_fmaf(k8[e], __builtin_fmaf(asg[e], kav[r], -kav[r]), k8[e]); bon += r8[e] * kd8[e] * rkv[r]; } }
                ss += __shfl_xor(ss, 16); ss += __shfl_xor(ss, 32); bon += __shfl_xor(bon, 16); bon += __shfl_xor(bon, 32);
                if (g == 0) { NRM[half * 64 + tq] = ss; BON[half * 64 + tq] = bon; }
#pragma unroll
                for (int e = 0; e < 8; ++e) { float x = lw8[e]; x += dpp_row_shr<0x111>(x); x += dpp_row_shr<0x112>(x); x += dpp_row_shr<0x114>(x); x += dpp_row_shr<0x118>(x); pfx[e] = x; }
                if (c15 == 15) { *(LAS f32x4*)(SEG + tbq * 64 + 32 * half + 4 * g) = (f32x4){pfx[0], pfx[1], pfx[2], pfx[3]}; *(LAS f32x4*)(SEG + tbq * 64 + 32 * half + 16 + 4 * g) = (f32x4){pfx[4], pfx[5], pfx[6], pfx[7]}; }
            }
            if (chunk > c0 && !pre) { const int st = (chunk - 1) * 64 + tF; const int p = dir ? (len - 1 - st) : st;
                *(u32x4*)(yd + (size_t)(base + p) * D + head * 64 + 8 * c8) = *(const LAS u32x4*)(YS + tF * RS + 8 * c8); }
            __syncthreads();
            {
                f32x4 of0 = zero4, of1 = zero4;
                for (int s = 0; s < tbq; ++s) { of0 += *(const LAS f32x4*)(SEG + s * 64 + 32 * half + 4 * g); of1 += *(const LAS f32x4*)(SEG + s * 64 + 32 * half + 16 + 4 * g); }
                const float inv = __builtin_amdgcn_rcpf(fmaxf(sqrtf(NRM[tq] + NRM[64 + tq]), 1e-12f));
                if (half == 0 && g == 0) BS[((size_t)dir * TT + rowq) * 32 + head] = BON[tq] + BON[64 + tq];
#pragma unroll
                for (int cbi = 0; cbi < 2; ++cbi) { const int cl = 32 * half + 16 * cbi + 4 * g; float ah[4], bh[4], kh[4], rh[4];
#pragma unroll
                    for (int r = 0; r < 4; ++r) { const int e = 4 * cbi + r; const float lg = pfx[e] + (cbi ? of1[r] : of0[r]); const float lm = lg - lw8[e];
                        const float e1 = __builtin_amdgcn_exp2f(lg), e2 = __builtin_amdgcn_rcpf(e1), e3 = __builtin_amdgcn_exp2f(lm); const float kk = kkr[e] * inv;
                        ah[r] = -kk * e3; bh[r] = kk * asg[e] * e2; kh[r] = kd8[e] * e2; rh[r] = r8[e] * e1; }
                    const u32x2 aw = {pk2(ah[0], ah[1]), pk2(ah[2], ah[3])}, bw = {pk2(bh[0], bh[1]), pk2(bh[2], bh[3])}, kw = {pk2(kh[0], kh[1]), pk2(kh[2], kh[3])}, rw = {pk2(rh[0], rh[1]), pk2(rh[2], rh[3])};
                    *(LAS u32x2*)(AH + tq * RS + cl) = aw; *(LAS u32x2*)(BH + tq * RS + cl) = bw; *(LAS u32x2*)(KH + tq * RS + cl) = kw; *(LAS u32x2*)(RH + tq * RS + cl) = rw;
                    const unsigned bww[2] = {bw.x, bw.y}, kww[2] = {kw.x, kw.y}, vww[2] = {vkeep[cbi].x, vkeep[cbi].y};
#pragma unroll
                    for (int r = 0; r < 4; ++r) { BT[(cl + r) * RS + tq] = (bf16_t)((r & 1) ? (bww[r >> 1] >> 16) : (bww[r >> 1] & 0xffffu)); KT[(cl + r) * RS + tq] = (bf16_t)((r & 1) ? (kww[r >> 1] >> 16) : (kww[r >> 1] & 0xffffu));
                        VT[(cl + r) * RS + tq] = (bf16_t)((r & 1) ? (vww[r >> 1] >> 16) : (vww[r >> 1] & 0xffffu)); }
                    if (tq == 63) *(LAS f32x4*)(GL + cl) = (f32x4){__builtin_amdgcn_exp2f(pfx[4 * cbi] + (cbi ? of1[0] : of0[0])), __builtin_amdgcn_exp2f(pfx[4 * cbi + 1] + (cbi ? of1[1] : of0[1])), __builtin_amdgcn_exp2f(pfx[4 * cbi + 2] + (cbi ? of1[2] : of0[2])), __builtin_amdgcn_exp2f(pfx[4 * cbi + 3] + (cbi ? of1[3] : of0[3]))}; }
            }
            __syncthreads();
            {
                const int tloc = c15;
                if (kindD == 0) {
                    bf16x8 bfA[2];
#pragma unroll
                    for (int ks = 0; ks < 2; ++ks) bfA[ks] = *(const LAS bf16x8*)(AH + (16 * tbD + c15) * RS + 32 * ks + 8 * g);
                    f32x4 GT1[4] = {zero4, zero4, zero4, zero4};
#pragma unroll
                    for (int ib = 0; ib < 4; ++ib) if (ib <= tbD) {
                        f32x4 a1 = zero4;
#pragma unroll
                        for (int ks = 0; ks < 2; ++ks) a1 = __builtin_amdgcn_mfma_f32_16x16x32_bf16(*(const LAS bf16x8*)(BH + (16 * ib + c15) * RS + 32 * ks + 8 * g), bfA[ks], a1, 0, 0, 0);
                        if (ib == tbD) {
#pragma unroll
                            for (int r = 0; r < 4; ++r) if (!(4 * g + r < tloc)) a1[r] = 0.f; }
                        GT1[ib] = a1;
                    }
                    const f32x4 m1 = (tbD >= 2) ? GT1[1] : zero4, m2 = (tbD == 3) ? GT1[2] : zero4;
                    const u32x4 F01 = {pk2(GT1[0][0], GT1[0][1]), pk2(GT1[0][2], GT1[0][3]), pk2(m1[0], m1[1]), pk2(m1[2], m1[3])};
                    const u32x4 F23 = {pk2(m2[0], m2[1]), pk2(m2[2], m2[3]), 0u, 0u};
                    if (tbD == 1) *(LAS u32x4*)(MABF + (0 * 64 + lane) * 16) = F01;
                    if (tbD == 2) *(LAS u32x4*)(MABF + (1 * 64 + lane) * 16) = F01;
                    if (tbD == 3) { *(LAS u32x4*)(MABF + (2 * 64 + lane) * 16) = F01; *(LAS u32x4*)(MABF + (3 * 64 + lane) * 16) = F23; }
                    f32x4 dg = GT1[0]; dg = (tbD == 1) ? GT1[1] : dg; dg = (tbD == 2) ? GT1[2] : dg; dg = (tbD == 3) ? GT1[3] : dg;
                    *(LAS f32x4*)(MS + (tbD * 16 + c15) * 16 + 4 * g) = dg;
                    asm volatile("s_waitcnt lgkmcnt(0)" ::: "memory");
                    const int lane_o = lane;
                    if (lane < 16) { float x[16];
#pragma unroll
                        for (int t = 0; t < 16; ++t) { const LAS f32x4* mr = (const LAS f32x4*)(MS + (tbD * 16 + t) * 16); float s = (t == lane_o) ? 1.0f : 0.0f;
#pragma unroll
                            for (int i4 = 0; i4 < (t + 3) / 4; ++i4) { const f32x4 m = mr[i4];
#pragma unroll
                                for (int q = 0; q < 4; ++q) if (4 * i4 + q < t) s += m[q] * x[4 * i4 + q]; }
                            x[t] = s; }
#pragma unroll
                        for (int t = 0; t < 16; ++t) TTI[(tbD * 16 + t) * 20 + lane] = (bf16_t)(pk2(x[t], 0.f) & 0xffffu); }
                } else {
                    bf16x8 bfR[2], bfA[2];
#pragma unroll
                    for (int ks = 0; ks < 2; ++ks) { bfR[ks] = *(const LAS bf16x8*)(RH + (16 * tbD + c15) * RS + 32 * ks + 8 * g); bfA[ks] = *(const LAS bf16x8*)(AH + (16 * tbD + c15) * RS + 32 * ks + 8 * g); }
                    f32x4 GT1[4] = {zero4, zero4, zero4, zero4}, GT2[4] = {zero4, zero4, zero4, zero4}, GT3[4] = {zero4, zero4, zero4, zero4};
#pragma unroll
                    for (int ib = 0; ib < 4; ++ib) if (ib <= tbD) {
                        f32x4 a1 = zero4, a2 = zero4, a3 = zero4;
#pragma unroll
                        for (int ks = 0; ks < 2; ++ks) { const bf16x8 f1 = *(const LAS bf16x8*)(BH + (16 * ib + c15) * RS + 32 * ks + 8 * g), f2 = *(const LAS bf16x8*)(KH + (16 * ib + c15) * RS + 32 * ks + 8 * g);
                            a1 = __builtin_amdgcn_mfma_f32_16x16x32_bf16(f1, bfR[ks], a1, 0, 0, 0); a2 = __builtin_amdgcn_mfma_f32_16x16x32_bf16(f2, bfR[ks], a2, 0, 0, 0); a3 = __builtin_amdgcn_mfma_f32_16x16x32_bf16(f2, bfA[ks], a3, 0, 0, 0); }
                        if (ib == tbD) {
#pragma unroll
                            for (int r = 0; r < 4; ++r) { const int il = 4 * g + r; if (!(il <= tloc)) { a1[r] = 0.f; a2[r] = 0.f; } if (!(il < tloc)) a3[r] = 0.f; } }
                        GT1[ib] = a1; GT2[ib] = a2; GT3[ib] = a3;
                    }
                    const u32x4 F01 = {pk2(GT1[0][0], GT1[0][1]), pk2(GT1[0][2], GT1[0][3]), pk2(GT1[1][0], GT1[1][1]), pk2(GT1[1][2], GT1[1][3])};
                    const u32x4 F23 = {pk2(GT1[2][0], GT1[2][1]), pk2(GT1[2][2], GT1[2][3]), pk2(GT1[3][0], GT1[3][1]), pk2(GT1[3][2], GT1[3][3])};
                    const int nb = tbD == 0 ? 0 : (tbD == 1 ? 1 : (tbD == 2 ? 2 : 4));
                    *(LAS u32x4*)(NRBF + (nb * 64 + lane) * 16) = F01;
                    if (tbD >= 2) *(LAS u32x4*)(NRBF + ((nb + 1) * 64 + lane) * 16) = F23;
                    const u32x4 N_01 = {pk2(GT2[0][0], GT2[0][1]), pk2(GT2[0][2], GT2[0][3]), pk2(GT2[1][0], GT2[1][1]), pk2(GT2[1][2], GT2[1][3])};
                    const u32x4 N_23 = {pk2(GT2[2][0], GT2[2][1]), pk2(GT2[2][2], GT2[2][3]), pk2(GT2[3][0], GT2[3][1]), pk2(GT2[3][2], GT2[3][3])};
                    const u32x4 M_01 = {pk2(GT3[0][0], GT3[0][1]), pk2(GT3[0][2], GT3[0][3]), pk2(GT3[1][0], GT3[1][1]), pk2(GT3[1][2], GT3[1][3])};
                    const u32x4 M_23 = {pk2(GT3[2][0], GT3[2][1]), pk2(GT3[2][2], GT3[2][3]), pk2(GT3[3][0], GT3[3][1]), pk2(GT3[3][2], GT3[3][3])};
#pragma unroll
                    for (int vb = 0; vb < 4; ++vb) { const LAS bf16_t* vp = VT + (16 * vb + c15) * RS + 4 * g;
                        const u32x2 v0 = *(const LAS u32x2*)(vp), v1 = *(const LAS u32x2*)(vp + 16);
                        const bf16x8 vf01 = __builtin_bit_cast(bf16x8, (u32x4){v0.x, v0.y, v1.x, v1.y});
                        f32x4 accn = __builtin_amdgcn_mfma_f32_16x16x32_bf16(__builtin_bit_cast(bf16x8, N_01), vf01, zero4, 0, 0, 0);
                        f32x4 accm = __builtin_amdgcn_mfma_f32_16x16x32_bf16(__builtin_bit_cast(bf16x8, M_01), vf01, zero4, 0, 0, 0);
                        if (tbD >= 2) { const u32x2 v2 = *(const LAS u32x2*)(vp + 32), v3 = *(const LAS u32x2*)(vp + 48);
                            const bf16x8 vf23 = __builtin_bit_cast(bf16x8, (u32x4){v2.x, v2.y, v3.x, v3.y});
                            accn = __builtin_amdgcn_mfma_f32_16x16x32_bf16(__builtin_bit_cast(bf16x8, N_23), vf23, accn, 0, 0, 0);
                            accm = __builtin_amdgcn_mfma_f32_16x16x32_bf16(__builtin_bit_cast(bf16x8, M_23), vf23, accm, 0, 0, 0); }
                        *(LAS u32x2*)(NRKV + ((tbD * 4 + vb) * 64 + lane) * 8) = (u32x2){pk2(accn[0], accn[1]), pk2(accn[2], accn[3])};
                        *(LAS u32x2*)(MAKV + ((tbD * 4 + vb) * 64 + lane) * 8) = (u32x2){pk2(accm[0], accm[1]), pk2(accm[2], accm[3])}; }
                }
#pragma unroll
                for (int q2 = 0; q2 < 2; ++q2) { const int id = 2 * wave + q2, kb = id >> 2, vb = id & 3; f32x4 acc = zero4;
#pragma unroll
                    for (int ks = 0; ks < 2; ++ks) acc = __builtin_amdgcn_mfma_f32_16x16x32_bf16(*(const LAS bf16x8*)(KT + (16 * kb + c15) * RS + 32 * ks + 8 * g), *(const LAS bf16x8*)(VT + (16 * vb + c15) * RS + 32 * ks + 8 * g), acc, 0, 0, 0);
                    *(LAS f32x4*)(KVI + (id * 64 + lane) * 16) = acc; }
            }
            __syncthreads();
            if (chunk + 1 < cfull) SCAN_PREFETCH(chunk + 1);
            if (pre) {
                const int j = chunk - c0; const int slot = __builtin_amdgcn_readfirstlane(pair * SCAN_NH + j);
                unsigned char* dstp = slot < SCAN_SLOTS_OUT ? (unsigned char*)outp() + (size_t)slot * SCAN_SLOT : (unsigned char*)ws + WS_POOL + 576 * MiB + (size_t)(slot - SCAN_SLOTS_OUT) * SCAN_SLOT;
                const __amdgpu_buffer_rsrc_t drs = __builtin_amdgcn_make_buffer_rsrc(dstp, 0, SCAN_SLOT, 0x00020000);
#pragma unroll
                for (int q = 0; q < 9; ++q) { const int u = tid_o + 512 * q;
                    if (q < 8 || u < SCAN_DUMP_U) { const int off = 16 * u + (u >= 1152 ? 18432 : 0) + (u >= 1728 ? 27648 : 0) + (u >= 3776 ? 2048 : 0) + (u >= 4416 ? 4096 : 0);
                        __builtin_amdgcn_raw_buffer_store_b128(*(const LAS u32x4*)(lds + off), drs, 16 * u, 0, 16); } }
            } else {
            if (wave < 4) scan_stage_e(lds, ST, lane, wave);
            __syncthreads();
            }
        }
        if (pre) {
            asm volatile("s_waitcnt vmcnt(0)" ::: "memory");
            __syncthreads();
            if (tid == 0) __hip_atomic_store((GAS unsigned*)flag, (unsigned)SCAN_NH, __ATOMIC_RELAXED, __HIP_MEMORY_SCOPE_AGENT);
        }
        if (cfull < nch) {
            if (wave == 0) {
                while ((unsigned)__builtin_amdgcn_readfirstlane(__hip_atomic_load((GAS unsigned*)flag, __ATOMIC_RELAXED, __HIP_MEMORY_SCOPE_AGENT)) < (unsigned)SCAN_NH) __builtin_amdgcn_s_sleep(2);
                __builtin_amdgcn_fence(__ATOMIC_ACQUIRE, "agent"); }
            __syncthreads();
            u32x4 pf[9];
#define DUMP_OFF(u) (16 * (u) + ((u) >= 1152 ? 18432 : 0) + ((u) >= 1728 ? 27648 : 0) + ((u) >= 3776 ? 2048 : 0) + ((u) >= 4416 ? 4096 : 0))
#define DUMP_LOAD(j_) do { const int slot_ = __builtin_amdgcn_readfirstlane(pair * SCAN_NH + (j_)); \
            const u32x4* srcp_ = (const u32x4*)(slot_ < SCAN_SLOTS_OUT ? (const unsigned char*)outp() + (size_t)slot_ * SCAN_SLOT : (const unsigned char*)ws + WS_POOL + 576 * MiB + (size_t)(slot_ - SCAN_SLOTS_OUT) * SCAN_SLOT); \
            _Pragma("unroll") for (int q = 0; q < 9; ++q) { const int u = tid_p + 512 * q; if (q < 8 || u < SCAN_DUMP_U) pf[q] = srcp_[u]; } } while (0)
            int tid_p = tid; asm volatile("" : "+v"(tid_p));
            DUMP_LOAD(0);
#pragma unroll 1
            for (int chunk = cfull; chunk < nch; ++chunk) {
                int tid_o = tid; asm volatile("" : "+v"(tid_o));
                const int tF = tid_o >> 3, c8 = tid_o & 7; const int tid_p = tid_o;
#pragma unroll
                for (int q = 0; q < 9; ++q) { const int u = tid_o + 512 * q; if (q < 8 || u < SCAN_DUMP_U) *(LAS u32x4*)(lds + DUMP_OFF(u)) = pf[q]; }
                { const int st = (chunk - 1) * 64 + tF; const int p = dir ? (len - 1 - st) : st;
                  *(u32x4*)(yd + (size_t)(base + p) * D + head * 64 + 8 * c8) = *(const LAS u32x4*)(YS + tF * RS + 8 * c8); }
                __syncthreads();
                if (chunk + 1 < nch) DUMP_LOAD(chunk + 1 - cfull);
                if (wave < 4) scan_stage_e(lds, ST, tid_o & 63, wave);
                __syncthreads();
            }
#undef DUMP_LOAD
#undef DUMP_OFF
        }
        if (!pre) { const int tF = tid >> 3, c8 = tid & 7; const int st = (nch - 1) * 64 + tF; const int p = dir ? (len - 1 - st) : st;
          *(u32x4*)(yd + (size_t)(base + p) * D + head * 64 + 8 * c8) = *(const LAS u32x4*)(YS + tF * RS + 8 * c8); }
        }
#undef SCAN_PREFETCH
    }
}

static __device__ PHASE_ATTR void ph_fin(int jm) {
    FRAME();
    bf16_t* YF = (bf16_t*)(ws + P_YF); const bf16_t* YB = (const bf16_t*)(ws + P_YB); const bf16_t* Vb = (const bf16_t*)(ws + (jm == 0 ? WS_VF : P_V)); const float* BS = (const float*)(ws + P_BS);
    const float* gnw = inp(23) + (size_t)jm * D; const float* gnb = inp(24) + (size_t)jm * D;
    u32x4 aq[4], bq[4], vq4[4]; float b0q[4], b1q[4];
#define FIN_LOAD(row_) do { const size_t r_ = (size_t)(row_); \
        _Pragma("unroll") for (int i = 0; i < 4; ++i) { const int e = 8 * (lane + 64 * i); aq[i] = *(const u32x4*)(YF + r_ * D + e); bq[i] = *(const u32x4*)(YB + r_ * D + e); vq4[i] = *(const u32x4*)(Vb + r_ * D + e); \
            b0q[i] = BS[r_ * 32 + (e >> 6)]; b1q[i] = BS[((size_t)TT + r_) * 32 + (e >> 6)]; } } while (0)
    int row = gw;
    if (row < TT) FIN_LOAD(row);
    for (; row < TT; row += NGW) {
        u32x4 ac[4], bc[4], vc[4]; float b0c[4], b1c[4];
#pragma unroll
        for (int i = 0; i < 4; ++i) { ac[i] = aq[i]; bc[i] = bq[i]; vc[i] = vq4[i]; b0c[i] = b0q[i]; b1c[i] = b1q[i]; }
        if (row + NGW < TT) FIN_LOAD(row + NGW);
#pragma unroll
        for (int i = 0; i < 4; ++i) { const int e = 8 * (lane + 64 * i);
            const unsigned aw[4] = {ac[i].x, ac[i].y, ac[i].z, ac[i].w}, bw[4] = {bc[i].x, bc[i].y, bc[i].z, bc[i].w}, vw[4] = {vc[i].x, vc[i].y, vc[i].z, vc[i].w};
            float y[8], v8[8]; float s = 0.f;
#pragma unroll
            for (int j = 0; j < 4; ++j) { y[2 * j] = bflo(aw[j]) + bflo(bw[j]); y[2 * j + 1] = bfhi(aw[j]) + bfhi(bw[j]); v8[2 * j] = bflo(vw[j]); v8[2 * j + 1] = bfhi(vw[j]); s += y[2 * j] + y[2 * j + 1]; }
            s += __shfl_xor(s, 1); s += __shfl_xor(s, 2); s += __shfl_xor(s, 4);
            const float mean = s * (1.0f / 64.0f); float q = 0.f;
#pragma unroll
            for (int j = 0; j < 8; ++j) { y[j] -= mean; q += y[j] * y[j]; }
            q += __shfl_xor(q, 1); q += __shfl_xor(q, 2); q += __shfl_xor(q, 4);
            const float rstd = rsqrtf(q * (1.0f / 64.0f) + GN_EPS);
            const float bonus = 0.5f * (b0c[i] + b1c[i]);
            const f32x4 w0 = *(const f32x4*)(gnw + e), w1 = *(const f32x4*)(gnw + e + 4), c0 = *(const f32x4*)(gnb + e), c1 = *(const f32x4*)(gnb + e + 4);
            float o[8];
#pragma unroll
            for (int j = 0; j < 8; ++j) o[j] = y[j] * rstd * (j < 4 ? w0[j] : w1[j - 4]) + (j < 4 ? c0[j] : c1[j - 4]) + bonus * v8[j];
            *(u32x4*)(YF + (size_t)row * D + e) = (u32x4){pk2(o[0], o[1]), pk2(o[2], o[3]), pk2(o[4], o[5]), pk2(o[6], o[7])}; }
    }
#undef FIN_LOAD
}

typedef short v4i16_t __attribute__((ext_vector_type(4)));
struct AttItem { int base, h, c, b0, Lc; };
__device__ __forceinline__ AttItem att_decode(int pair, int dsh) {
    const int it = pair * 2; int seq, h, cb, S_len;
    if (it < 8192) { seq = it >> 12; h = (it >> 8) & 15; cb = it & 255; S_len = 16384; }
    else { const int i2 = it - 8192; seq = 2 + (i2 >> 11); h = (i2 >> 7) & 15; cb = i2 & 127; S_len = 8192; }
    AttItem a; a.base = seq < 2 ? seq * 16384 : 32768 + (seq - 2) * 8192; a.h = h; a.Lc = S_len >> dsh; const int nb = a.Lc >> 6; a.c = cb / nb; a.b0 = cb % nb; return a;
}
static __device__ PHASE_ATTR void ph_att(int gi) {
    FRAME();
    const int dil = 1 << (2 * gi), dsh = 2 * gi;
    const bf16_t* QKV = (const bf16_t*)(ws + P_QKV);
    bf16_t* const Og = (bf16_t*)(ws + P_O0 + (size_t)gi * 192 * MiB); float* const LSEg = (float*)(ws + P_LSE) + (size_t)gi * TT * 16;
    bf16_t* const O0 = (bf16_t*)(ws + P_O0); const bf16_t* const O1 = (const bf16_t*)(ws + P_O0 + 192 * MiB); const float* const LS = (const float*)(ws + P_LSE);
    constexpr int KRS = 136, VRS = 144;
    LAS bf16_t* Ks = (LAS bf16_t*)lds; LAS bf16_t* Vs = (LAS bf16_t*)(lds + 256 * KRS * 2);
    const int qi = wave >> 2, wi = wave & 3, c15 = lane & 15, gq = lane >> 4;
    u32x4 kv[16]; bf16x8 qf[4];
#define ATT_PREFETCH(A) do { _Pragma("unroll") for (int i = 0; i < 16; ++i) { const int key = (tid >> 4) + 32 * (i & 7), part = tid & 15; \
            int ip = 64 * ((A).b0 - 1) + key; ip = ip < 0 ? 0 : (ip > (A).Lc - 1 ? (A).Lc - 1 : ip); \
            kv[i] = *(const u32x4*)(QKV + (size_t)((A).base + ip * dil + (A).c) * (3 * D) + ((i >> 3) ? 2 * D : D) + (A).h * 128 + 8 * part); } \
        { const size_t rq = (size_t)((A).base + (64 * ((A).b0 + qi) + 16 * wi + c15) * dil + (A).c); \
          _Pragma("unroll") for (int ks = 0; ks < 4; ++ks) qf[ks] = *(const bf16x8*)(QKV + rq * (3 * D) + (A).h * 128 + 32 * ks + 8 * gq); } } while (0)
    const int ppw = (6144 + G - 1) / G;
    int pair = bid_ * ppw; const int pair_end = (pair + ppw < 6144) ? pair + ppw : 6144;
    if (pair < pair_end) { const AttItem A0 = att_decode(pair, dsh); ATT_PREFETCH(A0); }
    for (; pair < pair_end; ++pair) {
        const AttItem A = att_decode(pair, dsh);
        const int base = A.base, h = A.h, c = A.c, Lc = A.Lc;
#pragma unroll
        for (int i = 0; i < 16; ++i) { const int key = (tid >> 4) + 32 * (i & 7), part = tid & 15;
            if (i >> 3) *(LAS u32x4*)(Vs + key * VRS + 8 * part) = kv[i]; else *(LAS u32x4*)(Ks + key * KRS + 8 * part) = kv[i]; }
        bf16x8 q[4];
#pragma unroll
        for (int ks = 0; ks < 4; ++ks) q[ks] = qf[ks];
        const int b = A.b0 + qi;
        const int iq = 64 * b + 16 * wi + c15; const size_t rowq = (size_t)(base + iq * dil + c);
        __syncthreads();
        if (pair + 1 < pair_end) { const AttItem An = att_decode(pair + 1, dsh); ATT_PREFETCH(An); }
        const int k0w = 16 * wi;
        f32x4 sc[9];
#pragma unroll
        for (int nt = 0; nt < 9; ++nt) { const LAS bf16_t* kp = Ks + (64 * qi + k0w + 16 * nt + c15) * KRS + 8 * gq;
            f32x4 a = {0.f, 0.f, 0.f, 0.f};
#pragma unroll
            for (int ks = 0; ks < 4; ++ks) a = __builtin_amdgcn_mfma_f32_16x16x32_bf16(*(const LAS bf16x8*)(kp + 32 * ks), q[ks], a, 0, 0, 0);
            sc[nt] = a * 0.08838834764831845f; }
#pragma unroll
        for (int r = 0; r < 4; ++r) { const int d0 = 4 * gq + r - c15;
            if (d0 < 0) sc[0][r] = -INFINITY;
            if (d0 > 0) sc[8][r] = -INFINITY; }
        if (b == 0 || b == (Lc >> 6) - 1) {
#pragma unroll
            for (int nt = 0; nt < 9; ++nt)
#pragma unroll
                for (int r = 0; r < 4; ++r) { const int ip = 64 * (b - 1) + k0w + 16 * nt + 4 * gq + r; if (ip < 0 || ip >= Lc) sc[nt][r] = -INFINITY; } }
        float mx = -INFINITY;
#pragma unroll
        for (int nt = 0; nt < 9; ++nt) mx = fmaxf(mx, fmaxf(fmaxf(sc[nt][0], sc[nt][1]), fmaxf(sc[nt][2], sc[nt][3])));
        mx = fmaxf(mx, __shfl_xor(mx, 16)); mx = fmaxf(mx, __shfl_xor(mx, 32));
        float sum = 0.f;
#pragma unroll
        for (int nt = 0; nt < 9; ++nt)
#pragma unroll
            for (int r = 0; r < 4; ++r) { const float p = fast_exp(sc[nt][r] - mx); sc[nt][r] = p; sum += p; }
        sum += __shfl_xor(sum, 16); sum += __shfl_xor(sum, 32);
        const float rs = __builtin_amdgcn_rcpf(sum); const float lse = mx + __logf(sum);
        float w0 = 0.f, w1 = 0.f, w2 = 1.f;
        if (gi == 2) { const float l0 = LS[rowq * 16 + h], l1 = LS[((size_t)TT + rowq) * 16 + h]; const float m = fmaxf(lse, fmaxf(l0, l1));
            w0 = fast_exp(l0 - m); w1 = fast_exp(l1 - m); w2 = fast_exp(lse - m); const float r3 = __builtin_amdgcn_rcpf(w0 + w1 + w2); w0 *= r3; w1 *= r3; w2 *= r3; }
        else if (gq == 0) LSEg[rowq * 16 + h] = lse;
        bf16x8 pf[5];
#pragma unroll
        for (int ks = 0; ks < 4; ++ks) { const f32x4 p0 = sc[2 * ks] * rs, p1 = sc[2 * ks + 1] * rs;
            const u32x4 w = {pk2(p0[0], p0[1]), pk2(p0[2], p0[3]), pk2(p1[0], p1[1]), pk2(p1[2], p1[3])}; pf[ks] = __builtin_bit_cast(bf16x8, w); }
        { const f32x4 p0 = sc[8] * rs; const u32x4 w = {pk2(p0[0], p0[1]), pk2(p0[2], p0[3]), 0u, 0u}; pf[4] = __builtin_bit_cast(bf16x8, w); }
        const LAS bf16_t* vbase = Vs + (64 * qi + k0w + 4 * gq + (c15 >> 2)) * VRS + 4 * (c15 & 3);
#pragma unroll
        for (int dt = 0; dt < 8; ++dt) {
            f32x4 o = {0.f, 0.f, 0.f, 0.f};
#pragma unroll
            for (int ks = 0; ks < 5; ++ks) {
                const v4i16_t lo = __builtin_amdgcn_ds_read_tr16_b64_v4i16((LAS v4i16_t*)(vbase + (32 * ks) * VRS + 16 * dt));
                v4i16_t hi = {0, 0, 0, 0};
                if (ks < 4) hi = __builtin_amdgcn_ds_read_tr16_b64_v4i16((LAS v4i16_t*)(vbase + (32 * ks + 16) * VRS + 16 * dt));
                const bf16x8 vf = {lo[0], lo[1], lo[2], lo[3], hi[0], hi[1], hi[2], hi[3]};
                o = __builtin_amdgcn_mfma_f32_16x16x32_bf16(vf, pf[ks], o, 0, 0, 0);
            }
            const size_t oo = rowq * D + h * 128 + 16 * dt + 4 * gq;
            if (gi == 2) { const u32x2 a0 = *(const u32x2*)(O0 + oo), a1 = *(const u32x2*)(O1 + oo);
                o = (f32x4){w0 * bflo(a0.x) + w1 * bflo(a1.x) + w2 * o[0], w0 * bfhi(a0.x) + w1 * bfhi(a1.x) + w2 * o[1], w0 * bflo(a0.y) + w1 * bflo(a1.y) + w2 * o[2], w0 * bfhi(a0.y) + w1 * bfhi(a1.y) + w2 * o[3]};
                *(u32x2*)(O0 + oo) = (u32x2){pk2(o[0], o[1]), pk2(o[2], o[3])}; }
            else *(u32x2*)(Og + oo) = (u32x2){pk2(o[0], o[1]), pk2(o[2], o[3])};
        }
        __syncthreads();
    }
#undef ATT_PREFETCH
}

static __device__ PHASE_ATTR void ph_norm(int L, int sub, size_t h_off) {
    FRAME();
    float* Y = outp(); bf16_t* XB = (bf16_t*)(ws + P_XN);
    float* RSX = (float*)(ws + WS_RSX); const bf16_t* hsrc = (const bf16_t*)(ws + h_off);
    const float alpha = (sub == 1) ? 1.0f : 0.5f;
    const float* gpost = inp(3) + (size_t)(L * 3 + sub) * D;
    const bool last = (L == DEPTH - 1 && sub == 2), first = (L == 0 && sub == 0); const float* in0 = inp(0); const float* in1 = inp(1);
    u32x4 hq[4], xq[4]; f32x4 xf[4][2];
#define NORM_LOAD(row_) do { const size_t r_ = (size_t)(row_); \
        _Pragma("unroll") for (int i = 0; i < 4; ++i) { const int e = 8 * (lane + 64 * i); hq[i] = *(const u32x4*)(hsrc + r_ * D + e); \
            if (first) { const float* xs_ = r_ < 32768 ? in0 + r_ * D : in1 + (r_ - 32768) * D; xf[i][0] = *(const f32x4*)(xs_ + e); xf[i][1] = *(const f32x4*)(xs_ + e + 4); } \
            else xq[i] = *(const u32x4*)(XB + r_ * D + e); } } while (0)
    int row = gw;
    if (row < TT) NORM_LOAD(row);
    for (; row < TT; row += NGW) {
        float xv[4][8]; float ssh = 0.f;
        float hv[4][8];
#pragma unroll
        for (int i = 0; i < 4; ++i) {
            if (first) {
#pragma unroll
                for (int j = 0; j < 4; ++j) { xv[i][j] = xf[i][0][j]; xv[i][4 + j] = xf[i][1][j]; } }
            else { const unsigned xww[4] = {xq[i].x, xq[i].y, xq[i].z, xq[i].w};
#pragma unroll
                for (int j = 0; j < 4; ++j) { xv[i][2 * j] = bflo(xww[j]); xv[i][2 * j + 1] = bfhi(xww[j]); } }
            const unsigned hww[4] = {hq[i].x, hq[i].y, hq[i].z, hq[i].w};
#pragma unroll
            for (int j = 0; j < 4; ++j) { hv[i][2 * j] = bflo(hww[j]); hv[i][2 * j + 1] = bfhi(hww[j]); ssh += hv[i][2 * j] * hv[i][2 * j] + hv[i][2 * j + 1] * hv[i][2 * j + 1]; } }
        if (row + NGW < TT) NORM_LOAD(row + NGW);
        const float rh = rsqrtf(wave_sum(ssh) * (1.0f / D) + NORM_EPS) * alpha;
        float ssx = 0.f;
        float* ydst = Y + (size_t)row * D;
#pragma unroll
        for (int i = 0; i < 4; ++i) { const int e = 8 * (lane + 64 * i); const f32x4 ga = *(const f32x4*)(gpost + e), gb = *(const f32x4*)(gpost + e + 4);
#pragma unroll
            for (int j = 0; j < 8; ++j) { xv[i][j] += hv[i][j] * rh * (j < 4 ? ga[j] : gb[j - 4]); ssx += xv[i][j] * xv[i][j]; }
            if (last) { *(f32x4*)(ydst + e) = (f32x4){xv[i][0], xv[i][1], xv[i][2], xv[i][3]}; *(f32x4*)(ydst + e + 4) = (f32x4){xv[i][4], xv[i][5], xv[i][6], xv[i][7]}; }
            else *(u32x4*)(XB + (size_t)row * D + e) = (u32x4){pk2(xv[i][0], xv[i][1]), pk2(xv[i][2], xv[i][3]), pk2(xv[i][4], xv[i][5]), pk2(xv[i][6], xv[i][7])}; }
        if (!last) { const float rx = rsqrtf(wave_sum(ssx) * (1.0f / D) + NORM_EPS); if (lane == 0) RSX[row] = rx; }
    }
#undef NORM_LOAD
}
static __device__ __noinline__ void grid_bar() {
    LAS unsigned char* lds = (LAS unsigned char*)lds_raw;
    XcdBarrier b; b.bar = (unsigned*)(wsp() + WS_CTL) + CW_BAR; b.st = (volatile LAS unsigned*)(lds + MISC_OFF) + 8; b.x = b.st[2];
    xcd_barrier(b);
}
#define STEP(call) do { if (step >= lo && step < hi) { call; if (step + 1 < hi) grid_bar(); } ++step; } while (0)
template <int L> __device__ __forceinline__ void layer_prog(int& step, const int lo, const int hi) {
    constexpr int jm = L >> 1; constexpr bool is_attn = (L & 1) != 0;
    STEP(ph_ffn_up(0));
    STEP(ph_gemm_plain(P_H, FF, W_DN0, D, FF, P_HOUT, D));
    STEP(ph_norm(L, 0, P_HOUT));
    if constexpr (!is_attn) {
        STEP(ph_mix(jm, 0));
        STEP(ph_g1(jm, 0));
        STEP(ph_mix(jm, 1));
        STEP(ph_g1(jm, 1));
        if constexpr (jm > 0) { STEP(ph_gv(jm)); } else { ++step; }
        STEP(ph_scan(jm));
        STEP(ph_fin(jm));
        STEP(ph_gg());
        STEP(ph_gemm_plain(P_YF, D, W_GO, D, D, P_R, D));
        STEP(ph_norm(L, 1, P_R));
    } else {
        STEP(ph_qkv(0));
        STEP(ph_att(0));
        STEP(ph_qkv(1));
        STEP(ph_att(1));
        STEP(ph_qkv(2));
        STEP(ph_att(2));
        STEP(ph_gemm_plain(P_O0, D, W_GO, D, D, P_QKV, D));
        STEP(ph_norm(L, 1, P_QKV));
    }
    STEP(ph_ffn_up(1));
    STEP(ph_gemm_plain(P_H, FF, W_DN1, D, FF, P_HOUT, D));
    STEP({ ph_norm(L, 2, P_HOUT); if (L + 1 < DEPTH) ph_conv(L + 1); });
}
__global__ void __launch_bounds__(NWAVES * 64, 2) enc_fwd(Args args) {
    LAS unsigned char* lds = (LAS unsigned char*)lds_raw;
    volatile LAS unsigned* MISC = (volatile LAS unsigned*)(lds + MISC_OFF);
    const int tid = threadIdx.x;
    if (tid < 128) ((LAS unsigned*)(lds + CTRL_OFF))[tid] = 0u;
    if (tid < 30) { const unsigned long long v = tid < 28 ? (unsigned long long)args.in[tid] : (tid == 28 ? (unsigned long long)args.out : (unsigned long long)args.ws);
        LAS unsigned* p = (LAS unsigned*)(lds + PTR_OFF) + 2 * tid; p[0] = (unsigned)v; p[1] = (unsigned)(v >> 32); }
    __syncthreads();
    const int lo = args.step_lo, hi = args.step_hi;
    if (hi - lo > 1) { const XcdBarrier b = xcd_barrier_post((unsigned*)(args.ws + WS_CTL) + CW_BAR, MISC + 8); if (tid == 0) MISC[10] = b.x; }
    __syncthreads();
    int step = 0;
    STEP({ ph_init(); ph_conv(0); });
    layer_prog<0>(step, lo, hi);
    layer_prog<1>(step, lo, hi);
    layer_prog<2>(step, lo, hi);
    layer_prog<3>(step, lo, hi);
}
#undef STEP

static int n_steps_total() {
    int s = 1;
    for (int L = 0; L < DEPTH; ++L) { s += 3; s += (L & 1) ? 8 : 10; s += 3; }
    return s;
}

extern "C" void kernel_launch(void* const* d_in, const int* in_sizes, int n_in, void* d_out, int out_size, void* d_ws, size_t ws_size, hipStream_t stream) {
    static int grid = 0;
    if (grid == 0) {
        if (n_in != 28 || out_size != TT * D || ws_size < WS_END) { fprintf(stderr, "kernel_launch: unexpected shapes (n_in %d, out %d, ws %zu, need %zu)\n", n_in, out_size, ws_size, (size_t)WS_END); grid = -1; return; }
        int dev = 0, cus = 0, per_cu = 0;
        if (hipGetDevice(&dev) != hipSuccess || hipDeviceGetAttribute(&cus, hipDeviceAttributeMultiprocessorCount, dev) != hipSuccess) { grid = -1; return; }
        if (hipFuncSetAttribute((const void*)enc_fwd, hipFuncAttributeMaxDynamicSharedMemorySize, LDS_BYTES) != hipSuccess) { grid = -1; return; }
        if (hipOccupancyMaxActiveBlocksPerMultiprocessor(&per_cu, (const void*)enc_fwd, NWAVES * 64, LDS_BYTES) != hipSuccess || per_cu < 1) { fprintf(stderr, "kernel_launch: occupancy query says %d\n", per_cu); }
        (void)hipGetLastError();
        grid = cus;
    }
    if (grid < 0) return;
    (void)hipMemsetAsync((char*)d_ws + WS_CTL, 0, CTL_ZERO_BYTES, stream);
    Args a{};
    for (int i = 0; i < 28; ++i) a.in[i] = (const float*)d_in[i];
    a.out = (float*)d_out; a.ws = (unsigned char*)d_ws;
    const int NS = n_steps_total();
#if MK_ONE_LAUNCH
    a.step_lo = 0; a.step_hi = NS;
    hipLaunchKernelGGL(enc_fwd, dim3(grid), dim3(NWAVES * 64), LDS_BYTES, stream, a);
#else
    for (int s = 0; s < NS; ++s) {
        a.step_lo = s; a.step_hi = s + 1;
        hipLaunchKernelGGL(enc_fwd, dim3(grid), dim3(NWAVES * 64), LDS_BYTES, stream, a);
    }
#endif
}
```

```cpp
#include <hip/hip_runtime.h>
#include <cstdio>
#include <cstdint>

#ifndef MK_ONE_LAUNCH
#define MK_ONE_LAUNCH 1
#endif

#ifndef PHASE_ATTR
#define PHASE_ATTR __forceinline__
#endif
#define LAS __attribute__((address_space(3)))
#define GAS __attribute__((address_space(1)))
typedef unsigned short bf16_t;
typedef short bf16x8 __attribute__((ext_vector_type(8)));
typedef float f32x4 __attribute__((ext_vector_type(4)));
typedef float f32x2 __attribute__((ext_vector_type(2)));
typedef unsigned u32x4 __attribute__((ext_vector_type(4)));
typedef unsigned u32x2 __attribute__((ext_vector_type(2)));
typedef __bf16 bf16x2_t __attribute__((ext_vector_type(2)));

constexpr int D = 2048, FF = 5632, TT = 49152, DEPTH = 4;
constexpr int HID = 1024;
constexpr int NG1 = 3 * D + 256, NG2 = 768;
constexpr float NORM_EPS = 1e-6f, GN_EPS = 64e-5f;

__device__ __forceinline__ float bflo(unsigned w) { return __uint_as_float(w << 16); }
__device__ __forceinline__ float bfhi(unsigned w) { return __uint_as_float(w & 0xffff0000u); }
__device__ __forceinline__ unsigned pk2(float lo, float hi) { f32x2 v = {lo, hi}; bf16x2_t b = __builtin_convertvector(v, bf16x2_t); return __builtin_bit_cast(unsigned, b); }
__device__ __forceinline__ float wave_sum(float v) {
#pragma unroll
    for (int o = 1; o < 64; o <<= 1) v += __shfl_xor(v, o);
    return v;
}
__device__ __forceinline__ float fast_exp(float x) { return __builtin_amdgcn_exp2f(x * 1.4426950408889634f); }
__device__ __forceinline__ float sigmoidf_(float x) { return __builtin_amdgcn_rcpf(1.0f + fast_exp(-x)); }
__device__ __forceinline__ float siluf_(float x) { return x * sigmoidf_(x); }
__device__ __forceinline__ float tanhf_(float x) { return 1.0f - 2.0f * __builtin_amdgcn_rcpf(1.0f + fast_exp(2.0f * x)); }
__device__ __forceinline__ void row_decode(int row, int& base, int& pos, int& len) {
    if (row < 32768) { base = row & ~16383; pos = row & 16383; len = 16384; }
    else { const int r2 = row - 32768; base = 32768 + (r2 & ~8191); pos = r2 & 8191; len = 8192; }
}

namespace pg8 {
#define PG8_LAS __attribute__((address_space(3)))
constexpr int BM = 256, BK = 64, HALF = 128, HTB = HALF * BK * 2, STAGE_BYTES = 8 * HTB, NXCD = 8, WGM = 8;
__host__ __device__ __forceinline__ int lds_byte(int r, int c) { const int st = (r >> 4) * 2 + (c >> 5), rr = r & 15, cc = c & 31, ob = rr * 64 + cc * 2; return st * 1024 + (ob ^ (((ob >> 9) & 1) << 5)); }
__host__ __device__ __forceinline__ void stage_rc(int b, int& R, int& C) { const int st = b / 1024, sb = b % 1024, swz = sb ^ (((sb >> 9) & 1) << 5); R = (st >> 1) * 16 + swz / 64; C = (st & 1) * 32 + (swz % 64) / 2; }
__host__ __device__ __forceinline__ int perm32(int rho) { const int n = rho >> 4, i = rho & 15; return 8 * (i >> 2) + 4 * n + (i & 3); }
struct Unit { int pm, pn; };
struct Gemm { const bf16_t* A; const bf16_t* Bt; int M, N, K, lda; size_t a_gstride = 0; int g0 = 1 << 30, g1 = 1 << 30; };
struct StaticOrder {
    int nM, nN, nwg, G, c;
    __host__ __device__ void init(int M, int N, int G_, int c_) { nM = M / BM; nN = N / BM; nwg = nM * nN; G = G_; c = c_; }
    __host__ __device__ bool next(int i, Unit& u) const {
        const long L = (long)i * G + c; if (L >= nwg) return false;
        int wgid = (int)L; { const int q = nwg / NXCD, r = nwg % NXCD, xcd = wgid % NXCD, off = wgid / NXCD; wgid = (xcd < r ? xcd * (q + 1) : r * (q + 1) + (xcd - r) * q) + off; }
        const int nig = WGM * nN, gid = wgid / nig, fm = gid * WGM, gsz = (nM - fm) < WGM ? (nM - fm) : WGM;
        u.pm = fm + ((wgid % nig) % gsz); u.pn = (wgid % nig) / gsz; return true;
    }
    __device__ __forceinline__ void a_ready(const Unit&) const {}
    __device__ __forceinline__ void done(const Unit&) const {}
};

struct EpiSwiGLU {
    static constexpr bool PERM = true, AFTER_DRAIN = false;
    bf16_t* H; const float* rs;
    __device__ __forceinline__ void operator()(const f32x4 (&acc)[2][2][4][2], const Unit& u, int wr, int wc, int fr, int fq) const {
        const int row0 = u.pm * BM + wr * 64 + fr, col = u.pn * 128 + wc * 32 + 8 * fq;
#pragma unroll
        for (int ai = 0; ai < 2; ++ai)
#pragma unroll
            for (int m = 0; m < 4; ++m) { const int row = row0 + ai * HALF + m * 16; const float r = rs[row];
                const f32x4 g0 = acc[ai][0][m][0] * r, g1 = acc[ai][0][m][1] * r, u0 = acc[ai][1][m][0] * r, u1 = acc[ai][1][m][1] * r;
                u32x4 w;
                w.x = pk2(siluf_(g0[0]) * u0[0], siluf_(g0[1]) * u0[1]); w.y = pk2(siluf_(g0[2]) * u0[2], siluf_(g0[3]) * u0[3]);
                w.z = pk2(siluf_(g1[0]) * u1[0], siluf_(g1[1]) * u1[1]); w.w = pk2(siluf_(g1[2]) * u1[2], siluf_(g1[3]) * u1[3]);
                *(u32x4*)(H + (size_t)row * FF + col) = w;
            }
    }
};
struct EpiPlain {
    static constexpr bool PERM = true, AFTER_DRAIN = false;
    bf16_t* O; int ldc;
    __device__ __forceinline__ void operator()(const f32x4 (&acc)[2][2][4][2], const Unit& u, int wr, int wc, int fr, int fq) const {
        const int row0 = u.pm * BM + wr * 64 + fr, col0 = u.pn * BM + wc * 32 + 8 * fq;
#pragma unroll
        for (int ai = 0; ai < 2; ++ai)
#pragma unroll
            for (int m = 0; m < 4; ++m) { bf16_t* rowp = O + (size_t)(row0 + ai * HALF + m * 16) * ldc + col0;
#pragma unroll
                for (int bj = 0; bj < 2; ++bj) { const f32x4 v0 = acc[ai][bj][m][0], v1 = acc[ai][bj][m][1];
                    u32x4 w; w.x = pk2(v0[0], v0[1]); w.y = pk2(v0[2], v0[3]); w.z = pk2(v1[0], v1[1]); w.w = pk2(v1[2], v1[3]);
                    *(u32x4*)(rowp + bj * HALF) = w; } }
    }
};
struct EpiQKV {
    static constexpr bool PERM = true, AFTER_DRAIN = false;
    bf16_t* O; const f32x2* tab; const float* rs;
    __device__ __forceinline__ void operator()(const f32x4 (&acc)[2][2][4][2], const Unit& u, int wr, int wc, int fr, int fq) const {
        const int row0 = u.pm * BM + wr * 64 + fr, col0 = u.pn * BM + wc * 32 + 8 * fq;
        const bool rot = (u.pn < 16);
        f32x2 cs[2][4];
#pragma unroll
        for (int ai = 0; ai < 2; ++ai)
#pragma unroll
            for (int m = 0; m < 4; ++m) { cs[ai][m] = (f32x2){1.f, 0.f};
                if (rot) { const int row = row0 + ai * HALF + m * 16; const int pos = row < 32768 ? (row & 16383) : (row & 8191); cs[ai][m] = tab[pos * 16 + 4 * wc + fq]; } }
#pragma unroll
        for (int ai = 0; ai < 2; ++ai)
#pragma unroll
            for (int m = 0; m < 4; ++m) { const int row = row0 + ai * HALF + m * 16; bf16_t* rowp = O + (size_t)row * (3 * D) + col0; const f32x2 c = cs[ai][m]; const float r = rs[row];
#pragma unroll
                for (int bj = 0; bj < 2; ++bj) { const f32x4 v0 = acc[ai][bj][m][0] * r, v1 = acc[ai][bj][m][1] * r;
                    u32x4 w; w.x = pk2(v0[0] * c[0] - v0[1] * c[1], v0[0] * c[1] + v0[1] * c[0]); w.y = pk2(v0[2], v0[3]); w.z = pk2(v1[0], v1[1]); w.w = pk2(v1[2], v1[3]);
                    *(u32x4*)(rowp + bj * HALF) = w; } }
    }
};
struct EpiG1 {
    static constexpr bool PERM = true, AFTER_DRAIN = false;
    unsigned char* ws; size_t r_off, v_off, h_off; int mode;
    __device__ __forceinline__ void operator()(const f32x4 (&acc)[2][2][4][2], const Unit& u, int wr, int wc, int fr, int fq) const {
        const int row0 = u.pm * BM + wr * 64 + fr; const int t = u.pn >> 3;
        size_t off = r_off + (size_t)t * (192u << 20); int ldc = D, colt = (u.pn & 7) * BM, act = 0;
        if (t == 2) off = v_off;
        if (t >= 3) { off = h_off; ldc = HID; colt = 768; }
        if (mode == 1) { off = h_off; ldc = HID; colt = u.pn * BM; act = (u.pn == 0) ? 1 : ((u.pn == 2) ? 2 : 0); }
        bf16_t* base = (bf16_t*)(ws + off);
        const int col0 = colt + wc * 32 + 8 * fq;
#pragma unroll
        for (int ai = 0; ai < 2; ++ai)
#pragma unroll
            for (int m = 0; m < 4; ++m) { bf16_t* rowp = base + (size_t)(row0 + ai * HALF + m * 16) * ldc + col0;
#pragma unroll
                for (int bj = 0; bj < 2; ++bj) { f32x4 v0 = acc[ai][bj][m][0], v1 = acc[ai][bj][m][1];
                    if (act == 1) {
#pragma unroll
                        for (int j = 0; j < 4; ++j) { v0[j] = tanhf_(v0[j]); v1[j] = tanhf_(v1[j]); } }
                    if (act == 2) {
#pragma unroll
                        for (int j = 0; j < 4; ++j) { v0[j] = sigmoidf_(v0[j]); v1[j] = sigmoidf_(v1[j]); } }
                    u32x4 w; w.x = pk2(v0[0], v0[1]); w.y = pk2(v0[2], v0[3]); w.z = pk2(v1[0], v1[1]); w.w = pk2(v1[2], v1[3]);
                    *(u32x4*)(rowp + bj * HALF) = w; } }
    }
};
struct EpiVres {
    static constexpr bool PERM = true, AFTER_DRAIN = false;
    bf16_t* V; const bf16_t* VF; const float* v0;
    __device__ __forceinline__ void operator()(const f32x4 (&acc)[2][2][4][2], const Unit& u, int wr, int wc, int fr, int fq) const {
        const int row0 = u.pm * BM + wr * 64 + fr, col0 = u.pn * BM + wc * 32 + 8 * fq;
#pragma unroll
        for (int ai = 0; ai < 2; ++ai)
#pragma unroll
            for (int m = 0; m < 4; ++m) { const size_t ro = (size_t)(row0 + ai * HALF + m * 16) * D + col0;
#pragma unroll
                for (int bj = 0; bj < 2; ++bj) { const f32x4 a0 = acc[ai][bj][m][0], a1 = acc[ai][bj][m][1];
                    const u32x4 vv = *(const u32x4*)(V + ro + bj * HALF), vf = *(const u32x4*)(VF + ro + bj * HALF);
                    const f32x4 b0 = *(const f32x4*)(v0 + col0 + bj * HALF), b1 = *(const f32x4*)(v0 + col0 + bj * HALF + 4);
                    float o[8]; const unsigned vw[4] = {vv.x, vv.y, vv.z, vv.w}, fw[4] = {vf.x, vf.y, vf.z, vf.w};
#pragma unroll
                    for (int j = 0; j < 4; ++j) { const float g0 = sigmoidf_((j < 2 ? b0[2 * j] : b1[2 * j - 4]) + (j < 2 ? a0[2 * j] : a1[2 * j - 4]));
                        const float g1 = sigmoidf_((j < 2 ? b0[2 * j + 1] : b1[2 * j - 3]) + (j < 2 ? a0[2 * j + 1] : a1[2 * j - 3]));
                        const float x0 = bflo(vw[j]), x1 = bfhi(vw[j]), f0 = bflo(fw[j]), f1 = bfhi(fw[j]);
                        o[2 * j] = x0 + (f0 - x0) * g0; o[2 * j + 1] = x1 + (f1 - x1) * g1; }
                    u32x4 w; w.x = pk2(o[0], o[1]); w.y = pk2(o[2], o[3]); w.z = pk2(o[4], o[5]); w.w = pk2(o[6], o[7]);
                    *(u32x4*)(V + ro + bj * HALF) = w; } }
    }
};
struct EpiGmul {
    static constexpr bool PERM = true, AFTER_DRAIN = false;
    bf16_t* Y;
    __device__ __forceinline__ void operator()(const f32x4 (&acc)[2][2][4][2], const Unit& u, int wr, int wc, int fr, int fq) const {
        const int row0 = u.pm * BM + wr * 64 + fr, col0 = u.pn * BM + wc * 32 + 8 * fq;
#pragma unroll
        for (int ai = 0; ai < 2; ++ai)
#pragma unroll
            for (int m = 0; m < 4; ++m) { const size_t ro = (size_t)(row0 + ai * HALF + m * 16) * D + col0;
#pragma unroll
                for (int bj = 0; bj < 2; ++bj) { const f32x4 a0 = acc[ai][bj][m][0], a1 = acc[ai][bj][m][1];
                    const u32x4 y = *(const u32x4*)(Y + ro + bj * HALF);
                    u32x4 w; w.x = pk2(bflo(y.x) * a0[0], bfhi(y.x) * a0[1]); w.y = pk2(bflo(y.y) * a0[2], bfhi(y.y) * a0[3]);
                    w.z = pk2(bflo(y.z) * a1[0], bfhi(y.z) * a1[1]); w.w = pk2(bflo(y.w) * a1[2], bfhi(y.w) * a1[3]);
                    *(u32x4*)(Y + ro + bj * HALF) = w; } }
    }
};

template <class Epi, class Sched, bool ALIGN_EPI = false, bool SP2 = false>
__device__ __forceinline__ void gemm_phase(PG8_LAS unsigned char* lds, const Gemm g, const Sched& S, const Epi& E, const int tid) {
    const int wid = __builtin_amdgcn_readfirstlane(tid >> 6), lane = tid & 63, wr = wid >> 2, wc = wid & 3, fr = lane & 15, fq = lane >> 4;
    const int K = g.K, nt = K / BK, lda = g.lda;
    unsigned voffA[2], voffB[2];
#pragma unroll
    for (int i = 0; i < 2; ++i) { int R, C; stage_rc(tid * 16 + i * 8192, R, C); const int Rb = Epi::PERM ? ((R & ~31) + perm32(R & 31)) : R;
        voffA[i] = (unsigned)(R * lda + C) * 2u; voffB[i] = (unsigned)(Rb * K + C) * 2u; }
    const size_t kstep = (size_t)(BK * 2);
    const size_t hstepA = (size_t)HALF * lda * 2, hstepB = (size_t)HALF * K * 2;
    const size_t tstepA = 2 * hstepA, tstepB = 2 * hstepB;
    const unsigned ldsw = (unsigned)wid * 1024u;
    const int aoff = lds_byte(wr * 64 + fr, fq * 8), boff = lds_byte(wc * 32 + fr, fq * 8);
#define PG8_SA(b, h) (((b) * 2 + (h)) * HTB)
#define PG8_SB(b, h) ((4 + (b) * 2 + (h)) * HTB)
#define PG8_STAGE(bufoff, gbase, voff) do { _Pragma("unroll") for (int _i = 0; _i < 2; ++_i) \
        __builtin_amdgcn_global_load_lds((const unsigned*)((const char*)(gbase) + (voff)[_i]), (PG8_LAS unsigned*)(lds + (bufoff) + ldsw + _i * 8192), 16, 0, 0); } while (0)
#define PG8_LDA(dst, b, h) do { _Pragma("unroll") for (int m = 0; m < 4; ++m) _Pragma("unroll") for (int k = 0; k < 2; ++k) dst[m][k] = *(const PG8_LAS bf16x8*)(lds + PG8_SA(b, h) + aoff + m * 2048 + k * 1024); } while (0)
#define PG8_LDB(dst, b, h) do { _Pragma("unroll") for (int n = 0; n < 2; ++n) _Pragma("unroll") for (int k = 0; k < 2; ++k) dst[n][k] = *(const PG8_LAS bf16x8*)(lds + PG8_SB(b, h) + boff + n * 2048 + k * 1024); } while (0)
#define PG8_MMA(ai, bj, At, Bt) do { __builtin_amdgcn_s_setprio(1); _Pragma("unroll") for (int m = 0; m < 4; ++m) _Pragma("unroll") for (int n = 0; n < 2; ++n) _Pragma("unroll") for (int k = 0; k < 2; ++k) \
        acc[ai][bj][m][n] = __builtin_amdgcn_mfma_f32_16x16x32_bf16(Bt[n][k], At[m][k], acc[ai][bj][m][n], 0, 0, 0); __builtin_amdgcn_s_setprio(0); } while (0)
#define PG8_WAIT_V(n) asm volatile("s_waitcnt vmcnt(" #n ")" ::: "memory")
#define PG8_WAIT_L(n) asm volatile("s_waitcnt lgkmcnt(" #n ")" ::: "memory")
#define PG8_BAR __builtin_amdgcn_s_barrier()
#define PG8_SCHED __builtin_amdgcn_sched_barrier(0)
    Unit cur, nxt; int ui = 0;
    if (!S.next(0, cur)) return;
    f32x4 acc[2][2][4][2];
#pragma unroll
    for (int a = 0; a < 2; ++a)
#pragma unroll
        for (int b = 0; b < 2; ++b)
#pragma unroll
            for (int m = 0; m < 4; ++m)
#pragma unroll
                for (int n = 0; n < 2; ++n) acc[a][b][m][n] = (f32x4){0.f, 0.f, 0.f, 0.f};
    bf16x8 At[4][2], B0[2][2], B1[2][2];
    const char* cA = (const char*)g.A + (size_t)cur.pm * tstepA + (size_t)((cur.pn >= g.g0) + (cur.pn >= g.g1)) * g.a_gstride; const char* cB = (const char*)g.Bt + (size_t)cur.pn * tstepB;
    S.a_ready(cur);
    if constexpr (SP2) {
        PG8_STAGE(PG8_SB(0, 0), cB, voffB); PG8_STAGE(PG8_SB(0, 1), cB + hstepB, voffB); PG8_STAGE(PG8_SA(0, 0), cA, voffA); PG8_STAGE(PG8_SA(0, 1), cA + hstepA, voffA);
        if (wr == 1) PG8_BAR;
        PG8_WAIT_V(2); PG8_BAR;
        PG8_STAGE(PG8_SB(1, 0), cB + kstep, voffB); PG8_STAGE(PG8_SA(1, 0), cA + kstep, voffA); PG8_STAGE(PG8_SB(1, 1), cB + hstepB + kstep, voffB);
        PG8_WAIT_V(6); PG8_BAR;
    } else {
        PG8_STAGE(PG8_SB(0, 0), cB, voffB); PG8_STAGE(PG8_SA(0, 0), cA, voffA); PG8_STAGE(PG8_SB(0, 1), cB + hstepB, voffB); PG8_STAGE(PG8_SA(0, 1), cA + hstepA, voffA);
        if (wr == 1) PG8_BAR;
        PG8_WAIT_V(4); PG8_BAR;
        PG8_STAGE(PG8_SB(1, 0), cB + kstep, voffB); PG8_STAGE(PG8_SA(1, 0), cA + kstep, voffA); PG8_STAGE(PG8_SB(1, 1), cB + hstepB + kstep, voffB);
        PG8_WAIT_V(6); PG8_BAR;
    }
    for (;;) {
        const bool has_next = S.next(ui + 1, nxt);
        const char* nA = has_next ? (const char*)g.A + (size_t)nxt.pm * tstepA + (size_t)((nxt.pn >= g.g0) + (nxt.pn >= g.g1)) * g.a_gstride : cA; const char* nB = has_next ? (const char*)g.Bt + (size_t)nxt.pn * tstepB : cB;
        for (int t = 0; t < nt; t += 2) {
            const bool last = (t == nt - 2);
            const char* a1 = cA + (size_t)(t + 1) * kstep;
            const char* a2 = last ? nA : cA + (size_t)(t + 2) * kstep; const char* b2 = last ? nB : cB + (size_t)(t + 2) * kstep;
            const char* a3 = a2 + kstep; const char* b3 = b2 + kstep;
            if (last && has_next) S.a_ready(nxt);
            if constexpr (SP2) {
            PG8_LDB(B0, 0, 0); PG8_LDB(B1, 0, 1); PG8_SCHED; PG8_LDA(At, 0, 0); PG8_STAGE(PG8_SA(1, 1), a1 + hstepA, voffA);
            PG8_WAIT_V(8); PG8_WAIT_L(0); PG8_BAR; PG8_MMA(0, 0, At, B0); PG8_MMA(0, 1, At, B1); PG8_BAR; PG8_SCHED;
            PG8_LDA(At, 0, 1); PG8_STAGE(PG8_SB(0, 0), b2, voffB); PG8_STAGE(PG8_SB(0, 1), b2 + hstepB, voffB); PG8_STAGE(PG8_SA(0, 0), a2, voffA);
            PG8_WAIT_V(8); PG8_WAIT_L(0); PG8_BAR; PG8_MMA(1, 0, At, B0); PG8_MMA(1, 1, At, B1); PG8_BAR; PG8_SCHED;
            PG8_LDB(B0, 1, 0); PG8_LDB(B1, 1, 1); PG8_SCHED; PG8_LDA(At, 1, 0); PG8_STAGE(PG8_SA(0, 1), a2 + hstepA, voffA);
            PG8_WAIT_V(8); PG8_WAIT_L(0); PG8_BAR; PG8_MMA(0, 0, At, B0); PG8_MMA(0, 1, At, B1); PG8_BAR; PG8_SCHED;
            PG8_LDA(At, 1, 1); PG8_STAGE(PG8_SB(1, 0), b3, voffB); PG8_STAGE(PG8_SB(1, 1), b3 + hstepB, voffB); PG8_STAGE(PG8_SA(1, 0), a3, voffA);
            PG8_WAIT_V(8); PG8_WAIT_L(0); PG8_BAR; PG8_MMA(1, 0, At, B0); PG8_MMA(1, 1, At, B1); PG8_BAR; PG8_SCHED;
            } else {
            PG8_LDB(B0, 0, 0); PG8_SCHED; PG8_LDA(At, 0, 0); PG8_STAGE(PG8_SA(1, 1), a1 + hstepA, voffA);
            PG8_WAIT_L(8); PG8_BAR; PG8_WAIT_L(0); PG8_MMA(0, 0, At, B0); PG8_BAR; PG8_SCHED;
            PG8_LDB(B1, 0, 1); PG8_STAGE(PG8_SB(0, 0), b2, voffB);
            PG8_BAR; PG8_WAIT_L(0); PG8_MMA(0, 1, At, B1); PG8_BAR;
            PG8_LDA(At, 0, 1); PG8_STAGE(PG8_SA(0, 0), a2, voffA);
            PG8_BAR; PG8_WAIT_L(0); PG8_MMA(1, 0, At, B0); PG8_BAR; PG8_SCHED;
            PG8_STAGE(PG8_SB(0, 1), b2 + hstepB, voffB);
            PG8_WAIT_V(6); PG8_BAR; PG8_MMA(1, 1, At, B1); PG8_BAR;
            PG8_LDB(B0, 1, 0); PG8_SCHED; PG8_LDA(At, 1, 0); PG8_STAGE(PG8_SA(0, 1), a2 + hstepA, voffA);
            PG8_WAIT_L(8); PG8_BAR; PG8_WAIT_L(0); PG8_MMA(0, 0, At, B0); PG8_BAR; PG8_SCHED;
            PG8_LDB(B1, 1, 1); PG8_STAGE(PG8_SB(1, 0), b3, voffB);
            PG8_BAR; PG8_WAIT_L(0); PG8_MMA(0, 1, At, B1); PG8_BAR;
            PG8_LDA(At, 1, 1); PG8_STAGE(PG8_SA(1, 0), a3, voffA);
            PG8_BAR; PG8_WAIT_L(0); PG8_MMA(1, 0, At, B0); PG8_BAR; PG8_SCHED;
            PG8_STAGE(PG8_SB(1, 1), b3 + hstepB, voffB);
            PG8_WAIT_V(6); PG8_BAR; PG8_MMA(1, 1, At, B1); PG8_BAR;
            }
        }
        if constexpr (ALIGN_EPI) { if (wr == 0) PG8_BAR; }
        if constexpr (!Epi::AFTER_DRAIN) { E(acc, cur, wr, wc, fr, fq); S.done(cur); }
        if (!has_next) break;
#pragma unroll
        for (int a = 0; a < 2; ++a)
#pragma unroll
            for (int b = 0; b < 2; ++b)
#pragma unroll
                for (int m = 0; m < 4; ++m)
#pragma unroll
                    for (int n = 0; n < 2; ++n) acc[a][b][m][n] = (f32x4){0.f, 0.f, 0.f, 0.f};
        cur = nxt; cA = nA; cB = nB; ++ui;
        if constexpr (ALIGN_EPI) { if (wr == 1) PG8_BAR; }
    }
    PG8_WAIT_V(0);
    if constexpr (!ALIGN_EPI) { if (wr == 0) PG8_BAR; }
    PG8_BAR;
#undef PG8_SA
#undef PG8_SB
#undef PG8_STAGE
#undef PG8_LDA
#undef PG8_LDB
#undef PG8_MMA
#undef PG8_WAIT_V
#undef PG8_WAIT_L
#undef PG8_BAR
#undef PG8_SCHED
}
}

#define XB_TMO      128
#define XB_XCNT(j)  (256  + 64 * (j))
#define XB_XSUB(j)  (1280 + 64 * (j))
#define XB_XGEN(j)  (2304 + 64 * (j))
#define XB_TOP      3328
#define XB_TOPGEN   3392
#define XCD_BAR_WORDS 3456
#define XB_SPIN_CAP (1u << 22)
__device__ __forceinline__ unsigned xb_ld(unsigned* p)              { return __hip_atomic_load(p, __ATOMIC_RELAXED, __HIP_MEMORY_SCOPE_AGENT); }
__device__ __forceinline__ unsigned xb_add(unsigned* p, unsigned v) { return __hip_atomic_fetch_add(p, v, __ATOMIC_RELAXED, __HIP_MEMORY_SCOPE_AGENT); }
__device__ __forceinline__ unsigned xb_xcc_id() { return (unsigned)__builtin_amdgcn_s_getreg((3 << 11) | 20) & 0xFu; }
#define XB_SPIN(cond, bar) do { unsigned _sp = 0; while (cond) { __builtin_amdgcn_s_sleep(1); \
    if ((++_sp & 255u) == 0u) { if (xb_ld(&(bar)[XB_TMO])) break; if (_sp > XB_SPIN_CAP) { atomicAdd(&(bar)[XB_TMO], 1u); break; } } } } while (0)
struct XcdBarrier { unsigned* bar; unsigned x; volatile LAS unsigned* st; };
__device__ __forceinline__ XcdBarrier xcd_barrier_post(unsigned* bar, volatile LAS unsigned* st) {
    XcdBarrier b; b.bar = bar; b.x = xb_xcc_id(); b.st = st;
    if (threadIdx.x == 0) (void)xb_add(&bar[XB_XCNT(b.x)], 1u);
    return b;
}
__device__ __forceinline__ void xcd_barrier_complete(unsigned* bar, unsigned x, unsigned& nloc, unsigned& nx) {
    const unsigned G = gridDim.x * gridDim.y * gridDim.z;
    unsigned sum, cnt, mine, sp = 0u;
    for (;;) {
        sum = 0u; cnt = 0u; mine = 0u;
#pragma unroll
        for (unsigned j = 0; j < 16; ++j) { const unsigned c = xb_ld(&bar[XB_XCNT(j)]); sum += c; cnt += (c > 0u) ? 1u : 0u; mine = (j == x) ? c : mine; }
        if (sum == G) break;
        __builtin_amdgcn_s_sleep(1);
        if ((++sp & 255u) == 0u) { if (xb_ld(&bar[XB_TMO])) break; if (sp > XB_SPIN_CAP) { atomicAdd(&bar[XB_TMO], 1u); break; } }
    }
    nloc = mine > 0u ? mine : 1u; nx = cnt > 0u ? cnt : 1u;
}
__device__ __forceinline__ void xcd_barrier(const XcdBarrier& b) {
    asm volatile("s_waitcnt vmcnt(0)" ::: "memory");
    __syncthreads();
    if (threadIdx.x == 0) {
        unsigned* bar = b.bar;
        __builtin_amdgcn_s_waitcnt(0);
        unsigned nloc = b.st[0], nx = b.st[1];
        if (nloc == 0u) { xcd_barrier_complete(bar, b.x, nloc, nx); b.st[0] = nloc; b.st[1] = nx; }
        const unsigned old = xb_add(&bar[XB_XSUB(b.x)], 1u);
        const unsigned gen = old / nloc;
        if (old + 1u == (gen + 1u) * nloc) {
            __builtin_amdgcn_fence(__ATOMIC_RELEASE, "agent");
            asm volatile("s_waitcnt vmcnt(0)" ::: "memory");
            const unsigned og = xb_add(&bar[XB_TOP], 1u);
            const unsigned tg = og / nx;
            if (og + 1u == (tg + 1u) * nx) xb_add(&bar[XB_TOPGEN], 1u);
            else XB_SPIN(xb_ld(&bar[XB_TOPGEN]) == tg, bar);
            __builtin_amdgcn_fence(__ATOMIC_ACQUIRE, "agent");
            xb_add(&bar[XB_XGEN(b.x)], 1u);
            asm volatile("s_waitcnt vmcnt(0)" ::: "memory");
        } else {
            XB_SPIN(xb_ld(&bar[XB_XGEN(b.x)]) == gen, bar);
            __builtin_amdgcn_fence(__ATOMIC_ACQUIRE, "agent");
            asm volatile("s_waitcnt vmcnt(0)" ::: "memory");
        }
    }
    __syncthreads();
}

constexpr size_t MiB = 1u << 20;
constexpr size_t WS_CTL = 0, CTL_ZERO_BYTES = 1 * MiB;
constexpr size_t WS_ROPE = 1 * MiB;
constexpr size_t WS_WTS = 4 * MiB;
constexpr size_t W_UP0 = WS_WTS, W_DN0 = WS_WTS + 44 * MiB, W_UP1 = WS_WTS + 66 * MiB, W_DN1 = WS_WTS + 110 * MiB;
constexpr size_t W_MIX = WS_WTS + 132 * MiB;
constexpr size_t W_G2 = W_MIX + 25 * MiB, W_GG = W_MIX + 28 * MiB, W_GV = W_MIX + 29 * MiB;
constexpr size_t W_GO = WS_WTS + 212 * MiB;
constexpr size_t WS_VF = 228 * MiB;
constexpr size_t WS_POOL = 420 * MiB;
constexpr size_t P_XN = WS_POOL;
constexpr size_t P_H = WS_POOL + 192 * MiB, P_HOUT = WS_POOL + 720 * MiB;
constexpr size_t P_MIX = WS_POOL + 192 * MiB;
constexpr size_t P_YF = WS_POOL + 192 * MiB, P_YB = WS_POOL + 384 * MiB, P_R = WS_POOL + 768 * MiB, P_K = WS_POOL + 960 * MiB, P_V = WS_POOL + 1152 * MiB,
                 P_HID = WS_POOL + 1344 * MiB, P_BS = WS_POOL + 1440 * MiB;
constexpr size_t P_QKV = WS_POOL + 192 * MiB, P_O0 = WS_POOL + 768 * MiB, P_LSE = WS_POOL + 1344 * MiB;
constexpr size_t WS_END = WS_POOL + 1452 * MiB;
constexpr int CW_BAR = 4096;
constexpr size_t WS_SCANFLAG = 512 * 1024;
constexpr int SCAN_NH = 63;
constexpr int SCAN_DUMP_U = 4592, SCAN_SLOT = 73728, SCAN_SLOTS_OUT = 5461;
constexpr size_t WS_RSX = 65536;

constexpr int RING_BYTES = 131072, CTRL_OFF = 143360, MISC_OFF = CTRL_OFF + 256, LDS_BYTES = 163840;
constexpr int NWAVES = 8;

struct Args { const float* in[28]; float* out; unsigned char* ws; int step_lo, step_hi; };

struct Seg { unsigned long long woff, soff, doff; int widx, sidx, ldw, col0, ldt, row0, k0dst, nkb, nnb, ilv, item0, pad0; };
__device__ __forceinline__ void seg_add(LAS Seg* s, int& n, int& items, int widx, size_t woff, int sidx, size_t soff, size_t doff, int ldw, int col0, int ldt, int row0, int k0dst, int nkb, int nnb, int ilv) {
    s[n].widx = widx; s[n].woff = woff; s[n].sidx = sidx; s[n].soff = soff; s[n].doff = doff; s[n].ldw = ldw; s[n].col0 = col0; s[n].ldt = ldt; s[n].row0 = row0; s[n].k0dst = k0dst; s[n].nkb = nkb; s[n].nnb = nnb; s[n].ilv = ilv; s[n].item0 = items;
    items += nkb * nnb; ++n;
}

extern __shared__ __attribute__((aligned(16))) unsigned char lds_raw[];
constexpr int PTR_OFF = CTRL_OFF + 512;
__device__ __forceinline__ unsigned long long ptr_ld(int i) {
    const LAS unsigned* p = (const LAS unsigned*)((LAS unsigned char*)lds_raw + PTR_OFF) + 2 * i;
    const unsigned lo = __builtin_amdgcn_readfirstlane(p[0]), hi = __builtin_amdgcn_readfirstlane(p[1]);
    return ((unsigned long long)hi << 32) | lo;
}
__device__ __forceinline__ const float* inp(int i) { return (const float*)(const GAS float*)ptr_ld(i); }
__device__ __forceinline__ float* outp() { return (float*)(GAS float*)ptr_ld(28); }
__device__ __forceinline__ unsigned char* wsp() { return (unsigned char*)(GAS unsigned char*)ptr_ld(29); }
#define FRAME() LAS unsigned char* lds = (LAS unsigned char*)lds_raw; int tid = threadIdx.x; asm volatile("" : "+v"(tid)); const int lane = tid & 63, wave = __builtin_amdgcn_readfirstlane(tid >> 6); \
    int bid_ = blockIdx.x, G = gridDim.x; asm volatile("" : "+s"(bid_), "+s"(G)); const int gw = bid_ * NWAVES + wave, NGW = G * NWAVES; unsigned char* ws = wsp(); (void)lds; (void)lane; (void)gw; (void)NGW; (void)ws; (void)G

static __device__ PHASE_ATTR void ph_init() {
    FRAME();
    const float* in0 = inp(0); const float* in1 = inp(1);
    {
        f32x2* tab = (f32x2*)(ws + WS_ROPE);
        for (int idx = bid_ * 512 + tid; idx < 16384 * 16; idx += G * 512) {
            const int pos = idx >> 4, i = idx & 15;
            double iv = 1.0;
            iv = (i == 1) ? 0.44036660267178046 : iv; iv = (i == 2) ? 0.19392274474868576 : iv; iv = (i == 3) ? 0.08539710028576561 : iv; iv = (i == 4) ? 0.03760603093086393 : iv;
            iv = (i == 5) ? 0.016560440080994446 : iv; iv = (i == 6) ? 0.007292664737217109 : iv; iv = (i == 7) ? 0.003211445994752591 : iv; iv = (i == 8) ? 0.001414213562373095 : iv;
            iv = (i == 9) ? 0.000622772421914596 : iv; iv = (i == 10) ? 0.0002742481756762073 : iv; iv = (i == 11) ? 0.00012076973741146504 : iv; iv = (i == 12) ? 5.318295896944988e-05 : iv;
            iv = (i == 13) ? 2.341999896140934e-05 : iv; iv = (i == 14) ? 1.031338537721246e-05 : iv; iv = (i == 15) ? 4.5416704806078695e-06 : iv;
            double t = (double)pos * iv * 0.15915494309189535; t = t - __builtin_rint(t);
            const float tf = (float)t;
            tab[idx] = (f32x2){__builtin_amdgcn_cosf(tf), __builtin_amdgcn_sinf(tf)};
        }
    }
    bf16_t* XB = (bf16_t*)(ws + P_XN); float* RSX = (float*)(ws + WS_RSX);
    for (int row = gw; row < TT; row += NGW) {
        const float* src = row < 32768 ? in0 + (size_t)row * D : in1 + (size_t)(row - 32768) * D;
        float ss = 0.f;
#pragma unroll
        for (int i = 0; i < 4; ++i) { const int e = 8 * (lane + 64 * i); const f32x4 a = *(const f32x4*)(src + e), b = *(const f32x4*)(src + e + 4);
#pragma unroll
            for (int j = 0; j < 4; ++j) ss += a[j] * a[j] + b[j] * b[j];
            *(u32x4*)(XB + (size_t)row * D + e) = (u32x4){pk2(a[0], a[1]), pk2(a[2], a[3]), pk2(b[0], b[1]), pk2(b[2], b[3])}; }
        const float rx = rsqrtf(wave_sum(ss) * (1.0f / D) + NORM_EPS);
        if (lane == 0) RSX[row] = rx;
    }
}

__device__ __forceinline__ void conv_load(const LAS Seg* sp, int local, int lane, f32x4 (&v)[8]) {
    const int widx = sp->widx; if (widx < 0) return;
    const int ldw = sp->ldw, nnb = sp->nnb, kb = local / nnb, nb = local % nnb;
    const float* p = inp(widx) + sp->woff + (size_t)(64 * kb + (lane >> 3)) * ldw + sp->col0 + 32 * nb + 4 * (lane & 7);
#pragma unroll
    for (int i = 0; i < 8; ++i) v[i] = *(const f32x4*)(p + (size_t)(8 * i) * ldw);
}
__device__ __forceinline__ void conv_finish(const LAS Seg* sp, int local, LAS float* scr, int lane, const f32x4 (&v)[8], unsigned char* ws) {
    const int widx = sp->widx, sidx = sp->sidx, ldt = sp->ldt, row0 = sp->row0, k0dst = sp->k0dst, nnb = sp->nnb, ilv = sp->ilv;
    bf16_t* dst = (bf16_t*)(ws + sp->doff);
    const int kb = local / nnb, nb = local % nnb, k0 = 64 * kb, n0 = 32 * nb, c = lane & 7;
    if (widx >= 0) {
        const float* scale = sidx >= 0 ? inp(sidx) + sp->soff + k0 + (lane >> 3) : nullptr;
#pragma unroll
        for (int i = 0; i < 8; ++i) { const int kk = (lane >> 3) + 8 * i; const float sc = scale ? scale[8 * i] : 1.0f;
            LAS float* s = scr + kk * 33 + 4 * (lane & 7); s[0] = v[i][0] * sc; s[1] = v[i][1] * sc; s[2] = v[i][2] * sc; s[3] = v[i][3] * sc; }
        asm volatile("s_waitcnt lgkmcnt(0)" ::: "memory");
    }
#pragma unroll
    for (int j = 0; j < 4; ++j) { const int n = (lane >> 3) + 8 * j; const int nn = n0 + n;
        int drow = row0 + ((ilv == 1) ? (256 * (nn >> 7) + (nn & 127)) : nn);
        if (ilv == 2 && ((nn >> 11) % 3) < 2) {
            const int co = nn & 127;
            const int nl = co < 32 ? (8 * (co & 15) + (co >> 4)) : (8 * ((co - 32) / 6) + 2 + (co - 32) % 6);
            drow = row0 + (nn & ~127) + nl; }
        u32x4 o = {0u, 0u, 0u, 0u};
        if (widx >= 0) { const LAS float* s = scr + (8 * c) * 33 + n;
            o.x = pk2(s[0 * 33], s[1 * 33]); o.y = pk2(s[2 * 33], s[3 * 33]); o.z = pk2(s[4 * 33], s[5 * 33]); o.w = pk2(s[6 * 33], s[7 * 33]); }
        *(u32x4*)(dst + (size_t)drow * ldt + k0dst + k0 + 8 * c) = o; }
    asm volatile("s_waitcnt lgkmcnt(0)" ::: "memory");
}
static __device__ PHASE_ATTR void ph_conv(int L) {
    FRAME();
    const int jm = L >> 1; const bool is_attn = (L & 1) != 0;
    LAS Seg* segs = (LAS Seg*)lds; LAS int* nseg_p = (LAS int*)(lds + 4096); LAS float* scr = (LAS float*)(lds + 8192 + wave * 8448);
    if (tid == 0) {
        int n = 0, items = 0;
        for (int f = 0; f < 2; ++f) {
            const size_t wo = (size_t)(L * 2 + f) * D * FF;
            const size_t up = f ? W_UP1 : W_UP0, dn = f ? W_DN1 : W_DN0;
            seg_add(segs, n, items, 4, wo, 2, (size_t)(L * 3 + 2 * f) * D, up, FF, 0, D, 0, 0, D / 64, FF / 32, 1);
            seg_add(segs, n, items, 5, wo, 2, (size_t)(L * 3 + 2 * f) * D, up, FF, 0, D, 128, 0, D / 64, FF / 32, 1);
            seg_add(segs, n, items, 6, wo, -1, 0, dn, D, 0, FF, 0, 0, FF / 64, D / 32, 0);
        }
        if (!is_attn) {
            for (int p = 0; p < 3; ++p) seg_add(segs, n, items, 8, (size_t)(jm * 3 + p) * D * D, -1, 0, W_MIX, D, 0, D, p * D, 0, D / 64, D / 32, 0);
            if (jm > 0) { seg_add(segs, n, items, 16, (size_t)(jm - 1) * D * 64, -1, 0, W_MIX, 64, 0, D, 3 * D, 0, D / 64, 2, 0);
                          seg_add(segs, n, items, -1, 0, -1, 0, W_MIX, 0, 0, D, 3 * D + 64, 0, D / 64, 6, 0);
                          seg_add(segs, n, items, 17, (size_t)(jm - 1) * 64 * D, -1, 0, W_GV, D, 0, 256, 0, 0, 1, D / 32, 0);
                          seg_add(segs, n, items, -1, 0, -1, 0, W_GV, 0, 0, 256, 0, 64, 3, D / 32, 0); }
            else seg_add(segs, n, items, -1, 0, -1, 0, W_MIX, 0, 0, D, 3 * D, 0, D / 64, 8, 0);
            for (int d = 0; d < 2; ++d) {
                seg_add(segs, n, items, 10, (size_t)(jm * 2 + d) * D * 96, -1, 0, W_G2, 96, 0, D, d * 128, 0, D / 64, 3, 0);
                seg_add(segs, n, items, -1, 0, -1, 0, W_G2, 0, 0, D, d * 128 + 96, 0, D / 64, 1, 0);
                seg_add(segs, n, items, 13, (size_t)(jm * 2 + d) * D * 96, -1, 0, W_G2, 96, 0, D, 256 + d * 128, 0, D / 64, 3, 0);
                seg_add(segs, n, items, -1, 0, -1, 0, W_G2, 0, 0, D, 256 + d * 128 + 96, 0, D / 64, 1, 0);
            }
            seg_add(segs, n, items, 18, (size_t)jm * D * 256, -1, 0, W_G2, 256, 0, D, 512, 0, D / 64, 8, 0);
            seg_add(segs, n, items, 19, (size_t)jm * 256 * D, -1, 0, W_GG, D, 0, 256, 0, 0, 4, D / 32, 0);
            seg_add(segs, n, items, 25, (size_t)jm * D * D, -1, 0, W_GO, D, 0, D, 0, 0, D / 64, D / 32, 0);
        } else {
            seg_add(segs, n, items, 26, (size_t)jm * D * 9 * D, 2, (size_t)(L * 3 + 1) * D, W_MIX, 9 * D, 0, D, 0, 0, D / 64, 9 * D / 32, 2);
            seg_add(segs, n, items, 27, (size_t)jm * D * D, -1, 0, W_GO, D, 0, D, 0, 0, D / 64, D / 32, 0);
        }
        segs[n].item0 = items; nseg_p[0] = n; nseg_p[1] = items;
    }
    __syncthreads();
    const int total = nseg_p[1];
    f32x4 cur[8], nxt[8];
#pragma unroll
    for (int i = 0; i < 8; ++i) { cur[i] = (f32x4){0.f, 0.f, 0.f, 0.f}; nxt[i] = cur[i]; }
    int it = gw, si = 0;
    if (it < total) { while (it >= segs[si + 1].item0) ++si; conv_load(segs + si, it - segs[si].item0, lane, cur); }
    while (it < total) {
        const int itn = it + NGW; int sn = si;
        if (itn < total) { while (itn >= segs[sn + 1].item0) ++sn; conv_load(segs + sn, itn - segs[sn].item0, lane, nxt); }
        conv_finish(segs + si, it - segs[si].item0, scr, lane, cur, ws);
#pragma unroll
        for (int i = 0; i < 8; ++i) cur[i] = nxt[i];
        it = itn; si = sn;
    }
    __syncthreads();
}

static __device__ PHASE_ATTR void ph_ffn_up(int f) {
    FRAME();
    pg8::Gemm g{(const bf16_t*)(ws + P_XN), (const bf16_t*)(ws + (f ? W_UP1 : W_UP0)), TT, 2 * FF, D, D}; pg8::StaticOrder S; S.init(TT, 2 * FF, G, bid_);
    pg8::EpiSwiGLU E{(bf16_t*)(ws + P_H), (const float*)(ws + WS_RSX)};
    pg8::gemm_phase<pg8::EpiSwiGLU, pg8::StaticOrder, true, true>(lds, g, S, E, tid);
}
static __device__ PHASE_ATTR void ph_gemm_plain(size_t a_off, int lda, size_t b_off, int N, int K, size_t o_off, int ldc) {
    FRAME();
    pg8::Gemm g{(const bf16_t*)(ws + a_off), (const bf16_t*)(ws + b_off), TT, N, K, lda}; pg8::StaticOrder S; S.init(TT, N, G, bid_);
    pg8::EpiPlain E{(bf16_t*)(ws + o_off), ldc};
    pg8::gemm_phase<pg8::EpiPlain, pg8::StaticOrder, true, true>(lds, g, S, E, tid);
}
static __device__ PHASE_ATTR void ph_qkv(int gi) {
    FRAME();
    pg8::Gemm g{(const bf16_t*)(ws + P_XN), (const bf16_t*)(ws + W_MIX) + (size_t)gi * 3 * D * D, TT, 3 * D, D, D}; pg8::StaticOrder S; S.init(TT, 3 * D, G, bid_);
    pg8::EpiQKV E{(bf16_t*)(ws + P_QKV), (const f32x2*)(ws + WS_ROPE), (const float*)(ws + WS_RSX)};
    pg8::gemm_phase<pg8::EpiQKV, pg8::StaticOrder, true, true>(lds, g, S, E, tid);
}
static __device__ PHASE_ATTR void ph_g1(int jm, int round) {
    FRAME();
    pg8::Gemm g{(const bf16_t*)(ws + P_MIX), (const bf16_t*)(ws + (round ? W_G2 : W_MIX)), TT, round ? NG2 : NG1, D, D, (size_t)192 * MiB, round ? 1 : 8, round ? 2 : 16};
    pg8::StaticOrder S; S.init(TT, round ? NG2 : NG1, G, bid_);
    pg8::EpiG1 E{ws, P_R, (jm == 0 ? WS_VF : P_V), P_HID, round};
    pg8::gemm_phase<pg8::EpiG1, pg8::StaticOrder, true, true>(lds, g, S, E, tid);
}
static __device__ PHASE_ATTR void ph_gv(int jm) {
    FRAME();
    pg8::Gemm g{(const bf16_t*)(ws + P_HID) + 768, (const bf16_t*)(ws + W_GV), TT, D, 256, HID}; pg8::StaticOrder S; S.init(TT, D, G, bid_);
    pg8::EpiVres E{(bf16_t*)(ws + P_V), (const bf16_t*)(ws + WS_VF), inp(15) + (size_t)(jm - 1) * D};
    pg8::gemm_phase<pg8::EpiVres, pg8::StaticOrder, true, true>(lds, g, S, E, tid);
}
static __device__ PHASE_ATTR void ph_gg() {
    FRAME();
    pg8::Gemm g{(const bf16_t*)(ws + P_HID) + 512, (const bf16_t*)(ws + W_GG), TT, D, 256, HID}; pg8::StaticOrder S; S.init(TT, D, G, bid_);
    pg8::EpiGmul E{(bf16_t*)(ws + P_YF)};
    pg8::gemm_phase<pg8::EpiGmul, pg8::StaticOrder, true, true>(lds, g, S, E, tid);
}

static __device__ PHASE_ATTR void ph_mix(int jm, int round) {
    FRAME();
    const bf16_t* XB = (const bf16_t*)(ws + P_XN); const float* RSX = (const float*)(ws + WS_RSX); bf16_t* MX = (bf16_t*)(ws + P_MIX);
    const float* mu = inp(7) + (size_t)jm * 6 * D; const float* gpre = inp(2) + (size_t)((2 * jm) * 3 + 1) * D;
    const int m0 = round ? 1 : 0, m1 = round ? 4 : 2, m2 = round ? 5 : 3;
    u32x4 cq[4], pq[4], nq[4]; float rcq, rpq, rnq;
#define MIX_LOAD(row_) do { const int r_ = (row_); int base_, pos_, len_; row_decode(r_, base_, pos_, len_); const bf16_t* a_ = XB + (size_t)r_ * D; \
        rcq = RSX[r_]; rpq = pos_ > 0 ? RSX[r_ - 1] : 0.f; rnq = pos_ < len_ - 1 ? RSX[r_ + 1] : 0.f; \
        _Pragma("unroll") for (int i = 0; i < 4; ++i) { const int e = 8 * (lane + 64 * i); cq[i] = *(const u32x4*)(a_ + e); pq[i] = (u32x4){0u, 0u, 0u, 0u}; nq[i] = (u32x4){0u, 0u, 0u, 0u}; \
            if (pos_ > 0) pq[i] = *(const u32x4*)(a_ - D + e); if (pos_ < len_ - 1) nq[i] = *(const u32x4*)(a_ + D + e); } } while (0)
    int row = gw;
    if (row < TT) MIX_LOAD(row);
    for (; row < TT; row += NGW) {
        u32x4 cc[4], pc[4], nc[4];
#pragma unroll
        for (int i = 0; i < 4; ++i) { cc[i] = cq[i]; pc[i] = pq[i]; nc[i] = nq[i]; }
        const float rc = rcq, rp = rpq, rn = rnq;
        if (row + NGW < TT) MIX_LOAD(row + NGW);
#pragma unroll
        for (int i = 0; i < 4; ++i) { const int e = 8 * (lane + 64 * i);
            const unsigned cw[4] = {cc[i].x, cc[i].y, cc[i].z, cc[i].w}, pw[4] = {pc[i].x, pc[i].y, pc[i].z, pc[i].w}, nw[4] = {nc[i].x, nc[i].y, nc[i].z, nc[i].w};
            const f32x4 ga = *(const f32x4*)(gpre + e), gb = *(const f32x4*)(gpre + e + 4);
            float cv[8], xx[8];
#pragma unroll
            for (int j = 0; j < 4; ++j) { const float g0 = j < 2 ? ga[2 * j] : gb[2 * j - 4], g1 = j < 2 ? ga[2 * j + 1] : gb[2 * j - 3];
                cv[2 * j] = bflo(cw[j]) * rc * g0; cv[2 * j + 1] = bfhi(cw[j]) * rc * g1;
                xx[2 * j] = 0.5f * (bflo(pw[j]) * rp + bflo(nw[j]) * rn) * g0 - cv[2 * j]; xx[2 * j + 1] = 0.5f * (bfhi(pw[j]) * rp + bfhi(nw[j]) * rn) * g1 - cv[2 * j + 1]; }
#pragma unroll
            for (int m = 0; m < 3; ++m) { const int mi = m == 0 ? m0 : (m == 1 ? m1 : m2);
                const f32x4 ma = *(const f32x4*)(mu + mi * D + e), mb = *(const f32x4*)(mu + mi * D + e + 4);
                const u32x4 o = {pk2(cv[0] + xx[0] * ma[0], cv[1] + xx[1] * ma[1]), pk2(cv[2] + xx[2] * ma[2], cv[3] + xx[3] * ma[3]), pk2(cv[4] + xx[4] * mb[0], cv[5] + xx[5] * mb[1]), pk2(cv[6] + xx[6] * mb[2], cv[7] + xx[7] * mb[3])};
                *(u32x4*)(MX + (size_t)m * TT * D + (size_t)row * D + e) = o; }
        }
    }
#undef MIX_LOAD
}

static __device__ __forceinline__ void scan_stage_e(LAS unsigned char* lds, f32x4 (&ST)[4], const int lane, const int vb) {
    constexpr int RS = 72;
    LAS bf16_t* AH = (LAS bf16_t*)(lds); LAS bf16_t* RH = (LAS bf16_t*)(lds + 9216); LAS bf16_t* BT = (LAS bf16_t*)(lds + 36864); LAS bf16_t* YS = (LAS bf16_t*)(lds + 64512);
    LAS unsigned char* KVI = lds + 73728; LAS unsigned char* MAKV = lds + 90112; LAS unsigned char* NRKV = lds + 98304;
    LAS unsigned char* MABF = lds + 108544; LAS unsigned char* NRBF = lds + 112640; LAS bf16_t* TTI = (LAS bf16_t*)(lds + 122880); LAS float* GL = (LAS float*)(lds + 125440);
    const int c15 = lane & 15, g = lane >> 4; const f32x4 zero4 = {0.f, 0.f, 0.f, 0.f};
#define PK_LO(x) __builtin_bit_cast(bf16x8, (u32x4){pk2((x)[0], (x)[1]), pk2((x)[2], (x)[3]), 0u, 0u})
#define PK_2(x, y) __builtin_bit_cast(bf16x8, (u32x4){pk2((x)[0], (x)[1]), pk2((x)[2], (x)[3]), pk2((y)[0], (y)[1]), pk2((y)[2], (y)[3])})
#define ROWFRAG(P) __builtin_bit_cast(bf16x8, (u32x4){(P)[0].x, (P)[0].y, (P)[1].x, (P)[1].y})
                u32x2 ahq[4][4], mkq[4];
#pragma unroll
                for (int tb = 0; tb < 4; ++tb) { const LAS bf16_t* ap = AH + (16 * tb + c15) * RS + 4 * g;
#pragma unroll
                    for (int q = 0; q < 4; ++q) ahq[tb][q] = *(const LAS u32x2*)(ap + 16 * q);
                    mkq[tb] = *(const LAS u32x2*)(MAKV + ((tb * 4 + vb) * 64 + lane) * 8); }
                const u32x4 Sf0 = {pk2(ST[0][0], ST[0][1]), pk2(ST[0][2], ST[0][3]), pk2(ST[1][0], ST[1][1]), pk2(ST[1][2], ST[1][3])};
                const u32x4 Sf1 = {pk2(ST[2][0], ST[2][1]), pk2(ST[2][2], ST[2][3]), pk2(ST[3][0], ST[3][1]), pk2(ST[3][2], ST[3][3])};
                __builtin_amdgcn_sched_barrier(0);
                u32x2 tfq[4]; bf16x8 mf[4];
#pragma unroll
                for (int tb = 0; tb < 4; ++tb) { tfq[tb] = *(const LAS u32x2*)(TTI + (tb * 16 + c15) * 20 + 4 * g); mf[tb] = *(const LAS bf16x8*)(MABF + (tb * 64 + lane) * 16); }
                f32x4 U[4];
#pragma unroll
                for (int tb = 0; tb < 4; ++tb) {
                    f32x4 acc = {bflo(mkq[tb].x), bfhi(mkq[tb].x), bflo(mkq[tb].y), bfhi(mkq[tb].y)};
                    acc = __builtin_amdgcn_mfma_f32_16x16x32_bf16(ROWFRAG(ahq[tb]), __builtin_bit_cast(bf16x8, Sf0), acc, 0, 0, 0);
                    acc = __builtin_amdgcn_mfma_f32_16x16x32_bf16(ROWFRAG(ahq[tb] + 2), __builtin_bit_cast(bf16x8, Sf1), acc, 0, 0, 0);
                    U[tb] = acc; }
                __builtin_amdgcn_sched_barrier(0);
                u32x2 rhq[4][4], nkq[4];
#pragma unroll
                for (int tb = 0; tb < 4; ++tb) { const LAS bf16_t* rp = RH + (16 * tb + c15) * RS + 4 * g;
#pragma unroll
                    for (int q = 0; q < 4; ++q) rhq[tb][q] = *(const LAS u32x2*)(rp + 16 * q);
                    nkq[tb] = *(const LAS u32x2*)(NRKV + ((tb * 4 + vb) * 64 + lane) * 8); }
                f32x4 Y1[4];
#pragma unroll
                for (int tb = 0; tb < 4; ++tb) {
                    f32x4 acy = {bflo(nkq[tb].x), bfhi(nkq[tb].x), bflo(nkq[tb].y), bfhi(nkq[tb].y)};
                    acy = __builtin_amdgcn_mfma_f32_16x16x32_bf16(ROWFRAG(rhq[tb]), __builtin_bit_cast(bf16x8, Sf0), acy, 0, 0, 0);
                    acy = __builtin_amdgcn_mfma_f32_16x16x32_bf16(ROWFRAG(rhq[tb] + 2), __builtin_bit_cast(bf16x8, Sf1), acy, 0, 0, 0);
                    Y1[tb] = acy; }
                const bf16x8 tf0 = __builtin_bit_cast(bf16x8, (u32x4){tfq[0].x, tfq[0].y, 0u, 0u}), tf1 = __builtin_bit_cast(bf16x8, (u32x4){tfq[1].x, tfq[1].y, 0u, 0u});
                const bf16x8 tf2 = __builtin_bit_cast(bf16x8, (u32x4){tfq[2].x, tfq[2].y, 0u, 0u}), tf3 = __builtin_bit_cast(bf16x8, (u32x4){tfq[3].x, tfq[3].y, 0u, 0u});
                f32x4 SA0 = __builtin_amdgcn_mfma_f32_16x16x32_bf16(tf0, PK_LO(U[0]), zero4, 0, 0, 0);
                f32x4 rhs = __builtin_amdgcn_mfma_f32_16x16x32_bf16(mf[0], PK_LO(SA0), U[1], 0, 0, 0);
                f32x4 SA1 = __builtin_amdgcn_mfma_f32_16x16x32_bf16(tf1, PK_LO(rhs), zero4, 0, 0, 0);
                const bf16x8 SAf0 = PK_2(SA0, SA1);
                rhs = __builtin_amdgcn_mfma_f32_16x16x32_bf16(mf[1], SAf0, U[2], 0, 0, 0);
                f32x4 SA2 = __builtin_amdgcn_mfma_f32_16x16x32_bf16(tf2, PK_LO(rhs), zero4, 0, 0, 0);
                rhs = __builtin_amdgcn_mfma_f32_16x16x32_bf16(mf[2], SAf0, U[3], 0, 0, 0);
                rhs = __builtin_amdgcn_mfma_f32_16x16x32_bf16(mf[3], PK_LO(SA2), rhs, 0, 0, 0);
                f32x4 SA3 = __builtin_amdgcn_mfma_f32_16x16x32_bf16(tf3, PK_LO(rhs), zero4, 0, 0, 0);
                const bf16x8 SAf1 = PK_2(SA2, SA3);
                __builtin_amdgcn_sched_barrier(0);
                bf16x8 nrf[6];
#pragma unroll
                for (int i = 0; i < 6; ++i) nrf[i] = *(const LAS bf16x8*)(NRBF + (i * 64 + lane) * 16);
                f32x4 kvq[4], glq[4]; u32x2 btq[4][4];
#pragma unroll
                for (int kb = 0; kb < 4; ++kb) { const LAS bf16_t* bp = BT + (16 * kb + c15) * RS + 4 * g;
#pragma unroll
                    for (int q = 0; q < 4; ++q) btq[kb][q] = *(const LAS u32x2*)(bp + 16 * q);
                    kvq[kb] = *(const LAS f32x4*)(KVI + ((kb * 4 + vb) * 64 + lane) * 16); glq[kb] = *(const LAS f32x4*)(GL + 16 * kb + 4 * g); }
#pragma unroll
                for (int tb = 0; tb < 4; ++tb) { const int nb = tb == 0 ? 0 : (tb == 1 ? 1 : (tb == 2 ? 2 : 4));
                    f32x4 acc = __builtin_amdgcn_mfma_f32_16x16x32_bf16(nrf[nb], SAf0, Y1[tb], 0, 0, 0);
                    if (tb >= 2) acc = __builtin_amdgcn_mfma_f32_16x16x32_bf16(nrf[nb + 1], SAf1, acc, 0, 0, 0);
#pragma unroll
                    for (int r = 0; r < 4; ++r) YS[(16 * tb + 4 * g + r) * RS + 16 * vb + c15] = (bf16_t)(pk2(acc[r], 0.f) & 0xffffu); }
#pragma unroll
                for (int kb = 0; kb < 4; ++kb) { f32x4 acc = kvq[kb];
                    acc = __builtin_amdgcn_mfma_f32_16x16x32_bf16(ROWFRAG(btq[kb]), SAf0, acc, 0, 0, 0);
                    acc = __builtin_amdgcn_mfma_f32_16x16x32_bf16(ROWFRAG(btq[kb] + 2), SAf1, acc, 0, 0, 0);
                    ST[kb] = glq[kb] * (ST[kb] + acc); }
#undef ROWFRAG
#undef PK_LO
#undef PK_2
}

constexpr float NLOG2E = -1.4426950408889634f;
template <int CTRL> __device__ __forceinline__ float dpp_row_shr(float v) { return __builtin_bit_cast(float, __builtin_amdgcn_update_dpp(0, __builtin_bit_cast(int, v), CTRL, 0xf, 0xf, true)); }
static __device__ PHASE_ATTR void ph_scan(int jm) {
    FRAME();
    const bf16_t* Rb = (const bf16_t*)(ws + P_R); const bf16_t* Kb = (const bf16_t*)(ws + P_K); const bf16_t* Vb = (const bf16_t*)(ws + (jm == 0 ? WS_VF : P_V));
    const bf16_t* Hd = (const bf16_t*)(ws + P_HID); float* BS = (float*)(ws + P_BS);
    constexpr int RS = 72;
    LAS bf16_t* AH = (LAS bf16_t*)(lds); LAS bf16_t* RH = (LAS bf16_t*)(lds + 9216); LAS bf16_t* BH = (LAS bf16_t*)(lds + 18432); LAS bf16_t* KH = (LAS bf16_t*)(lds + 27648);
    LAS bf16_t* BT = (LAS bf16_t*)(lds + 36864); LAS bf16_t* KT = (LAS bf16_t*)(lds + 46080); LAS bf16_t* VT = (LAS bf16_t*)(lds + 55296); LAS bf16_t* YS = (LAS bf16_t*)(lds + 64512);
    LAS unsigned char* KVI = lds + 73728; LAS unsigned char* MAKV = lds + 90112; LAS unsigned char* NRKV = lds + 98304;
    LAS float* SEG = (LAS float*)(lds + 106496); LAS float* NRM = (LAS float*)(lds + 107520); LAS float* BON = (LAS float*)(lds + 108032);
    LAS unsigned char* MABF = lds + 108544; LAS unsigned char* NRBF = lds + 112640;
    LAS float* MS = (LAS float*)(lds + 118784); LAS bf16_t* TTI = (LAS bf16_t*)(lds + 122880);
    LAS float* GL = (LAS float*)(lds + 125440); LAS float* PAR = (LAS float*)(lds + 125696);
    LAS unsigned char* W2F = lds + 147456;
    LAS unsigned char* A2F = lds + 126976;
    const int c15 = lane & 15, g = lane >> 4;
    const int tbq = wave & 3, half = wave >> 2;
    const int tF = tid >> 3, c8 = tid & 7;
    const int tbD = wave & 3, kindD = wave >> 2;
    const f32x4 zero4 = {0.f, 0.f, 0.f, 0.f};
    for (int it = bid_; it < 256; it += G) {
        const int seq = it & 3, head = (it >> 2) & 31, dir = it >> 7;
        const bool split = (G == 256);
        const bool helper = split && seq >= 2;
        const int pair = (seq & 1) | (head << 1) | (dir << 6);
        unsigned* flag = (unsigned*)(ws + WS_SCANFLAG + (size_t)jm * 8192 + (size_t)pair * 64);
#pragma unroll 1
        for (int pass = helper ? 0 : 1; pass < 2; ++pass) {
        __syncthreads();
        if (tid < 64) { const int c = head * 64 + tid;
            PAR[tid] = NLOG2E * inp(9)[(size_t)(jm * 2 + dir) * D + c]; PAR[64 + tid] = NLOG2E * inp(12)[(size_t)(jm * 2 + dir) * D + c];
            PAR[128 + tid] = inp(20)[(size_t)jm * D + c]; PAR[192 + tid] = inp(21)[(size_t)jm * D + c]; PAR[256 + tid] = inp(22)[(size_t)jm * D + c]; }
        int lane_s = lane; asm volatile("" : "+v"(lane_s));
        const int c15s = lane_s & 15, gs = lane_s >> 4;
#pragma unroll
        for (int kind = 0; kind < 2; ++kind)
#pragma unroll
            for (int cbi = 0; cbi < 2; ++cbi) { const float* M = (kind == 0 ? inp(11) : inp(14)) + (size_t)(jm * 2 + dir) * 96 * D + head * 64;
                const unsigned mo = (unsigned)(8 * gs * D + 16 * (2 * half + cbi) + c15s);
#pragma unroll
                for (int ks = 0; ks < 3; ++ks) { float x[8];
#pragma unroll
                    for (int j = 0; j < 8; ++j) x[j] = M[mo + (unsigned)((32 * ks + j) * D)];
                    const u32x4 w = {pk2(NLOG2E * x[0], NLOG2E * x[1]), pk2(NLOG2E * x[2], NLOG2E * x[3]), pk2(NLOG2E * x[4], NLOG2E * x[5]), pk2(NLOG2E * x[6], NLOG2E * x[7])};
                    *(LAS u32x4*)((kind == 0 ? W2F : A2F) + (((half * 2 + cbi) * 3 + ks) * 64 + lane_s) * 16) = w; }
                __builtin_amdgcn_sched_barrier(0); }
        bf16_t* yd = (bf16_t*)(ws + (dir ? P_YB : P_YF));
        const int cofs = head * 64 + 32 * half + 4 * g;
        bf16x8 hwf[3], haf[3]; u32x2 rq[2], kq[2], vq[2];
#define SCAN_PREFETCH(chunk_) do { const int st_ = (chunk_) * 64 + 16 * tbq + c15; const size_t row_ = (size_t)(base + (dir ? (len - 1 - st_) : st_)); \
            const bf16_t* hp_ = Hd + row_ * HID + dir * 128 + 8 * g; \
            _Pragma("unroll") for (int ks = 0; ks < 3; ++ks) { hwf[ks] = *(const bf16x8*)(hp_ + 32 * ks); haf[ks] = *(const bf16x8*)(hp_ + 256 + 32 * ks); } \
            _Pragma("unroll") for (int cbi = 0; cbi < 2; ++cbi) { rq[cbi] = *(const u32x2*)(Rb + row_ * D + cofs + 16 * cbi); kq[cbi] = *(const u32x2*)(Kb + row_ * D + cofs + 16 * cbi); vq[cbi] = *(const u32x2*)(Vb + row_ * D + cofs + 16 * cbi); } } while (0)
        const int sq = pass ? seq : seq - 2; const bool pre = (pass == 0);
        const int base = sq < 2 ? sq * 16384 : 32768 + (sq - 2) * 8192, len = sq < 2 ? 16384 : 8192;
        const int nch = len >> 6;
        const int c0 = pre ? nch - SCAN_NH : 0;
        const int cfull = (split && !pre && sq < 2) ? nch - SCAN_NH : nch;
        f32x4 ST[4] = {zero4, zero4, zero4, zero4};
        SCAN_PREFETCH(c0);
        __syncthreads();
#pragma unroll 1
        for (int chunk = c0; chunk < cfull; ++chunk) {
            int tid_o = tid; asm volatile("" : "+v"(tid_o));
            const int lane = tid_o & 63, c15 = lane & 15, g = lane >> 4, tF = tid_o >> 3, c8 = tid_o & 7;
            const int cofs = head * 64 + 32 * half + 4 * g;
            const int tq = 16 * tbq + c15;
            const int stq = chunk * 64 + tq; const size_t rowq = (size_t)(base + (dir ? (len - 1 - stq) : stq));
            float r8[8], lw8[8], asg[8], kkr[8], kd8[8], pfx[8]; u32x2 vkeep[2];
            {
                f32x4 accw[2] = {zero4, zero4}, acca[2] = {zero4, zero4};
#pragma unroll
                for (int cbi = 0; cbi < 2; ++cbi)
#pragma unroll
                    for (int ks = 0; ks < 3; ++ks) { accw[cbi] = __builtin_amdgcn_mfma_f32_16x16x32_bf16(*(const LAS bf16x8*)(W2F + (((half * 2 + cbi) * 3 + ks) * 64 + lane) * 16), hwf[ks], accw[cbi], 0, 0, 0); acca[cbi] = __builtin_amdgcn_mfma_f32_16x16x32_bf16(*(const LAS bf16x8*)(A2F + (((half * 2 + cbi) * 3 + ks) * 64 + lane) * 16), haf[ks], acca[cbi], 0, 0, 0); }
                float k8[8]; float ss = 0.f, bon = 0.f;
#pragma unroll
                for (int cbi = 0; cbi < 2; ++cbi) { const int cl = 32 * half + 16 * cbi + 4 * g;
                    const f32x4 w0v = *(const LAS f32x4*)(PAR + cl), a0v = *(const LAS f32x4*)(PAR + 64 + cl), kkv = *(const LAS f32x4*)(PAR + 128 + cl), kav = *(const LAS f32x4*)(PAR + 192 + cl), rkv = *(const LAS f32x4*)(PAR + 256 + cl);
                    const unsigned rw2[2] = {rq[cbi].x, rq[cbi].y}, kw2[2] = {kq[cbi].x, kq[cbi].y}; vkeep[cbi] = vq[cbi];
#pragma unroll
                    for (int r = 0; r < 4; ++r) { const int e = 4 * cbi + r;
                        r8[e] = (r & 1) ? bfhi(rw2[r >> 1]) : bflo(rw2[r >> 1]); k8[e] = (r & 1) ? bfhi(kw2[r >> 1]) : bflo(kw2[r >> 1]);
                        const float wr = w0v[r] + accw[cbi][r], ar = a0v[r] + acca[cbi][r];
                        lw8[e] = -0.87503877491452760f * __builtin_amdgcn_rcpf(1.0f + __builtin_amdgcn_exp2f(wr));
                        asg[e] = __builtin_amdgcn_rcpf(1.0f + __builtin_amdgcn_exp2f(ar)); kkr[e] = k8[e] * kkv[r]; ss += kkr[e] * kkr[e];
                        kd8[e] = __builtin_fmaf(k8[e], __builtin_fmaf(asg[e], kav[r], -kav[r]), k8[e]); bon += r8[e] * kd8[e] * rkv[r]; } }
                ss += __shfl_xor(ss, 16); ss += __shfl_xor(ss, 32); bon += __shfl_xor(bon, 16); bon += __shfl_xor(bon, 32);
                if (g == 0) { NRM[half * 64 + tq] = ss; BON[half * 64 + tq] = bon; }
#pragma unroll
                for (int e = 0; e < 8; ++e) { float x = lw8[e]; x += dpp_row_shr<0x111>(x); x += dpp_row_shr<0x112>(x); x += dpp_row_shr<0x114>(x); x += dpp_row_shr<0x118>(x); pfx[e] = x; }
                if (c15 == 15) { *(LAS f32x4*)(SEG + tbq * 64 + 32 * half + 4 * g) = (f32x4){pfx[0], pfx[1], pfx[2], pfx[3]}; *(LAS f32x4*)(SEG + tbq * 64 + 32 * half + 16 + 4 * g) = (f32x4){pfx[4], pfx[5], pfx[6], pfx[7]}; }
            }
            if (chunk > c0 && !pre) { const int st = (chunk - 1) * 64 + tF; const int p = dir ? (len - 1 - st) : st;
                *(u32x4*)(yd + (size_t)(base + p) * D + head * 64 + 8 * c8) = *(const LAS u32x4*)(YS + tF * RS + 8 * c8); }
            __syncthreads();
            {
                f32x4 of0 = zero4, of1 = zero4;
                for (int s = 0; s < tbq; ++s) { of0 += *(const LAS f32x4*)(SEG + s * 64 + 32 * half + 4 * g); of1 += *(const LAS f32x4*)(SEG + s * 64 + 32 * half + 16 + 4 * g); }
                const float inv = __builtin_amdgcn_rcpf(fmaxf(sqrtf(NRM[tq] + NRM[64 + tq]), 1e-12f));
                if (half == 0 && g == 0) BS[((size_t)dir * TT + rowq) * 32 + head] = BON[tq] + BON[64 + tq];
#pragma unroll
                for (int cbi = 0; cbi < 2; ++cbi) { const int cl = 32 * half + 16 * cbi + 4 * g; float ah[4], bh[4], kh[4], rh[4];
#pragma unroll
                    for (int r = 0; r < 4; ++r) { const int e = 4 * cbi + r; const float lg = pfx[e] + (cbi ? of1[r] : of0[r]); const float lm = lg - lw8[e];
                        const float e1 = __builtin_amdgcn_exp2f(lg), e2 = __builtin_amdgcn_rcpf(e1), e3 = __builtin_amdgcn_exp2f(lm); const float kk = kkr[e] * inv;
                        ah[r] = -kk * e3; bh[r] = kk * asg[e] * e2; kh[r] = kd8[e] * e2; rh[r] = r8[e] * e1; }
                    const u32x2 aw = {pk2(ah[0], ah[1]), pk2(ah[2], ah[3])}, bw = {pk2(bh[0], bh[1]), pk2(bh[2], bh[3])}, kw = {pk2(kh[0], kh[1]), pk2(kh[2], kh[3])}, rw = {pk2(rh[0], rh[1]), pk2(rh[2], rh[3])};
                    *(LAS u32x2*)(AH + tq * RS + cl) = aw; *(LAS u32x2*)(BH + tq * RS + cl) = bw; *(LAS u32x2*)(KH + tq * RS + cl) = kw; *(LAS u32x2*)(RH + tq * RS + cl) = rw;
                    const unsigned bww[2] = {bw.x, bw.y}, kww[2] = {kw.x, kw.y}, vww[2] = {vkeep[cbi].x, vkeep[cbi].y};
#pragma unroll
                    for (int r = 0; r < 4; ++r) { BT[(cl + r) * RS + tq] = (bf16_t)((r & 1) ? (bww[r >> 1] >> 16) : (bww[r >> 1] & 0xffffu)); KT[(cl + r) * RS + tq] = (bf16_t)((r & 1) ? (kww[r >> 1] >> 16) : (kww[r >> 1] & 0xffffu));
                        VT[(cl + r) * RS + tq] = (bf16_t)((r & 1) ? (vww[r >> 1] >> 16) : (vww[r >> 1] & 0xffffu)); }
                    if (tq == 63) *(LAS f32x4*)(GL + cl) = (f32x4){__builtin_amdgcn_exp2f(pfx[4 * cbi] + (cbi ? of1[0] : of0[0])), __builtin_amdgcn_exp2f(pfx[4 * cbi + 1] + (cbi ? of1[1] : of0[1])), __builtin_amdgcn_exp2f(pfx[4 * cbi + 2] + (cbi ? of1[2] : of0[2])), __builtin_amdgcn_exp2f(pfx[4 * cbi + 3] + (cbi ? of1[3] : of0[3]))}; }
            }
            __syncthreads();
            {
                const int tloc = c15;
                if (kindD == 0) {
                    bf16x8 bfA[2];
#pragma unroll
                    for (int ks = 0; ks < 2; ++ks) bfA[ks] = *(const LAS bf16x8*)(AH + (16 * tbD + c15) * RS + 32 * ks + 8 * g);
                    f32x4 GT1[4] = {zero4, zero4, zero4, zero4};
#pragma unroll
                    for (int ib = 0; ib < 4; ++ib) if (ib <= tbD) {
                        f32x4 a1 = zero4;
#pragma unroll
                        for (int ks = 0; ks < 2; ++ks) a1 = __builtin_amdgcn_mfma_f32_16x16x32_bf16(*(const LAS bf16x8*)(BH + (16 * ib + c15) * RS + 32 * ks + 8 * g), bfA[ks], a1, 0, 0, 0);
                        if (ib == tbD) {
#pragma unroll
                            for (int r = 0; r < 4; ++r) if (!(4 * g + r < tloc)) a1[r] = 0.f; }
                        GT1[ib] = a1;
                    }
                    const f32x4 m1 = (tbD >= 2) ? GT1[1] : zero4, m2 = (tbD == 3) ? GT1[2] : zero4;
                    const u32x4 F01 = {pk2(GT1[0][0], GT1[0][1]), pk2(GT1[0][2], GT1[0][3]), pk2(m1[0], m1[1]), pk2(m1[2], m1[3])};
                    const u32x4 F23 = {pk2(m2[0], m2[1]), pk2(m2[2], m2[3]), 0u, 0u};
                    if (tbD == 1) *(LAS u32x4*)(MABF + (0 * 64 + lane) * 16) = F01;
                    if (tbD == 2) *(LAS u32x4*)(MABF + (1 * 64 + lane) * 16) = F01;
                    if (tbD == 3) { *(LAS u32x4*)(MABF + (2 * 64 + lane) * 16) = F01; *(LAS u32x4*)(MABF + (3 * 64 + lane) * 16) = F23; }
                    f32x4 dg = GT1[0]; dg = (tbD == 1) ? GT1[1] : dg; dg = (tbD == 2) ? GT1[2] : dg; dg = (tbD == 3) ? GT1[3] : dg;
                    *(LAS f32x4*)(MS + (tbD * 16 + c15) * 16 + 4 * g) = dg;
                    asm volatile("s_waitcnt lgkmcnt(0)" ::: "memory");
                    const int lane_o = lane;
                    if (lane < 16) { float x[16];
#pragma unroll
                        for (int t = 0; t < 16; ++t) { const LAS f32x4* mr = (const LAS f32x4*)(MS + (tbD * 16 + t) * 16); float s = (t == lane_o) ? 1.0f : 0.0f; f32x2 s2 = {0.f, 0.f};
#pragma unroll
                            for (int i4 = 0; i4 < (t + 3) / 4; ++i4) { const f32x4 m = mr[i4];
#pragma unroll
                                for (int p = 0; p < 2; ++p) { const int i0 = 4 * i4 + 2 * p;
                                    if (i0 + 1 < t) s2 += (f32x2){m[2 * p], m[2 * p + 1]} * (f32x2){x[i0], x[i0 + 1]};
                                    else if (i0 < t) s += m[2 * p] * x[i0]; } }
                            x[t] = s + (s2[0] + s2[1]); }
#pragma unroll
                        for (int t = 0; t < 16; ++t) TTI[(tbD * 16 + t) * 20 + lane] = (bf16_t)(pk2(x[t], 0.f) & 0xffffu); }
                } else {
                    bf16x8 bfR[2], bfA[2];
#pragma unroll
                    for (int ks = 0; ks < 2; ++ks) { bfR[ks] = *(const LAS bf16x8*)(RH + (16 * tbD + c15) * RS + 32 * ks + 8 * g); bfA[ks] = *(const LAS bf16x8*)(AH + (16 * tbD + c15) * RS + 32 * ks + 8 * g); }
                    f32x4 GT1[4] = {zero4, zero4, zero4, zero4}, GT2[4] = {zero4, zero4, zero4, zero4}, GT3[4] = {zero4, zero4, zero4, zero4};
#pragma unroll
                    for (int ib = 0; ib < 4; ++ib) if (ib <= tbD) {
                        f32x4 a1 = zero4, a2 = zero4, a3 = zero4;
#pragma unroll
                        for (int ks = 0; ks < 2; ++ks) { const bf16x8 f1 = *(const LAS bf16x8*)(BH + (16 * ib + c15) * RS + 32 * ks + 8 * g), f2 = *(const LAS bf16x8*)(KH + (16 * ib + c15) * RS + 32 * ks + 8 * g);
                            a1 = __builtin_amdgcn_mfma_f32_16x16x32_bf16(f1, bfR[ks], a1, 0, 0, 0); a2 = __builtin_amdgcn_mfma_f32_16x16x32_bf16(f2, bfR[ks], a2, 0, 0, 0); a3 = __builtin_amdgcn_mfma_f32_16x16x32_bf16(f2, bfA[ks], a3, 0, 0, 0); }
                        if (ib == tbD) {
#pragma unroll
                            for (int r = 0; r < 4; ++r) { const int il = 4 * g + r; if (!(il <= tloc)) { a1[r] = 0.f; a2[r] = 0.f; } if (!(il < tloc)) a3[r] = 0.f; } }
                        GT1[ib] = a1; GT2[ib] = a2; GT3[ib] = a3;
                    }
                    const u32x4 F01 = {pk2(GT1[0][0], GT1[0][1]), pk2(GT1[0][2], GT1[0][3]), pk2(GT1[1][0], GT1[1][1]), pk2(GT1[1][2], GT1[1][3])};
                    const u32x4 F23 = {pk2(GT1[2][0], GT1[2][1]), pk2(GT1[2][2], GT1[2][3]), pk2(GT1[3][0], GT1[3][1]), pk2(GT1[3][2], GT1[3][3])};
                    const int nb = tbD == 0 ? 0 : (tbD == 1 ? 1 : (tbD == 2 ? 2 : 4));
                    *(LAS u32x4*)(NRBF + (nb * 64 + lane) * 16) = F01;
                    if (tbD >= 2) *(LAS u32x4*)(NRBF + ((nb + 1) * 64 + lane) * 16) = F23;
                    const u32x4 N_01 = {pk2(GT2[0][0], GT2[0][1]), pk2(GT2[0][2], GT2[0][3]), pk2(GT2[1][0], GT2[1][1]), pk2(GT2[1][2], GT2[1][3])};
                    const u32x4 N_23 = {pk2(GT2[2][0], GT2[2][1]), pk2(GT2[2][2], GT2[2][3]), pk2(GT2[3][0], GT2[3][1]), pk2(GT2[3][2], GT2[3][3])};
                    const u32x4 M_01 = {pk2(GT3[0][0], GT3[0][1]), pk2(GT3[0][2], GT3[0][3]), pk2(GT3[1][0], GT3[1][1]), pk2(GT3[1][2], GT3[1][3])};
                    const u32x4 M_23 = {pk2(GT3[2][0], GT3[2][1]), pk2(GT3[2][2], GT3[2][3]), pk2(GT3[3][0], GT3[3][1]), pk2(GT3[3][2], GT3[3][3])};
#pragma unroll
                    for (int vb = 0; vb < 4; ++vb) { const LAS bf16_t* vp = VT + (16 * vb + c15) * RS + 4 * g;
                        const u32x2 v0 = *(const LAS u32x2*)(vp), v1 = *(const LAS u32x2*)(vp + 16);
                        const bf16x8 vf01 = __builtin_bit_cast(bf16x8, (u32x4){v0.x, v0.y, v1.x, v1.y});
                        f32x4 accn = __builtin_amdgcn_mfma_f32_16x16x32_bf16(__builtin_bit_cast(bf16x8, N_01), vf01, zero4, 0, 0, 0);
                        f32x4 accm = __builtin_amdgcn_mfma_f32_16x16x32_bf16(__builtin_bit_cast(bf16x8, M_01), vf01, zero4, 0, 0, 0);
                        if (tbD >= 2) { const u32x2 v2 = *(const LAS u32x2*)(vp + 32), v3 = *(const LAS u32x2*)(vp + 48);
                            const bf16x8 vf23 = __builtin_bit_cast(bf16x8, (u32x4){v2.x, v2.y, v3.x, v3.y});
                            accn = __builtin_amdgcn_mfma_f32_16x16x32_bf16(__builtin_bit_cast(bf16x8, N_23), vf23, accn, 0, 0, 0);
                            accm = __builtin_amdgcn_mfma_f32_16x16x32_bf16(__builtin_bit_cast(bf16x8, M_23), vf23, accm, 0, 0, 0); }
                        *(LAS u32x2*)(NRKV + ((tbD * 4 + vb) * 64 + lane) * 8) = (u32x2){pk2(accn[0], accn[1]), pk2(accn[2], accn[3])};
                        *(LAS u32x2*)(MAKV + ((tbD * 4 + vb) * 64 + lane) * 8) = (u32x2){pk2(accm[0], accm[1]), pk2(accm[2], accm[3])}; }
                }
#pragma unroll
                for (int q2 = 0; q2 < 2; ++q2) { const int id = 2 * wave + q2, kb = id >> 2, vb = id & 3; f32x4 acc = zero4;
#pragma unroll
                    for (int ks = 0; ks < 2; ++ks) acc = __builtin_amdgcn_mfma_f32_16x16x32_bf16(*(const LAS bf16x8*)(KT + (16 * kb + c15) * RS + 32 * ks + 8 * g), *(const LAS bf16x8*)(VT + (16 * vb + c15) * RS + 32 * ks + 8 * g), acc, 0, 0, 0);
                    *(LAS f32x4*)(KVI + (id * 64 + lane) * 16) = acc; }
            }
            __syncthreads();
            if (chunk + 1 < cfull) SCAN_PREFETCH(chunk + 1);
            if (pre) {
                const int j = chunk - c0; const int slot = __builtin_amdgcn_readfirstlane(pair * SCAN_NH + j);
                unsigned char* dstp = slot < SCAN_SLOTS_OUT ? (unsigned char*)outp() + (size_t)slot * SCAN_SLOT : (unsigned char*)ws + WS_POOL + 576 * MiB + (size_t)(slot - SCAN_SLOTS_OUT) * SCAN_SLOT;
                const __amdgpu_buffer_rsrc_t drs = __builtin_amdgcn_make_buffer_rsrc(dstp, 0, SCAN_SLOT, 0x00020000);
#pragma unroll
                for (int q = 0; q < 9; ++q) { const int u = tid_o + 512 * q;
                    if (q < 8 || u < SCAN_DUMP_U) { const int off = 16 * u + (u >= 1152 ? 18432 : 0) + (u >= 1728 ? 27648 : 0) + (u >= 3776 ? 2048 : 0) + (u >= 4416 ? 4096 : 0);
                        __builtin_amdgcn_raw_buffer_store_b128(*(const LAS u32x4*)(lds + off), drs, 16 * u, 0, 16); } }
            } else {
            if (wave < 4) scan_stage_e(lds, ST, lane, wave);
            __syncthreads();
            }
        }
        if (pre) {
            asm volatile("s_waitcnt vmcnt(0)" ::: "memory");
            __syncthreads();
            if (tid == 0) __hip_atomic_store((GAS unsigned*)flag, (unsigned)SCAN_NH, __ATOMIC_RELAXED, __HIP_MEMORY_SCOPE_AGENT);
        }
        if (cfull < nch) {
            if (wave == 0) {
                while ((unsigned)__builtin_amdgcn_readfirstlane(__hip_atomic_load((GAS unsigned*)flag, __ATOMIC_RELAXED, __HIP_MEMORY_SCOPE_AGENT)) < (unsigned)SCAN_NH) __builtin_amdgcn_s_sleep(2);
                __builtin_amdgcn_fence(__ATOMIC_ACQUIRE, "agent"); }
            __syncthreads();
            u32x4 pf[9];
#define DUMP_OFF(u) (16 * (u) + ((u) >= 1152 ? 18432 : 0) + ((u) >= 1728 ? 27648 : 0) + ((u) >= 3776 ? 2048 : 0) + ((u) >= 4416 ? 4096 : 0))
#define DUMP_LOAD(j_) do { const int slot_ = __builtin_amdgcn_readfirstlane(pair * SCAN_NH + (j_)); \
            const u32x4* srcp_ = (const u32x4*)(slot_ < SCAN_SLOTS_OUT ? (const unsigned char*)outp() + (size_t)slot_ * SCAN_SLOT : (const unsigned char*)ws + WS_POOL + 576 * MiB + (size_t)(slot_ - SCAN_SLOTS_OUT) * SCAN_SLOT); \
            _Pragma("unroll") for (int q = 0; q < 9; ++q) { const int u = tid_p + 512 * q; if (q < 8 || u < SCAN_DUMP_U) pf[q] = srcp_[u]; } } while (0)
            int tid_p = tid; asm volatile("" : "+v"(tid_p));
            DUMP_LOAD(0);
#pragma unroll 1
            for (int chunk = cfull; chunk < nch; ++chunk) {
                int tid_o = tid; asm volatile("" : "+v"(tid_o));
                const int tF = tid_o >> 3, c8 = tid_o & 7; const int tid_p = tid_o;
#pragma unroll
                for (int q = 0; q < 9; ++q) { const int u = tid_o + 512 * q; if (q < 8 || u < SCAN_DUMP_U) *(LAS u32x4*)(lds + DUMP_OFF(u)) = pf[q]; }
                { const int st = (chunk - 1) * 64 + tF; const int p = dir ? (len - 1 - st) : st;
                  *(u32x4*)(yd + (size_t)(base + p) * D + head * 64 + 8 * c8) = *(const LAS u32x4*)(YS + tF * RS + 8 * c8); }
                __syncthreads();
                if (chunk + 1 < nch) DUMP_LOAD(chunk + 1 - cfull);
                if (wave < 4) scan_stage_e(lds, ST, tid_o & 63, wave);
                __syncthreads();
            }
#undef DUMP_LOAD
#undef DUMP_OFF
        }
        if (!pre) { const int tF = tid >> 3, c8 = tid & 7; const int st = (nch - 1) * 64 + tF; const int p = dir ? (len - 1 - st) : st;
          *(u32x4*)(yd + (size_t)(base + p) * D + head * 64 + 8 * c8) = *(const LAS u32x4*)(YS + tF * RS + 8 * c8); }
        }
#undef SCAN_PREFETCH
    }
}

static __device__ PHASE_ATTR void ph_fin(int jm) {
    FRAME();
    bf16_t* YF = (bf16_t*)(ws + P_YF); const bf16_t* YB = (const bf16_t*)(ws + P_YB); const bf16_t* Vb = (const bf16_t*)(ws + (jm == 0 ? WS_VF : P_V)); const float* BS = (const float*)(ws + P_BS);
    const float* gnw = inp(23) + (size_t)jm * D; const float* gnb = inp(24) + (size_t)jm * D;
    u32x4 aq[4], bq[4], vq4[4]; float b0q[4], b1q[4];
#define FIN_LOAD(row_) do { const size_t r_ = (size_t)(row_); \
        _Pragma("unroll") for (int i = 0; i < 4; ++i) { const int e = 8 * (lane + 64 * i); aq[i] = *(const u32x4*)(YF + r_ * D + e); bq[i] = *(const u32x4*)(YB + r_ * D + e); vq4[i] = *(const u32x4*)(Vb + r_ * D + e); \
            b0q[i] = BS[r_ * 32 + (e >> 6)]; b1q[i] = BS[((size_t)TT + r_) * 32 + (e >> 6)]; } } while (0)
    int row = gw;
    if (row < TT) FIN_LOAD(row);
    for (; row < TT; row += NGW) {
        u32x4 ac[4], bc[4], vc[4]; float b0c[4], b1c[4];
#pragma unroll
        for (int i = 0; i < 4; ++i) { ac[i] = aq[i]; bc[i] = bq[i]; vc[i] = vq4[i]; b0c[i] = b0q[i]; b1c[i] = b1q[i]; }
        if (row + NGW < TT) FIN_LOAD(row + NGW);
#pragma unroll
        for (int i = 0; i < 4; ++i) { const int e = 8 * (lane + 64 * i);
            const unsigned aw[4] = {ac[i].x, ac[i].y, ac[i].z, ac[i].w}, bw[4] = {bc[i].x, bc[i].y, bc[i].z, bc[i].w}, vw[4] = {vc[i].x, vc[i].y, vc[i].z, vc[i].w};
            float y[8], v8[8]; float s = 0.f;
#pragma unroll
            for (int j = 0; j < 4; ++j) { y[2 * j] = bflo(aw[j]) + bflo(bw[j]); y[2 * j + 1] = bfhi(aw[j]) + bfhi(bw[j]); v8[2 * j] = bflo(vw[j]); v8[2 * j + 1] = bfhi(vw[j]); s += y[2 * j] + y[2 * j + 1]; }
            s += __shfl_xor(s, 1); s += __shfl_xor(s, 2); s += __shfl_xor(s, 4);
            const float mean = s * (1.0f / 64.0f); float q = 0.f;
#pragma unroll
            for (int j = 0; j < 8; ++j) { y[j] -= mean; q += y[j] * y[j]; }
            q += __shfl_xor(q, 1); q += __shfl_xor(q, 2); q += __shfl_xor(q, 4);
            const float rstd = rsqrtf(q * (1.0f / 64.0f) + GN_EPS);
            const float bonus = 0.5f * (b0c[i] + b1c[i]);
            const f32x4 w0 = *(const f32x4*)(gnw + e), w1 = *(const f32x4*)(gnw + e + 4), c0 = *(const f32x4*)(gnb + e), c1 = *(const f32x4*)(gnb + e + 4);
            float o[8];
#pragma unroll
            for (int j = 0; j < 8; ++j) o[j] = y[j] * rstd * (j < 4 ? w0[j] : w1[j - 4]) + (j < 4 ? c0[j] : c1[j - 4]) + bonus * v8[j];
            *(u32x4*)(YF + (size_t)row * D + e) = (u32x4){pk2(o[0], o[1]), pk2(o[2], o[3]), pk2(o[4], o[5]), pk2(o[6], o[7])}; }
    }
#undef FIN_LOAD
}

typedef short v4i16_t __attribute__((ext_vector_type(4)));
struct AttItem { int base, h, c, b0, Lc; };
__device__ __forceinline__ AttItem att_decode(int pair, int dsh) {
    const int it = pair * 2; int seq, h, cb, S_len;
    if (it < 8192) { seq = it >> 12; h = (it >> 8) & 15; cb = it & 255; S_len = 16384; }
    else { const int i2 = it - 8192; seq = 2 + (i2 >> 11); h = (i2 >> 7) & 15; cb = i2 & 127; S_len = 8192; }
    AttItem a; a.base = seq < 2 ? seq * 16384 : 32768 + (seq - 2) * 8192; a.h = h; a.Lc = S_len >> dsh; const int nb = a.Lc >> 6; a.c = cb / nb; a.b0 = cb % nb; return a;
}
static __device__ PHASE_ATTR void ph_att(int gi) {
    FRAME();
    const int dil = 1 << (2 * gi), dsh = 2 * gi;
    const bf16_t* QKV = (const bf16_t*)(ws + P_QKV);
    bf16_t* const Og = (bf16_t*)(ws + P_O0 + (size_t)gi * 192 * MiB); float* const LSEg = (float*)(ws + P_LSE) + (size_t)gi * TT * 16;
    bf16_t* const O0 = (bf16_t*)(ws + P_O0); const bf16_t* const O1 = (const bf16_t*)(ws + P_O0 + 192 * MiB); const float* const LS = (const float*)(ws + P_LSE);
    constexpr int KRS = 136, VRS = 144;
    LAS bf16_t* Ks = (LAS bf16_t*)lds; LAS bf16_t* Vs = (LAS bf16_t*)(lds + 256 * KRS * 2);
    const int qi = wave >> 2, wi = wave & 3, c15 = lane & 15, gq = lane >> 4;
    u32x4 kv[16]; bf16x8 qf[4];
#define ATT_PREFETCH(A) do { _Pragma("unroll") for (int i = 0; i < 16; ++i) { const int key = (tid >> 4) + 32 * (i & 7), part = tid & 15; \
            int ip = 64 * ((A).b0 - 1) + key; ip = ip < 0 ? 0 : (ip > (A).Lc - 1 ? (A).Lc - 1 : ip); \
            kv[i] = *(const u32x4*)(QKV + (size_t)((A).base + ip * dil + (A).c) * (3 * D) + ((i >> 3) ? 2 * D : D) + (A).h * 128 + 8 * part); } \
        { const size_t rq = (size_t)((A).base + (64 * ((A).b0 + qi) + 16 * wi + c15) * dil + (A).c); \
          _Pragma("unroll") for (int ks = 0; ks < 4; ++ks) qf[ks] = *(const bf16x8*)(QKV + rq * (3 * D) + (A).h * 128 + 32 * ks + 8 * gq); } } while (0)
    const int ppw = (6144 + G - 1) / G;
    int pair = bid_ * ppw; const int pair_end = (pair + ppw < 6144) ? pair + ppw : 6144;
    if (pair < pair_end) { const AttItem A0 = att_decode(pair, dsh); ATT_PREFETCH(A0); }
    for (; pair < pair_end; ++pair) {
        const AttItem A = att_decode(pair, dsh);
        const int base = A.base, h = A.h, c = A.c, Lc = A.Lc;
#pragma unroll
        for (int i = 0; i < 16; ++i) { const int key = (tid >> 4) + 32 * (i & 7), part = tid & 15;
            if (i >> 3) *(LAS u32x4*)(Vs + key * VRS + 8 * part) = kv[i]; else *(LAS u32x4*)(Ks + key * KRS + 8 * part) = kv[i]; }
        bf16x8 q[4];
#pragma unroll
        for (int ks = 0; ks < 4; ++ks) q[ks] = qf[ks];
        const int b = A.b0 + qi;
        const int iq = 64 * b + 16 * wi + c15; const size_t rowq = (size_t)(base + iq * dil + c);
        __syncthreads();
        if (pair + 1 < pair_end) { const AttItem An = att_decode(pair + 1, dsh); ATT_PREFETCH(An); }
        const int k0w = 16 * wi;
        f32x4 sc[9];
#pragma unroll
        for (int nt = 0; nt < 9; ++nt) { const LAS bf16_t* kp = Ks + (64 * qi + k0w + 16 * nt + c15) * KRS + 8 * gq;
            f32x4 a = {0.f, 0.f, 0.f, 0.f};
#pragma unroll
            for (int ks = 0; ks < 4; ++ks) a = __builtin_amdgcn_mfma_f32_16x16x32_bf16(*(const LAS bf16x8*)(kp + 32 * ks), q[ks], a, 0, 0, 0);
            sc[nt] = a * 0.08838834764831845f; }
#pragma unroll
        for (int r = 0; r < 4; ++r) { const int d0 = 4 * gq + r - c15;
            if (d0 < 0) sc[0][r] = -INFINITY;
            if (d0 > 0) sc[8][r] = -INFINITY; }
        if (b == 0 || b == (Lc >> 6) - 1) {
#pragma unroll
            for (int nt = 0; nt < 9; ++nt)
#pragma unroll
                for (int r = 0; r < 4; ++r) { const int ip = 64 * (b - 1) + k0w + 16 * nt + 4 * gq + r; if (ip < 0 || ip >= Lc) sc[nt][r] = -INFINITY; } }
        float mx = -INFINITY;
#pragma unroll
        for (int nt = 0; nt < 9; ++nt) mx = fmaxf(mx, fmaxf(fmaxf(sc[nt][0], sc[nt][1]), fmaxf(sc[nt][2], sc[nt][3])));
        mx = fmaxf(mx, __shfl_xor(mx, 16)); mx = fmaxf(mx, __shfl_xor(mx, 32));
        float sum = 0.f;
#pragma unroll
        for (int nt = 0; nt < 9; ++nt)
#pragma unroll
            for (int r = 0; r < 4; ++r) { const float p = fast_exp(sc[nt][r] - mx); sc[nt][r] = p; sum += p; }
        sum += __shfl_xor(sum, 16); sum += __shfl_xor(sum, 32);
        const float rs = __builtin_amdgcn_rcpf(sum); const float lse = mx + __logf(sum);
        float w0 = 0.f, w1 = 0.f, w2 = 1.f;
        if (gi == 2) { const float l0 = LS[rowq * 16 + h], l1 = LS[((size_t)TT + rowq) * 16 + h]; const float m = fmaxf(lse, fmaxf(l0, l1));
            w0 = fast_exp(l0 - m); w1 = fast_exp(l1 - m); w2 = fast_exp(lse - m); const float r3 = __builtin_amdgcn_rcpf(w0 + w1 + w2); w0 *= r3; w1 *= r3; w2 *= r3; }
        else if (gq == 0) LSEg[rowq * 16 + h] = lse;
        bf16x8 pf[5];
#pragma unroll
        for (int ks = 0; ks < 4; ++ks) { const f32x4 p0 = sc[2 * ks] * rs, p1 = sc[2 * ks + 1] * rs;
            const u32x4 w = {pk2(p0[0], p0[1]), pk2(p0[2], p0[3]), pk2(p1[0], p1[1]), pk2(p1[2], p1[3])}; pf[ks] = __builtin_bit_cast(bf16x8, w); }
        { const f32x4 p0 = sc[8] * rs; const u32x4 w = {pk2(p0[0], p0[1]), pk2(p0[2], p0[3]), 0u, 0u}; pf[4] = __builtin_bit_cast(bf16x8, w); }
        const LAS bf16_t* vbase = Vs + (64 * qi + k0w + 4 * gq + (c15 >> 2)) * VRS + 4 * (c15 & 3);
#pragma unroll
        for (int dt = 0; dt < 8; ++dt) {
            f32x4 o = {0.f, 0.f, 0.f, 0.f};
#pragma unroll
            for (int ks = 0; ks < 5; ++ks) {
                const v4i16_t lo = __builtin_amdgcn_ds_read_tr16_b64_v4i16((LAS v4i16_t*)(vbase + (32 * ks) * VRS + 16 * dt));
                v4i16_t hi = {0, 0, 0, 0};
                if (ks < 4) hi = __builtin_amdgcn_ds_read_tr16_b64_v4i16((LAS v4i16_t*)(vbase + (32 * ks + 16) * VRS + 16 * dt));
                const bf16x8 vf = {lo[0], lo[1], lo[2], lo[3], hi[0], hi[1], hi[2], hi[3]};
                o = __builtin_amdgcn_mfma_f32_16x16x32_bf16(vf, pf[ks], o, 0, 0, 0);
            }
            const size_t oo = rowq * D + h * 128 + 16 * dt + 4 * gq;
            if (gi == 2) { const u32x2 a0 = *(const u32x2*)(O0 + oo), a1 = *(const u32x2*)(O1 + oo);
                o = (f32x4){w0 * bflo(a0.x) + w1 * bflo(a1.x) + w2 * o[0], w0 * bfhi(a0.x) + w1 * bfhi(a1.x) + w2 * o[1], w0 * bflo(a0.y) + w1 * bflo(a1.y) + w2 * o[2], w0 * bfhi(a0.y) + w1 * bfhi(a1.y) + w2 * o[3]};
                *(u32x2*)(O0 + oo) = (u32x2){pk2(o[0], o[1]), pk2(o[2], o[3])}; }
            else *(u32x2*)(Og + oo) = (u32x2){pk2(o[0], o[1]), pk2(o[2], o[3])};
        }
        __syncthreads();
    }
#undef ATT_PREFETCH
}

static __device__ PHASE_ATTR void ph_norm(int L, int sub, size_t h_off) {
    FRAME();
    float* Y = outp(); bf16_t* XB = (bf16_t*)(ws + P_XN);
    float* RSX = (float*)(ws + WS_RSX); const bf16_t* hsrc = (const bf16_t*)(ws + h_off);
    const float alpha = (sub == 1) ? 1.0f : 0.5f;
    const float* gpost = inp(3) + (size_t)(L * 3 + sub) * D;
    const bool last = (L == DEPTH - 1 && sub == 2), first = (L == 0 && sub == 0); const float* in0 = inp(0); const float* in1 = inp(1);
    u32x4 hq[4], xq[4]; f32x4 xf[4][2];
#define NORM_LOAD(row_) do { const size_t r_ = (size_t)(row_); \
        _Pragma("unroll") for (int i = 0; i < 4; ++i) { const int e = 8 * (lane + 64 * i); hq[i] = *(const u32x4*)(hsrc + r_ * D + e); \
            if (first) { const float* xs_ = r_ < 32768 ? in0 + r_ * D : in1 + (r_ - 32768) * D; xf[i][0] = *(const f32x4*)(xs_ + e); xf[i][1] = *(const f32x4*)(xs_ + e + 4); } \
            else xq[i] = *(const u32x4*)(XB + r_ * D + e); } } while (0)
    int row = gw;
    if (row < TT) NORM_LOAD(row);
    for (; row < TT; row += NGW) {
        float xv[4][8]; float ssh = 0.f;
        float hv[4][8];
#pragma unroll
        for (int i = 0; i < 4; ++i) {
            if (first) {
#pragma unroll
                for (int j = 0; j < 4; ++j) { xv[i][j] = xf[i][0][j]; xv[i][4 + j] = xf[i][1][j]; } }
            else { const unsigned xww[4] = {xq[i].x, xq[i].y, xq[i].z, xq[i].w};
#pragma unroll
                for (int j = 0; j < 4; ++j) { xv[i][2 * j] = bflo(xww[j]); xv[i][2 * j + 1] = bfhi(xww[j]); } }
            const unsigned hww[4] = {hq[i].x, hq[i].y, hq[i].z, hq[i].w};
#pragma unroll
            for (int j = 0; j < 4; ++j) { hv[i][2 * j] = bflo(hww[j]); hv[i][2 * j + 1] = bfhi(hww[j]); ssh += hv[i][2 * j] * hv[i][2 * j] + hv[i][2 * j + 1] * hv[i][2 * j + 1]; } }
        if (row + NGW < TT) NORM_LOAD(row + NGW);
        const float rh = rsqrtf(wave_sum(ssh) * (1.0f / D) + NORM_EPS) * alpha;
        float ssx = 0.f;
        float* ydst = Y + (size_t)row * D;
#pragma unroll
        for (int i = 0; i < 4; ++i) { const int e = 8 * (lane + 64 * i); const f32x4 ga = *(const f32x4*)(gpost + e), gb = *(const f32x4*)(gpost + e + 4);
#pragma unroll
            for (int j = 0; j < 8; ++j) { xv[i][j] += hv[i][j] * rh * (j < 4 ? ga[j] : gb[j - 4]); ssx += xv[i][j] * xv[i][j]; }
            if (last) { *(f32x4*)(ydst + e) = (f32x4){xv[i][0], xv[i][1], xv[i][2], xv[i][3]}; *(f32x4*)(ydst + e + 4) = (f32x4){xv[i][4], xv[i][5], xv[i][6], xv[i][7]}; }
            else *(u32x4*)(XB + (size_t)row * D + e) = (u32x4){pk2(xv[i][0], xv[i][1]), pk2(xv[i][2], xv[i][3]), pk2(xv[i][4], xv[i][5]), pk2(xv[i][6], xv[i][7])}; }
        if (!last) { const float rx = rsqrtf(wave_sum(ssx) * (1.0f / D) + NORM_EPS); if (lane == 0) RSX[row] = rx; }
    }
#undef NORM_LOAD
}
static __device__ __noinline__ void grid_bar() {
    LAS unsigned char* lds = (LAS unsigned char*)lds_raw;
    XcdBarrier b; b.bar = (unsigned*)(wsp() + WS_CTL) + CW_BAR; b.st = (volatile LAS unsigned*)(lds + MISC_OFF) + 8; b.x = b.st[2];
    xcd_barrier(b);
}
#define STEP(call) do { if (step >= lo && step < hi) { call; if (step + 1 < hi) grid_bar(); } ++step; } while (0)
template <int L> __device__ __forceinline__ void layer_prog(int& step, const int lo, const int hi) {
    constexpr int jm = L >> 1; constexpr bool is_attn = (L & 1) != 0;
    STEP(ph_ffn_up(0));
    STEP(ph_gemm_plain(P_H, FF, W_DN0, D, FF, P_HOUT, D));
    STEP(ph_norm(L, 0, P_HOUT));
    if constexpr (!is_attn) {
        STEP(ph_mix(jm, 0));
        STEP(ph_g1(jm, 0));
        STEP(ph_mix(jm, 1));
        STEP(ph_g1(jm, 1));
        if constexpr (jm > 0) { STEP(ph_gv(jm)); } else { ++step; }
        STEP(ph_scan(jm));
        STEP(ph_fin(jm));
        STEP(ph_gg());
        STEP(ph_gemm_plain(P_YF, D, W_GO, D, D, P_R, D));
        STEP(ph_norm(L, 1, P_R));
    } else {
        STEP(ph_qkv(0));
        STEP(ph_att(0));
        STEP(ph_qkv(1));
        STEP(ph_att(1));
        STEP(ph_qkv(2));
        STEP(ph_att(2));
        STEP(ph_gemm_plain(P_O0, D, W_GO, D, D, P_QKV, D));
        STEP(ph_norm(L, 1, P_QKV));
    }
    STEP(ph_ffn_up(1));
    STEP(ph_gemm_plain(P_H, FF, W_DN1, D, FF, P_HOUT, D));
    STEP({ ph_norm(L, 2, P_HOUT); if (L + 1 < DEPTH) ph_conv(L + 1); });
}
__global__ void __launch_bounds__(NWAVES * 64, 2) enc_fwd(Args args) {
    LAS unsigned char* lds = (LAS unsigned char*)lds_raw;
    volatile LAS unsigned* MISC = (volatile LAS unsigned*)(lds + MISC_OFF);
    const int tid = threadIdx.x;
    if (tid < 128) ((LAS unsigned*)(lds + CTRL_OFF))[tid] = 0u;
    if (tid < 30) { const unsigned long long v = tid < 28 ? (unsigned long long)args.in[tid] : (tid == 28 ? (unsigned long long)args.out : (unsigned long long)args.ws);
        LAS unsigned* p = (LAS unsigned*)(lds + PTR_OFF) + 2 * tid; p[0] = (unsigned)v; p[1] = (unsigned)(v >> 32); }
    __syncthreads();
    const int lo = args.step_lo, hi = args.step_hi;
    if (hi - lo > 1) { const XcdBarrier b = xcd_barrier_post((unsigned*)(args.ws + WS_CTL) + CW_BAR, MISC + 8); if (tid == 0) MISC[10] = b.x; }
    __syncthreads();
    int step = 0;
    STEP({ ph_init(); ph_conv(0); });
    layer_prog<0>(step, lo, hi);
    layer_prog<1>(step, lo, hi);
    layer_prog<2>(step, lo, hi);
    layer_prog<3>(step, lo, hi);
}
#undef STEP

static int n_steps_total() {
    int s = 1;
    for (int L = 0; L < DEPTH; ++L) { s += 3; s += (L & 1) ? 8 : 10; s += 3; }
    return s;
}

extern "C" void kernel_launch(void* const* d_in, const int* in_sizes, int n_in, void* d_out, int out_size, void* d_ws, size_t ws_size, hipStream_t stream) {
    static int grid = 0;
    if (grid == 0) {
        if (n_in != 28 || out_size != TT * D || ws_size < WS_END) { fprintf(stderr, "kernel_launch: unexpected shapes (n_in %d, out %d, ws %zu, need %zu)\n", n_in, out_size, ws_size, (size_t)WS_END); grid = -1; return; }
        int dev = 0, cus = 0, per_cu = 0;
        if (hipGetDevice(&dev) != hipSuccess || hipDeviceGetAttribute(&cus, hipDeviceAttributeMultiprocessorCount, dev) != hipSuccess) { grid = -1; return; }
        if (hipFuncSetAttribute((const void*)enc_fwd, hipFuncAttributeMaxDynamicSharedMemorySize, LDS_BYTES) != hipSuccess) { grid = -1; return; }
        if (hipOccupancyMaxActiveBlocksPerMultiprocessor(&per_cu, (const void*)enc_fwd, NWAVES * 64, LDS_BYTES) != hipSuccess || per_cu < 1) { fprintf(stderr, "kernel_launch: occupancy query says %d\n", per_cu); }
        (void)hipGetLastError();
        grid = cus;
    }
    if (grid < 0) return;
    (void)hipMemsetAsync((char*)d_ws + WS_CTL, 0, CTL_ZERO_BYTES, stream);
    Args a{};
    for (int i = 0; i < 28; ++i) a.in[i] = (const float*)d_in[i];
    a.out = (float*)d_out; a.ws = (unsigned char*)d_ws;
    const int NS = n_steps_total();
#if MK_ONE_LAUNCH
    a.step_lo = 0; a.step_hi = NS;
    hipLaunchKernelGGL(enc_fwd, dim3(grid), dim3(NWAVES * 64), LDS_BYTES, stream, a);
#else
    for (int s = 0; s < NS; ++s) {
        a.step_lo = s; a.step_hi = s + 1;
        hipLaunchKernelGGL(enc_fwd, dim3(grid), dim3(NWAVES * 64), LDS_BYTES, stream, a);
    }
#endif
}
```
